# Optimizing an MI355X kernel written in HIP

```python
import math
import jax, jax.numpy as jnp
from jax import lax
import numpy as np

D_MODEL = 2048
BATCH = 1
SEQ = 8192
DEPTH = 1

ATT_HEADS = 8
ATT_HEAD_DIM = 128
ATT_WIDTH = ATT_HEADS * ATT_HEAD_DIM
MOBA_BLOCK = 256
MOBA_TOPK = 3
Q_CHUNK = 128
ROPE_THETA = 500000.0
ROPE_DIM = ATT_HEAD_DIM // 4
RWKV_HEAD_DIM = 64
RWKV_WIDTH = 1024
RWKV_HEADS = RWKV_WIDTH // RWKV_HEAD_DIM
DECAY_LORA = 96
AAA_LORA = 96
GATE_LORA = 256
GN_EPS = 64e-5
IN_WIDTH = 3 * ATT_WIDTH + 3 * RWKV_WIDTH + 2 * D_MODEL
N_GROUPS = 8
EXPERTS_PER_GROUP = 8
N_EXPERTS = N_GROUPS * EXPERTS_PER_GROUP
TOP_K = 2
EXPERT_FF = 512
EXPERT_BLOCK = 128
RMS_EPS = 1e-6
NEG = -1e30

kernel_name = "hybrid_moba_rwkv7_hmoe_block"


def rms_norm(z, g):
    zf = z.astype(jnp.float32)
    zf = zf * lax.rsqrt(jnp.mean(zf * zf, axis=-1, keepdims=True) + RMS_EPS)
    return zf.astype(z.dtype) * g


def shift_right(z):
    return jnp.pad(z, ((0, 0), (1, 0), (0, 0)))[:, :-1]


def partial_rope(z, pos):
    half = ROPE_DIM // 2
    inv = ROPE_THETA ** (-jnp.arange(half, dtype=jnp.float32) / half)
    ang = pos.astype(jnp.float32)[:, None] * inv[None, :]
    cos = jnp.cos(ang).astype(z.dtype)
    sin = jnp.sin(ang).astype(z.dtype)
    z1 = z[..., :half]
    z2 = z[..., half:ROPE_DIM]
    rot = jnp.concatenate([z1 * cos - z2 * sin, z2 * cos + z1 * sin], axis=-1)
    return jnp.concatenate([rot, z[..., ROPE_DIM:]], axis=-1)


def moba_attention(q, k, v):
    B, H, S, Dh = q.shape
    nb = -(-S // MOBA_BLOCK)
    sp = nb * MOBA_BLOCK
    pad = ((0, 0), (0, 0), (0, sp - S), (0, 0))
    q, k, v = jnp.pad(q, pad), jnp.pad(k, pad), jnp.pad(v, pad)
    kb = k.reshape(B, H, nb, MOBA_BLOCK, Dh)
    vb = v.reshape(B, H, nb, MOBA_BLOCK, Dh)
    kmean = jnp.mean(kb.astype(jnp.float32), axis=3)
    nc = sp // Q_CHUNK
    qc = q.reshape(B, H, nc, Q_CHUNK, Dh).transpose(2, 0, 1, 3, 4)
    ntop = min(MOBA_TOPK, nb)
    scale = ATT_HEAD_DIM ** -0.5
    bi = jnp.arange(B)[:, None, None, None]
    hi = jnp.arange(H)[None, :, None, None]

    def one_chunk(args):
        ci, qx = args
        qblk = (ci * Q_CHUNK) // MOBA_BLOCK
        qpos = ci * Q_CHUNK + jnp.arange(Q_CHUNK)
        gate = jnp.einsum('bhqd,bhnd->bhqn', qx.astype(jnp.float32), kmean)
        gate = jnp.where(jnp.arange(nb) < qblk, gate, NEG)
        _, sel = lax.top_k(gate, ntop)
        valid = sel < qblk
        k_own = lax.dynamic_index_in_dim(kb, qblk, axis=2, keepdims=False)
        v_own = lax.dynamic_index_in_dim(vb, qblk, axis=2, keepdims=False)
        kpos = qblk * MOBA_BLOCK + jnp.arange(MOBA_BLOCK)
        s_own = jnp.einsum('bhqd,bhkd->bhqk', qx, k_own).astype(jnp.float32) * scale
        s_own = jnp.where(kpos[None, :] <= qpos[:, None], s_own, NEG)
        k_sel = kb[bi, hi, sel]
        v_sel = vb[bi, hi, sel]
        s_sel = jnp.einsum('bhqd,bhqnkd->bhqnk', qx, k_sel).astype(jnp.float32) * scale
        s_sel = jnp.where(valid[..., None], s_sel, NEG)
        s_all = jnp.concatenate([s_own, s_sel.reshape(B, H, Q_CHUNK, ntop * MOBA_BLOCK)], axis=-1)
        p = jax.nn.softmax(s_all, axis=-1).astype(v.dtype)
        p_own = p[..., :MOBA_BLOCK]
        p_sel = p[..., MOBA_BLOCK:].reshape(B, H, Q_CHUNK, ntop, MOBA_BLOCK)
        return (jnp.einsum('bhqk,bhkd->bhqd', p_own, v_own)
                + jnp.einsum('bhqnk,bhqnkd->bhqd', p_sel, v_sel))

    out = lax.map(one_chunk, (jnp.arange(nc), qc))
    out = out.transpose(1, 2, 0, 3, 4).reshape(B, H, sp, Dh)
    return out[:, :, :S]


def rwkv7_time_mix(h, r, k, v, mu_w, mu_a, mu_g, w0, w_w1, w_w2, a0, w_a1, w_a2,
                   w_g1, w_g2, k_k, k_a, r_k, gn_w, gn_b):
    B, S, _ = h.shape
    H, N = RWKV_HEADS, RWKV_HEAD_DIM
    f32 = jnp.float32
    dh = shift_right(h) - h
    xw = h + dh * mu_w
    xa = h + dh * mu_a
    xg = h + dh * mu_g
    d = (w0 + jnp.tanh(xw @ w_w1) @ w_w2).astype(f32)
    w = jnp.exp(-math.exp(-0.5) * jax.nn.sigmoid(d))
    a = jax.nn.sigmoid((a0 + (xa @ w_a1) @ w_a2).astype(f32))
    g = jax.nn.sigmoid(xg @ w_g1) @ w_g2
    rf, kf, vf = r.astype(f32), k.astype(f32), v.astype(f32)
    kk = (kf * k_k).reshape(B, S, H, N)
    kk = kk / jnp.maximum(jnp.sqrt(jnp.sum(kk * kk, axis=-1, keepdims=True)), 1e-12)
    kt = kf * (1.0 + (a - 1.0) * k_a)
    rh, wh, kth, vh, ah = (z.reshape(B, S, H, N) for z in (rf, w, kt, vf, a))
    xs = tuple(jnp.moveaxis(z, 1, 0) for z in (rh, wh, kth, vh, kk, ah))

    def step(state, inp):
        r_t, w_t, k_t, v_t, kk_t, a_t = inp
        sa = jnp.einsum('bhvk,bhk->bhv', state, -kk_t)
        state = (state * w_t[:, :, None, :]
                 + sa[..., None] * (kk_t * a_t)[:, :, None, :]
                 + v_t[..., None] * k_t[:, :, None, :])
        return state, jnp.einsum('bhvk,bhk->bhv', state, r_t)

    _, ys = lax.scan(step, jnp.zeros((B, H, N, N), f32), xs)
    y = jnp.moveaxis(ys, 0, 1)
    mean = jnp.mean(y, axis=-1, keepdims=True)
    var = jnp.mean(jnp.square(y - mean), axis=-1, keepdims=True)
    yn = ((y - mean) * lax.rsqrt(var + GN_EPS)).reshape(B, S, RWKV_WIDTH) * gn_w + gn_b
    bonus = (jnp.sum(rh * kth * r_k, axis=-1, keepdims=True) * vh).reshape(B, S, RWKV_WIDTH)
    return ((yn + bonus) * g).astype(h.dtype)


def token_mixer(h, w_in, mu_r, mu_k, mu_v, mu_w, mu_a, mu_g, w0, w_w1, w_w2, a0, w_a1, w_a2,
                w_g1, w_g2, k_k, k_a, r_k, gn_w, gn_b, w_up_att, w_up_rwkv, w_o):
    B, S, _ = h.shape
    proj = h @ w_in
    q, k, v, rkv, gates = jnp.split(
        proj, [ATT_WIDTH, 2 * ATT_WIDTH, 3 * ATT_WIDTH, 3 * ATT_WIDTH + 3 * RWKV_WIDTH], axis=-1)
    gate_att, gate_rwkv = jnp.split(gates, 2, axis=-1)
    pos = jnp.arange(S)
    def heads(z):
        return z.reshape(B, S, ATT_HEADS, ATT_HEAD_DIM).transpose(0, 2, 1, 3)
    qh = partial_rope(heads(q), pos)
    kh = partial_rope(heads(k), pos)
    o_att = moba_attention(qh, kh, heads(v)).transpose(0, 2, 1, 3).reshape(B, S, ATT_WIDTH)
    mu_rkv = jnp.concatenate([mu_r, mu_k, mu_v])
    rkv = rkv + (shift_right(rkv) - rkv) * mu_rkv
    r, kr, vr = jnp.split(rkv, 3, axis=-1)
    o_rwkv = rwkv7_time_mix(h, r, kr, vr, mu_w, mu_a, mu_g, w0, w_w1, w_w2, a0, w_a1, w_a2,
                            w_g1, w_g2, k_k, k_a, r_k, gn_w, gn_b)
    mix = (jax.nn.sigmoid(gate_att) * (o_att @ w_up_att)
           + jax.nn.sigmoid(gate_rwkv) * (o_rwkv @ w_up_rwkv))
    return mix @ w_o


def hierarchical_moe(h, w_rg, b_rg, w_re, b_re, w_gate_e, w_up_e, w_down_e):
    B, S, D = h.shape
    N = B * S
    t = h.reshape(N, D)
    pg = jax.nn.softmax((t @ w_rg).astype(jnp.float32) + b_rg, axis=-1)
    pg_top, g_idx = lax.top_k(pg, 1)
    le = ((t @ w_re).astype(jnp.float32) + b_re).reshape(N, N_GROUPS, EXPERTS_PER_GROUP)
    le = jnp.take_along_axis(le, g_idx[:, :, None], axis=1)[:, 0]
    pe = jax.nn.softmax(le, axis=-1)
    pe_top, e_local = lax.top_k(pe, TOP_K)
    wts = pg_top * pe_top / jnp.sum(pe_top, axis=-1, keepdims=True)
    e_idx = g_idx * EXPERTS_PER_GROUP + e_local
    P = N * TOP_K
    n_blk = (P + N_EXPERTS * (EXPERT_BLOCK - 1) + EXPERT_BLOCK - 1) // EXPERT_BLOCK
    e_flat = e_idx.reshape(P)
    tok_flat = jnp.repeat(jnp.arange(N, dtype=jnp.int32), TOP_K)
    w_flat = wts.reshape(P)
    order = jnp.argsort(e_flat)
    e_s, tok_s, w_s = e_flat[order], tok_flat[order], w_flat[order]
    counts = jnp.zeros((N_EXPERTS,), jnp.int32).at[e_flat].add(1)
    start = jnp.cumsum(counts) - counts
    pcounts = (counts + EXPERT_BLOCK - 1) // EXPERT_BLOCK * EXPERT_BLOCK
    pend = jnp.cumsum(pcounts)
    pstart = pend - pcounts
    dest = pstart[e_s] + (jnp.arange(P, dtype=jnp.int32) - start[e_s])
    buf_tok = jnp.zeros((n_blk * EXPERT_BLOCK,), jnp.int32).at[dest].set(tok_s)
    buf_w = jnp.zeros((n_blk * EXPERT_BLOCK,), jnp.float32).at[dest].set(w_s)
    blk_e = jnp.clip(jnp.searchsorted(pend, jnp.arange(n_blk, dtype=jnp.int32) * EXPERT_BLOCK,
                                      side='right'), 0, N_EXPERTS - 1)
    x_buf = t[buf_tok].reshape(n_blk, EXPERT_BLOCK, D)

    def run_block(args):
        xb, e = args
        hid = jax.nn.silu(xb @ w_gate_e[e]) * (xb @ w_up_e[e])
        return hid @ w_down_e[e]

    y_buf = lax.map(run_block, (x_buf, blk_e)).reshape(n_blk * EXPERT_BLOCK, D)
    out = jax.ops.segment_sum(y_buf * buf_w[:, None], buf_tok, num_segments=N)
    return out.astype(h.dtype).reshape(B, S, D)


def setup_inputs(seed: int = 0) -> dict:
    key = jax.random.key(seed)
    ks = iter(jax.random.split(key, 64))
    L, D = DEPTH, D_MODEL
    def nrm(shape, scale):
        return jax.random.normal(next(ks), shape, jnp.float32) * scale
    def uni(shape, lo, hi):
        return jax.random.uniform(next(ks), shape, jnp.float32, lo, hi)
    return {
        "x": nrm((BATCH, SEQ, D), 1.0),
        "c": nrm((BATCH, D), 1.0),
        "w_ada": nrm((L, D, 6 * D), 0.1 * D ** -0.5),
        "b_ada": nrm((L, 6 * D), 0.02),
        "g_pre_mix": 1.0 + nrm((L, D), 0.02),
        "g_post_mix": 1.0 + nrm((L, D), 0.02),
        "g_pre_ffn": 1.0 + nrm((L, D), 0.02),
        "g_post_ffn": 1.0 + nrm((L, D), 0.02),
        "w_in": nrm((L, D, IN_WIDTH), D ** -0.5),
        "mu_r": uni((L, RWKV_WIDTH), 0.0, 1.0),
        "mu_k": uni((L, RWKV_WIDTH), 0.0, 1.0),
        "mu_v": uni((L, RWKV_WIDTH), 0.0, 1.0),
        "mu_w": uni((L, D), 0.0, 1.0),
        "mu_a": uni((L, D), 0.0, 1.0),
        "mu_g": uni((L, D), 0.0, 1.0),
        "w0": uni((L, RWKV_WIDTH), -3.0, 1.0),
        "w_w1": nrm((L, D, DECAY_LORA), D ** -0.5),
        "w_w2": nrm((L, DECAY_LORA, RWKV_WIDTH), DECAY_LORA ** -0.5),
        "a0": nrm((L, RWKV_WIDTH), 0.5),
        "w_a1": nrm((L, D, AAA_LORA), D ** -0.5),
        "w_a2": nrm((L, AAA_LORA, RWKV_WIDTH), AAA_LORA ** -0.5),
        "w_g1": nrm((L, D, GATE_LORA), D ** -0.5),
        "w_g2": nrm((L, GATE_LORA, RWKV_WIDTH), GATE_LORA ** -0.5),
        "k_k": 0.85 + nrm((L, RWKV_WIDTH), 0.05),
        "k_a": 1.0 + nrm((L, RWKV_WIDTH), 0.05),
        "r_k": nrm((L, RWKV_HEADS, RWKV_HEAD_DIM), 0.1),
        "gn_w": 1.0 + nrm((L, RWKV_WIDTH), 0.02),
        "gn_b": nrm((L, RWKV_WIDTH), 0.02),
        "w_up_att": nrm((L, ATT_WIDTH, D), ATT_WIDTH ** -0.5),
        "w_up_rwkv": nrm((L, RWKV_WIDTH, D), RWKV_WIDTH ** -0.5),
        "w_o": nrm((L, D, D), D ** -0.5),
        "w_rg": nrm((L, D, N_GROUPS), D ** -0.5),
        "b_rg": nrm((L, N_GROUPS), 0.01),
        "w_re": nrm((L, D, N_EXPERTS), D ** -0.5),
        "b_re": nrm((L, N_EXPERTS), 0.01),
        "w_gate_e": nrm((L, N_EXPERTS, D, EXPERT_FF), D ** -0.5),
        "w_up_e": nrm((L, N_EXPERTS, D, EXPERT_FF), D ** -0.5),
        "w_down_e": nrm((L, N_EXPERTS, EXPERT_FF, D), EXPERT_FF ** -0.5),
    }


def reference(x, c, w_ada, b_ada, g_pre_mix, g_post_mix, g_pre_ffn, g_post_ffn, w_in,
              mu_r, mu_k, mu_v, mu_w, mu_a, mu_g, w0, w_w1, w_w2, a0, w_a1, w_a2,
              w_g1, w_g2, k_k, k_a, r_k, gn_w, gn_b, w_up_att, w_up_rwkv, w_o,
              w_rg, b_rg, w_re, b_re, w_gate_e, w_up_e, w_down_e):
    for l in range(DEPTH):
        ada = (c @ w_ada[l] + b_ada[l])[:, None, :]
        sh1, sc1, gt1, sh2, sc2, gt2 = jnp.split(ada, 6, axis=-1)
        h = rms_norm(x, g_pre_mix[l]) * (1.0 + sc1) + sh1
        y = token_mixer(h, w_in[l], mu_r[l], mu_k[l], mu_v[l], mu_w[l], mu_a[l], mu_g[l],
                        w0[l], w_w1[l], w_w2[l], a0[l], w_a1[l], w_a2[l], w_g1[l], w_g2[l],
                        k_k[l], k_a[l], r_k[l], gn_w[l], gn_b[l],
                        w_up_att[l], w_up_rwkv[l], w_o[l])
        x = x + gt1 * rms_norm(y, g_post_mix[l])
        h = rms_norm(x, g_pre_ffn[l]) * (1.0 + sc2) + sh2
        y = hierarchical_moe(h, w_rg[l], b_rg[l], w_re[l], b_re[l],
                             w_gate_e[l], w_up_e[l], w_down_e[l])
        x = x + gt2 * rms_norm(y, g_post_ffn[l])
    return x
```

```cpp
#include <hip/hip_runtime.h>
#include <cstdio>
#include <cstdint>

typedef unsigned short bf16;
__device__ __forceinline__ float bf2f(bf16 b) { return __uint_as_float(((unsigned)b) << 16); }
__device__ __forceinline__ bf16 f2bf(float f) { unsigned u = __float_as_uint(f); u += 0x7fffu + ((u >> 16) & 1u); return (bf16)(u >> 16); }
__device__ __forceinline__ float sigmoidf_(float x) { return __builtin_amdgcn_rcpf(1.0f + __expf(-x)); }

#ifndef N_LAUNCH_PER_PHASE
#define N_LAUNCH_PER_PHASE 0
#endif
#ifndef REP_PHASE
#define REP_PHASE -1
#define REP_N 0
#endif
#ifndef REP_SCAN
#define REP_SCAN 0
#endif
#ifndef REP_P11A
#define REP_P11A 0
#endif
#ifndef REP_P11B
#define REP_P11B 0
#endif
#ifndef REP_R1A
#define REP_R1A 0
#define REP_R1B 0
#define REP_R1C 0
#endif
#ifndef REP_R1NR
#define REP_R1NR 0
#endif
#ifndef REP_R1S0
#define REP_R1S0 0
#endif
constexpr int S = 8192, D = 2048;
constexpr int AH = 8, AD = 128, AW = 1024, MB = 256, NB = S / MB;
constexpr int RH = 16, RN = 64, RW = 1024;
constexpr int LW = 96, LA = 96, LG = 256, LO = LW + LA + LG;
constexpr int INW = 3 * AW + 3 * RW + 2 * D;
constexpr int NE = 64, NG = 8, EPG = 8, FF = 512;
constexpr int MAXROWS = 32768;
constexpr int MAXTILES = MAXROWS / 256;

constexpr size_t MiB = 1u << 20;
constexpr size_t WS_CTL   = 0;
constexpr size_t WS_ADA   = 1 * MiB;
constexpr size_t WS_ROPE  = 2 * MiB;
constexpr size_t WS_KMEAN = 3 * MiB;
constexpr size_t WS_WL2   = 3 * MiB + 256 * 1024;
constexpr size_t WS_ROUTE = 5 * MiB;
constexpr size_t WS_TOK   = 6 * MiB;
constexpr size_t WS_WR    = 7 * MiB;
constexpr size_t WS_H     = 8 * MiB;
constexpr size_t WS_Q     = 40 * MiB;
constexpr size_t WS_K     = 56 * MiB;
constexpr size_t WS_V     = 72 * MiB;
constexpr size_t WS_RKV   = 88 * MiB;
constexpr size_t WS_GATE  = 184 * MiB;
constexpr size_t WS_LORA  = 248 * MiB;
constexpr size_t WS_LORAB = 424 * MiB;
constexpr size_t WS_AL2   = 280 * MiB;
constexpr size_t WS_LW    = 296 * MiB;
constexpr size_t WS_A     = 328 * MiB;
constexpr size_t WS_G     = 360 * MiB;
constexpr size_t WS_OCAT  = 392 * MiB;
constexpr size_t WS_MIX   = 424 * MiB;
constexpr size_t WS_Y     = 456 * MiB;
constexpr size_t WS_X1    = 520 * MiB;
constexpr size_t WS_H2    = 584 * MiB;
constexpr size_t WS_WUPT  = 616 * MiB;
constexpr size_t WS_WOT   = 624 * MiB;
constexpr size_t WS_WGUT  = 632 * MiB;
constexpr size_t WS_WDT   = 888 * MiB;
constexpr size_t WS_END   = 1016 * MiB;
constexpr size_t WS_W1T   = WS_Y;
constexpr size_t WS_XBUF  = WS_H;
constexpr size_t WS_HID   = 136 * MiB;
constexpr size_t WS_YBUF  = 168 * MiB;
constexpr size_t WS_ALIST = 8 * MiB, WS_AMASK = 12 * MiB, WS_AML = 13 * MiB, WS_APART = 248 * MiB;
constexpr size_t WS_RWP = 456 * MiB, WS_RWQ = 472 * MiB, WS_RWR = 504 * MiB, WS_RWY = 520 * MiB, WS_RWH = 552 * MiB, WS_RWB = 568 * MiB;
constexpr size_t WS_NR = WS_MIX, WS_NW = WS_NR + 32 * MiB, WS_NKT = WS_NR + 64 * MiB, WS_NV = WS_NR + 96 * MiB, WS_NKK = WS_NR + 128 * MiB, WS_NY = WS_NR + 160 * MiB;
constexpr size_t WS_MIXTMP = WS_Y;
constexpr size_t WS_GTMP = WS_Y;

constexpr int CW_CNT = 1024;
constexpr int CW_FILL = 1152;
constexpr int CW_OFF = 1280;
constexpr int CW_NT = 1408;
constexpr int CW_ACNT = 1536;
constexpr int CW_AQ = 1920;

namespace pg8 {
#define PG8_LAS __attribute__((address_space(3)))
typedef unsigned short bf16_t;
typedef short bf16x8 __attribute__((ext_vector_type(8)));
typedef float f32x4 __attribute__((ext_vector_type(4)));
typedef unsigned u32x4 __attribute__((ext_vector_type(4)));
typedef int i32x8_t __attribute__((ext_vector_type(8)));
template <bool IS8> struct FragSel { typedef bf16x8 T; static constexpr int NK = 2; };
template <> struct FragSel<true> { typedef i32x8_t T; static constexpr int NK = 1; };
template <int F8> struct FragT : FragSel<(F8 != 0)> {};
constexpr int BM = 256, BK = 64, HALF = 128, HTB = HALF * BK * 2  , STAGE_BYTES = 8 * HTB, NXCD = 8, WGM = 8;

__host__ __device__ __forceinline__ int lds_byte(int r, int c) { const int st = (r >> 4) * 2 + (c >> 5), rr = r & 15, cc = c & 31, ob = rr * 64 + cc * 2; return st * 1024 + (ob ^ (((ob >> 9) & 1) << 5)); }
__host__ __device__ __forceinline__ void stage_rc(int b, int& R, int& C) { const int st = b / 1024, sb = b % 1024, swz = sb ^ (((sb >> 9) & 1) << 5); R = (st >> 1) * 16 + swz / 64; C = (st & 1) * 32 + (swz % 64) / 2; }
__host__ __device__ __forceinline__ int perm32(int rho) { const int n = rho >> 4, i = rho & 15; return 8 * (i >> 2) + 4 * n + (i & 3); }

struct Unit { int pm, pn, koff, koffB; };
struct Gemm { const bf16_t* A; const bf16_t* Bt; int M, N, K, lda, ldb; };

struct StaticOrder {
    int nM, nN, nwg, G, c;
    __host__ __device__ void init(int M, int N, int G_, int c_) { nM = M / BM; nN = N / BM; nwg = nM * nN; G = G_; c = c_; }
    __host__ __device__ bool next(int i, Unit& u) const {
        const long L = (long)i * G + c; if (L >= nwg) return false;
        int wgid = (int)L; { const int q = nwg / NXCD, r = nwg % NXCD, xcd = wgid % NXCD, off = wgid / NXCD; wgid = (xcd < r ? xcd * (q + 1) : r * (q + 1) + (xcd - r) * q) + off; }
        const int nig = WGM * nN, gid = wgid / nig, fm = gid * WGM, gsz = (nM - fm) < WGM ? (nM - fm) : WGM;
        u.pm = fm + ((wgid % nig) % gsz); u.pn = (wgid % nig) / gsz; u.koff = 0; u.koffB = 0; return true;
    }
    __device__ __forceinline__ void a_ready(const Unit&) const {}
    __device__ __forceinline__ void done(const Unit&) const {}
};

__device__ __forceinline__ unsigned cvt_pk_bf16(float lo, float hi) { unsigned r; asm volatile("v_cvt_pk_bf16_f32 %0, %1, %2" : "=v"(r) : "v"(lo), "v"(hi)); return r; }
template <class Epi, class Sched, bool ALIGN_EPI = false, bool SP2 = false, int F8 = 0, bool HM = false>
__device__ __forceinline__ void gemm_phase(PG8_LAS unsigned char* lds, const Gemm g, const Sched& S, const Epi& E) {
    int tid_ = threadIdx.x; asm volatile("" : "+v"(tid_));
    const int tid = tid_, wid = __builtin_amdgcn_readfirstlane(tid >> 6), lane = tid & 63, wr = wid >> 2, wc = wid & 3, fr = lane & 15, fq = lane >> 4;
    const int K = g.K, nt = K / BK;
    unsigned voffA[2], voffB[2];
#pragma unroll
    for (int i = 0; i < 2; ++i) { int R, C; stage_rc(tid * 16 + i * 8192, R, C); const int Rb = Epi::PERM ? ((R & ~31) + perm32(R & 31)) : R;
        voffA[i] = (unsigned)(R * g.lda + C) * 2u; voffB[i] = (unsigned)(Rb * g.ldb + C) * 2u; }
    const size_t kstep = (size_t)(BK * 2);
    const size_t hstepA = HM ? (size_t)0 : (size_t)HALF * g.lda * 2, hstepB = (size_t)HALF * g.ldb * 2;
    const size_t tstepA = (HM ? 1 : 2) * (size_t)HALF * g.lda * 2, tstepB = 2 * hstepB;
    const unsigned ldsw = (unsigned)wid * 1024u;
    const int aoff = lds_byte(wr * 64 + fr, fq * 8), boff = lds_byte(wc * 32 + fr, fq * 8);
#define PG8_SA(b, h) (((b) * 2 + (h)) * HTB)
#define PG8_SB(b, h) ((4 + (b) * 2 + (h)) * HTB)
#define PG8_STAGE(bufoff, gbase, voff) do { _Pragma("unroll") for (int _i = 0; _i < 2; ++_i) \
        __builtin_amdgcn_global_load_lds((const unsigned*)((const char*)(gbase) + (voff)[_i]), (PG8_LAS unsigned*)(lds + (bufoff) + ldsw + _i * 8192), 16, 0, 0); } while (0)
#define PG8_CAT(lo, hi) __builtin_bit_cast(i32x8_t, __builtin_shufflevector(lo, hi, 0, 1, 2, 3, 4, 5, 6, 7, 8, 9, 10, 11, 12, 13, 14, 15))
#define PG8_RD(off) (*(const PG8_LAS bf16x8*)(lds + (off)))
#define PG8_LDA(dst, b, h) do { if constexpr (!(HM && (h) == 1)) _Pragma("unroll") for (int m = 0; m < 4; ++m) { if constexpr (F8 == 0) { _Pragma("unroll") for (int k = 0; k < 2; ++k) dst[m][k] = PG8_RD(PG8_SA(b, h) + aoff + m * 2048 + k * 1024); } \
        else dst[m][0] = PG8_CAT(PG8_RD(PG8_SA(b, h) + aoff + m * 2048), PG8_RD(PG8_SA(b, h) + aoff + m * 2048 + 1024)); } } while (0)
#define PG8_LDB(dst, b, h) do { _Pragma("unroll") for (int n = 0; n < 2; ++n) { if constexpr (F8 == 0) { _Pragma("unroll") for (int k = 0; k < 2; ++k) dst[n][k] = PG8_RD(PG8_SB(b, h) + boff + n * 2048 + k * 1024); } \
        else dst[n][0] = PG8_CAT(PG8_RD(PG8_SB(b, h) + boff + n * 2048), PG8_RD(PG8_SB(b, h) + boff + n * 2048 + 1024)); } } while (0)
#define PG8_MMA(ai, bj, At, Bt) do { __builtin_amdgcn_s_setprio(1); if constexpr (!(HM && (ai) == 1)) _Pragma("unroll") for (int m = 0; m < 4; ++m) _Pragma("unroll") for (int n = 0; n < 2; ++n) { \
        if constexpr (F8 == 0) { _Pragma("unroll") for (int k = 0; k < 2; ++k) acc[ai][bj][m][n] = __builtin_amdgcn_mfma_f32_16x16x32_bf16(Bt[n][k], At[m][k], acc[ai][bj][m][n], 0, 0, 0); } \
        else acc[ai][bj][m][n] = __builtin_amdgcn_mfma_scale_f32_16x16x128_f8f6f4(Bt[n][0], At[m][0], acc[ai][bj][m][n], 0, 0, 0, (F8 & 255) * 0x01010101, 0, ((F8 >> 8) & 255) * 0x01010101); } \
        __builtin_amdgcn_s_setprio(0); } while (0)
#define PG8_WAIT_V(n) asm volatile("s_waitcnt vmcnt(" #n ")" ::: "memory")
#define PG8_WAIT_L(n) asm volatile("s_waitcnt lgkmcnt(" #n ")" ::: "memory")
#define PG8_BAR __builtin_amdgcn_s_barrier()
#define PG8_SCHED __builtin_amdgcn_sched_barrier(0)
    Unit cur, nxt; int ui = 0;
    if (!S.next(0, cur)) return;
    f32x4 acc[2][2][4][2];
#pragma unroll
    for (int a = 0; a < 2; ++a)
#pragma unroll
        for (int b = 0; b < 2; ++b)
#pragma unroll
            for (int m = 0; m < 4; ++m)
#pragma unroll
                for (int n = 0; n < 2; ++n) acc[a][b][m][n] = (f32x4){0.f, 0.f, 0.f, 0.f};
    typename FragT<F8>::T At[4][FragT<F8>::NK], B0[2][FragT<F8>::NK], B1[2][FragT<F8>::NK];
    const char* cA = (const char*)g.A + (size_t)cur.pm * tstepA + cur.koff; const char* cB = (const char*)g.Bt + (size_t)cur.pn * tstepB + cur.koffB;
    S.a_ready(cur);
    if constexpr (SP2) {
        PG8_STAGE(PG8_SB(0, 0), cB, voffB); PG8_STAGE(PG8_SB(0, 1), cB + hstepB, voffB); PG8_STAGE(PG8_SA(0, 0), cA, voffA); PG8_STAGE(PG8_SA(0, 1), cA + hstepA, voffA);
        if (wr == 1) PG8_BAR;
        PG8_WAIT_V(2); PG8_BAR;
        PG8_STAGE(PG8_SB(1, 0), cB + kstep, voffB); PG8_STAGE(PG8_SA(1, 0), cA + kstep, voffA); PG8_STAGE(PG8_SB(1, 1), cB + hstepB + kstep, voffB);
        PG8_WAIT_V(6); PG8_BAR;
    } else {
        PG8_STAGE(PG8_SB(0, 0), cB, voffB); PG8_STAGE(PG8_SA(0, 0), cA, voffA); PG8_STAGE(PG8_SB(0, 1), cB + hstepB, voffB); PG8_STAGE(PG8_SA(0, 1), cA + hstepA, voffA);
        if (wr == 1) PG8_BAR;
        PG8_WAIT_V(4); PG8_BAR;
        PG8_STAGE(PG8_SB(1, 0), cB + kstep, voffB); PG8_STAGE(PG8_SA(1, 0), cA + kstep, voffA); PG8_STAGE(PG8_SB(1, 1), cB + hstepB + kstep, voffB);
        PG8_WAIT_V(6); PG8_BAR;
    }
    for (;;) {
        const bool has_next = S.next(ui + 1, nxt);
        const char* nA = has_next ? (const char*)g.A + (size_t)nxt.pm * tstepA + nxt.koff : cA; const char* nB = has_next ? (const char*)g.Bt + (size_t)nxt.pn * tstepB + nxt.koffB : cB;
#pragma nounroll
        for (int t = 0; t < nt; t += 2) {
            const bool last = (t == nt - 2);
            const char* a1 = cA + (size_t)(t + 1) * kstep;
            const char* a2 = last ? nA : cA + (size_t)(t + 2) * kstep; const char* b2 = last ? nB : cB + (size_t)(t + 2) * kstep;
            const char* a3 = a2 + kstep; const char* b3 = b2 + kstep;
            if (last && has_next) S.a_ready(nxt);
            if constexpr (SP2) {
            PG8_LDB(B0, 0, 0); PG8_LDB(B1, 0, 1); PG8_SCHED; PG8_LDA(At, 0, 0); PG8_STAGE(PG8_SA(1, 1), a1 + hstepA, voffA);
            PG8_WAIT_V(8); PG8_WAIT_L(0); PG8_BAR; PG8_MMA(0, 0, At, B0); PG8_MMA(0, 1, At, B1); PG8_BAR; PG8_SCHED;
            PG8_LDA(At, 0, 1); PG8_STAGE(PG8_SB(0, 0), b2, voffB); PG8_STAGE(PG8_SB(0, 1), b2 + hstepB, voffB); PG8_STAGE(PG8_SA(0, 0), a2, voffA);
            PG8_WAIT_V(8); PG8_WAIT_L(0); PG8_BAR; PG8_MMA(1, 0, At, B0); PG8_MMA(1, 1, At, B1); PG8_BAR; PG8_SCHED;
            PG8_LDB(B0, 1, 0); PG8_LDB(B1, 1, 1); PG8_SCHED; PG8_LDA(At, 1, 0); PG8_STAGE(PG8_SA(0, 1), a2 + hstepA, voffA);
            PG8_WAIT_V(8); PG8_WAIT_L(0); PG8_BAR; PG8_MMA(0, 0, At, B0); PG8_MMA(0, 1, At, B1); PG8_BAR; PG8_SCHED;
            PG8_LDA(At, 1, 1); PG8_STAGE(PG8_SB(1, 0), b3, voffB); PG8_STAGE(PG8_SB(1, 1), b3 + hstepB, voffB); PG8_STAGE(PG8_SA(1, 0), a3, voffA);
            PG8_WAIT_V(8); PG8_WAIT_L(0); PG8_BAR; PG8_MMA(1, 0, At, B0); PG8_MMA(1, 1, At, B1); PG8_BAR; PG8_SCHED;
            } else {
            PG8_LDB(B0, 0, 0); PG8_SCHED; PG8_LDA(At, 0, 0); PG8_STAGE(PG8_SA(1, 1), a1 + hstepA, voffA);
            PG8_WAIT_L(8); PG8_BAR; PG8_WAIT_L(0); PG8_MMA(0, 0, At, B0); PG8_BAR; PG8_SCHED;
            PG8_LDB(B1, 0, 1); PG8_STAGE(PG8_SB(0, 0), b2, voffB);
            PG8_BAR; PG8_WAIT_L(0); PG8_MMA(0, 1, At, B1); PG8_BAR;
            PG8_LDA(At, 0, 1); PG8_STAGE(PG8_SA(0, 0), a2, voffA);
            PG8_BAR; PG8_WAIT_L(0); PG8_MMA(1, 0, At, B0); PG8_BAR; PG8_SCHED;
            PG8_STAGE(PG8_SB(0, 1), b2 + hstepB, voffB);
            PG8_WAIT_V(6); PG8_BAR; PG8_MMA(1, 1, At, B1); PG8_BAR;
            PG8_LDB(B0, 1, 0); PG8_SCHED; PG8_LDA(At, 1, 0); PG8_STAGE(PG8_SA(0, 1), a2 + hstepA, voffA);
            PG8_WAIT_L(8); PG8_BAR; PG8_WAIT_L(0); PG8_MMA(0, 0, At, B0); PG8_BAR; PG8_SCHED;
            PG8_LDB(B1, 1, 1); PG8_STAGE(PG8_SB(1, 0), b3, voffB);
            PG8_BAR; PG8_WAIT_L(0); PG8_MMA(0, 1, At, B1); PG8_BAR;
            PG8_LDA(At, 1, 1); PG8_STAGE(PG8_SA(1, 0), a3, voffA);
            PG8_BAR; PG8_WAIT_L(0); PG8_MMA(1, 0, At, B0); PG8_BAR; PG8_SCHED;
            PG8_STAGE(PG8_SB(1, 1), b3 + hstepB, voffB);
            PG8_WAIT_V(6); PG8_BAR; PG8_MMA(1, 1, At, B1); PG8_BAR;
            }
        }
        if constexpr (ALIGN_EPI) { if (wr == 0) PG8_BAR; }
        if constexpr (!Epi::AFTER_DRAIN) { E(acc, cur, wr, wc, fr, fq); S.done(cur); }
        if (!has_next) break;
        {
#pragma unroll
        for (int a = 0; a < 2; ++a)
#pragma unroll
            for (int b = 0; b < 2; ++b)
#pragma unroll
                for (int m = 0; m < 4; ++m)
#pragma unroll
                    for (int n = 0; n < 2; ++n) acc[a][b][m][n] = (f32x4){0.f, 0.f, 0.f, 0.f};
        }
        cur = nxt; cA = nA; cB = nB; ++ui;
        if constexpr (ALIGN_EPI) { if (wr == 1) PG8_BAR; }
    }
    PG8_WAIT_V(0);
    if constexpr (!ALIGN_EPI) { if (wr == 0) PG8_BAR; }
    PG8_BAR;
    if constexpr (Epi::AFTER_DRAIN) { E.fused(acc, cur, wr, wc, fr, fq, lds, wid, lane); S.done(cur); }
#undef PG8_SA
#undef PG8_SB
#undef PG8_STAGE
#undef PG8_LDA
#undef PG8_LDB
#undef PG8_MMA
#undef PG8_CAT
#undef PG8_RD
#undef PG8_WAIT_V
#undef PG8_WAIT_L
#undef PG8_BAR
#undef PG8_SCHED
}
}

#define XB_TMO      128
#define XB_XCNT(j)  (256  + 64 * (j))
#define XB_XSUB(j)  (1280 + 64 * (j))
#define XB_XGEN(j)  (2304 + 64 * (j))
#define XB_TOP      3328
#define XB_TOPGEN   3392
#define XCD_BAR_WORDS 3456
#define XB_SPIN_CAP (1u << 18)
#define LAS __attribute__((address_space(3)))

__device__ __forceinline__ unsigned xb_ld(unsigned* p)              { return __hip_atomic_load(p, __ATOMIC_RELAXED, __HIP_MEMORY_SCOPE_AGENT); }
__device__ __forceinline__ unsigned xb_add(unsigned* p, unsigned v) { return __hip_atomic_fetch_add(p, v, __ATOMIC_RELAXED, __HIP_MEMORY_SCOPE_AGENT); }
__device__ __forceinline__ unsigned xb_xcc_id() { return (unsigned)__builtin_amdgcn_s_getreg((3 << 11) | 20) & 0xFu; }
#define XB_SPIN(cond, bar) do { unsigned _sp = 0; while (cond) { __builtin_amdgcn_s_sleep(1); \
    if ((++_sp & 255u) == 0u) { if (xb_ld(&(bar)[XB_TMO])) break; if (_sp > XB_SPIN_CAP) { atomicAdd(&(bar)[XB_TMO], 1u); break; } } } } while (0)

struct XcdBarrier {
    unsigned* bar; unsigned x;
    volatile LAS unsigned* st;
};

__device__ __forceinline__ XcdBarrier xcd_barrier_post(unsigned* bar, volatile LAS unsigned* st) {
    XcdBarrier b; b.bar = bar; b.x = xb_xcc_id(); b.st = st;
    if (threadIdx.x == 0) (void)xb_add(&bar[XB_XCNT(b.x)], 1u);
    return b;
}
__device__ __forceinline__ void xcd_barrier_complete(unsigned* bar, unsigned x, unsigned& nloc, unsigned& nx) {
    const unsigned G = gridDim.x * gridDim.y * gridDim.z;
    unsigned sum, cnt, mine, sp = 0u;
    for (;;) {
        sum = 0u; cnt = 0u; mine = 0u;
#pragma unroll
        for (unsigned j = 0; j < 16; ++j) { const unsigned c = xb_ld(&bar[XB_XCNT(j)]); sum += c; cnt += (c > 0u) ? 1u : 0u; mine = (j == x) ? c : mine; }
        if (sum == G) break;
        __builtin_amdgcn_s_sleep(1);
        if ((++sp & 255u) == 0u) { if (xb_ld(&bar[XB_TMO])) break; if (sp > XB_SPIN_CAP) { atomicAdd(&bar[XB_TMO], 1u); break; } }
    }
    nloc = mine > 0u ? mine : 1u; nx = cnt > 0u ? cnt : 1u;
}

__device__ __forceinline__ void xcd_barrier(const XcdBarrier& b) {
    asm volatile("s_waitcnt vmcnt(0)" ::: "memory");
    __syncthreads();
    if (threadIdx.x == 0) {
        unsigned* bar = b.bar;
        __builtin_amdgcn_s_waitcnt(0);
        unsigned nloc = b.st[0], nx = b.st[1];
        if (nloc == 0u) { xcd_barrier_complete(bar, b.x, nloc, nx); b.st[0] = nloc; b.st[1] = nx; }
        const unsigned old = xb_add(&bar[XB_XSUB(b.x)], 1u);
        const unsigned gen = old / nloc;
        if (old + 1u == (gen + 1u) * nloc) {
            __builtin_amdgcn_fence(__ATOMIC_RELEASE, "agent");
            asm volatile("s_waitcnt vmcnt(0)" ::: "memory");
            const unsigned og = xb_add(&bar[XB_TOP], 1u);
            const unsigned tg = og / nx;
            if (og + 1u == (tg + 1u) * nx) xb_add(&bar[XB_TOPGEN], 1u);
            else XB_SPIN(xb_ld(&bar[XB_TOPGEN]) == tg, bar);
            __builtin_amdgcn_fence(__ATOMIC_ACQUIRE, "agent");
            xb_add(&bar[XB_XGEN(b.x)], 1u);
            asm volatile("s_waitcnt vmcnt(0)" ::: "memory");
        } else {
            XB_SPIN(xb_ld(&bar[XB_XGEN(b.x)]) == gen, bar);
            __builtin_amdgcn_fence(__ATOMIC_ACQUIRE, "agent");
            asm volatile("s_waitcnt vmcnt(0)" ::: "memory");
        }
    }
    __syncthreads();
}

constexpr int NWAVES = 8, NTHR = 512;
constexpr int RING_BYTES = 131072;
constexpr int LDS_BYTES = 147456;
constexpr int LDSCTL_OFF = LDS_BYTES - 16;
constexpr int CW_BAR = 4096;
typedef float f32x4 __attribute__((ext_vector_type(4)));
typedef unsigned u32x4 __attribute__((ext_vector_type(4)));
typedef unsigned u32x2 __attribute__((ext_vector_type(2)));
typedef short bf16x8 __attribute__((ext_vector_type(8)));
#define LDS_WAIT() asm volatile("s_waitcnt lgkmcnt(0)" ::: "memory")
typedef __bf16 bf16x2_t __attribute__((ext_vector_type(2)));
typedef float f32x2_t __attribute__((ext_vector_type(2)));
__device__ __forceinline__ unsigned pk2(float lo, float hi) { const f32x2_t v = {lo, hi}; return __builtin_bit_cast(unsigned, __builtin_convertvector(v, bf16x2_t)); }
__device__ __forceinline__ int lane_fresh() { int l; asm volatile("v_mbcnt_lo_u32_b32 %0, -1, 0\n\tv_mbcnt_hi_u32_b32 %0, -1, %0" : "=v"(l)); return l; }
#define DPP_ADD(v, ctrl) ((v) + __builtin_bit_cast(float, __builtin_amdgcn_update_dpp(0, __builtin_bit_cast(int, (v)), (ctrl), 0xf, 0xf, true)))
__device__ __forceinline__ float wave_sum(float v) {
    v = DPP_ADD(v, 0xB1);
    v = DPP_ADD(v, 0x4E);
    v = DPP_ADD(v, 0x141);
    v = DPP_ADD(v, 0x140);
    const int iv = __builtin_bit_cast(int, v);
    return (__builtin_bit_cast(float, __builtin_amdgcn_readlane(iv, 0)) + __builtin_bit_cast(float, __builtin_amdgcn_readlane(iv, 16)))
         + (__builtin_bit_cast(float, __builtin_amdgcn_readlane(iv, 32)) + __builtin_bit_cast(float, __builtin_amdgcn_readlane(iv, 48)));
}

constexpr int N1 = 11264;
struct Args { const float* in[38]; float* out; unsigned char* ws; int ph_lo, ph_hi; };

__device__ __forceinline__ void tr_item(const float* W, int ldw, int k0, int n0, bf16* dst, int ldd, const float* mu, int mode, LAS float* scr, int lane) {
    f32x4 v[8];
#pragma unroll
    for (int i = 0; i < 8; ++i) v[i] = *(const f32x4*)(W + (size_t)(k0 + 8 * i + (lane >> 3)) * ldw + n0 + 4 * (lane & 7));
#pragma unroll
    for (int i = 0; i < 8; ++i) { const int kk = 8 * i + (lane >> 3); f32x4 t = v[i];
        if (mode == 1) t = t * (1.0f - mu[k0 + kk]); else if (mode == 2) t = t * mu[k0 + kk];
        LAS float* s = scr + kk * 33 + 4 * (lane & 7); s[0] = t.x; s[1] = t.y; s[2] = t.z; s[3] = t.w; }
    LDS_WAIT(); asm volatile("" ::: "memory");
    const int c = lane & 7;
#pragma unroll
    for (int j = 0; j < 4; ++j) { const int n = (lane >> 3) + 8 * j; const LAS float* s = scr + (8 * c) * 33 + n;
        u32x4 o; o.x = pk2(s[0 * 33], s[1 * 33]); o.y = pk2(s[2 * 33], s[3 * 33]); o.z = pk2(s[4 * 33], s[5 * 33]); o.w = pk2(s[6 * 33], s[7 * 33]);
        *(u32x4*)(dst + (size_t)n * ldd + 8 * c) = o; }
    LDS_WAIT(); asm volatile("" ::: "memory");
}
__device__ __forceinline__ unsigned pk_fp8x4(float a, float b, float c, float d, float sc) {
    a = fminf(fmaxf(a * sc, -448.f), 448.f); b = fminf(fmaxf(b * sc, -448.f), 448.f); c = fminf(fmaxf(c * sc, -448.f), 448.f); d = fminf(fmaxf(d * sc, -448.f), 448.f);
    int p = __builtin_amdgcn_cvt_pk_fp8_f32(a, b, 0, false); p = __builtin_amdgcn_cvt_pk_fp8_f32(c, d, p, true); return (unsigned)p; }
__device__ __forceinline__ void tr_item8(const float* W, int ldw, int k0, int n0, unsigned char* dst, int ldd, float sc, LAS float* scr, int lane) {
    f32x4 v[8];
#pragma unroll
    for (int i = 0; i < 8; ++i) v[i] = *(const f32x4*)(W + (size_t)(k0 + 8 * i + (lane >> 3)) * ldw + n0 + 4 * (lane & 7));
#pragma unroll
    for (int i = 0; i < 8; ++i) { const int kk = 8 * i + (lane >> 3); LAS float* s = scr + kk * 33 + 4 * (lane & 7); s[0] = v[i].x; s[1] = v[i].y; s[2] = v[i].z; s[3] = v[i].w; }
    LDS_WAIT(); asm volatile("" ::: "memory");
    const int c = lane & 7;
#pragma unroll
    for (int j = 0; j < 4; ++j) { const int n = (lane >> 3) + 8 * j; const LAS float* s = scr + (8 * c) * 33 + n;
        u32x2 o; o.x = pk_fp8x4(s[0 * 33], s[1 * 33], s[2 * 33], s[3 * 33], sc); o.y = pk_fp8x4(s[4 * 33], s[5 * 33], s[6 * 33], s[7 * 33], sc);
        *(u32x2*)(dst + (size_t)n * ldd + 8 * c) = o; }
    LDS_WAIT(); asm volatile("" ::: "memory");
}

struct ConvTile { const float* src; int ldw; unsigned char* dst; int rs; int kind; float sc; };
constexpr int CT_IN = (D / 128) * (INW / 128), CT_UP = (AW / 128) * (D / 128), CT_O = (D / 128) * (D / 128), CT_EG = (D / 128) * (FF / 128), CT_ED = (FF / 128) * (D / 128);
constexpr int CT_ALL = CT_IN + 2 * CT_UP + CT_O + NE * (2 * CT_EG + CT_ED);
__device__ __forceinline__ ConvTile conv_decode(int T, const float* const* in, unsigned char* ws) {
    ConvTile t; int r = T;
    if (r < CT_IN) { const int kt = r / (INW / 128), nt = r % (INW / 128), k0 = 128 * kt, n0 = 128 * nt; int dr = n0;
        if (n0 >= 3 * AW + 3 * RW + D) { const int cc = n0 - (3 * AW + 3 * RW + D); dr = 3 * AW + 3 * RW + 256 * (cc / 128) + 128; }
        else if (n0 >= 3 * AW + 3 * RW) { const int cc = n0 - (3 * AW + 3 * RW); dr = 3 * AW + 3 * RW + 256 * (cc / 128); }
        t.src = in[8] + (size_t)k0 * INW + n0; t.ldw = INW; t.dst = ws + WS_W1T + ((size_t)dr * D + k0) * 2; t.rs = D * 2; t.kind = 0; t.sc = 1.f; return t; } r -= CT_IN;
    if (r < 2 * CT_UP) { const int which = r / CT_UP, q = r % CT_UP, kt = q / (D / 128), nt = q % (D / 128), k0 = 128 * kt, n0 = 128 * nt;
        t.src = in[28 + which] + (size_t)k0 * D + n0; t.ldw = D; t.dst = ws + WS_WUPT + ((size_t)n0 * D + which * AW + k0) * 2; t.rs = D * 2; t.kind = 0; t.sc = 1.f; return t; } r -= 2 * CT_UP;
    if (r < CT_O) { const int kt = r / (D / 128), nt = r % (D / 128), k0 = 128 * kt, n0 = 128 * nt;
        t.src = in[30] + (size_t)k0 * D + n0; t.ldw = D; t.dst = ws + WS_WOT + ((size_t)n0 * D + k0) * 2; t.rs = D * 2; t.kind = 0; t.sc = 1.f; return t; } r -= CT_O;
    const int e = r / (2 * CT_EG + CT_ED); r -= e * (2 * CT_EG + CT_ED);
    if (r < 2 * CT_EG) { const int up = r / CT_EG, q = r % CT_EG, kt = q / (FF / 128), nt = q % (FF / 128), k0 = 128 * kt;
        t.src = in[35 + up] + (size_t)e * D * FF + (size_t)k0 * FF + 128 * nt; t.ldw = FF; t.dst = ws + WS_WGUT + ((size_t)e * 1024 + 256 * nt + 128 * up) * D + k0; t.rs = D; t.kind = 1; t.sc = 256.f; return t; } r -= 2 * CT_EG;
    { const int kt = r / (D / 128), nt = r % (D / 128), k0 = 128 * kt, n0 = 128 * nt;
        t.src = in[37] + (size_t)e * FF * D + (size_t)k0 * D + n0; t.ldw = D; t.dst = ws + WS_WDT + ((size_t)e * D + n0) * FF + k0; t.rs = FF; t.kind = 1; t.sc = 128.f; return t; }
}
__device__ __forceinline__ int conv_off(int k, int n) { return k * 132 + 16 * (k >> 5) + n; }
__device__ __forceinline__ void item_kn(int it, int N, int& k0, int& n0) { const int nblk = N / 32; k0 = 64 * (it / nblk); n0 = 32 * (it % nblk); }

struct EpiProj {
    static constexpr bool PERM = true, AFTER_DRAIN = false, MIDK = false;
    bf16* q; bf16* k; bf16* v; float* rkv; bf16* gate; float* lora; float* lorab; const float* rope;
    __device__ __forceinline__ void operator()(const pg8::f32x4 (&acc)[2][2][4][2], const pg8::Unit& u, int wr, int wc, int fr, int fq) const {
        const int row0 = u.pm * 256 + wr * 64 + fr; const int pn = u.pn; const int colw = wc * 32 + 8 * fq;
        if (pn < 8) {
            bf16* base = (pn < 4 ? q : k) + (pn & 3) * 256 + colw;
            const float sgn = fq < 2 ? -1.0f : 1.0f;
#pragma unroll
            for (int ai = 0; ai < 2; ++ai)
#pragma unroll
                for (int m = 0; m < 4; ++m) { const int row = row0 + ai * 128 + m * 16;
                    f32x4 c0, c1, c2, c3;
                    if (wc == 0) { const float* rp = rope + ((size_t)row * 16 + 8 * (fq & 1)) * 2; c0 = *(const f32x4*)rp; c1 = *(const f32x4*)(rp + 4); c2 = *(const f32x4*)(rp + 8); c3 = *(const f32x4*)(rp + 12); }
#pragma unroll
                    for (int bj = 0; bj < 2; ++bj) { f32x4 v0 = acc[ai][bj][m][0], v1 = acc[ai][bj][m][1];
                        if (wc == 0) {
                            f32x4 p0, p1;
#pragma unroll
                            for (int j = 0; j < 4; ++j) { p0[j] = __shfl_xor(v0[j], 32) * sgn; p1[j] = __shfl_xor(v1[j], 32) * sgn; }
                            v0[0] = v0[0] * c0[0] + p0[0] * c0[1]; v0[1] = v0[1] * c0[2] + p0[1] * c0[3]; v0[2] = v0[2] * c1[0] + p0[2] * c1[1]; v0[3] = v0[3] * c1[2] + p0[3] * c1[3];
                            v1[0] = v1[0] * c2[0] + p1[0] * c2[1]; v1[1] = v1[1] * c2[2] + p1[1] * c2[3]; v1[2] = v1[2] * c3[0] + p1[2] * c3[1]; v1[3] = v1[3] * c3[2] + p1[3] * c3[3];
                        }
                        u32x4 w; w.x = pk2(v0[0], v0[1]); w.y = pk2(v0[2], v0[3]); w.z = pk2(v1[0], v1[1]); w.w = pk2(v1[2], v1[3]);
                        *(u32x4*)(base + (size_t)row * AW + bj * 128) = w; } }
        } else if (pn < 12) {
            bf16* base = v + (pn - 8) * 256 + colw;
#pragma unroll
            for (int ai = 0; ai < 2; ++ai)
#pragma unroll
                for (int m = 0; m < 4; ++m) { const int row = row0 + ai * 128 + m * 16;
#pragma unroll
                    for (int bj = 0; bj < 2; ++bj) { const f32x4 v0 = acc[ai][bj][m][0], v1 = acc[ai][bj][m][1];
                        u32x4 w; w.x = pk2(v0[0], v0[1]); w.y = pk2(v0[2], v0[3]); w.z = pk2(v1[0], v1[1]); w.w = pk2(v1[2], v1[3]);
                        *(u32x4*)(base + (size_t)row * AW + bj * 128) = w; } }
        } else if (pn < 24) {
            float* base = rkv + (pn - 12) * 256 + colw;
#pragma unroll
            for (int ai = 0; ai < 2; ++ai)
#pragma unroll
                for (int m = 0; m < 4; ++m) { const int row = row0 + ai * 128 + m * 16;
#pragma unroll
                    for (int bj = 0; bj < 2; ++bj) { float* p = base + (size_t)row * (3 * RW) + bj * 128; *(f32x4*)p = acc[ai][bj][m][0]; *(f32x4*)(p + 4) = acc[ai][bj][m][1]; } }
        } else if (pn < 40) {
            bf16* base = gate + (pn - 24) * 128 + colw;
#pragma unroll
            for (int ai = 0; ai < 2; ++ai)
#pragma unroll
                for (int m = 0; m < 4; ++m) { const int row = row0 + ai * 128 + m * 16;
                    const f32x4 a0 = acc[ai][0][m][0], a1 = acc[ai][0][m][1], r0 = acc[ai][1][m][0], r1 = acc[ai][1][m][1]; float ra[8], sr[8];
#pragma unroll
                    for (int j = 0; j < 4; ++j) { const float ea = __expf(-a0[j]), er = __expf(-r0[j]), ea1 = __expf(-a1[j]), er1 = __expf(-r1[j]);
                        sr[j] = __builtin_amdgcn_rcpf(1.0f + er); ra[j] = (1.0f + er) * __builtin_amdgcn_rcpf(1.0f + ea); sr[4 + j] = __builtin_amdgcn_rcpf(1.0f + er1); ra[4 + j] = (1.0f + er1) * __builtin_amdgcn_rcpf(1.0f + ea1); }
                    u32x4 w; w.x = pk2(ra[0], ra[1]); w.y = pk2(ra[2], ra[3]); w.z = pk2(ra[4], ra[5]); w.w = pk2(ra[6], ra[7]);
                    *(u32x4*)(base + (size_t)row * (2 * D)) = w;
                    w.x = pk2(sr[0], sr[1]); w.y = pk2(sr[2], sr[3]); w.z = pk2(sr[4], sr[5]); w.w = pk2(sr[6], sr[7]);
                    *(u32x4*)(base + (size_t)row * (2 * D) + D) = w; }
        } else {
            float* base = (u.koff ? lorab : lora) + (pn - 40) * 256 + colw;
#pragma unroll
            for (int ai = 0; ai < 2; ++ai)
#pragma unroll
                for (int m = 0; m < 4; ++m) { const int row = row0 + ai * 128 + m * 16;
#pragma unroll
                    for (int bj = 0; bj < 2; ++bj) { float* p = base + (size_t)row * 1024 + bj * 128; *(f32x4*)p = acc[ai][bj][m][0]; *(f32x4*)(p + 4) = acc[ai][bj][m][1]; } }
        }
    }
};


struct LoraOrder { int G, c;
    __device__ bool next(int i, pg8::Unit& u) const { const int L = i * G + c; if (L >= (S / 256) * 8) return false; u.pm = L >> 3; u.pn = 40 + ((L >> 1) & 3); u.koff = (L & 1) * AW * 2; u.koffB = u.koff; return true; }
    __device__ __forceinline__ void a_ready(const pg8::Unit&) const {}
    __device__ __forceinline__ void done(const pg8::Unit&) const {} };
__device__ __forceinline__ void unpack8(const u32x4 w, float (&f)[8]) {
    f[0] = __uint_as_float(w.x << 16); f[1] = __uint_as_float(w.x & 0xffff0000u); f[2] = __uint_as_float(w.y << 16); f[3] = __uint_as_float(w.y & 0xffff0000u);
    f[4] = __uint_as_float(w.z << 16); f[5] = __uint_as_float(w.z & 0xffff0000u); f[6] = __uint_as_float(w.w << 16); f[7] = __uint_as_float(w.w & 0xffff0000u);
}
struct EpiMix {
    static constexpr bool PERM = true, AFTER_DRAIN = false, MIDK = false;
    const bf16* gate; bf16* mix;
    __device__ __forceinline__ void operator()(const pg8::f32x4 (&acc)[2][2][4][2], const pg8::Unit& u, int wr, int wc, int fr, int fq) const {
        const int row0 = u.pm * 256 + wr * 64 + fr; const int col0 = u.pn * 256 + wc * 32 + 8 * fq;
        if (u.koff == 0) {
#pragma unroll
            for (int ai = 0; ai < 2; ++ai)
#pragma unroll
                for (int m = 0; m < 4; ++m) { const size_t row = row0 + ai * 128 + m * 16; const bf16* gp = gate + row * (2 * D) + col0;
#pragma unroll
                    for (int bj = 0; bj < 2; ++bj) { float ga[8]; unpack8(*(const u32x4*)(gp + bj * 128), ga); const pg8::f32x4 v0 = acc[ai][bj][m][0], v1 = acc[ai][bj][m][1];
                        u32x4 w; w.x = pk2(v0[0] * ga[0], v0[1] * ga[1]); w.y = pk2(v0[2] * ga[2], v0[3] * ga[3]); w.z = pk2(v1[0] * ga[4], v1[1] * ga[5]); w.w = pk2(v1[2] * ga[6], v1[3] * ga[7]);
                        *(u32x4*)(mix + row * D + col0 + bj * 128) = w; } }
        } else {
#pragma unroll
            for (int ai = 0; ai < 2; ++ai)
#pragma unroll
                for (int m = 0; m < 4; ++m) { const size_t row = row0 + ai * 128 + m * 16; const bf16* gp = gate + row * (2 * D) + D + col0;
#pragma unroll
                    for (int bj = 0; bj < 2; ++bj) { float gr[8], tp[8]; unpack8(*(const u32x4*)(gp + bj * 128), gr); unpack8(*(const u32x4*)(mix + row * D + col0 + bj * 128), tp); const pg8::f32x4 v0 = acc[ai][bj][m][0], v1 = acc[ai][bj][m][1];
                        u32x4 w; w.x = pk2((v0[0] + tp[0]) * gr[0], (v0[1] + tp[1]) * gr[1]); w.y = pk2((v0[2] + tp[2]) * gr[2], (v0[3] + tp[3]) * gr[3]);
                        w.z = pk2((v1[0] + tp[4]) * gr[4], (v1[1] + tp[5]) * gr[5]); w.w = pk2((v1[2] + tp[6]) * gr[6], (v1[3] + tp[7]) * gr[7]);
                        *(u32x4*)(mix + row * D + col0 + bj * 128) = w; } }
        }
    }
};
struct MixOrder {
    int G, c;
    __device__ bool next(int i, pg8::Unit& u) const { const int L = (i >> 1) * G + c; if (L >= (S / 256) * (D / 256)) return false; u.pm = L / (D / 256); u.pn = L % (D / 256); u.koff = (i & 1) * AW * 2; u.koffB = u.koff; return true; }
    __device__ __forceinline__ void a_ready(const pg8::Unit&) const {}
    __device__ __forceinline__ void done(const pg8::Unit&) const {}
};
struct EpiBf16P {
    static constexpr bool PERM = true, AFTER_DRAIN = false, MIDK = false;
    bf16* C; long ldc;
    __device__ __forceinline__ void operator()(const pg8::f32x4 (&acc)[2][2][4][2], const pg8::Unit& u, int wr, int wc, int fr, int fq) const {
        const int row0 = u.pm * 256 + wr * 64 + fr; const int col0 = u.pn * 256 + wc * 32 + 8 * fq;
#pragma unroll
        for (int ai = 0; ai < 2; ++ai)
#pragma unroll
            for (int m = 0; m < 4; ++m) { bf16* p = C + (size_t)(row0 + ai * 128 + m * 16) * ldc + col0;
#pragma unroll
                for (int bj = 0; bj < 2; ++bj) { const pg8::f32x4 v0 = acc[ai][bj][m][0], v1 = acc[ai][bj][m][1];
                    u32x4 w; w.x = pk2(v0[0], v0[1]); w.y = pk2(v0[2], v0[3]); w.z = pk2(v1[0], v1[1]); w.w = pk2(v1[2], v1[3]);
                    *(u32x4*)(p + bj * 128) = w; } }
    }
};
struct EpiF32P {
    static constexpr bool PERM = true, AFTER_DRAIN = false, MIDK = false;
    float* C; long ldc;
    __device__ __forceinline__ void operator()(const pg8::f32x4 (&acc)[2][2][4][2], const pg8::Unit& u, int wr, int wc, int fr, int fq) const {
        const int row0 = u.pm * 256 + wr * 64 + fr; const int col0 = u.pn * 256 + wc * 32 + 8 * fq;
#pragma unroll
        for (int ai = 0; ai < 2; ++ai)
#pragma unroll
            for (int m = 0; m < 4; ++m) { float* p = C + (size_t)(row0 + ai * 128 + m * 16) * ldc + col0;
#pragma unroll
                for (int bj = 0; bj < 2; ++bj) { *(f32x4*)(p + bj * 128) = acc[ai][bj][m][0]; *(f32x4*)(p + bj * 128 + 4) = acc[ai][bj][m][1]; } }
    }
};
struct ExpertOrder {
    const int* tile_e; int ntiles, nj, G, c;
    __device__ bool next(int i, pg8::Unit& u) const { const int L = i * G + c; const int pm = L / nj; if (pm >= ntiles) return false; u.pm = pm; u.pn = tile_e[pm] * nj + (L % nj); u.koff = 0; u.koffB = 0; return true; }
    __device__ __forceinline__ void a_ready(const pg8::Unit&) const {}
    __device__ __forceinline__ void done(const pg8::Unit&) const {}
};
struct EpiHid {
    static constexpr bool PERM = true, AFTER_DRAIN = false, MIDK = false;
    unsigned char* hid;
    __device__ __forceinline__ void operator()(const pg8::f32x4 (&acc)[2][2][4][2], const pg8::Unit& u, int wr, int wc, int fr, int fq) const {
        const int row0 = u.pm * 128 + wr * 64 + fr; const int col0 = (u.pn & 3) * 128 + wc * 32 + 8 * fq;
#pragma unroll
        for (int ai = 0; ai < 1; ++ai)
#pragma unroll
            for (int m = 0; m < 4; ++m) { const pg8::f32x4 g0 = acc[ai][0][m][0], g1 = acc[ai][0][m][1], u0 = acc[ai][1][m][0], u1 = acc[ai][1][m][1]; float o[8];
#pragma unroll
                for (int j = 0; j < 4; ++j) { o[j] = g0[j] * sigmoidf_(g0[j]) * u0[j]; o[4 + j] = g1[j] * sigmoidf_(g1[j]) * u1[j]; }
                u32x2 w; w.x = pk_fp8x4(o[0], o[1], o[2], o[3], 8.0f); w.y = pk_fp8x4(o[4], o[5], o[6], o[7], 8.0f);
                *(u32x2*)(hid + (size_t)(row0 + ai * 128 + m * 16) * FF + col0) = w; }
    }
};
struct EpiYbuf {
    static constexpr bool PERM = true, AFTER_DRAIN = false, MIDK = false;
    bf16* ybuf;
    __device__ __forceinline__ void operator()(const pg8::f32x4 (&acc)[2][2][4][2], const pg8::Unit& u, int wr, int wc, int fr, int fq) const {
        const int row0 = u.pm * 128 + wr * 64 + fr; const int col0 = (u.pn & 7) * 256 + wc * 32 + 8 * fq;
#pragma unroll
        for (int ai = 0; ai < 1; ++ai)
#pragma unroll
            for (int m = 0; m < 4; ++m) { bf16* p = ybuf + (size_t)(row0 + ai * 128 + m * 16) * D + col0;
#pragma unroll
                for (int bj = 0; bj < 2; ++bj) { const pg8::f32x4 v0 = acc[ai][bj][m][0], v1 = acc[ai][bj][m][1];
                    u32x4 w; w.x = pk2(v0[0], v0[1]); w.y = pk2(v0[2], v0[3]); w.z = pk2(v1[0], v1[1]); w.w = pk2(v1[2], v1[3]);
                    *(u32x4*)(p + bj * 128) = w; } }
    }
};
constexpr int RS8 = D + 8;

typedef short s16x4 __attribute__((ext_vector_type(4)));
constexpr int KST = 136, VST = 144;
constexpr int KT_BYTES = 64 * KST * 2, VT_BYTES = 64 * VST * 2;
constexpr int AT_BUF = KT_BYTES + VT_BYTES;
constexpr int AT_G = 2 * AT_BUF;
constexpr int AT_HIST = AT_G + 8 * 2112;
constexpr int AT_ITEMS = AT_HIST + 256;
constexpr int LIST_PER_HEAD = 256 * 496;
__device__ __forceinline__ int list_off(int j) { return 256 * (31 * j - (j * (j - 1)) / 2); }
__device__ __forceinline__ s16x4 tr_read4(unsigned addr) { return __builtin_amdgcn_ds_read_tr16_b64_v4i16((LAS s16x4*)(size_t)addr); }

struct AttnBufs { const bf16* q; const bf16* k; const bf16* v; const bf16* kmh; const bf16* kml; unsigned* mask; int* list; int* cnt; bf16* part; float* ml; };

__device__ __forceinline__ void moba_select_unit(LAS unsigned char* lds, const AttnBufs& A, int head, int qt, int tid, int lane, int wave) {
    const int q0 = qt * 128, qblk = qt >> 1, g4 = lane >> 4, c16 = lane & 15; const int myq = q0 + wave * 16 + c16;
    LAS int* hist = (LAS int*)(lds + AT_HIST); LAS int* base = hist + 32;
    if (tid < 32) hist[tid] = 0;
    __syncthreads();
    unsigned msk = 0u; int lp0 = 0, lp1 = 0, lp2 = 0, b0 = 0, b1 = 0, b2 = 0, nsel = 0;
    if (qblk > 0) {
        bf16x8 qf[4];
#pragma unroll
        for (int ks = 0; ks < 4; ++ks) qf[ks] = *(const bf16x8*)(A.q + (size_t)myq * AW + head * AD + 32 * ks + 8 * g4);
        f32x4 gs[2] = {(f32x4){0.f, 0.f, 0.f, 0.f}, (f32x4){0.f, 0.f, 0.f, 0.f}};
#pragma unroll
        for (int mt = 0; mt < 2; ++mt)
#pragma unroll
            for (int ks = 0; ks < 4; ++ks) { const size_t o = (size_t)(head * NB + 16 * mt + c16) * AD + 32 * ks + 8 * g4;
                gs[mt] = __builtin_amdgcn_mfma_f32_16x16x32_bf16(*(const bf16x8*)(A.kmh + o), qf[ks], gs[mt], 0, 0, 0);
                gs[mt] = __builtin_amdgcn_mfma_f32_16x16x32_bf16(*(const bf16x8*)(A.kml + o), qf[ks], gs[mt], 0, 0, 0); }
        LAS float* G = (LAS float*)(lds + AT_G + wave * 2112);
#pragma unroll
        for (int mt = 0; mt < 2; ++mt)
#pragma unroll
            for (int rg = 0; rg < 4; ++rg) G[c16 * 33 + 16 * mt + 4 * g4 + rg] = gs[mt][rg];
        LDS_WAIT(); asm volatile("" ::: "memory");
        if (lane < 16) {
            nsel = qblk < 3 ? qblk : 3;
            float gvv[32];
#pragma unroll
            for (int n = 0; n < 32; ++n) gvv[n] = G[lane * 33 + n];
#pragma unroll
            for (int n = 0; n < 32; ++n) gvv[n] = n < qblk ? gvv[n] : -3e38f;
#pragma unroll
            for (int t = 0; t < 3; ++t) if (t < nsel) { float best = -3e38f; int bi = 0;
#pragma unroll
                for (int n = 0; n < 32; ++n) { const bool take = gvv[n] > best; best = take ? gvv[n] : best; bi = take ? n : bi; }
#pragma unroll
                for (int n = 0; n < 32; ++n) gvv[n] = (n == bi) ? -3e38f : gvv[n];
                msk |= 1u << bi;
                const int lp = atomicAdd((int*)&hist[bi], 1); if (t == 0) { lp0 = lp; b0 = bi; } else if (t == 1) { lp1 = lp; b1 = bi; } else { lp2 = lp; b2 = bi; } }
        }
    }
    if (lane < 16) A.mask[head * S + myq] = msk;
    __syncthreads();
    if (tid < 32) { const int hcount = hist[tid]; base[tid] = hcount > 0 ? atomicAdd(A.cnt + head * NB + tid, hcount) : 0; }
    __syncthreads();
    if (lane < 16) { int* lh = A.list + head * LIST_PER_HEAD;
        if (nsel > 0) lh[list_off(b0) + base[b0] + lp0] = myq;
        if (nsel > 1) lh[list_off(b1) + base[b1] + lp1] = myq;
        if (nsel > 2) lh[list_off(b2) + base[b2] + lp2] = myq; }
    __syncthreads();
}

__device__ __forceinline__ void moba_item2(LAS unsigned char* lds, const AttnBufs& A, int head, int kvb, bool own, int r, int cntj, int tid, int lane, int wave) {
    const int g4 = lane >> 4, c16 = lane & 15;
    int myq[2]; bool valid[2];
    if (own) { myq[0] = kvb * MB + wave * 32 + c16; myq[1] = myq[0] + 16; valid[0] = true; valid[1] = true; }
    else { const int* lp = A.list + head * LIST_PER_HEAD + list_off(kvb);
#pragma unroll
        for (int g = 0; g < 2; ++g) { const int e = r * 256 + wave * 32 + 16 * g + c16; valid[g] = e < cntj; myq[g] = lp[valid[g] ? e : 0]; } }
    const bool wave_valid = own || (r * 256 + wave * 32 < cntj);
    const int qfirst = kvb * MB + wave * 32;
    bf16x8 qf[2][4];
#pragma unroll
    for (int g = 0; g < 2; ++g)
#pragma unroll
        for (int ks = 0; ks < 4; ++ks) qf[g][ks] = *(const bf16x8*)(A.q + (size_t)myq[g] * AW + head * AD + 32 * ks + 8 * g4);
    f32x4 oacc[2][8];
#pragma unroll
    for (int g = 0; g < 2; ++g)
#pragma unroll
        for (int dt = 0; dt < 8; ++dt) oacc[g][dt] = (f32x4){0.f, 0.f, 0.f, 0.f};
    float mrun[2] = {-1e30f, -1e30f}, lrun[2] = {0.f, 0.f};
    const float sc2 = 0.08838834764831845f * 1.4426950408889634f;
    const int r0 = tid >> 4, ch = tid & 15;
    u32x4 kr[2], vr[2];
    const bf16* kg = A.k + (size_t)(kvb * MB + r0) * AW + head * AD + 8 * ch; const bf16* vg = A.v + (size_t)(kvb * MB + r0) * AW + head * AD + 8 * ch;
    LAS unsigned char* kst = lds + (r0 * KST + 8 * ch) * 2; LAS unsigned char* vst = lds + KT_BYTES + (r0 * VST + 8 * ch) * 2;
    const LAS unsigned char* kld = lds + (c16 * KST + 8 * g4) * 2; const LAS unsigned char* vld = lds + KT_BYTES + ((4 * g4 + (c16 >> 2)) * VST + 4 * (c16 & 3)) * 2;
#define GLD(it) do { kr[0] = *(const u32x4*)(kg + (size_t)(64 * (it)) * AW); kr[1] = *(const u32x4*)(kg + (size_t)(64 * (it) + 32) * AW); vr[0] = *(const u32x4*)(vg + (size_t)(64 * (it)) * AW); vr[1] = *(const u32x4*)(vg + (size_t)(64 * (it) + 32) * AW); } while (0)
#define LST(b) do { *(LAS u32x4*)(kst + (b) * AT_BUF) = kr[0]; *(LAS u32x4*)(kst + (b) * AT_BUF + 32 * KST * 2) = kr[1]; *(LAS u32x4*)(vst + (b) * AT_BUF) = vr[0]; *(LAS u32x4*)(vst + (b) * AT_BUF + 32 * VST * 2) = vr[1]; } while (0)
    GLD(0); LST(0);
    __syncthreads();
#pragma nounroll
    for (int it = 0; it < 4; ++it) {
        const int kp0 = kvb * MB + 64 * it; const int b = it & 1;
        if (it + 1 < 4) GLD(it + 1);
        if (wave_valid && (!own || kp0 <= qfirst + 31)) {
            const LAS unsigned char* Kb = kld + b * AT_BUF; const LAS unsigned char* vb = vld + b * AT_BUF;
            f32x4 st[2][4];
#pragma unroll
            for (int mt = 0; mt < 4; ++mt) { st[0][mt] = (f32x4){0.f, 0.f, 0.f, 0.f}; st[1][mt] = st[0][mt];
#pragma unroll
                for (int ks = 0; ks < 4; ++ks) { const bf16x8 kf = *(const LAS bf16x8*)(Kb + (16 * mt * KST + 32 * ks) * 2);
                    st[0][mt] = __builtin_amdgcn_mfma_f32_16x16x32_bf16(kf, qf[0][ks], st[0][mt], 0, 0, 0);
                    st[1][mt] = __builtin_amdgcn_mfma_f32_16x16x32_bf16(kf, qf[1][ks], st[1][mt], 0, 0, 0); } }
            bf16x8 pf[2][2];
#pragma unroll
            for (int g = 0; g < 2; ++g) {
                if (own && kp0 + 63 > qfirst + 16 * g) {
#pragma unroll
                    for (int mt = 0; mt < 4; ++mt)
#pragma unroll
                        for (int rg = 0; rg < 4; ++rg) { const int kpos = kp0 + 16 * mt + 4 * g4 + rg; st[g][mt][rg] = (kpos <= myq[g]) ? st[g][mt][rg] : -1e30f; }
                }
                float mloc = fmaxf(fmaxf(fmaxf(st[g][0][0], st[g][0][1]), fmaxf(st[g][0][2], st[g][0][3])), fmaxf(fmaxf(st[g][1][0], st[g][1][1]), fmaxf(st[g][1][2], st[g][1][3])));
                mloc = fmaxf(mloc, fmaxf(fmaxf(fmaxf(st[g][2][0], st[g][2][1]), fmaxf(st[g][2][2], st[g][2][3])), fmaxf(fmaxf(st[g][3][0], st[g][3][1]), fmaxf(st[g][3][2], st[g][3][3]))));
                mloc = fmaxf(mloc, __shfl_xor(mloc, 16)); mloc = fmaxf(mloc, __shfl_xor(mloc, 32));
                const float mnew = fmaxf(mrun[g], mloc * sc2); const float alpha = __builtin_amdgcn_exp2f(mrun[g] - mnew); mrun[g] = mnew;
                float psum = 0.f;
#pragma unroll
                for (int mt = 0; mt < 4; ++mt)
#pragma unroll
                    for (int rg = 0; rg < 4; ++rg) { const float p = __builtin_amdgcn_exp2f(fmaf(st[g][mt][rg], sc2, -mnew)); st[g][mt][rg] = p; psum += p; }
                lrun[g] = lrun[g] * alpha + psum;
#pragma unroll
                for (int dt = 0; dt < 8; ++dt) oacc[g][dt] = oacc[g][dt] * alpha;
#pragma unroll
                for (int s = 0; s < 2; ++s) { u32x4 w; w.x = pk2(st[g][2 * s][0], st[g][2 * s][1]); w.y = pk2(st[g][2 * s][2], st[g][2 * s][3]); w.z = pk2(st[g][2 * s + 1][0], st[g][2 * s + 1][1]); w.w = pk2(st[g][2 * s + 1][2], st[g][2 * s + 1][3]);
                    pf[g][s] = __builtin_bit_cast(bf16x8, w); }
            }
#pragma unroll
            for (int dt = 0; dt < 8; ++dt)
#pragma unroll
                for (int s = 0; s < 2; ++s) {
                    const s16x4 lo = __builtin_amdgcn_ds_read_tr16_b64_v4i16((LAS s16x4*)(vb + (32 * s * VST + 16 * dt) * 2));
                    const s16x4 hi = __builtin_amdgcn_ds_read_tr16_b64_v4i16((LAS s16x4*)(vb + ((32 * s + 16) * VST + 16 * dt) * 2));
                    bf16x8 vf; vf[0] = lo[0]; vf[1] = lo[1]; vf[2] = lo[2]; vf[3] = lo[3]; vf[4] = hi[0]; vf[5] = hi[1]; vf[6] = hi[2]; vf[7] = hi[3];
                    oacc[0][dt] = __builtin_amdgcn_mfma_f32_16x16x32_bf16(vf, pf[0][s], oacc[0][dt], 0, 0, 0);
                    oacc[1][dt] = __builtin_amdgcn_mfma_f32_16x16x32_bf16(vf, pf[1][s], oacc[1][dt], 0, 0, 0); }
        }
        if (it + 1 < 4) LST(b ^ 1);
        __syncthreads();
    }
#undef GLD
#undef LST
#pragma unroll
    for (int g = 0; g < 2; ++g) {
        float l = lrun[g]; l += __shfl_xor(l, 16); l += __shfl_xor(l, 32);
        if (valid[g] && wave_valid) {
            int slot = 0; if (!own) { const unsigned mk = A.mask[head * S + myq[g]]; slot = 1 + __builtin_popcount(mk & ((1u << kvb) - 1u)); }
            const size_t pidx = ((size_t)(head * S + myq[g])) * 4 + slot;
            const float inv = 1.0f / l;
            bf16* orow = A.part + pidx * AD + 4 * g4;
#pragma unroll
            for (int dt = 0; dt < 8; ++dt) { u32x2 w; w.x = pk2(oacc[g][dt][0] * inv, oacc[g][dt][1] * inv); w.y = pk2(oacc[g][dt][2] * inv, oacc[g][dt][3] * inv); *(u32x2*)(orow + 16 * dt) = w; }
            if (g4 == 0) { A.ml[pidx * 2] = mrun[g]; A.ml[pidx * 2 + 1] = l; }
        }
    }
}
__device__ __forceinline__ void moba_items(LAS unsigned char* lds, const AttnBufs& A, int* qhead, LAS int* pre, LAS int* tick, int tid, int lane, int wave) {
    const int nitems = AH * NB + pre[256];
    if (tid == 0) tick[0] = atomicAdd(qhead, 1);
    __syncthreads();
    int item = tick[0];
    while (item < nitems) {
        __syncthreads();
        if (tid == 0) tick[0] = atomicAdd(qhead, 1);
        if (item < AH * NB) moba_item2(lds, A, item >> 5, item & 31, true, 0, 0, tid, lane, wave);
        else { const int s = item - AH * NB; int lo_ = 0, hi_ = 256;
            while (hi_ - lo_ > 1) { const int mid = (lo_ + hi_) >> 1; if (pre[mid] <= s) lo_ = mid; else hi_ = mid; }
            moba_item2(lds, A, lo_ >> 5, lo_ & 31, false, s - pre[lo_], A.cnt[lo_], tid, lane, wave); }
        __syncthreads();
        item = tick[0];
    }
}

constexpr int RST = 72, SLOTB = 64 * RST * 2;
constexpr int NCH = S / 64;
__device__ __forceinline__ bf16x8 frag_rows(const LAS bf16* M, int r0, int k0, int c16, int g4) { return *(const LAS bf16x8*)(M + (r0 + c16) * RST + k0 + 8 * g4); }
__device__ __forceinline__ bf16x8 frag_cols(const LAS bf16* M, int c0, int k0, int c16, int g4) {
    const unsigned base = (unsigned)(size_t)M; const int tq = c16 >> 2, tp = c16 & 3;
    const s16x4 lo = tr_read4(base + ((k0 + 8 * g4 + tq) * RST + c0 + 4 * tp) * 2);
    const s16x4 hi = tr_read4(base + ((k0 + 8 * g4 + 4 + tq) * RST + c0 + 4 * tp) * 2);
    bf16x8 r; r[0] = lo[0]; r[1] = lo[1]; r[2] = lo[2]; r[3] = lo[3]; r[4] = hi[0]; r[5] = hi[1]; r[6] = hi[2]; r[7] = hi[3]; return r;
}
__device__ __forceinline__ void st_tile(LAS bf16* M, const f32x4 v, int r0, int c0, int c16, int g4) {
#pragma unroll
    for (int rg = 0; rg < 4; rg += 2) { const unsigned p = pk2(v[rg], v[rg + 1]); M[(r0 + 4 * g4 + rg) * RST + c0 + c16] = (bf16)(p & 0xffffu); M[(r0 + 4 * g4 + rg + 1) * RST + c0 + c16] = (bf16)(p >> 16); }
}
#define MFMA16(a, b, c) __builtin_amdgcn_mfma_f32_16x16x32_bf16(a, b, c, 0, 0, 0)

struct RwkvBufs { const float* rkv; const float* lw; const float* av; bf16* P; float* QmT; bf16* Rt; float* Yi; float* bonus; };

#define R1_BAR() do { asm volatile("s_waitcnt lgkmcnt(0)" ::: "memory"); __builtin_amdgcn_s_barrier(); asm volatile("" ::: "memory"); } while (0)
struct R1In { float lwv[8], av[8], rr[9], kr[9], vr[9]; };
__device__ __forceinline__ void rwkv_r1_load(R1In& I, const RwkvBufs& B, int head, int chunk, int lane, int wave) {
    const int ch = head * RN + lane; const int t0 = chunk * 64 + wave * 8;
#pragma unroll
    for (int i = 0; i < 8; ++i) { I.lwv[i] = B.lw[(size_t)(t0 + i) * RW + ch]; I.av[i] = B.av[(size_t)(t0 + i) * RW + ch]; }
#pragma unroll
    for (int i = 0; i < 9; ++i) { const int t = t0 - 1 + i; if (t >= 0) { const float* cr = B.rkv + (size_t)t * (3 * RW) + ch; I.rr[i] = cr[0]; I.kr[i] = cr[RW]; I.vr[i] = cr[2 * RW]; } else { I.rr[i] = 0.f; I.kr[i] = 0.f; I.vr[i] = 0.f; } }
}
__device__ __forceinline__ void rwkv_r1_unit(LAS unsigned char* lds, const RwkvBufs& B, const float* const* in, R1In& I, int head, int chunk, int nhead, int nchunk, int tid, int lane, int wave) {
    LAS bf16* sA = (LAS bf16*)(lds + 0 * SLOTB); LAS bf16* sB = (LAS bf16*)(lds + 1 * SLOTB); LAS bf16* sK = (LAS bf16*)(lds + 2 * SLOTB); LAS bf16* sR = (LAS bf16*)(lds + 3 * SLOTB); LAS bf16* sV = (LAS bf16*)(lds + 4 * SLOTB);
    LAS bf16* sM0 = (LAS bf16*)(lds + 5 * SLOTB); LAS bf16* sM1 = (LAS bf16*)(lds + 6 * SLOTB); LAS bf16* sT0 = (LAS bf16*)(lds + 7 * SLOTB); LAS bf16* sT1 = (LAS bf16*)(lds + 8 * SLOTB);
    LAS bf16* sLak = (LAS bf16*)(lds + 9 * SLOTB); LAS bf16* sMrb = (LAS bf16*)(lds + 10 * SLOTB); LAS bf16* sMrk = (LAS bf16*)(lds + 11 * SLOTB); LAS bf16* sX = (LAS bf16*)(lds + 12 * SLOTB);
    LAS bf16* sW = (LAS bf16*)(lds + 13 * SLOTB); LAS bf16* sU = (LAS bf16*)(lds + 14 * SLOTB);
    LAS float* cs = (LAS float*)(lds + 15 * SLOTB); LAS float* gC = cs + 512;
    const int c16 = lane & 15, g4 = lane >> 4;
    {
        const int ch = head * RN + lane; const int t0 = chunk * 64 + wave * 8;
        const float mur = in[9][ch], muk = in[10][ch], muv = in[11][ch], kkc = in[23][ch], kac = in[24][ch], rkc = in[25][ch];
        float run = 0.f;
#pragma unroll
        for (int i = 0; i < 8; ++i) run += I.lwv[i];
        cs[wave * 64 + lane] = run;
        R1_BAR();
        float off = 0.f;
        for (int w = 0; w < wave; ++w) off += cs[w * 64 + lane];
        float gcur = off;
#pragma unroll
        for (int i = 0; i < 8; ++i) {
            const int t = t0 + i;
            const float r0 = I.rr[i + 1], k0 = I.kr[i + 1], v0 = I.vr[i + 1], rp = I.rr[i], kp = I.kr[i], vp = I.vr[i];
            const float r = r0 + (rp - r0) * mur, kx = k0 + (kp - k0) * muk, vx = v0 + (vp - v0) * muv;
            const float a = I.av[i];
            float kk = kx * kkc; const float ss = wave_sum(kk * kk); kk = kk * __builtin_amdgcn_rcpf(fmaxf(sqrtf(ss), 1e-12f));
            const float kt = kx * (1.0f + (a - 1.0f) * kac);
            const float bn = wave_sum(r * kt * rkc);
            if (lane == 0) B.bonus[(size_t)t * RH + head] = bn;
            const float gprev = gcur; gcur += I.lwv[i];
            const float eg = __expf(gcur), egp = __expf(gprev), eng = __expf(-gcur);
            const int tl = wave * 8 + i;
            { const unsigned pab = pk2(-kk * egp, kk * a * eng), pkr = pk2(kt * eng, r * eg), pv_ = pk2(vx, vx);
              sA[tl * RST + lane] = (bf16)(pab & 0xffffu); sB[tl * RST + lane] = (bf16)(pab >> 16); sK[tl * RST + lane] = (bf16)(pkr & 0xffffu); sR[tl * RST + lane] = (bf16)(pkr >> 16); sV[tl * RST + lane] = (bf16)(pv_ & 0xffffu); }
        }
        if (wave == 7) gC[lane] = __expf(gcur);
    }
    if (nhead >= 0) rwkv_r1_load(I, B, nhead, nchunk, lane, wave);
    R1_BAR();
    const int mt = wave >> 1, ntb = 2 * (wave & 1);
    f32x4 Treg[2];
    for (int r14 = 0; r14 < 1 + REP_R1A; ++r14) {
        f32x4 ab[2], ak[2], rb[2], rk[2];
#pragma unroll
        for (int n = 0; n < 2; ++n) { ab[n] = (f32x4){0.f, 0.f, 0.f, 0.f}; ak[n] = ab[n]; rb[n] = ab[n]; rk[n] = ab[n]; }
#pragma unroll
        for (int s = 0; s < 2; ++s) { const bf16x8 aA = frag_rows(sA, 16 * mt, 32 * s, c16, g4), aR = frag_rows(sR, 16 * mt, 32 * s, c16, g4);
#pragma unroll
            for (int n = 0; n < 2; ++n) { const bf16x8 bB = frag_rows(sB, 16 * (ntb + n), 32 * s, c16, g4), bK = frag_rows(sK, 16 * (ntb + n), 32 * s, c16, g4);
                ab[n] = MFMA16(aA, bB, ab[n]); ak[n] = MFMA16(aA, bK, ak[n]); rb[n] = MFMA16(aR, bB, rb[n]); rk[n] = MFMA16(aR, bK, rk[n]); } }
#pragma unroll
        for (int n = 0; n < 2; ++n) { const int i = 16 * (ntb + n) + c16;
#pragma unroll
            for (int rg = 0; rg < 4; ++rg) { const int t = 16 * mt + 4 * g4 + rg; const bool lo = i < t, le = i <= t;
                ab[n][rg] = lo ? ab[n][rg] : 0.f; ak[n][rg] = lo ? ak[n][rg] : 0.f; rb[n][rg] = le ? rb[n][rg] : 0.f; rk[n][rg] = le ? rk[n][rg] : 0.f;
                Treg[n][rg] = ab[n][rg] + (i == t ? 1.0f : 0.f); }
            st_tile(sM0, ab[n], 16 * mt, 16 * (ntb + n), c16, g4); st_tile(sT0, Treg[n], 16 * mt, 16 * (ntb + n), c16, g4);
            st_tile(sLak, ak[n], 16 * mt, 16 * (ntb + n), c16, g4); st_tile(sMrb, rb[n], 16 * mt, 16 * (ntb + n), c16, g4); st_tile(sMrk, rk[n], 16 * mt, 16 * (ntb + n), c16, g4); }
    }
    R1_BAR();
    LAS bf16* Tc = sT0; LAS bf16* Tn = sT1; LAS bf16* Mc = sM0; LAS bf16* Mn = sM1;
    {
        f32x4 am[2] = {(f32x4){0.f, 0.f, 0.f, 0.f}, (f32x4){0.f, 0.f, 0.f, 0.f}}, ax[2] = {(f32x4){0.f, 0.f, 0.f, 0.f}, (f32x4){0.f, 0.f, 0.f, 0.f}};
#pragma unroll
        for (int s = 0; s < 2; ++s) { const bf16x8 aM = frag_rows(Mc, 16 * mt, 32 * s, c16, g4), aL = frag_rows(sLak, 16 * mt, 32 * s, c16, g4);
#pragma unroll
            for (int n = 0; n < 2; ++n) { am[n] = MFMA16(aM, frag_cols(Mc, 16 * (ntb + n), 32 * s, c16, g4), am[n]); ax[n] = MFMA16(aL, frag_cols(sV, 16 * (ntb + n), 32 * s, c16, g4), ax[n]); } }
#pragma unroll
        for (int n = 0; n < 2; ++n) { st_tile(Mn, am[n], 16 * mt, 16 * (ntb + n), c16, g4); st_tile(sX, ax[n], 16 * mt, 16 * (ntb + n), c16, g4); }
        R1_BAR();
        LAS bf16* t2 = Mc; Mc = Mn; Mn = t2;
    }
    for (int kround = 1; kround <= 5 + REP_R1NR; ++kround) {
        f32x4 am[2] = {(f32x4){0.f, 0.f, 0.f, 0.f}, (f32x4){0.f, 0.f, 0.f, 0.f}};
#pragma unroll
        for (int s = 0; s < 2; ++s) { const bf16x8 aT = frag_rows(Tc, 16 * mt, 32 * s, c16, g4), aM = frag_rows(Mc, 16 * mt, 32 * s, c16, g4);
#pragma unroll
            for (int n = 0; n < 2; ++n) { const bf16x8 bM = frag_cols(Mc, 16 * (ntb + n), 32 * s, c16, g4); Treg[n] = MFMA16(aT, bM, Treg[n]); am[n] = MFMA16(aM, bM, am[n]); } }
#pragma unroll
        for (int n = 0; n < 2; ++n) { st_tile(Tn, Treg[n], 16 * mt, 16 * (ntb + n), c16, g4); st_tile(Mn, am[n], 16 * mt, 16 * (ntb + n), c16, g4); }
        R1_BAR();
        LAS bf16* t1 = Tc; Tc = Tn; Tn = t1; LAS bf16* t2 = Mc; Mc = Mn; Mn = t2;
    }
    for (int rwu = 0; rwu < 1 + REP_R1B; ++rwu) {
        f32x4 aw[2] = {(f32x4){0.f, 0.f, 0.f, 0.f}, (f32x4){0.f, 0.f, 0.f, 0.f}}, au[2] = {(f32x4){0.f, 0.f, 0.f, 0.f}, (f32x4){0.f, 0.f, 0.f, 0.f}};
#pragma unroll
        for (int s = 0; s < 2; ++s) { const bf16x8 aT = frag_rows(Tc, 16 * mt, 32 * s, c16, g4);
#pragma unroll
            for (int n = 0; n < 2; ++n) { aw[n] = MFMA16(aT, frag_cols(sA, 16 * (ntb + n), 32 * s, c16, g4), aw[n]); au[n] = MFMA16(aT, frag_cols(sX, 16 * (ntb + n), 32 * s, c16, g4), au[n]); } }
#pragma unroll
        for (int n = 0; n < 2; ++n) { st_tile(sW, aw[n], 16 * mt, 16 * (ntb + n), c16, g4); st_tile(sU, au[n], 16 * mt, 16 * (ntb + n), c16, g4); }
    }
    R1_BAR();
    for (int rs8 = 0; rs8 < 1 + REP_R1C; ++rs8) {
        const size_t ub = (size_t)(head * NCH + chunk) * 4096;
        f32x4 pp[2], qq[2], rr[2], yy[2];
#pragma unroll
        for (int n = 0; n < 2; ++n) { pp[n] = (f32x4){0.f, 0.f, 0.f, 0.f}; qq[n] = pp[n]; rr[n] = pp[n]; yy[n] = pp[n]; }
#pragma unroll
        for (int s = 0; s < 2; ++s) {
            const bf16x8 cW = frag_cols(sW, 16 * mt, 32 * s, c16, g4), cB = frag_cols(sB, 16 * mt, 32 * s, c16, g4), cK = frag_cols(sK, 16 * mt, 32 * s, c16, g4), cU = frag_cols(sU, 16 * mt, 32 * s, c16, g4), cV = frag_cols(sV, 16 * mt, 32 * s, c16, g4);
#pragma unroll
            for (int n = 0; n < 2; ++n) { const int c0 = 16 * (ntb + n);
                const bf16x8 bB = frag_cols(sB, c0, 32 * s, c16, g4), bU = frag_cols(sU, c0, 32 * s, c16, g4), bV = frag_cols(sV, c0, 32 * s, c16, g4);
                const bf16x8 rMrb = frag_rows(sMrb, c0, 32 * s, c16, g4), rMrk = frag_rows(sMrk, c0, 32 * s, c16, g4);
                pp[n] = MFMA16(cW, bB, pp[n]);
                qq[n] = MFMA16(cB, bU, qq[n]); qq[n] = MFMA16(cK, bV, qq[n]);
                rr[n] = MFMA16(cW, rMrb, rr[n]);
                yy[n] = MFMA16(cU, rMrb, yy[n]); yy[n] = MFMA16(cV, rMrk, yy[n]); } }
#pragma unroll
        for (int n = 0; n < 2; ++n) { const int j = 16 * (ntb + n) + c16; const int i0 = 16 * mt + 4 * g4;
            {
                const float gc = gC[j]; float o[4];
#pragma unroll
                for (int rg = 0; rg < 4; ++rg) o[rg] = gc * (pp[n][rg] + ((i0 + rg) == j ? 1.0f : 0.f));
                u32x2 w; w.x = pk2(o[0], o[1]); w.y = pk2(o[2], o[3]); *(u32x2*)(B.P + ub + (size_t)j * 64 + i0) = w; }
            {
                f32x4 o;
#pragma unroll
                for (int rg = 0; rg < 4; ++rg) o[rg] = gC[i0 + rg] * qq[n][rg];
                *(f32x4*)(B.QmT + ub + (size_t)j * 64 + i0) = o; }
            {
                const u32x2 rb2 = *(const LAS u32x2*)(sR + j * RST + i0); float o[4];
                o[0] = rr[n][0] + __uint_as_float(rb2.x << 16); o[1] = rr[n][1] + __uint_as_float(rb2.x & 0xffff0000u); o[2] = rr[n][2] + __uint_as_float(rb2.y << 16); o[3] = rr[n][3] + __uint_as_float(rb2.y & 0xffff0000u);
                u32x2 w; w.x = pk2(o[0], o[1]); w.y = pk2(o[2], o[3]); *(u32x2*)(B.Rt + ub + (size_t)j * 64 + i0) = w; }
            *(f32x4*)(B.Yi + ub + (size_t)j * 64 + i0) = yy[n];
        }
    }
    R1_BAR();
}

constexpr int R2_PST = 136, R2_QST = 272, R2_QOFF = 64 * R2_PST, R2_SLOT = R2_QOFF + 16 * R2_QST;
__device__ __forceinline__ void rwkv_r2_wg(LAS unsigned char* lds, const bf16* __restrict__ P, const float* __restrict__ QmT, bf16* __restrict__ H0T, int head, int cg, int wave, int lane) {
    const int c16 = lane & 15, g4 = lane >> 4;
    const int lt = ((wave & 3) << 6) | lane;
#define R2_BAR() do { asm volatile("s_waitcnt lgkmcnt(0)" ::: "memory"); __builtin_amdgcn_s_barrier(); asm volatile("" ::: "memory"); } while (0)
    if (wave >= 4) {
        constexpr int NST = 8;
        u32x4 st[NST][3];
        auto gl = [&](int c, u32x4 (&r)[3]) { const size_t ub = (size_t)(head * NCH + c) * 4096;
            const u32x4* p = (const u32x4*)(P + ub); const u32x4* q = (const u32x4*)(QmT + ub + (size_t)(16 * cg) * 64);
            r[0] = p[lt]; r[1] = p[lt + 256]; r[2] = q[lt]; };
        auto lw = [&](int slot, const u32x4 (&r)[3]) { LAS unsigned char* s = lds + slot * R2_SLOT;
#pragma unroll
            for (int i = 0; i < 2; ++i) { const int idx = lt + 256 * i; LAS u32x2* d = (LAS u32x2*)(s + (idx >> 3) * R2_PST + (idx & 7) * 16); u32x2 a; a.x = r[i].x; a.y = r[i].y; u32x2 b; b.x = r[i].z; b.y = r[i].w; d[0] = a; d[1] = b; }
            *(LAS u32x4*)(s + R2_QOFF + (lt >> 4) * R2_QST + (lt & 15) * 16) = r[2]; };
#pragma unroll
        for (int j = 0; j < NST; ++j) gl(j, st[j]);
        lw(0, st[0]); gl(NST, st[0]);
        R2_BAR();
        for (int c4 = 0; c4 < NCH / NST; ++c4) {
#pragma unroll
            for (int j = 0; j < NST; ++j) { const int c = NST * c4 + j;
                if (c + 1 < NCH) lw((c + 1) & 1, st[(j + 1) % NST]);
                if (c + 1 + NST < NCH) gl(c + 1 + NST, st[(j + 1) % NST]);
                R2_BAR(); }
        }
    } else if (wave == 0) {
        f32x4 hacc[4];
#pragma unroll
        for (int m = 0; m < 4; ++m) hacc[m] = (f32x4){0.f, 0.f, 0.f, 0.f};
        R2_BAR();
        for (int c = 0; c < NCH; ++c) {
            const LAS unsigned char* s = lds + (c & 1) * R2_SLOT; const size_t ub = (size_t)(head * NCH + c) * 4096;
            bf16x8 af[4][2]; f32x4 qv[4];
#pragma unroll
            for (int m = 0; m < 4; ++m) { qv[m] = *(const LAS f32x4*)(s + R2_QOFF + c16 * R2_QST + (16 * m + 4 * g4) * 4);
#pragma unroll
                for (int sx = 0; sx < 2; ++sx) { const LAS unsigned char* pr = s + (16 * m + c16) * R2_PST + (32 * sx + 4 * g4) * 2; const u32x2 a = *(const LAS u32x2*)pr, b = *(const LAS u32x2*)(pr + 32);
                    u32x4 w; w.x = a.x; w.y = a.y; w.z = b.x; w.w = b.y; af[m][sx] = __builtin_bit_cast(bf16x8, w); } }
            bf16x8 bfr[2];
#pragma unroll
            for (int sx = 0; sx < 2; ++sx) { u32x4 w; w.x = pk2(hacc[2 * sx][0], hacc[2 * sx][1]); w.y = pk2(hacc[2 * sx][2], hacc[2 * sx][3]); w.z = pk2(hacc[2 * sx + 1][0], hacc[2 * sx + 1][1]); w.w = pk2(hacc[2 * sx + 1][2], hacc[2 * sx + 1][3]);
                bfr[sx] = __builtin_bit_cast(bf16x8, w);
                u32x2 h0; h0.x = w.x; h0.y = w.y; *(u32x2*)(H0T + ub + (size_t)(16 * cg + c16) * 64 + 16 * (2 * sx) + 4 * g4) = h0;
                u32x2 h1; h1.x = w.z; h1.y = w.w; *(u32x2*)(H0T + ub + (size_t)(16 * cg + c16) * 64 + 16 * (2 * sx + 1) + 4 * g4) = h1; }
#pragma unroll
            for (int m = 0; m < 4; ++m) { hacc[m] = MFMA16(af[m][0], bfr[0], qv[m]); hacc[m] = MFMA16(af[m][1], bfr[1], hacc[m]); }
            R2_BAR();
        }
    } else {
        for (int c = 0; c <= NCH; ++c) R2_BAR();
    }
#undef R2_BAR
}

__device__ __forceinline__ void rwkv_r3_wave(const RwkvBufs& B, const bf16* __restrict__ H0T, const float* const* in, const float* __restrict__ gv, bf16* __restrict__ ocat, int head, int chunk, int nt, int lane) {
    const int c16 = lane & 15, g4 = lane >> 4; const size_t ub = (size_t)(head * NCH + chunk) * 4096;
    const int t = chunk * 64 + 16 * nt + c16;
    bf16x8 rf[2], hf[4][2]; f32x4 y[4], gw[4], gb[4], muv[4], gg[4], v0[4], vp[4];
#pragma unroll
    for (int s = 0; s < 2; ++s) rf[s] = *(const bf16x8*)(B.Rt + ub + (size_t)(16 * nt + c16) * 64 + 32 * s + 8 * g4);
#pragma unroll
    for (int m = 0; m < 4; ++m) { y[m] = *(const f32x4*)(B.Yi + ub + (size_t)(16 * nt + c16) * 64 + 16 * m + 4 * g4);
#pragma unroll
        for (int s = 0; s < 2; ++s) hf[m][s] = *(const bf16x8*)(H0T + ub + (size_t)(16 * m + c16) * 64 + 32 * s + 8 * g4); }
    const float bn = B.bonus[(size_t)t * RH + head];
#pragma unroll
    for (int m = 0; m < 4; ++m) { const int ch = head * RN + 16 * m + 4 * g4;
        gw[m] = *(const f32x4*)(in[26] + ch); gb[m] = *(const f32x4*)(in[27] + ch); muv[m] = *(const f32x4*)(in[11] + ch); gg[m] = *(const f32x4*)(gv + (size_t)t * RW + ch);
        v0[m] = *(const f32x4*)(B.rkv + (size_t)t * (3 * RW) + 2 * RW + ch); vp[m] = (f32x4){0.f, 0.f, 0.f, 0.f}; if (t > 0) vp[m] = *(const f32x4*)(B.rkv + (size_t)(t - 1) * (3 * RW) + 2 * RW + ch); }
    float s1 = 0.f;
#pragma unroll
    for (int m = 0; m < 4; ++m) {
#pragma unroll
        for (int s = 0; s < 2; ++s) y[m] = MFMA16(hf[m][s], rf[s], y[m]);
        s1 += (y[m][0] + y[m][1]) + (y[m][2] + y[m][3]); }
    s1 += __shfl_xor(s1, 16); s1 += __shfl_xor(s1, 32);
    const float mean = s1 * (1.0f / 64.0f); float s2 = 0.f;
#pragma unroll
    for (int m = 0; m < 4; ++m) { y[m] = y[m] - mean; s2 += (y[m][0] * y[m][0] + y[m][1] * y[m][1]) + (y[m][2] * y[m][2] + y[m][3] * y[m][3]); }
    s2 += __shfl_xor(s2, 16); s2 += __shfl_xor(s2, 32);
    const float rstd = rsqrtf(s2 * (1.0f / 64.0f) + 64e-5f);
#pragma unroll
    for (int m = 0; m < 4; ++m) { const int ch = head * RN + 16 * m + 4 * g4;
        const f32x4 vx = v0[m] + (vp[m] - v0[m]) * muv[m];
        const f32x4 o = (y[m] * rstd * gw[m] + gb[m] + vx * bn) * gg[m];
        u32x2 w; w.x = pk2(o[0], o[1]); w.y = pk2(o[2], o[3]); *(u32x2*)(ocat + (size_t)t * (2 * RW) + RW + ch) = w; }
}
template <int WHICH> struct Lora2Order { int G, c;
    __device__ bool next(int i, pg8::Unit& u) const { const int L = i * G + c; if (L >= (S / 128) * 4) return false; u.pm = L >> 2; u.pn = WHICH * 4 + (L & 3); u.koff = WHICH * 512; u.koffB = 0; return true; }
    __device__ __forceinline__ void a_ready(const pg8::Unit&) const {}
    __device__ __forceinline__ void done(const pg8::Unit&) const {} };
template <int WHICH> struct EpiLora2 {
    static constexpr bool PERM = true, AFTER_DRAIN = false, MIDK = false;
    float* dst; const float* bias;
    __device__ __forceinline__ void operator()(const pg8::f32x4 (&acc)[2][2][4][2], const pg8::Unit& u, int wr, int wc, int fr, int fq) const {
        const int row0 = u.pm * 128 + wr * 64 + fr; const int col0 = (u.pn & 3) * 256 + wc * 32 + 8 * fq;
#pragma unroll
        for (int ai = 0; ai < 1; ++ai)
#pragma unroll
            for (int m = 0; m < 4; ++m) { float* p = dst + (size_t)(row0 + ai * 128 + m * 16) * RW + col0;
#pragma unroll
                for (int bj = 0; bj < 2; ++bj) { f32x4 v0 = acc[ai][bj][m][0], v1 = acc[ai][bj][m][1];
                    if (WHICH < 2) { const f32x4 b0 = *(const f32x4*)(bias + col0 + bj * 128), b1 = *(const f32x4*)(bias + col0 + bj * 128 + 4);
#pragma unroll
                        for (int j = 0; j < 4; ++j) { v0[j] = sigmoidf_(v0[j] + b0[j]); v1[j] = sigmoidf_(v1[j] + b1[j]); }
                        if (WHICH == 0) { v0 = v0 * -0.60653065971263342f; v1 = v1 * -0.60653065971263342f; } }
                    *(f32x4*)(p + bj * 128) = v0; *(f32x4*)(p + bj * 128 + 4) = v1; } }
    }
};

__global__ void __launch_bounds__(NTHR, 2) fwd(Args args) {
    extern __shared__ __attribute__((aligned(16))) unsigned char lds_raw[];
    LAS unsigned char* lds = (LAS unsigned char*)lds_raw;
    const int wave = __builtin_amdgcn_readfirstlane(threadIdx.x >> 6);
    const int G = gridDim.x, wg = blockIdx.x;
    unsigned char* ws = args.ws;
    unsigned* ctl = (unsigned*)(ws + WS_CTL);
    if (threadIdx.x < 4) ((LAS unsigned*)(lds + LDSCTL_OFF))[threadIdx.x] = 0u;
    __syncthreads();
    XcdBarrier bar = xcd_barrier_post(ctl + CW_BAR, (volatile LAS unsigned*)(lds + LDSCTL_OFF));
    const int lo = args.ph_lo, hi = args.ph_hi;
#define IN(k) (lo <= (k) && (k) < hi)
#define PH(k) for (int rep_ = 0; rep_ < ((k) == REP_PHASE ? 1 + REP_N : 1); ++rep_) if (IN(k))
#define SEAM(k) do { if (IN(k) && IN((k) + 1)) xcd_barrier(bar); } while (0)
    const int gw = wg * NWAVES + wave, NGW = G * NWAVES;

    const float* x = args.in[0];
    float* ada = (float*)(ws + WS_ADA); float* rope = (float*)(ws + WS_ROPE);
    bf16* h = (bf16*)(ws + WS_H); bf16* W1t = (bf16*)(ws + WS_W1T); bf16* Wupt = (bf16*)(ws + WS_WUPT); bf16* Wot = (bf16*)(ws + WS_WOT);
    unsigned char* Wgut = ws + WS_WGUT; unsigned char* Wdt = ws + WS_WDT;

    PH(0) { const int lane = lane_fresh(); const int tid = (wave << 6) | lane; (void)tid; (void)lane;
        {
            const float* c = args.in[1]; const float* w_ada = args.in[2]; const float* b_ada = args.in[3];
            LAS float* red = (LAS float*)lds;
            for (int u = wg; u < 6 * D / 64; u += G) {
                const int n = u * 64 + lane; float s = 0.f;
#pragma unroll 8
                for (int kq = wave; kq < D; kq += NWAVES) s += c[kq] * w_ada[(size_t)kq * (6 * D) + n];
                red[wave * 64 + lane] = s;
                __syncthreads();
                if (wave == 0) { float t = b_ada[n]; for (int w = 0; w < NWAVES; ++w) t += red[w * 64 + lane]; ada[n] = t; }
                __syncthreads();
            }
        }
        for (int i = wg * NTHR + tid; i < S * 16; i += G * NTHR) {
            const int pos = i >> 4, j = i & 15; const float inv = powf(500000.0f, -(float)j / 16.0f); const float ang = (float)pos * inv;
            rope[2 * i] = cosf(ang); rope[2 * i + 1] = sinf(ang);
        }
        for (int i = wg * NTHR + tid; i < 128 * D / 8; i += G * NTHR) ((u32x4*)(W1t + (size_t)(N1 - 128) * D))[i] = (u32x4){0u, 0u, 0u, 0u};
        {
            bf16* wrh = (bf16*)(ws + WS_WR); bf16* wrl = wrh + 80 * D; const float* w_rg = args.in[31]; const float* w_re = args.in[33];
            for (int i = wg * NTHR + tid; i < 80 * D; i += G * NTHR) { const int n = i / D, kq = i % D; const float v = n < NG ? w_rg[kq * NG + n] : (n < NG + NE ? w_re[kq * NE + n - NG] : 0.f);
                const bf16 hi = f2bf(v); wrh[i] = hi; wrl[i] = f2bf(v - bf2f(hi)); }
        }
        {
            bf16* wl2 = (bf16*)(ws + WS_WL2); const float* w_w2 = args.in[17]; const float* w_a2 = args.in[20]; const float* w_g2 = args.in[22];
            for (int i = wg * NTHR + tid; i < 3 * RW * 256; i += G * NTHR) { const int n = i >> 8, kq = i & 255, which = n / RW, cc = n % RW; float v = 0.f;
                if (which == 0) { if (kq < LW) v = w_w2[kq * RW + cc]; } else if (which == 1) { if (kq < LA) v = w_a2[kq * RW + cc]; } else v = w_g2[kq * RW + cc];
                wl2[i] = f2bf(v); }
        }
        LAS float* scr = (LAS float*)(lds + wave * 16384);
        constexpr int I_W = (D / 64) * (LW / 32), I_A = (D / 64) * (LA / 32), I_G = (D / 64) * (LG / 32);
        constexpr int NIT = 2 * (I_W + I_A + I_G);
        for (int it = gw; it < NIT; it += NGW) {
            int r = it, k0, n0;
            if (r < 2 * I_W) { const int md = 1 + r / I_W; item_kn(r % I_W, LW, k0, n0); tr_item(args.in[16], LW, k0, n0, W1t + (size_t)(INW + (md - 1) * LO + n0) * D + k0, D, args.in[12], md, scr, lane); continue; } r -= 2 * I_W;
            if (r < 2 * I_A) { const int md = 1 + r / I_A; item_kn(r % I_A, LA, k0, n0); tr_item(args.in[19], LA, k0, n0, W1t + (size_t)(INW + (md - 1) * LO + LW + n0) * D + k0, D, args.in[13], md, scr, lane); continue; } r -= 2 * I_A;
            const int md = 1 + r / I_G; item_kn(r % I_G, LG, k0, n0); tr_item(args.in[21], LG, k0, n0, W1t + (size_t)(INW + (md - 1) * LO + LW + LA + n0) * D + k0, D, args.in[14], md, scr, lane);
        }
        __syncthreads();
        {
            const int lr = tid >> 5, c4 = tid & 31, nl = lane & 15, kq = lane >> 4, ncol = 16 * wave + nl;
            f32x4 v[8]; int T = wg;
            if (T < CT_ALL) { const ConvTile t = conv_decode(T, args.in, ws);
#pragma unroll
                for (int i = 0; i < 8; ++i) v[i] = *(const f32x4*)(t.src + (size_t)(lr + 16 * i) * t.ldw + 4 * c4); }
            for (int itc = 0; T < CT_ALL; T += G, ++itc) {
                LAS float* buf = (LAS float*)(lds + (itc & 1) * 69632);
#pragma unroll
                for (int i = 0; i < 8; ++i) *(LAS f32x4*)(buf + conv_off(lr + 16 * i, 4 * c4)) = v[i];
                const ConvTile t = conv_decode(T, args.in, ws);
                if (T + G < CT_ALL) { const ConvTile tn = conv_decode(T + G, args.in, ws);
#pragma unroll
                    for (int i = 0; i < 8; ++i) v[i] = *(const f32x4*)(tn.src + (size_t)(lr + 16 * i) * tn.ldw + 4 * c4); }
                R1_BAR();
                float xv[32];
#pragma unroll
                for (int j = 0; j < 32; ++j) xv[j] = buf[conv_off(32 * kq + j, ncol)];
                if (t.kind) { unsigned char* d = t.dst + (size_t)ncol * t.rs + 32 * kq;
                    u32x4 o0, o1; o0.x = pk_fp8x4(xv[0], xv[1], xv[2], xv[3], t.sc); o0.y = pk_fp8x4(xv[4], xv[5], xv[6], xv[7], t.sc); o0.z = pk_fp8x4(xv[8], xv[9], xv[10], xv[11], t.sc); o0.w = pk_fp8x4(xv[12], xv[13], xv[14], xv[15], t.sc);
                    o1.x = pk_fp8x4(xv[16], xv[17], xv[18], xv[19], t.sc); o1.y = pk_fp8x4(xv[20], xv[21], xv[22], xv[23], t.sc); o1.z = pk_fp8x4(xv[24], xv[25], xv[26], xv[27], t.sc); o1.w = pk_fp8x4(xv[28], xv[29], xv[30], xv[31], t.sc);
                    *(u32x4*)d = o0; *(u32x4*)(d + 16) = o1; }
                else { unsigned char* d = t.dst + (size_t)ncol * t.rs + 64 * kq;
#pragma unroll
                    for (int q = 0; q < 4; ++q) { u32x4 o; o.x = pk2(xv[8 * q], xv[8 * q + 1]); o.y = pk2(xv[8 * q + 2], xv[8 * q + 3]); o.z = pk2(xv[8 * q + 4], xv[8 * q + 5]); o.w = pk2(xv[8 * q + 6], xv[8 * q + 7]); *(u32x4*)(d + 16 * q) = o; } }
            }
            __syncthreads();
        }
    }
    SEAM(0);
    PH(1) { const int lane = lane_fresh(); const int tid = (wave << 6) | lane; (void)tid; (void)lane;
        const float* g = args.in[4]; const float* sh1 = ada; const float* sc1 = ada + D;
        f32x4 gs[8], sh[8];
#pragma unroll
        for (int j = 0; j < 8; ++j) { const int c = 4 * lane + 256 * j; const f32x4 gg = *(const f32x4*)(g + c), ss = *(const f32x4*)(sc1 + c); gs[j] = gg * (ss + 1.0f); sh[j] = *(const f32x4*)(sh1 + c); }
        for (int rb = gw; rb < S; rb += 2 * NGW) {
            f32x4 v[2][8]; float s[2] = {0.f, 0.f};
#pragma unroll
            for (int q = 0; q < 2; ++q) { const f32x4* xr = (const f32x4*)(x + (size_t)(rb + q * NGW) * D) + lane;
#pragma unroll
                for (int j = 0; j < 8; ++j) v[q][j] = xr[64 * j]; }
#pragma unroll
            for (int q = 0; q < 2; ++q)
#pragma unroll
                for (int j = 0; j < 8; ++j) s[q] += (v[q][j].x * v[q][j].x + v[q][j].y * v[q][j].y) + (v[q][j].z * v[q][j].z + v[q][j].w * v[q][j].w);
            float r[2]; r[0] = rsqrtf(wave_sum(s[0]) * (1.0f / D) + 1e-6f); r[1] = rsqrtf(wave_sum(s[1]) * (1.0f / D) + 1e-6f);
#pragma unroll
            for (int q = 0; q < 2; ++q) { u32x2* o = (u32x2*)(h + (size_t)(rb + q * NGW) * D) + lane;
#pragma unroll
                for (int j = 0; j < 8; ++j) { const f32x4 t = v[q][j] * r[q] * gs[j] + sh[j]; u32x2 w; w.x = pk2(t.x, t.y); w.y = pk2(t.z, t.w); o[64 * j] = w; } }
        }
    }
    SEAM(1);
    PH(2) { const int lane = lane_fresh(); const int tid = (wave << 6) | lane; (void)tid; (void)lane;
        EpiProj E{(bf16*)(ws + WS_Q), (bf16*)(ws + WS_K), (bf16*)(ws + WS_V), (float*)(ws + WS_RKV), (bf16*)(ws + WS_GATE), (float*)(ws + WS_LORA), (float*)(ws + WS_LORAB), rope};
        { pg8::Gemm g{h, W1t, S, INW, D, D, D}; pg8::StaticOrder So; So.init(S, INW, G, wg);
          pg8::gemm_phase<EpiProj, pg8::StaticOrder, true, true>(lds, g, So, E); }
        { int ld_ = D; asm volatile("" : "+s"(ld_)); pg8::Gemm g{h, W1t, S, N1, AW, ld_, ld_}; LoraOrder So{G, wg};
          pg8::gemm_phase<EpiProj, LoraOrder, true, true>(lds, g, So, E); }
    }
    SEAM(2);

    bf16* qb = (bf16*)(ws + WS_Q); bf16* kb = (bf16*)(ws + WS_K); bf16* vb = (bf16*)(ws + WS_V);
    bf16* kmh = (bf16*)(ws + WS_KMEAN); bf16* kml = kmh + AH * NB * AD;
    AttnBufs AB{qb, kb, vb, kmh, kml, (unsigned*)(ws + WS_AMASK), (int*)(ws + WS_ALIST), (int*)ctl + CW_ACNT, (bf16*)(ws + WS_APART), (float*)(ws + WS_AML)};
    PH(3) { const int lane = lane_fresh(); const int tid = (wave << 6) | lane; (void)tid; (void)lane;
        for (int hb = wg; hb < AH * NB; hb += G) { const int hd = hb / NB, bk = hb % NB; LAS float* red = (LAS float*)lds;
            float s0 = 0.f, s1 = 0.f; const unsigned* src = (const unsigned*)(kb + (size_t)(bk * MB + wave * 32) * AW + hd * AD) + lane;
#pragma unroll 8
            for (int r = 0; r < 32; ++r) { const unsigned w2 = src[(size_t)r * (AW / 2)]; s0 += __uint_as_float(w2 << 16); s1 += __uint_as_float(w2 & 0xffff0000u); }
            red[wave * 128 + 2 * lane] = s0; red[wave * 128 + 2 * lane + 1] = s1;
            __syncthreads();
            if (tid < AD) { float s = 0.f;
#pragma unroll
                for (int w = 0; w < 8; ++w) s += red[w * 128 + tid];
                s *= (1.0f / MB); const bf16 hi = f2bf(s); kmh[hb * AD + tid] = hi; kml[hb * AD + tid] = f2bf(s - bf2f(hi)); }
            __syncthreads();
        }
        {
            const float* lora = (const float*)(ws + WS_LORA); bf16* al2 = (bf16*)(ws + WS_AL2);
#pragma unroll 4
            for (int i = wg * NTHR + tid; i < S * 768; i += G * NTHR) { const int t = i / 768, j = i % 768, which = j >> 8, jj = j & 255; float v = 0.f;
                const int src = which == 0 ? jj : (which == 1 ? LW + jj : LW + LA + jj); const bool real = which == 2 || jj < LW;
                if (real) { const float* lb = (const float*)(ws + WS_LORAB); v = lora[(size_t)t * 1024 + src] + lb[(size_t)t * 1024 + src] + (t > 0 ? lora[(size_t)(t - 1) * 1024 + LO + src] + lb[(size_t)(t - 1) * 1024 + LO + src] : 0.f); if (which == 0) v = 1.0f - 2.0f / (1.0f + __expf(2.0f * v)); else if (which == 2) v = sigmoidf_(v); }
                al2[i] = f2bf(v); }
        }
    }
    SEAM(3);
    PH(4) { const int lane = lane_fresh(); const int tid = (wave << 6) | lane; (void)tid; (void)lane;
#define L2CALL(W, DST, BIAS, CID) { int lda_ = 768; asm volatile("" : "+s"(lda_)); pg8::Gemm g{(const bf16*)(ws + WS_AL2), (const bf16*)(ws + WS_WL2), S, 3 * RW, 256, lda_, 256}; \
            Lora2Order<W> So{G, CID}; EpiLora2<W> E{DST, BIAS}; pg8::gemm_phase<EpiLora2<W>, Lora2Order<W>, true, true, 0, true>(lds, g, So, E); }
        L2CALL(0, (float*)(ws + WS_LW), args.in[15], wg)
        L2CALL(1, (float*)(ws + WS_A), args.in[18], wg)
        L2CALL(2, (float*)(ws + WS_G), nullptr, wg)
#undef L2CALL
        for (int u = wg; u < AH * 64; u += G) moba_select_unit(lds, AB, u >> 6, u & 63, tid, lane, wave);
    }
    SEAM(4);
    RwkvBufs RB{(const float*)(ws + WS_RKV), (const float*)(ws + WS_LW), (const float*)(ws + WS_A), (bf16*)(ws + WS_RWP), (float*)(ws + WS_RWQ), (bf16*)(ws + WS_RWR), (float*)(ws + WS_RWY), (float*)(ws + WS_RWB)};
    bf16* H0T = (bf16*)(ws + WS_RWH);
    PH(5) { const int lane = lane_fresh(); const int tid = (wave << 6) | lane; (void)tid; (void)lane; R1In I; if (wg < RH * NCH) rwkv_r1_load(I, RB, wg / NCH, wg % NCH, lane, wave);
        for (int u = wg; u < RH * NCH; u += G) { const int un = u + G; rwkv_r1_unit(lds, RB, args.in, I, u / NCH, u % NCH, un < RH * NCH ? un / NCH : -1, un % NCH, tid, lane, wave); } }
    SEAM(5);
    PH(7) { const int lane = lane_fresh(); const int tid = (wave << 6) | lane; (void)tid; (void)lane;
        if (wg < RH * 4) { for (int rsc = 0; rsc < 1 + REP_SCAN; ++rsc) { rwkv_r2_wg(lds, RB.P, RB.QmT, H0T, wg >> 2, wg & 3, wave, lane); __syncthreads(); } }
        LAS int* pre = (LAS int*)(lds + AT_ITEMS); LAS int* tick = pre + 260;
        if (tid < 256) pre[1 + tid] = (AB.cnt[tid] + 255) >> 8;
        __syncthreads();
        if (wave == 0) {
            int v0 = pre[1 + 4 * lane], v1 = pre[2 + 4 * lane], v2 = pre[3 + 4 * lane], v3 = pre[4 + 4 * lane]; v1 += v0; v2 += v1; v3 += v2; int tot = v3;
#pragma unroll
            for (int o = 1; o < 64; o <<= 1) { const int t = __shfl_up(tot, o); if (lane >= o) tot += t; }
            const int ex = tot - v3; pre[1 + 4 * lane] = ex + v0; pre[2 + 4 * lane] = ex + v1; pre[3 + 4 * lane] = ex + v2; pre[4 + 4 * lane] = ex + v3;
            if (lane == 0) pre[0] = 0; }
        __syncthreads();
        moba_items(lds, AB, (int*)ctl + CW_AQ + rep_, pre, tick, tid, lane, wave);
    }
    SEAM(7);
    PH(8) { const int lane = lane_fresh(); const int tid = (wave << 6) | lane; (void)tid; (void)lane; for (int u = wg * 2 + (wave >> 2); u < RH * NCH; u += 2 * G) rwkv_r3_wave(RB, H0T, args.in, (const float*)(ws + WS_G), (bf16*)(ws + WS_OCAT), u / NCH, u % NCH, wave & 3, lane);
#pragma unroll 2
        for (int i = wg * NTHR + tid; i < AH * S * 16; i += G * NTHR) { const int c8 = i & 15, hq = i >> 4, hh = hq / S, qq = hq % S;
            const unsigned mk = AB.mask[hq]; const f32x4 ml0 = *(const f32x4*)(AB.ml + (size_t)hq * 8), ml1 = *(const f32x4*)(AB.ml + (size_t)hq * 8 + 4);
            u32x4 pr[4];
#pragma unroll
            for (int s = 0; s < 4; ++s) pr[s] = *(const u32x4*)(AB.part + ((size_t)hq * 4 + s) * AD + 8 * c8);
            const int ns = 1 + __builtin_popcount(mk);
            const float m_[4] = {ml0[0], ml0[2], ml1[0], ml1[2]}, l_[4] = {ml0[1], ml0[3], ml1[1], ml1[3]};
            float mx = m_[0];
#pragma unroll
            for (int s = 1; s < 4; ++s) mx = (s < ns) ? fmaxf(mx, m_[s]) : mx;
            float wv[4]; float wsum = 0.f;
#pragma unroll
            for (int s = 0; s < 4; ++s) { wv[s] = s < ns ? l_[s] * __builtin_amdgcn_exp2f(m_[s] - mx) : 0.f; wsum += wv[s]; }
            const float inv = 1.0f / wsum; float o[8] = {0.f, 0.f, 0.f, 0.f, 0.f, 0.f, 0.f, 0.f};
#pragma unroll
            for (int s = 0; s < 4; ++s) { float pv[8]; unpack8(pr[s], pv); const float ws_ = wv[s] * inv;
#pragma unroll
                for (int j = 0; j < 8; ++j) o[j] += (s < ns) ? ws_ * pv[j] : 0.f; }
            u32x4 w; w.x = pk2(o[0], o[1]); w.y = pk2(o[2], o[3]); w.z = pk2(o[4], o[5]); w.w = pk2(o[6], o[7]);
            *(u32x4*)((bf16*)(ws + WS_OCAT) + (size_t)qq * (2 * AW) + hh * AD + 8 * c8) = w; }
    }
    SEAM(8);

    bf16* ocat = (bf16*)(ws + WS_OCAT); bf16* gate = (bf16*)(ws + WS_GATE); bf16* mix = (bf16*)(ws + WS_MIX); bf16* y = (bf16*)(ws + WS_Y); bf16* x1 = (bf16*)(ws + WS_X1);     unsigned char* h2 = ws + WS_H2;
    int* eidx = (int*)(ws + WS_ROUTE); float* ew = (float*)(ws + WS_ROUTE + 65536); int* slot = (int*)(ws + WS_ROUTE + 131072);
    int* tok = (int*)(ws + WS_TOK); int* tile_e = (int*)(ws + WS_TOK + 131072);
    unsigned char* xbuf = ws + WS_XBUF; unsigned char* hid = ws + WS_HID; bf16* ybuf = (bf16*)(ws + WS_YBUF);
    PH(9) { const int lane = lane_fresh(); const int tid = (wave << 6) | lane; (void)tid; (void)lane;
        pg8::Gemm g{ocat, Wupt, S, D, AW, D, D}; MixOrder So{G, wg};
        EpiMix E{gate, mix};
        pg8::gemm_phase<EpiMix, MixOrder, true, true>(lds, g, So, E);
    }
    SEAM(9);
    PH(10) { const int lane = lane_fresh(); const int tid = (wave << 6) | lane; (void)tid; (void)lane;
        pg8::Gemm g{mix, Wot, S, D, D, D, D}; pg8::StaticOrder So; So.init(S, D, G, wg);
        EpiBf16P E{y, D};
        pg8::gemm_phase<EpiBf16P, pg8::StaticOrder, true, true>(lds, g, So, E);
    }
    SEAM(10);
    PH(11) { const int lane = lane_fresh(); const int tid = (wave << 6) | lane; (void)tid; (void)lane;
        const float* gpost = args.in[5]; const float* gpre2 = args.in[6]; const float* gt1 = ada + 2 * D; const float* sh2 = ada + 3 * D; const float* sc2 = ada + 4 * D;
        const bf16* wrh = (const bf16*)(ws + WS_WR); const bf16* wrl = wrh + 80 * D; const float* b_rg = args.in[32]; const float* b_re = args.in[34];
        LAS bf16* Ah = (LAS bf16*)lds; LAS bf16* Al = Ah + 16 * RS8; LAS float* Pp = (LAS float*)lds;
        LAS float* Lg = (LAS float*)(lds + 8 * 16 * 80 * 4);
        for (int unit = wg; unit < S / 16; unit += G) {
            {
                const int rl0 = wave * 2, row0 = unit * 16 + rl0;
                f32x4 v[2][8], xv[2][8]; float s[2] = {0.f, 0.f};
#pragma unroll
                for (int rr = 0; rr < 2; ++rr) { const u32x2* yr = (const u32x2*)(y + (size_t)(row0 + rr) * D) + lane; const f32x4* xr = (const f32x4*)(x + (size_t)(row0 + rr) * D) + lane;
#pragma unroll
                    for (int j = 0; j < 8; ++j) { const u32x2 yb = yr[64 * j]; v[rr][j] = (f32x4){__uint_as_float(yb.x << 16), __uint_as_float(yb.x & 0xffff0000u), __uint_as_float(yb.y << 16), __uint_as_float(yb.y & 0xffff0000u)}; xv[rr][j] = xr[64 * j]; } }
#pragma unroll
                for (int rr = 0; rr < 2; ++rr)
#pragma unroll
                    for (int j = 0; j < 8; ++j) s[rr] += (v[rr][j].x * v[rr][j].x + v[rr][j].y * v[rr][j].y) + (v[rr][j].z * v[rr][j].z + v[rr][j].w * v[rr][j].w);
                float r1[2]; r1[0] = rsqrtf(wave_sum(s[0]) * (1.0f / D) + 1e-6f); r1[1] = rsqrtf(wave_sum(s[1]) * (1.0f / D) + 1e-6f); s[0] = 0.f; s[1] = 0.f;
#pragma unroll
                for (int rr = 0; rr < 2; ++rr)
#pragma unroll
                    for (int j = 0; j < 8; ++j) { const int c = 4 * lane + 256 * j; const f32x4 t = xv[rr][j] + *(const f32x4*)(gt1 + c) * *(const f32x4*)(gpost + c) * (v[rr][j] * r1[rr]); v[rr][j] = t;
                        { u32x2 xb; xb.x = pk2(t.x, t.y); xb.y = pk2(t.z, t.w); ((u32x2*)(x1 + (size_t)(row0 + rr) * D))[lane + 64 * j] = xb; } s[rr] += (t.x * t.x + t.y * t.y) + (t.z * t.z + t.w * t.w); }
                float r2[2]; r2[0] = rsqrtf(wave_sum(s[0]) * (1.0f / D) + 1e-6f); r2[1] = rsqrtf(wave_sum(s[1]) * (1.0f / D) + 1e-6f);
#pragma unroll
                for (int rr = 0; rr < 2; ++rr)
#pragma unroll
                    for (int j = 0; j < 8; ++j) { const int c = 4 * lane + 256 * j; const f32x4 t = v[rr][j] * r2[rr] * (*(const f32x4*)(gpre2 + c) * (*(const f32x4*)(sc2 + c) + 1.0f)) + *(const f32x4*)(sh2 + c);
                        u32x2 wh; wh.x = pk2(t.x, t.y); wh.y = pk2(t.z, t.w);
                        u32x2 wl; wl.x = pk2(t.x - __uint_as_float(wh.x << 16), t.y - __uint_as_float(wh.x & 0xffff0000u)); wl.y = pk2(t.z - __uint_as_float(wh.y << 16), t.w - __uint_as_float(wh.y & 0xffff0000u));
                        ((unsigned*)(h2 + (size_t)(row0 + rr) * D))[lane + 64 * j] = pk_fp8x4(t.x, t.y, t.z, t.w, 8.0f);
                        *(LAS u32x2*)(Ah + (rl0 + rr) * RS8 + c) = wh; *(LAS u32x2*)(Al + (rl0 + rr) * RS8 + c) = wl; }
            }
            R1_BAR();
            f32x4 acc[5];
#pragma unroll
            for (int nt = 0; nt < 5; ++nt) acc[nt] = (f32x4){0.f, 0.f, 0.f, 0.f};
            for (int rmf = 0; rmf < 1 + REP_P11B; ++rmf) {
#pragma unroll
            for (int nt = 0; nt < 5; ++nt) acc[nt] = (f32x4){0.f, 0.f, 0.f, 0.f};
#pragma unroll 2
            for (int ks = 0; ks < 8; ++ks) {
                const int k0 = 256 * wave + 32 * ks + 8 * (lane >> 4);
                const bf16x8 ah = *(const LAS bf16x8*)(Ah + (lane & 15) * RS8 + k0), al = *(const LAS bf16x8*)(Al + (lane & 15) * RS8 + k0);
#pragma unroll
                for (int nt = 0; nt < 5; ++nt) { const bf16x8 bh = *(const bf16x8*)(wrh + (size_t)(16 * nt + (lane & 15)) * D + k0), bl = *(const bf16x8*)(wrl + (size_t)(16 * nt + (lane & 15)) * D + k0);
                    acc[nt] = __builtin_amdgcn_mfma_f32_16x16x32_bf16(ah, bh, acc[nt], 0, 0, 0);
                    acc[nt] = __builtin_amdgcn_mfma_f32_16x16x32_bf16(al, bh, acc[nt], 0, 0, 0);
                    acc[nt] = __builtin_amdgcn_mfma_f32_16x16x32_bf16(ah, bl, acc[nt], 0, 0, 0); }
            }
            }
            R1_BAR();
#pragma unroll
            for (int nt = 0; nt < 5; ++nt)
#pragma unroll
                for (int rg = 0; rg < 4; ++rg) Pp[(wave * 16 + 4 * (lane >> 4) + rg) * 80 + 16 * nt + (lane & 15)] = acc[nt][rg];
            R1_BAR();
            for (int i = tid; i < 16 * 72; i += NTHR) { const int r = i / 72, c = i % 72; float t = c < NG ? b_rg[c] : b_re[c - NG];
#pragma unroll
                for (int w = 0; w < 8; ++w) t += Pp[(w * 16 + r) * 80 + c];
                Lg[r * 72 + c] = t; }
            R1_BAR();
            if (tid < 16) {
                const LAS float* lg = Lg + tid * 72; const int row = unit * 16 + tid;
                float mx = lg[0]; int gi = 0; for (int j = 1; j < 8; ++j) if (lg[j] > mx) { mx = lg[j]; gi = j; }
                float sg = 0.f; for (int j = 0; j < 8; ++j) sg += __expf(lg[j] - mx);
                const float pg = 1.0f / sg;
                const LAS float* le = lg + 8 + gi * EPG;
                float m1 = le[0]; int i1 = 0; for (int j = 1; j < 8; ++j) if (le[j] > m1) { m1 = le[j]; i1 = j; }
                float m2 = -3e38f; int i2 = 0; for (int j = 0; j < 8; ++j) if (j != i1 && le[j] > m2) { m2 = le[j]; i2 = j; }
                const float e2 = __expf(m2 - m1); const float p1 = 1.0f / (1.0f + e2), p2 = e2 / (1.0f + e2);
                const int e1g = gi * EPG + i1, e2g = gi * EPG + i2;
                eidx[row * 2] = e1g; eidx[row * 2 + 1] = e2g; ew[row * 2] = pg * p1; ew[row * 2 + 1] = pg * p2;
                if (rep_ == 0) { atomicAdd((int*)ctl + CW_CNT + e1g, 1); atomicAdd((int*)ctl + CW_CNT + e2g, 1); }
            }
            R1_BAR();
        }
    }
    SEAM(11);
    PH(12) { const int lane = lane_fresh(); const int tid = (wave << 6) | lane; (void)tid; (void)lane;
        LAS int* offs = (LAS int*)lds;
        if (tid == 0) { int o = 0; for (int e = 0; e < NE; ++e) { offs[e] = o; const int nt = (((const int*)ctl)[CW_CNT + e] + 127) / 128; if (wg == 0) for (int t = 0; t < nt; ++t) tile_e[o / 128 + t] = e; o += nt * 128; }
            if (wg == 0) ((int*)ctl)[CW_NT] = o / 128; }
        __syncthreads();
        for (int p0 = gw * 8; p0 < S * 2; p0 += NGW * 8) {
            int row = 0;
            if (lane < 8) { const int p = p0 + lane; const int e = eidx[p]; const int pos = atomicAdd((int*)ctl + CW_FILL + e, 1); row = offs[e] + pos; tok[row] = p >> 1; slot[p] = row; }
            u32x4 buf[8][2];
#pragma unroll
            for (int i = 0; i < 8; ++i) { const u32x4* src = (const u32x4*)(h2 + (size_t)((p0 + i) >> 1) * D) + lane;
#pragma unroll
                for (int j = 0; j < 2; ++j) buf[i][j] = src[64 * j]; }
#pragma unroll
            for (int i = 0; i < 8; ++i) { const int ri = __shfl(row, i); u32x4* dst = (u32x4*)(xbuf + (size_t)ri * D) + lane;
#pragma unroll
                for (int j = 0; j < 2; ++j) dst[64 * j] = buf[i][j]; }
        }
    }
    SEAM(12);
    PH(13) { const int lane = lane_fresh(); const int tid = (wave << 6) | lane; (void)tid; (void)lane;
        const int ntl = ((const int*)ctl)[CW_NT];
        pg8::Gemm g{(const bf16*)xbuf, (const bf16*)Wgut, MAXROWS, NE * 1024, D / 2, D / 2, D / 2}; ExpertOrder So{tile_e, ntl, 4, G, wg};
        EpiHid E{hid};
        pg8::gemm_phase<EpiHid, ExpertOrder, true, true, (124 << 8) | 119, true>(lds, g, So, E);
    }
    SEAM(13);
    PH(14) { const int lane = lane_fresh(); const int tid = (wave << 6) | lane; (void)tid; (void)lane;
        const int ntl = ((const int*)ctl)[CW_NT];
        pg8::Gemm g{(const bf16*)hid, (const bf16*)Wdt, MAXROWS, NE * D, FF / 2, FF / 2, FF / 2}; ExpertOrder So{tile_e, ntl, 8, G, wg};
        EpiYbuf E{ybuf};
        pg8::gemm_phase<EpiYbuf, ExpertOrder, true, true, (124 << 8) | 120, true>(lds, g, So, E);
    }
    SEAM(14);
    PH(15) { const int lane = lane_fresh(); const int tid = (wave << 6) | lane; (void)tid; (void)lane;
        const float* gpost2 = args.in[7]; const float* gt2 = ada + 5 * D; float* out = args.out;
        for (int rb = gw; rb < S; rb += 2 * NGW) {
            int s0[2], s1[2]; float w0[2], w1[2]; const int rows[2] = {rb, rb + NGW};
#pragma unroll
            for (int q = 0; q < 2; ++q) { const int row = rows[q] < S ? rows[q] : rb; s0[q] = slot[row * 2]; s1[q] = slot[row * 2 + 1]; w0[q] = ew[row * 2]; w1[q] = ew[row * 2 + 1]; }
            u32x2 xb[2][8];
#pragma unroll
            for (int q = 0; q < 2; ++q) { const int row = rows[q] < S ? rows[q] : rb;
#pragma unroll
                for (int j = 0; j < 8; ++j) xb[q][j] = ((const u32x2*)(x1 + (size_t)row * D))[lane + 64 * j]; }
            f32x4 v[2][8]; float s[2] = {0.f, 0.f};
#pragma unroll
            for (int q = 0; q < 2; ++q) { const u32x2* y0 = (const u32x2*)(ybuf + (size_t)s0[q] * D) + lane; const u32x2* y1 = (const u32x2*)(ybuf + (size_t)s1[q] * D) + lane;
#pragma unroll
                for (int j = 0; j < 8; ++j) { const u32x2 a = y0[64 * j], b = y1[64 * j];
                    v[q][j].x = w0[q] * __uint_as_float(a.x << 16) + w1[q] * __uint_as_float(b.x << 16); v[q][j].y = w0[q] * __uint_as_float(a.x & 0xffff0000u) + w1[q] * __uint_as_float(b.x & 0xffff0000u);
                    v[q][j].z = w0[q] * __uint_as_float(a.y << 16) + w1[q] * __uint_as_float(b.y << 16); v[q][j].w = w0[q] * __uint_as_float(a.y & 0xffff0000u) + w1[q] * __uint_as_float(b.y & 0xffff0000u);
                    s[q] += (v[q][j].x * v[q][j].x + v[q][j].y * v[q][j].y) + (v[q][j].z * v[q][j].z + v[q][j].w * v[q][j].w); } }
            float r[2]; r[0] = rsqrtf(wave_sum(s[0]) * (1.0f / D) + 1e-6f); r[1] = rsqrtf(wave_sum(s[1]) * (1.0f / D) + 1e-6f);
#pragma unroll
            for (int q = 0; q < 2; ++q) if (rows[q] < S) {
#pragma unroll
                for (int j = 0; j < 8; ++j) { const int c = 4 * lane + 256 * j; const u32x2 xx = xb[q][j];
                    const f32x4 xf = (f32x4){__uint_as_float(xx.x << 16), __uint_as_float(xx.x & 0xffff0000u), __uint_as_float(xx.y << 16), __uint_as_float(xx.y & 0xffff0000u)};
                    ((f32x4*)(out + (size_t)rows[q] * D))[lane + 64 * j] = xf + *(const f32x4*)(gt2 + c) * (v[q][j] * r[q] * *(const f32x4*)(gpost2 + c)); } }
        }
    }
#undef IN
#undef SEAM
}
extern "C" void kernel_launch(void* const* d_in, const int* in_sizes, int n_in, void* d_out, int out_size, void* d_ws, size_t ws_size, hipStream_t stream) {
    static int grid = 0;
    if (grid == 0) {
        if (ws_size < WS_END || n_in != 38) { fprintf(stderr, "kernel_launch: unexpected workspace/inputs: %zu < %zu or n_in %d\n", ws_size, (size_t)WS_END, n_in); grid = -1; return; }
        int dev = 0, cus = 0;
        if (hipGetDevice(&dev) != hipSuccess || hipDeviceGetAttribute(&cus, hipDeviceAttributeMultiprocessorCount, dev) != hipSuccess) { fprintf(stderr, "device query failed\n"); grid = -1; return; }
        if (hipFuncSetAttribute((const void*)fwd, hipFuncAttributeMaxDynamicSharedMemorySize, LDS_BYTES) != hipSuccess) { fprintf(stderr, "hipFuncSetAttribute failed\n"); grid = -1; return; }
        grid = cus;
    }
    if (grid < 0) return;
    (void)hipMemsetAsync((char*)d_ws + WS_CTL, 0, 1 * MiB, stream);
    Args a{};
    for (int i = 0; i < 38; ++i) a.in[i] = (const float*)d_in[i];
    a.out = (float*)d_out; a.ws = (unsigned char*)d_ws;
#if N_LAUNCH_PER_PHASE
    for (int ph = 0; ph < 16; ++ph) { a.ph_lo = ph; a.ph_hi = ph + 1; hipLaunchKernelGGL(fwd, dim3(grid), dim3(NTHR), LDS_BYTES, stream, a); }
#else
    a.ph_lo = 0; a.ph_hi = 16; hipLaunchKernelGGL(fwd, dim3(grid), dim3(NTHR), LDS_BYTES, stream, a);
#endif
}
```

```cpp
#include <hip/hip_runtime.h>
#include <cstdio>
#include <cstdint>

typedef unsigned short bf16;
__device__ __forceinline__ float bf2f(bf16 b) { return __uint_as_float(((unsigned)b) << 16); }
__device__ __forceinline__ bf16 f2bf(float f) { unsigned u = __float_as_uint(f); u += 0x7fffu + ((u >> 16) & 1u); return (bf16)(u >> 16); }
__device__ __forceinline__ float sigmoidf_(float x) { return __builtin_amdgcn_rcpf(1.0f + __expf(-x)); }

#ifndef N_LAUNCH_PER_PHASE
#define N_LAUNCH_PER_PHASE 0
#endif
#ifndef REP_PHASE
#define REP_PHASE -1
#define REP_N 0
#endif
#ifndef REP_SCAN
#define REP_SCAN 0
#endif
#ifndef REP_P11A
#define REP_P11A 0
#endif
#ifndef REP_P11B
#define REP_P11B 0
#endif
#ifndef REP_R1A
#define REP_R1A 0
#define REP_R1B 0
#define REP_R1C 0
#endif
#ifndef REP_R1NR
#define REP_R1NR 0
#endif
#ifndef REP_R1S0
#define REP_R1S0 0
#endif
constexpr int S = 8192, D = 2048;
constexpr int AH = 8, AD = 128, AW = 1024, MB = 256, NB = S / MB;
constexpr int RH = 16, RN = 64, RW = 1024;
constexpr int LW = 96, LA = 96, LG = 256, LO = LW + LA + LG;
constexpr int INW = 3 * AW + 3 * RW + 2 * D;
constexpr int NE = 64, NG = 8, EPG = 8, FF = 512;
constexpr int MAXROWS = 32768;
constexpr int MAXTILES = MAXROWS / 256;

constexpr size_t MiB = 1u << 20;
constexpr size_t WS_CTL   = 0;
constexpr size_t WS_ADA   = 1 * MiB;
constexpr size_t WS_ROPE  = 2 * MiB;
constexpr size_t WS_KMEAN = 3 * MiB;
constexpr size_t WS_WL2   = 3 * MiB + 256 * 1024;
constexpr size_t WS_ROUTE = 5 * MiB;
constexpr size_t WS_TOK   = 6 * MiB;
constexpr size_t WS_WR    = 7 * MiB;
constexpr size_t WS_H     = 8 * MiB;
constexpr size_t WS_Q     = 40 * MiB;
constexpr size_t WS_K     = 56 * MiB;
constexpr size_t WS_V     = 72 * MiB;
constexpr size_t WS_RKV   = 88 * MiB;
constexpr size_t WS_GATE  = 184 * MiB;
constexpr size_t WS_LORA  = 248 * MiB;
constexpr size_t WS_LORAB = 424 * MiB;
constexpr size_t WS_AL2   = 280 * MiB;
constexpr size_t WS_LW    = 296 * MiB;
constexpr size_t WS_A     = 328 * MiB;
constexpr size_t WS_G     = 360 * MiB;
constexpr size_t WS_OCAT  = 392 * MiB;
constexpr size_t WS_MIX   = 424 * MiB;
constexpr size_t WS_Y     = 456 * MiB;
constexpr size_t WS_X1    = 520 * MiB;
constexpr size_t WS_H2    = 584 * MiB;
constexpr size_t WS_WUPT  = 616 * MiB;
constexpr size_t WS_WOT   = 624 * MiB;
constexpr size_t WS_WGUT  = 632 * MiB;
constexpr size_t WS_WDT   = 888 * MiB;
constexpr size_t WS_END   = 1016 * MiB;
constexpr size_t WS_W1T   = WS_Y;
constexpr size_t WS_XBUF  = WS_H;
constexpr size_t WS_HID   = 136 * MiB;
constexpr size_t WS_YBUF  = 168 * MiB;
constexpr size_t WS_ALIST = 8 * MiB, WS_AMASK = 12 * MiB, WS_AML = 13 * MiB, WS_APART = 248 * MiB;
constexpr size_t WS_RWP = 456 * MiB, WS_RWQ = 472 * MiB, WS_RWR = 504 * MiB, WS_RWY = 520 * MiB, WS_RWH = 552 * MiB, WS_RWB = 568 * MiB;
constexpr size_t WS_NR = WS_MIX, WS_NW = WS_NR + 32 * MiB, WS_NKT = WS_NR + 64 * MiB, WS_NV = WS_NR + 96 * MiB, WS_NKK = WS_NR + 128 * MiB, WS_NY = WS_NR + 160 * MiB;
constexpr size_t WS_MIXTMP = WS_Y;
constexpr size_t WS_GTMP = WS_Y;

constexpr int CW_CNT = 1024;
constexpr int CW_FILL = 1152;
constexpr int CW_OFF = 1280;
constexpr int CW_NT = 1408;
constexpr int CW_ACNT = 1536;
constexpr int CW_AQ = 1920;

namespace pg8 {
#define PG8_LAS __attribute__((address_space(3)))
typedef unsigned short bf16_t;
typedef short bf16x8 __attribute__((ext_vector_type(8)));
typedef float f32x4 __attribute__((ext_vector_type(4)));
typedef unsigned u32x4 __attribute__((ext_vector_type(4)));
typedef int i32x8_t __attribute__((ext_vector_type(8)));
template <bool IS8> struct FragSel { typedef bf16x8 T; static constexpr int NK = 2; };
template <> struct FragSel<true> { typedef i32x8_t T; static constexpr int NK = 1; };
template <int F8> struct FragT : FragSel<(F8 != 0)> {};
constexpr int BM = 256, BK = 64, HALF = 128, HTB = HALF * BK * 2  , STAGE_BYTES = 8 * HTB, NXCD = 8, WGM = 8;

__host__ __device__ __forceinline__ int lds_byte(int r, int c) { const int st = (r >> 4) * 2 + (c >> 5), rr = r & 15, cc = c & 31, ob = rr * 64 + cc * 2; return st * 1024 + (ob ^ (((ob >> 9) & 1) << 5)); }
__host__ __device__ __forceinline__ void stage_rc(int b, int& R, int& C) { const int st = b / 1024, sb = b % 1024, swz = sb ^ (((sb >> 9) & 1) << 5); R = (st >> 1) * 16 + swz / 64; C = (st & 1) * 32 + (swz % 64) / 2; }
__host__ __device__ __forceinline__ int perm32(int rho) { const int n = rho >> 4, i = rho & 15; return 8 * (i >> 2) + 4 * n + (i & 3); }

struct Unit { int pm, pn, koff, koffB; };
struct Gemm { const bf16_t* A; const bf16_t* Bt; int M, N, K, lda, ldb; };

struct StaticOrder {
    static constexpr bool GATHER = false; const int* tok = nullptr;
    int nM, nN, nwg, G, c;
    __host__ __device__ void init(int M, int N, int G_, int c_) { nM = M / BM; nN = N / BM; nwg = nM * nN; G = G_; c = c_; }
    __host__ __device__ bool next(int i, Unit& u) const {
        const long L = (long)i * G + c; if (L >= nwg) return false;
        int wgid = (int)L; { const int q = nwg / NXCD, r = nwg % NXCD, xcd = wgid % NXCD, off = wgid / NXCD; wgid = (xcd < r ? xcd * (q + 1) : r * (q + 1) + (xcd - r) * q) + off; }
        const int nig = WGM * nN, gid = wgid / nig, fm = gid * WGM, gsz = (nM - fm) < WGM ? (nM - fm) : WGM;
        u.pm = fm + ((wgid % nig) % gsz); u.pn = (wgid % nig) / gsz; u.koff = 0; u.koffB = 0; return true;
    }
    __device__ __forceinline__ void a_ready(const Unit&) const {}
    __device__ __forceinline__ void done(const Unit&) const {}
};

__device__ __forceinline__ unsigned cvt_pk_bf16(float lo, float hi) { unsigned r; asm volatile("v_cvt_pk_bf16_f32 %0, %1, %2" : "=v"(r) : "v"(lo), "v"(hi)); return r; }
template <class Epi, class Sched, bool ALIGN_EPI = false, bool SP2 = false, int F8 = 0, bool HM = false>
__device__ __forceinline__ void gemm_phase(PG8_LAS unsigned char* lds, const Gemm g, const Sched& S, const Epi& E) {
    int tid_ = threadIdx.x; asm volatile("" : "+v"(tid_));
    const int tid = tid_, wid = __builtin_amdgcn_readfirstlane(tid >> 6), lane = tid & 63, wr = wid >> 2, wc = wid & 3, fr = lane & 15, fq = lane >> 4;
    const int K = g.K, nt = K / BK;
    unsigned voffA[2], voffB[2], voffN[2] = {0u, 0u};
#pragma unroll
    for (int i = 0; i < 2; ++i) { int R, C; stage_rc(tid * 16 + i * 8192, R, C); const int Rb = Epi::PERM ? ((R & ~31) + perm32(R & 31)) : R;
        voffA[i] = (unsigned)(R * g.lda + C) * 2u; voffB[i] = (unsigned)(Rb * g.ldb + C) * 2u; }
    const size_t kstep = (size_t)(BK * 2);
    const size_t hstepA = HM ? (size_t)0 : (size_t)HALF * g.lda * 2, hstepB = (size_t)HALF * g.ldb * 2;
    const size_t tstepA = Sched::GATHER ? (size_t)0 : (HM ? 1 : 2) * (size_t)HALF * g.lda * 2, tstepB = 2 * hstepB;
    const unsigned ldsw = (unsigned)wid * 1024u;
    const int aoff = lds_byte(wr * 64 + fr, fq * 8), boff = lds_byte(wc * 32 + fr, fq * 8);
#define PG8_SA(b, h) (((b) * 2 + (h)) * HTB)
#define PG8_SB(b, h) ((4 + (b) * 2 + (h)) * HTB)
#define PG8_STAGE(bufoff, gbase, voff) do { _Pragma("unroll") for (int _i = 0; _i < 2; ++_i) \
        __builtin_amdgcn_global_load_lds((const unsigned*)((const char*)(gbase) + (voff)[_i]), (PG8_LAS unsigned*)(lds + (bufoff) + ldsw + _i * 8192), 16, 0, 0); } while (0)
#define PG8_CAT(lo, hi) __builtin_bit_cast(i32x8_t, __builtin_shufflevector(lo, hi, 0, 1, 2, 3, 4, 5, 6, 7, 8, 9, 10, 11, 12, 13, 14, 15))
#define PG8_RD(off) (*(const PG8_LAS bf16x8*)(lds + (off)))
#define PG8_LDA(dst, b, h) do { if constexpr (!(HM && (h) == 1)) _Pragma("unroll") for (int m = 0; m < 4; ++m) { if constexpr (F8 == 0) { _Pragma("unroll") for (int k = 0; k < 2; ++k) dst[m][k] = PG8_RD(PG8_SA(b, h) + aoff + m * 2048 + k * 1024); } \
        else dst[m][0] = PG8_CAT(PG8_RD(PG8_SA(b, h) + aoff + m * 2048), PG8_RD(PG8_SA(b, h) + aoff + m * 2048 + 1024)); } } while (0)
#define PG8_LDB(dst, b, h) do { _Pragma("unroll") for (int n = 0; n < 2; ++n) { if constexpr (F8 == 0) { _Pragma("unroll") for (int k = 0; k < 2; ++k) dst[n][k] = PG8_RD(PG8_SB(b, h) + boff + n * 2048 + k * 1024); } \
        else dst[n][0] = PG8_CAT(PG8_RD(PG8_SB(b, h) + boff + n * 2048), PG8_RD(PG8_SB(b, h) + boff + n * 2048 + 1024)); } } while (0)
#define PG8_MMA(ai, bj, At, Bt) do { __builtin_amdgcn_s_setprio(1); if constexpr (!(HM && (ai) == 1)) _Pragma("unroll") for (int m = 0; m < 4; ++m) _Pragma("unroll") for (int n = 0; n < 2; ++n) { \
        if constexpr (F8 == 0) { _Pragma("unroll") for (int k = 0; k < 2; ++k) acc[ai][bj][m][n] = __builtin_amdgcn_mfma_f32_16x16x32_bf16(Bt[n][k], At[m][k], acc[ai][bj][m][n], 0, 0, 0); } \
        else acc[ai][bj][m][n] = __builtin_amdgcn_mfma_scale_f32_16x16x128_f8f6f4(Bt[n][0], At[m][0], acc[ai][bj][m][n], 0, 0, 0, (F8 & 255) * 0x01010101, 0, ((F8 >> 8) & 255) * 0x01010101); } \
        __builtin_amdgcn_s_setprio(0); } while (0)
#define PG8_WAIT_V(n) asm volatile("s_waitcnt vmcnt(" #n ")" ::: "memory")
#define PG8_WAIT_L(n) asm volatile("s_waitcnt lgkmcnt(" #n ")" ::: "memory")
#define PG8_BAR __builtin_amdgcn_s_barrier()
#define PG8_SCHED __builtin_amdgcn_sched_barrier(0)
    Unit cur, nxt; int ui = 0;
    if (!S.next(0, cur)) return;
    f32x4 acc[2][2][4][2];
#pragma unroll
    for (int a = 0; a < 2; ++a)
#pragma unroll
        for (int b = 0; b < 2; ++b)
#pragma unroll
            for (int m = 0; m < 4; ++m)
#pragma unroll
                for (int n = 0; n < 2; ++n) acc[a][b][m][n] = (f32x4){0.f, 0.f, 0.f, 0.f};
    typename FragT<F8>::T At[4][FragT<F8>::NK], B0[2][FragT<F8>::NK], B1[2][FragT<F8>::NK];
    const char* cA = (const char*)g.A + (size_t)cur.pm * tstepA + cur.koff; const char* cB = (const char*)g.Bt + (size_t)cur.pn * tstepB + cur.koffB;
#define PG8_GVOFF(u, out) do { _Pragma("unroll") for (int i_ = 0; i_ < 2; ++i_) { int R_, C_; stage_rc(tid * 16 + i_ * 8192, R_, C_); out[i_] = ((unsigned)S.tok[(u).pm * 128 + R_] * (unsigned)g.lda + (unsigned)C_) * 2u; } } while (0)
    if constexpr (Sched::GATHER) PG8_GVOFF(cur, voffA);
    S.a_ready(cur);
    if constexpr (SP2) {
        PG8_STAGE(PG8_SB(0, 0), cB, voffB); PG8_STAGE(PG8_SB(0, 1), cB + hstepB, voffB); PG8_STAGE(PG8_SA(0, 0), cA, voffA); PG8_STAGE(PG8_SA(0, 1), cA + hstepA, voffA);
        if (wr == 1) PG8_BAR;
        PG8_WAIT_V(2); PG8_BAR;
        PG8_STAGE(PG8_SB(1, 0), cB + kstep, voffB); PG8_STAGE(PG8_SA(1, 0), cA + kstep, voffA); PG8_STAGE(PG8_SB(1, 1), cB + hstepB + kstep, voffB);
        PG8_WAIT_V(6); PG8_BAR;
    } else {
        PG8_STAGE(PG8_SB(0, 0), cB, voffB); PG8_STAGE(PG8_SA(0, 0), cA, voffA); PG8_STAGE(PG8_SB(0, 1), cB + hstepB, voffB); PG8_STAGE(PG8_SA(0, 1), cA + hstepA, voffA);
        if (wr == 1) PG8_BAR;
        PG8_WAIT_V(4); PG8_BAR;
        PG8_STAGE(PG8_SB(1, 0), cB + kstep, voffB); PG8_STAGE(PG8_SA(1, 0), cA + kstep, voffA); PG8_STAGE(PG8_SB(1, 1), cB + hstepB + kstep, voffB);
        PG8_WAIT_V(6); PG8_BAR;
    }
    for (;;) {
        const bool has_next = S.next(ui + 1, nxt);
        if constexpr (Sched::GATHER) { if (has_next) PG8_GVOFF(nxt, voffN); }
        const char* nA = has_next ? (const char*)g.A + (size_t)nxt.pm * tstepA + nxt.koff : cA; const char* nB = has_next ? (const char*)g.Bt + (size_t)nxt.pn * tstepB + nxt.koffB : cB;
#pragma nounroll
        for (int t = 0; t < nt; t += 2) {
            const bool last = (t == nt - 2);
            const char* a1 = cA + (size_t)(t + 1) * kstep;
            const char* a2 = last ? nA : cA + (size_t)(t + 2) * kstep; const char* b2 = last ? nB : cB + (size_t)(t + 2) * kstep;
            const char* a3 = a2 + kstep; const char* b3 = b2 + kstep;
            unsigned vA2[2] = {voffA[0], voffA[1]}; if constexpr (Sched::GATHER) { if (last) { vA2[0] = voffN[0]; vA2[1] = voffN[1]; } }
            if (last && has_next) S.a_ready(nxt);
            if constexpr (SP2) {
            PG8_LDB(B0, 0, 0); PG8_LDB(B1, 0, 1); PG8_SCHED; PG8_LDA(At, 0, 0); PG8_STAGE(PG8_SA(1, 1), a1 + hstepA, voffA);
            PG8_WAIT_V(8); PG8_WAIT_L(0); PG8_BAR; PG8_MMA(0, 0, At, B0); PG8_MMA(0, 1, At, B1); PG8_BAR; PG8_SCHED;
            PG8_LDA(At, 0, 1); PG8_STAGE(PG8_SB(0, 0), b2, voffB); PG8_STAGE(PG8_SB(0, 1), b2 + hstepB, voffB); PG8_STAGE(PG8_SA(0, 0), a2, vA2);
            PG8_WAIT_V(8); PG8_WAIT_L(0); PG8_BAR; PG8_MMA(1, 0, At, B0); PG8_MMA(1, 1, At, B1); PG8_BAR; PG8_SCHED;
            PG8_LDB(B0, 1, 0); PG8_LDB(B1, 1, 1); PG8_SCHED; PG8_LDA(At, 1, 0); PG8_STAGE(PG8_SA(0, 1), a2 + hstepA, vA2);
            PG8_WAIT_V(8); PG8_WAIT_L(0); PG8_BAR; PG8_MMA(0, 0, At, B0); PG8_MMA(0, 1, At, B1); PG8_BAR; PG8_SCHED;
            PG8_LDA(At, 1, 1); PG8_STAGE(PG8_SB(1, 0), b3, voffB); PG8_STAGE(PG8_SB(1, 1), b3 + hstepB, voffB); PG8_STAGE(PG8_SA(1, 0), a3, vA2);
            PG8_WAIT_V(8); PG8_WAIT_L(0); PG8_BAR; PG8_MMA(1, 0, At, B0); PG8_MMA(1, 1, At, B1); PG8_BAR; PG8_SCHED;
            } else {
            PG8_LDB(B0, 0, 0); PG8_SCHED; PG8_LDA(At, 0, 0); PG8_STAGE(PG8_SA(1, 1), a1 + hstepA, voffA);
            PG8_WAIT_L(8); PG8_BAR; PG8_WAIT_L(0); PG8_MMA(0, 0, At, B0); PG8_BAR; PG8_SCHED;
            PG8_LDB(B1, 0, 1); PG8_STAGE(PG8_SB(0, 0), b2, voffB);
            PG8_BAR; PG8_WAIT_L(0); PG8_MMA(0, 1, At, B1); PG8_BAR;
            PG8_LDA(At, 0, 1); PG8_STAGE(PG8_SA(0, 0), a2, vA2);
            PG8_BAR; PG8_WAIT_L(0); PG8_MMA(1, 0, At, B0); PG8_BAR; PG8_SCHED;
            PG8_STAGE(PG8_SB(0, 1), b2 + hstepB, voffB);
            PG8_WAIT_V(6); PG8_BAR; PG8_MMA(1, 1, At, B1); PG8_BAR;
            PG8_LDB(B0, 1, 0); PG8_SCHED; PG8_LDA(At, 1, 0); PG8_STAGE(PG8_SA(0, 1), a2 + hstepA, vA2);
            PG8_WAIT_L(8); PG8_BAR; PG8_WAIT_L(0); PG8_MMA(0, 0, At, B0); PG8_BAR; PG8_SCHED;
            PG8_LDB(B1, 1, 1); PG8_STAGE(PG8_SB(1, 0), b3, voffB);
            PG8_BAR; PG8_WAIT_L(0); PG8_MMA(0, 1, At, B1); PG8_BAR;
            PG8_LDA(At, 1, 1); PG8_STAGE(PG8_SA(1, 0), a3, vA2);
            PG8_BAR; PG8_WAIT_L(0); PG8_MMA(1, 0, At, B0); PG8_BAR; PG8_SCHED;
            PG8_STAGE(PG8_SB(1, 1), b3 + hstepB, voffB);
            PG8_WAIT_V(6); PG8_BAR; PG8_MMA(1, 1, At, B1); PG8_BAR;
            }
        }
        if constexpr (ALIGN_EPI) { if (wr == 0) PG8_BAR; }
        if constexpr (!Epi::AFTER_DRAIN) { E(acc, cur, wr, wc, fr, fq); S.done(cur); }
        if (!has_next) break;
        {
#pragma unroll
        for (int a = 0; a < 2; ++a)
#pragma unroll
            for (int b = 0; b < 2; ++b)
#pragma unroll
                for (int m = 0; m < 4; ++m)
#pragma unroll
                    for (int n = 0; n < 2; ++n) acc[a][b][m][n] = (f32x4){0.f, 0.f, 0.f, 0.f};
        }
        cur = nxt; cA = nA; cB = nB; ++ui;
        if constexpr (Sched::GATHER) { voffA[0] = voffN[0]; voffA[1] = voffN[1]; }
        if constexpr (ALIGN_EPI) { if (wr == 1) PG8_BAR; }
    }
    PG8_WAIT_V(0);
    if constexpr (!ALIGN_EPI) { if (wr == 0) PG8_BAR; }
    PG8_BAR;
    if constexpr (Epi::AFTER_DRAIN) { E.fused(acc, cur, wr, wc, fr, fq, lds, wid, lane); S.done(cur); }
#undef PG8_SA
#undef PG8_SB
#undef PG8_STAGE
#undef PG8_LDA
#undef PG8_LDB
#undef PG8_MMA
#undef PG8_CAT
#undef PG8_GVOFF
#undef PG8_RD
#undef PG8_WAIT_V
#undef PG8_WAIT_L
#undef PG8_BAR
#undef PG8_SCHED
}
}

#define XB_TMO      128
#define XB_XCNT(j)  (256  + 64 * (j))
#define XB_XSUB(j)  (1280 + 64 * (j))
#define XB_XGEN(j)  (2304 + 64 * (j))
#define XB_TOP      3328
#define XB_TOPGEN   3392
#define XCD_BAR_WORDS 3456
#define XB_SPIN_CAP (1u << 18)
#define LAS __attribute__((address_space(3)))

__device__ __forceinline__ unsigned xb_ld(unsigned* p)              { return __hip_atomic_load(p, __ATOMIC_RELAXED, __HIP_MEMORY_SCOPE_AGENT); }
__device__ __forceinline__ unsigned xb_add(unsigned* p, unsigned v) { return __hip_atomic_fetch_add(p, v, __ATOMIC_RELAXED, __HIP_MEMORY_SCOPE_AGENT); }
__device__ __forceinline__ unsigned xb_xcc_id() { return (unsigned)__builtin_amdgcn_s_getreg((3 << 11) | 20) & 0xFu; }
#define XB_SPIN(cond, bar) do { unsigned _sp = 0; while (cond) { __builtin_amdgcn_s_sleep(1); \
    if ((++_sp & 255u) == 0u) { if (xb_ld(&(bar)[XB_TMO])) break; if (_sp > XB_SPIN_CAP) { atomicAdd(&(bar)[XB_TMO], 1u); break; } } } } while (0)

struct XcdBarrier {
    unsigned* bar; unsigned x;
    volatile LAS unsigned* st;
};

__device__ __forceinline__ XcdBarrier xcd_barrier_post(unsigned* bar, volatile LAS unsigned* st) {
    XcdBarrier b; b.bar = bar; b.x = xb_xcc_id(); b.st = st;
    if (threadIdx.x == 0) (void)xb_add(&bar[XB_XCNT(b.x)], 1u);
    return b;
}
__device__ __forceinline__ void xcd_barrier_complete(unsigned* bar, unsigned x, unsigned& nloc, unsigned& nx) {
    const unsigned G = gridDim.x * gridDim.y * gridDim.z;
    unsigned sum, cnt, mine, sp = 0u;
    for (;;) {
        sum = 0u; cnt = 0u; mine = 0u;
#pragma unroll
        for (unsigned j = 0; j < 16; ++j) { const unsigned c = xb_ld(&bar[XB_XCNT(j)]); sum += c; cnt += (c > 0u) ? 1u : 0u; mine = (j == x) ? c : mine; }
        if (sum == G) break;
        __builtin_amdgcn_s_sleep(1);
        if ((++sp & 255u) == 0u) { if (xb_ld(&bar[XB_TMO])) break; if (sp > XB_SPIN_CAP) { atomicAdd(&bar[XB_TMO], 1u); break; } }
    }
    nloc = mine > 0u ? mine : 1u; nx = cnt > 0u ? cnt : 1u;
}

__device__ __forceinline__ void xcd_barrier(const XcdBarrier& b) {
    asm volatile("s_waitcnt vmcnt(0)" ::: "memory");
    __syncthreads();
    if (threadIdx.x == 0) {
        unsigned* bar = b.bar;
        __builtin_amdgcn_s_waitcnt(0);
        unsigned nloc = b.st[0], nx = b.st[1];
        if (nloc == 0u) { xcd_barrier_complete(bar, b.x, nloc, nx); b.st[0] = nloc; b.st[1] = nx; }
        const unsigned old = xb_add(&bar[XB_XSUB(b.x)], 1u);
        const unsigned gen = old / nloc;
        if (old + 1u == (gen + 1u) * nloc) {
            __builtin_amdgcn_fence(__ATOMIC_RELEASE, "agent");
            asm volatile("s_waitcnt vmcnt(0)" ::: "memory");
            const unsigned og = xb_add(&bar[XB_TOP], 1u);
            const unsigned tg = og / nx;
            if (og + 1u == (tg + 1u) * nx) xb_add(&bar[XB_TOPGEN], 1u);
            else XB_SPIN(xb_ld(&bar[XB_TOPGEN]) == tg, bar);
            __builtin_amdgcn_fence(__ATOMIC_ACQUIRE, "agent");
            xb_add(&bar[XB_XGEN(b.x)], 1u);
            asm volatile("s_waitcnt vmcnt(0)" ::: "memory");
        } else {
            XB_SPIN(xb_ld(&bar[XB_XGEN(b.x)]) == gen, bar);
            __builtin_amdgcn_fence(__ATOMIC_ACQUIRE, "agent");
            asm volatile("s_waitcnt vmcnt(0)" ::: "memory");
        }
    }
    __syncthreads();
}

constexpr int NWAVES = 8, NTHR = 512;
constexpr int RING_BYTES = 131072;
constexpr int LDS_BYTES = 147456;
constexpr int LDSCTL_OFF = LDS_BYTES - 16;
constexpr int CW_BAR = 4096;
typedef float f32x4 __attribute__((ext_vector_type(4)));
typedef unsigned u32x4 __attribute__((ext_vector_type(4)));
typedef unsigned u32x2 __attribute__((ext_vector_type(2)));
typedef short bf16x8 __attribute__((ext_vector_type(8)));
#define LDS_WAIT() asm volatile("s_waitcnt lgkmcnt(0)" ::: "memory")
typedef __bf16 bf16x2_t __attribute__((ext_vector_type(2)));
typedef float f32x2_t __attribute__((ext_vector_type(2)));
__device__ __forceinline__ unsigned pk2(float lo, float hi) { const f32x2_t v = {lo, hi}; return __builtin_bit_cast(unsigned, __builtin_convertvector(v, bf16x2_t)); }
__device__ __forceinline__ int lane_fresh() { int l; asm volatile("v_mbcnt_lo_u32_b32 %0, -1, 0\n\tv_mbcnt_hi_u32_b32 %0, -1, %0" : "=v"(l)); return l; }
#define DPP_ADD(v, ctrl) ((v) + __builtin_bit_cast(float, __builtin_amdgcn_update_dpp(0, __builtin_bit_cast(int, (v)), (ctrl), 0xf, 0xf, true)))
__device__ __forceinline__ float wave_sum(float v) {
    v = DPP_ADD(v, 0xB1);
    v = DPP_ADD(v, 0x4E);
    v = DPP_ADD(v, 0x141);
    v = DPP_ADD(v, 0x140);
    const int iv = __builtin_bit_cast(int, v);
    return (__builtin_bit_cast(float, __builtin_amdgcn_readlane(iv, 0)) + __builtin_bit_cast(float, __builtin_amdgcn_readlane(iv, 16)))
         + (__builtin_bit_cast(float, __builtin_amdgcn_readlane(iv, 32)) + __builtin_bit_cast(float, __builtin_amdgcn_readlane(iv, 48)));
}

constexpr int N1 = 11264;
struct Args { const float* in[38]; float* out; unsigned char* ws; int ph_lo, ph_hi; };

__device__ __forceinline__ void tr_item(const float* W, int ldw, int k0, int n0, bf16* dst, int ldd, const float* mu, int mode, LAS float* scr, int lane) {
    f32x4 v[8];
#pragma unroll
    for (int i = 0; i < 8; ++i) v[i] = *(const f32x4*)(W + (size_t)(k0 + 8 * i + (lane >> 3)) * ldw + n0 + 4 * (lane & 7));
#pragma unroll
    for (int i = 0; i < 8; ++i) { const int kk = 8 * i + (lane >> 3); f32x4 t = v[i];
        if (mode == 1) t = t * (1.0f - mu[k0 + kk]); else if (mode == 2) t = t * mu[k0 + kk];
        LAS float* s = scr + kk * 33 + 4 * (lane & 7); s[0] = t.x; s[1] = t.y; s[2] = t.z; s[3] = t.w; }
    LDS_WAIT(); asm volatile("" ::: "memory");
    const int c = lane & 7;
#pragma unroll
    for (int j = 0; j < 4; ++j) { const int n = (lane >> 3) + 8 * j; const LAS float* s = scr + (8 * c) * 33 + n;
        u32x4 o; o.x = pk2(s[0 * 33], s[1 * 33]); o.y = pk2(s[2 * 33], s[3 * 33]); o.z = pk2(s[4 * 33], s[5 * 33]); o.w = pk2(s[6 * 33], s[7 * 33]);
        *(u32x4*)(dst + (size_t)n * ldd + 8 * c) = o; }
    LDS_WAIT(); asm volatile("" ::: "memory");
}
__device__ __forceinline__ unsigned pk_fp8x4(float a, float b, float c, float d, float sc) {
    a = fminf(fmaxf(a * sc, -448.f), 448.f); b = fminf(fmaxf(b * sc, -448.f), 448.f); c = fminf(fmaxf(c * sc, -448.f), 448.f); d = fminf(fmaxf(d * sc, -448.f), 448.f);
    int p = __builtin_amdgcn_cvt_pk_fp8_f32(a, b, 0, false); p = __builtin_amdgcn_cvt_pk_fp8_f32(c, d, p, true); return (unsigned)p; }
__device__ __forceinline__ void tr_item8(const float* W, int ldw, int k0, int n0, unsigned char* dst, int ldd, float sc, LAS float* scr, int lane) {
    f32x4 v[8];
#pragma unroll
    for (int i = 0; i < 8; ++i) v[i] = *(const f32x4*)(W + (size_t)(k0 + 8 * i + (lane >> 3)) * ldw + n0 + 4 * (lane & 7));
#pragma unroll
    for (int i = 0; i < 8; ++i) { const int kk = 8 * i + (lane >> 3); LAS float* s = scr + kk * 33 + 4 * (lane & 7); s[0] = v[i].x; s[1] = v[i].y; s[2] = v[i].z; s[3] = v[i].w; }
    LDS_WAIT(); asm volatile("" ::: "memory");
    const int c = lane & 7;
#pragma unroll
    for (int j = 0; j < 4; ++j) { const int n = (lane >> 3) + 8 * j; const LAS float* s = scr + (8 * c) * 33 + n;
        u32x2 o; o.x = pk_fp8x4(s[0 * 33], s[1 * 33], s[2 * 33], s[3 * 33], sc); o.y = pk_fp8x4(s[4 * 33], s[5 * 33], s[6 * 33], s[7 * 33], sc);
        *(u32x2*)(dst + (size_t)n * ldd + 8 * c) = o; }
    LDS_WAIT(); asm volatile("" ::: "memory");
}

struct ConvTile { const float* src; int ldw; unsigned char* dst; int rs; int kind; float sc; };
constexpr int CT_IN = (D / 128) * (INW / 128), CT_UP = (AW / 128) * (D / 128), CT_O = (D / 128) * (D / 128), CT_EG = (D / 128) * (FF / 128), CT_ED = (FF / 128) * (D / 128);
constexpr int CT_ALL = CT_IN + 2 * CT_UP + CT_O + NE * (2 * CT_EG + CT_ED);
__device__ __forceinline__ ConvTile conv_decode(int T, const float* const* in, unsigned char* ws) {
    ConvTile t; int r = T;
    if (r < CT_IN) { const int kt = r / (INW / 128), nt = r % (INW / 128), k0 = 128 * kt, n0 = 128 * nt; int dr = n0;
        if (n0 >= 3 * AW + 3 * RW + D) { const int cc = n0 - (3 * AW + 3 * RW + D); dr = 3 * AW + 3 * RW + 256 * (cc / 128) + 128; }
        else if (n0 >= 3 * AW + 3 * RW) { const int cc = n0 - (3 * AW + 3 * RW); dr = 3 * AW + 3 * RW + 256 * (cc / 128); }
        t.src = in[8] + (size_t)k0 * INW + n0; t.ldw = INW; t.dst = ws + WS_W1T + ((size_t)dr * D + k0) * 2; t.rs = D * 2; t.kind = 0; t.sc = 1.f; return t; } r -= CT_IN;
    if (r < 2 * CT_UP) { const int which = r / CT_UP, q = r % CT_UP, kt = q / (D / 128), nt = q % (D / 128), k0 = 128 * kt, n0 = 128 * nt;
        t.src = in[28 + which] + (size_t)k0 * D + n0; t.ldw = D; t.dst = ws + WS_WUPT + ((size_t)n0 * D + which * AW + k0) * 2; t.rs = D * 2; t.kind = 0; t.sc = 1.f; return t; } r -= 2 * CT_UP;
    if (r < CT_O) { const int kt = r / (D / 128), nt = r % (D / 128), k0 = 128 * kt, n0 = 128 * nt;
        t.src = in[30] + (size_t)k0 * D + n0; t.ldw = D; t.dst = ws + WS_WOT + ((size_t)n0 * D + k0) * 2; t.rs = D * 2; t.kind = 0; t.sc = 1.f; return t; } r -= CT_O;
    const int e = r / (2 * CT_EG + CT_ED); r -= e * (2 * CT_EG + CT_ED);
    if (r < 2 * CT_EG) { const int up = r / CT_EG, q = r % CT_EG, kt = q / (FF / 128), nt = q % (FF / 128), k0 = 128 * kt;
        t.src = in[35 + up] + (size_t)e * D * FF + (size_t)k0 * FF + 128 * nt; t.ldw = FF; t.dst = ws + WS_WGUT + ((size_t)e * 1024 + 256 * nt + 128 * up) * D + k0; t.rs = D; t.kind = 1; t.sc = 256.f; return t; } r -= 2 * CT_EG;
    { const int kt = r / (D / 128), nt = r % (D / 128), k0 = 128 * kt, n0 = 128 * nt;
        t.src = in[37] + (size_t)e * FF * D + (size_t)k0 * D + n0; t.ldw = D; t.dst = ws + WS_WDT + ((size_t)e * D + n0) * FF + k0; t.rs = FF; t.kind = 1; t.sc = 128.f; return t; }
}
__device__ __forceinline__ int conv_off(int k, int n) { return k * 132 + 16 * (k >> 5) + n; }
__device__ __forceinline__ void item_kn(int it, int N, int& k0, int& n0) { const int nblk = N / 32; k0 = 64 * (it / nblk); n0 = 32 * (it % nblk); }

struct EpiProj {
    static constexpr bool PERM = true, AFTER_DRAIN = false, MIDK = false;
    bf16* q; bf16* k; bf16* v; float* rkv; bf16* gate; float* lora; float* lorab; const float* rope;
    __device__ __forceinline__ void operator()(const pg8::f32x4 (&acc)[2][2][4][2], const pg8::Unit& u, int wr, int wc, int fr, int fq) const {
        const int row0 = u.pm * 256 + wr * 64 + fr; const int pn = u.pn; const int colw = wc * 32 + 8 * fq;
        if (pn < 8) {
            bf16* base = (pn < 4 ? q : k) + (pn & 3) * 256 + colw;
            const float sgn = fq < 2 ? -1.0f : 1.0f;
#pragma unroll
            for (int ai = 0; ai < 2; ++ai)
#pragma unroll
                for (int m = 0; m < 4; ++m) { const int row = row0 + ai * 128 + m * 16;
                    f32x4 c0, c1, c2, c3;
                    if (wc == 0) { const float* rp = rope + ((size_t)row * 16 + 8 * (fq & 1)) * 2; c0 = *(const f32x4*)rp; c1 = *(const f32x4*)(rp + 4); c2 = *(const f32x4*)(rp + 8); c3 = *(const f32x4*)(rp + 12); }
#pragma unroll
                    for (int bj = 0; bj < 2; ++bj) { f32x4 v0 = acc[ai][bj][m][0], v1 = acc[ai][bj][m][1];
                        if (wc == 0) {
                            f32x4 p0, p1;
#pragma unroll
                            for (int j = 0; j < 4; ++j) { p0[j] = __shfl_xor(v0[j], 32) * sgn; p1[j] = __shfl_xor(v1[j], 32) * sgn; }
                            v0[0] = v0[0] * c0[0] + p0[0] * c0[1]; v0[1] = v0[1] * c0[2] + p0[1] * c0[3]; v0[2] = v0[2] * c1[0] + p0[2] * c1[1]; v0[3] = v0[3] * c1[2] + p0[3] * c1[3];
                            v1[0] = v1[0] * c2[0] + p1[0] * c2[1]; v1[1] = v1[1] * c2[2] + p1[1] * c2[3]; v1[2] = v1[2] * c3[0] + p1[2] * c3[1]; v1[3] = v1[3] * c3[2] + p1[3] * c3[3];
                        }
                        u32x4 w; w.x = pk2(v0[0], v0[1]); w.y = pk2(v0[2], v0[3]); w.z = pk2(v1[0], v1[1]); w.w = pk2(v1[2], v1[3]);
                        *(u32x4*)(base + (size_t)row * AW + bj * 128) = w; } }
        } else if (pn < 12) {
            bf16* base = v + (pn - 8) * 256 + colw;
#pragma unroll
            for (int ai = 0; ai < 2; ++ai)
#pragma unroll
                for (int m = 0; m < 4; ++m) { const int row = row0 + ai * 128 + m * 16;
#pragma unroll
                    for (int bj = 0; bj < 2; ++bj) { const f32x4 v0 = acc[ai][bj][m][0], v1 = acc[ai][bj][m][1];
                        u32x4 w; w.x = pk2(v0[0], v0[1]); w.y = pk2(v0[2], v0[3]); w.z = pk2(v1[0], v1[1]); w.w = pk2(v1[2], v1[3]);
                        *(u32x4*)(base + (size_t)row * AW + bj * 128) = w; } }
        } else if (pn < 24) {
            float* base = rkv + (pn - 12) * 256 + colw;
#pragma unroll
            for (int ai = 0; ai < 2; ++ai)
#pragma unroll
                for (int m = 0; m < 4; ++m) { const int row = row0 + ai * 128 + m * 16;
#pragma unroll
                    for (int bj = 0; bj < 2; ++bj) { float* p = base + (size_t)row * (3 * RW) + bj * 128; *(f32x4*)p = acc[ai][bj][m][0]; *(f32x4*)(p + 4) = acc[ai][bj][m][1]; } }
        } else if (pn < 40) {
            bf16* base = gate + (pn - 24) * 128 + colw;
#pragma unroll
            for (int ai = 0; ai < 2; ++ai)
#pragma unroll
                for (int m = 0; m < 4; ++m) { const int row = row0 + ai * 128 + m * 16;
                    const f32x4 a0 = acc[ai][0][m][0], a1 = acc[ai][0][m][1], r0 = acc[ai][1][m][0], r1 = acc[ai][1][m][1]; float ra[8], sr[8];
#pragma unroll
                    for (int j = 0; j < 4; ++j) { const float ea = __expf(-a0[j]), er = __expf(-r0[j]), ea1 = __expf(-a1[j]), er1 = __expf(-r1[j]);
                        sr[j] = __builtin_amdgcn_rcpf(1.0f + er); ra[j] = (1.0f + er) * __builtin_amdgcn_rcpf(1.0f + ea); sr[4 + j] = __builtin_amdgcn_rcpf(1.0f + er1); ra[4 + j] = (1.0f + er1) * __builtin_amdgcn_rcpf(1.0f + ea1); }
                    u32x4 w; w.x = pk2(ra[0], ra[1]); w.y = pk2(ra[2], ra[3]); w.z = pk2(ra[4], ra[5]); w.w = pk2(ra[6], ra[7]);
                    *(u32x4*)(base + (size_t)row * (2 * D)) = w;
                    w.x = pk2(sr[0], sr[1]); w.y = pk2(sr[2], sr[3]); w.z = pk2(sr[4], sr[5]); w.w = pk2(sr[6], sr[7]);
                    *(u32x4*)(base + (size_t)row * (2 * D) + D) = w; }
        } else {
            float* base = (u.koff ? lorab : lora) + (pn - 40) * 256 + colw;
#pragma unroll
            for (int ai = 0; ai < 2; ++ai)
#pragma unroll
                for (int m = 0; m < 4; ++m) { const int row = row0 + ai * 128 + m * 16;
#pragma unroll
                    for (int bj = 0; bj < 2; ++bj) { float* p = base + (size_t)row * 1024 + bj * 128; *(f32x4*)p = acc[ai][bj][m][0]; *(f32x4*)(p + 4) = acc[ai][bj][m][1]; } }
        }
    }
};


struct LoraOrder { static constexpr bool GATHER = false; const int* tok; int G, c;
    __device__ bool next(int i, pg8::Unit& u) const { const int L = i * G + c; if (L >= (S / 256) * 8) return false; u.pm = L >> 3; u.pn = 40 + ((L >> 1) & 3); u.koff = (L & 1) * AW * 2; u.koffB = u.koff; return true; }
    __device__ __forceinline__ void a_ready(const pg8::Unit&) const {}
    __device__ __forceinline__ void done(const pg8::Unit&) const {} };
__device__ __forceinline__ void unpack8(const u32x4 w, float (&f)[8]) {
    f[0] = __uint_as_float(w.x << 16); f[1] = __uint_as_float(w.x & 0xffff0000u); f[2] = __uint_as_float(w.y << 16); f[3] = __uint_as_float(w.y & 0xffff0000u);
    f[4] = __uint_as_float(w.z << 16); f[5] = __uint_as_float(w.z & 0xffff0000u); f[6] = __uint_as_float(w.w << 16); f[7] = __uint_as_float(w.w & 0xffff0000u);
}
struct EpiMix {
    static constexpr bool PERM = true, AFTER_DRAIN = false, MIDK = false;
    const bf16* gate; bf16* mix;
    __device__ __forceinline__ void operator()(const pg8::f32x4 (&acc)[2][2][4][2], const pg8::Unit& u, int wr, int wc, int fr, int fq) const {
        const int row0 = u.pm * 256 + wr * 64 + fr; const int col0 = u.pn * 256 + wc * 32 + 8 * fq;
        if (u.koff == 0) {
#pragma unroll
            for (int ai = 0; ai < 2; ++ai)
#pragma unroll
                for (int m = 0; m < 4; ++m) { const size_t row = row0 + ai * 128 + m * 16; const bf16* gp = gate + row * (2 * D) + col0;
#pragma unroll
                    for (int bj = 0; bj < 2; ++bj) { float ga[8]; unpack8(*(const u32x4*)(gp + bj * 128), ga); const pg8::f32x4 v0 = acc[ai][bj][m][0], v1 = acc[ai][bj][m][1];
                        u32x4 w; w.x = pk2(v0[0] * ga[0], v0[1] * ga[1]); w.y = pk2(v0[2] * ga[2], v0[3] * ga[3]); w.z = pk2(v1[0] * ga[4], v1[1] * ga[5]); w.w = pk2(v1[2] * ga[6], v1[3] * ga[7]);
                        *(u32x4*)(mix + row * D + col0 + bj * 128) = w; } }
        } else {
#pragma unroll
            for (int ai = 0; ai < 2; ++ai)
#pragma unroll
                for (int m = 0; m < 4; ++m) { const size_t row = row0 + ai * 128 + m * 16; const bf16* gp = gate + row * (2 * D) + D + col0;
#pragma unroll
                    for (int bj = 0; bj < 2; ++bj) { float gr[8], tp[8]; unpack8(*(const u32x4*)(gp + bj * 128), gr); unpack8(*(const u32x4*)(mix + row * D + col0 + bj * 128), tp); const pg8::f32x4 v0 = acc[ai][bj][m][0], v1 = acc[ai][bj][m][1];
                        u32x4 w; w.x = pk2((v0[0] + tp[0]) * gr[0], (v0[1] + tp[1]) * gr[1]); w.y = pk2((v0[2] + tp[2]) * gr[2], (v0[3] + tp[3]) * gr[3]);
                        w.z = pk2((v1[0] + tp[4]) * gr[4], (v1[1] + tp[5]) * gr[5]); w.w = pk2((v1[2] + tp[6]) * gr[6], (v1[3] + tp[7]) * gr[7]);
                        *(u32x4*)(mix + row * D + col0 + bj * 128) = w; } }
        }
    }
};
struct MixOrder {
    static constexpr bool GATHER = false; const int* tok; int G, c;
    __device__ bool next(int i, pg8::Unit& u) const { const int L = (i >> 1) * G + c; if (L >= (S / 256) * (D / 256)) return false; u.pm = L / (D / 256); u.pn = L % (D / 256); u.koff = (i & 1) * AW * 2; u.koffB = u.koff; return true; }
    __device__ __forceinline__ void a_ready(const pg8::Unit&) const {}
    __device__ __forceinline__ void done(const pg8::Unit&) const {}
};
struct EpiBf16P {
    static constexpr bool PERM = true, AFTER_DRAIN = false, MIDK = false;
    bf16* C; long ldc;
    __device__ __forceinline__ void operator()(const pg8::f32x4 (&acc)[2][2][4][2], const pg8::Unit& u, int wr, int wc, int fr, int fq) const {
        const int row0 = u.pm * 256 + wr * 64 + fr; const int col0 = u.pn * 256 + wc * 32 + 8 * fq;
#pragma unroll
        for (int ai = 0; ai < 2; ++ai)
#pragma unroll
            for (int m = 0; m < 4; ++m) { bf16* p = C + (size_t)(row0 + ai * 128 + m * 16) * ldc + col0;
#pragma unroll
                for (int bj = 0; bj < 2; ++bj) { const pg8::f32x4 v0 = acc[ai][bj][m][0], v1 = acc[ai][bj][m][1];
                    u32x4 w; w.x = pk2(v0[0], v0[1]); w.y = pk2(v0[2], v0[3]); w.z = pk2(v1[0], v1[1]); w.w = pk2(v1[2], v1[3]);
                    *(u32x4*)(p + bj * 128) = w; } }
    }
};
struct EpiF32P {
    static constexpr bool PERM = true, AFTER_DRAIN = false, MIDK = false;
    float* C; long ldc;
    __device__ __forceinline__ void operator()(const pg8::f32x4 (&acc)[2][2][4][2], const pg8::Unit& u, int wr, int wc, int fr, int fq) const {
        const int row0 = u.pm * 256 + wr * 64 + fr; const int col0 = u.pn * 256 + wc * 32 + 8 * fq;
#pragma unroll
        for (int ai = 0; ai < 2; ++ai)
#pragma unroll
            for (int m = 0; m < 4; ++m) { float* p = C + (size_t)(row0 + ai * 128 + m * 16) * ldc + col0;
#pragma unroll
                for (int bj = 0; bj < 2; ++bj) { *(f32x4*)(p + bj * 128) = acc[ai][bj][m][0]; *(f32x4*)(p + bj * 128 + 4) = acc[ai][bj][m][1]; } }
    }
};
template <bool GA> struct ExpertOrderT {
    static constexpr bool GATHER = GA; const int* tok;
    const int* tile_e; int ntiles, nj, G, c;
    __device__ bool next(int i, pg8::Unit& u) const { const int L = i * G + c; const int pm = L / nj; if (pm >= ntiles) return false; u.pm = pm; u.pn = tile_e[pm] * nj + (L % nj); u.koff = 0; u.koffB = 0; return true; }
    __device__ __forceinline__ void a_ready(const pg8::Unit&) const {}
    __device__ __forceinline__ void done(const pg8::Unit&) const {}
};
struct EpiHid {
    static constexpr bool PERM = true, AFTER_DRAIN = false, MIDK = false;
    unsigned char* hid;
    __device__ __forceinline__ void operator()(const pg8::f32x4 (&acc)[2][2][4][2], const pg8::Unit& u, int wr, int wc, int fr, int fq) const {
        const int row0 = u.pm * 128 + wr * 64 + fr; const int col0 = (u.pn & 3) * 128 + wc * 32 + 8 * fq;
#pragma unroll
        for (int ai = 0; ai < 1; ++ai)
#pragma unroll
            for (int m = 0; m < 4; ++m) { const pg8::f32x4 g0 = acc[ai][0][m][0], g1 = acc[ai][0][m][1], u0 = acc[ai][1][m][0], u1 = acc[ai][1][m][1]; float o[8];
#pragma unroll
                for (int j = 0; j < 4; ++j) { o[j] = g0[j] * sigmoidf_(g0[j]) * u0[j]; o[4 + j] = g1[j] * sigmoidf_(g1[j]) * u1[j]; }
                u32x2 w; w.x = pk_fp8x4(o[0], o[1], o[2], o[3], 8.0f); w.y = pk_fp8x4(o[4], o[5], o[6], o[7], 8.0f);
                *(u32x2*)(hid + (size_t)(row0 + ai * 128 + m * 16) * FF + col0) = w; }
    }
};
struct EpiYbuf {
    static constexpr bool PERM = true, AFTER_DRAIN = false, MIDK = false;
    bf16* ybuf;
    __device__ __forceinline__ void operator()(const pg8::f32x4 (&acc)[2][2][4][2], const pg8::Unit& u, int wr, int wc, int fr, int fq) const {
        const int row0 = u.pm * 128 + wr * 64 + fr; const int col0 = (u.pn & 7) * 256 + wc * 32 + 8 * fq;
#pragma unroll
        for (int ai = 0; ai < 1; ++ai)
#pragma unroll
            for (int m = 0; m < 4; ++m) { bf16* p = ybuf + (size_t)(row0 + ai * 128 + m * 16) * D + col0;
#pragma unroll
                for (int bj = 0; bj < 2; ++bj) { const pg8::f32x4 v0 = acc[ai][bj][m][0], v1 = acc[ai][bj][m][1];
                    u32x4 w; w.x = pk2(v0[0], v0[1]); w.y = pk2(v0[2], v0[3]); w.z = pk2(v1[0], v1[1]); w.w = pk2(v1[2], v1[3]);
                    *(u32x4*)(p + bj * 128) = w; } }
    }
};
constexpr int RS8 = D + 8;

typedef short s16x4 __attribute__((ext_vector_type(4)));
constexpr int KST = 136, VST = 144;
constexpr int KT_BYTES = 64 * KST * 2, VT_BYTES = 64 * VST * 2;
constexpr int AT_BUF = KT_BYTES + VT_BYTES;
constexpr int AT_G = 2 * AT_BUF;
constexpr int AT_HIST = AT_G + 8 * 2112;
constexpr int AT_ITEMS = AT_HIST + 256;
constexpr int LIST_PER_HEAD = 256 * 496;
__device__ __forceinline__ int list_off(int j) { return 256 * (31 * j - (j * (j - 1)) / 2); }
__device__ __forceinline__ s16x4 tr_read4(unsigned addr) { return __builtin_amdgcn_ds_read_tr16_b64_v4i16((LAS s16x4*)(size_t)addr); }

struct AttnBufs { const bf16* q; const bf16* k; const bf16* v; const bf16* kmh; const bf16* kml; unsigned* mask; int* list; int* cnt; bf16* part; float* ml; };

__device__ __forceinline__ void moba_select_unit(LAS unsigned char* lds, const AttnBufs& A, int head, int qt, int tid, int lane, int wave) {
    const int q0 = qt * 128, qblk = qt >> 1, g4 = lane >> 4, c16 = lane & 15; const int myq = q0 + wave * 16 + c16;
    LAS int* hist = (LAS int*)(lds + AT_HIST); LAS int* base = hist + 32;
    if (tid < 32) hist[tid] = 0;
    __syncthreads();
    unsigned msk = 0u; int lp0 = 0, lp1 = 0, lp2 = 0, b0 = 0, b1 = 0, b2 = 0, nsel = 0;
    if (qblk > 0) {
        bf16x8 qf[4];
#pragma unroll
        for (int ks = 0; ks < 4; ++ks) qf[ks] = *(const bf16x8*)(A.q + (size_t)myq * AW + head * AD + 32 * ks + 8 * g4);
        f32x4 gs[2] = {(f32x4){0.f, 0.f, 0.f, 0.f}, (f32x4){0.f, 0.f, 0.f, 0.f}};
#pragma unroll
        for (int mt = 0; mt < 2; ++mt)
#pragma unroll
            for (int ks = 0; ks < 4; ++ks) { const size_t o = (size_t)(head * NB + 16 * mt + c16) * AD + 32 * ks + 8 * g4;
                gs[mt] = __builtin_amdgcn_mfma_f32_16x16x32_bf16(*(const bf16x8*)(A.kmh + o), qf[ks], gs[mt], 0, 0, 0);
                gs[mt] = __builtin_amdgcn_mfma_f32_16x16x32_bf16(*(const bf16x8*)(A.kml + o), qf[ks], gs[mt], 0, 0, 0); }
        LAS float* G = (LAS float*)(lds + AT_G + wave * 2112);
#pragma unroll
        for (int mt = 0; mt < 2; ++mt)
#pragma unroll
            for (int rg = 0; rg < 4; ++rg) G[c16 * 33 + 16 * mt + 4 * g4 + rg] = gs[mt][rg];
        LDS_WAIT(); asm volatile("" ::: "memory");
        if (lane < 16) {
            nsel = qblk < 3 ? qblk : 3;
            float gvv[32];
#pragma unroll
            for (int n = 0; n < 32; ++n) gvv[n] = G[lane * 33 + n];
#pragma unroll
            for (int n = 0; n < 32; ++n) gvv[n] = n < qblk ? gvv[n] : -3e38f;
#pragma unroll
            for (int t = 0; t < 3; ++t) if (t < nsel) { float best = -3e38f; int bi = 0;
#pragma unroll
                for (int n = 0; n < 32; ++n) { const bool take = gvv[n] > best; best = take ? gvv[n] : best; bi = take ? n : bi; }
#pragma unroll
                for (int n = 0; n < 32; ++n) gvv[n] = (n == bi) ? -3e38f : gvv[n];
                msk |= 1u << bi;
                const int lp = atomicAdd((int*)&hist[bi], 1); if (t == 0) { lp0 = lp; b0 = bi; } else if (t == 1) { lp1 = lp; b1 = bi; } else { lp2 = lp; b2 = bi; } }
        }
    }
    if (lane < 16) A.mask[head * S + myq] = msk;
    __syncthreads();
    if (tid < 32) { const int hcount = hist[tid]; base[tid] = hcount > 0 ? atomicAdd(A.cnt + head * NB + tid, hcount) : 0; }
    __syncthreads();
    if (lane < 16) { int* lh = A.list + head * LIST_PER_HEAD;
        if (nsel > 0) lh[list_off(b0) + base[b0] + lp0] = myq;
        if (nsel > 1) lh[list_off(b1) + base[b1] + lp1] = myq;
        if (nsel > 2) lh[list_off(b2) + base[b2] + lp2] = myq; }
    __syncthreads();
}

__device__ __forceinline__ void moba_item2(LAS unsigned char* lds, const AttnBufs& A, int head, int kvb, bool own, int r, int cntj, int tid, int lane, int wave) {
    const int g4 = lane >> 4, c16 = lane & 15;
    int myq[2]; bool valid[2];
    if (own) { myq[0] = kvb * MB + wave * 32 + c16; myq[1] = myq[0] + 16; valid[0] = true; valid[1] = true; }
    else { const int* lp = A.list + head * LIST_PER_HEAD + list_off(kvb);
#pragma unroll
        for (int g = 0; g < 2; ++g) { const int e = r * 256 + wave * 32 + 16 * g + c16; valid[g] = e < cntj; myq[g] = lp[valid[g] ? e : 0]; } }
    const bool wave_valid = own || (r * 256 + wave * 32 < cntj);
    const int qfirst = kvb * MB + wave * 32;
    bf16x8 qf[2][4];
#pragma unroll
    for (int g = 0; g < 2; ++g)
#pragma unroll
        for (int ks = 0; ks < 4; ++ks) qf[g][ks] = *(const bf16x8*)(A.q + (size_t)myq[g] * AW + head * AD + 32 * ks + 8 * g4);
    f32x4 oacc[2][8];
#pragma unroll
    for (int g = 0; g < 2; ++g)
#pragma unroll
        for (int dt = 0; dt < 8; ++dt) oacc[g][dt] = (f32x4){0.f, 0.f, 0.f, 0.f};
    float mrun[2] = {-1e30f, -1e30f}, lrun[2] = {0.f, 0.f};
    const float sc2 = 0.08838834764831845f * 1.4426950408889634f;
    const int r0 = tid >> 4, ch = tid & 15;
    u32x4 kr[2], vr[2];
    const bf16* kg = A.k + (size_t)(kvb * MB + r0) * AW + head * AD + 8 * ch; const bf16* vg = A.v + (size_t)(kvb * MB + r0) * AW + head * AD + 8 * ch;
    LAS unsigned char* kst = lds + (r0 * KST + 8 * ch) * 2; LAS unsigned char* vst = lds + KT_BYTES + (r0 * VST + 8 * ch) * 2;
    const LAS unsigned char* kld = lds + (c16 * KST + 8 * g4) * 2; const LAS unsigned char* vld = lds + KT_BYTES + ((4 * g4 + (c16 >> 2)) * VST + 4 * (c16 & 3)) * 2;
#define GLD(it) do { kr[0] = *(const u32x4*)(kg + (size_t)(64 * (it)) * AW); kr[1] = *(const u32x4*)(kg + (size_t)(64 * (it) + 32) * AW); vr[0] = *(const u32x4*)(vg + (size_t)(64 * (it)) * AW); vr[1] = *(const u32x4*)(vg + (size_t)(64 * (it) + 32) * AW); } while (0)
#define LST(b) do { *(LAS u32x4*)(kst + (b) * AT_BUF) = kr[0]; *(LAS u32x4*)(kst + (b) * AT_BUF + 32 * KST * 2) = kr[1]; *(LAS u32x4*)(vst + (b) * AT_BUF) = vr[0]; *(LAS u32x4*)(vst + (b) * AT_BUF + 32 * VST * 2) = vr[1]; } while (0)
    GLD(0); LST(0);
    __syncthreads();
#pragma nounroll
    for (int it = 0; it < 4; ++it) {
        const int kp0 = kvb * MB + 64 * it; const int b = it & 1;
        if (it + 1 < 4) GLD(it + 1);
        if (wave_valid && (!own || kp0 <= qfirst + 31)) {
            const LAS unsigned char* Kb = kld + b * AT_BUF; const LAS unsigned char* vb = vld + b * AT_BUF;
            f32x4 st[2][4];
#pragma unroll
            for (int mt = 0; mt < 4; ++mt) { st[0][mt] = (f32x4){0.f, 0.f, 0.f, 0.f}; st[1][mt] = st[0][mt];
#pragma unroll
                for (int ks = 0; ks < 4; ++ks) { const bf16x8 kf = *(const LAS bf16x8*)(Kb + (16 * mt * KST + 32 * ks) * 2);
                    st[0][mt] = __builtin_amdgcn_mfma_f32_16x16x32_bf16(kf, qf[0][ks], st[0][mt], 0, 0, 0);
                    st[1][mt] = __builtin_amdgcn_mfma_f32_16x16x32_bf16(kf, qf[1][ks], st[1][mt], 0, 0, 0); } }
            bf16x8 pf[2][2];
#pragma unroll
            for (int g = 0; g < 2; ++g) {
                if (own && kp0 + 63 > qfirst + 16 * g) {
#pragma unroll
                    for (int mt = 0; mt < 4; ++mt)
#pragma unroll
                        for (int rg = 0; rg < 4; ++rg) { const int kpos = kp0 + 16 * mt + 4 * g4 + rg; st[g][mt][rg] = (kpos <= myq[g]) ? st[g][mt][rg] : -1e30f; }
                }
                float mloc = fmaxf(fmaxf(fmaxf(st[g][0][0], st[g][0][1]), fmaxf(st[g][0][2], st[g][0][3])), fmaxf(fmaxf(st[g][1][0], st[g][1][1]), fmaxf(st[g][1][2], st[g][1][3])));
                mloc = fmaxf(mloc, fmaxf(fmaxf(fmaxf(st[g][2][0], st[g][2][1]), fmaxf(st[g][2][2], st[g][2][3])), fmaxf(fmaxf(st[g][3][0], st[g][3][1]), fmaxf(st[g][3][2], st[g][3][3]))));
                mloc = fmaxf(mloc, __shfl_xor(mloc, 16)); mloc = fmaxf(mloc, __shfl_xor(mloc, 32));
                const float mnew = fmaxf(mrun[g], mloc * sc2); const float alpha = __builtin_amdgcn_exp2f(mrun[g] - mnew); mrun[g] = mnew;
                float psum = 0.f;
#pragma unroll
                for (int mt = 0; mt < 4; ++mt)
#pragma unroll
                    for (int rg = 0; rg < 4; ++rg) { const float p = __builtin_amdgcn_exp2f(fmaf(st[g][mt][rg], sc2, -mnew)); st[g][mt][rg] = p; psum += p; }
                lrun[g] = lrun[g] * alpha + psum;
#pragma unroll
                for (int dt = 0; dt < 8; ++dt) oacc[g][dt] = oacc[g][dt] * alpha;
#pragma unroll
                for (int s = 0; s < 2; ++s) { u32x4 w; w.x = pk2(st[g][2 * s][0], st[g][2 * s][1]); w.y = pk2(st[g][2 * s][2], st[g][2 * s][3]); w.z = pk2(st[g][2 * s + 1][0], st[g][2 * s + 1][1]); w.w = pk2(st[g][2 * s + 1][2], st[g][2 * s + 1][3]);
                    pf[g][s] = __builtin_bit_cast(bf16x8, w); }
            }
#pragma unroll
            for (int dt = 0; dt < 8; ++dt)
#pragma unroll
                for (int s = 0; s < 2; ++s) {
                    const s16x4 lo = __builtin_amdgcn_ds_read_tr16_b64_v4i16((LAS s16x4*)(vb + (32 * s * VST + 16 * dt) * 2));
                    const s16x4 hi = __builtin_amdgcn_ds_read_tr16_b64_v4i16((LAS s16x4*)(vb + ((32 * s + 16) * VST + 16 * dt) * 2));
                    bf16x8 vf; vf[0] = lo[0]; vf[1] = lo[1]; vf[2] = lo[2]; vf[3] = lo[3]; vf[4] = hi[0]; vf[5] = hi[1]; vf[6] = hi[2]; vf[7] = hi[3];
                    oacc[0][dt] = __builtin_amdgcn_mfma_f32_16x16x32_bf16(vf, pf[0][s], oacc[0][dt], 0, 0, 0);
                    oacc[1][dt] = __builtin_amdgcn_mfma_f32_16x16x32_bf16(vf, pf[1][s], oacc[1][dt], 0, 0, 0); }
        }
        if (it + 1 < 4) LST(b ^ 1);
        __syncthreads();
    }
#undef GLD
#undef LST
#pragma unroll
    for (int g = 0; g < 2; ++g) {
        float l = lrun[g]; l += __shfl_xor(l, 16); l += __shfl_xor(l, 32);
        if (valid[g] && wave_valid) {
            int slot = 0; if (!own) { const unsigned mk = A.mask[head * S + myq[g]]; slot = 1 + __builtin_popcount(mk & ((1u << kvb) - 1u)); }
            const size_t pidx = ((size_t)(head * S + myq[g])) * 4 + slot;
            const float inv = 1.0f / l;
            bf16* orow = A.part + pidx * AD + 4 * g4;
#pragma unroll
            for (int dt = 0; dt < 8; ++dt) { u32x2 w; w.x = pk2(oacc[g][dt][0] * inv, oacc[g][dt][1] * inv); w.y = pk2(oacc[g][dt][2] * inv, oacc[g][dt][3] * inv); *(u32x2*)(orow + 16 * dt) = w; }
            if (g4 == 0) { A.ml[pidx * 2] = mrun[g]; A.ml[pidx * 2 + 1] = l; }
        }
    }
}
__device__ __forceinline__ void moba_items(LAS unsigned char* lds, const AttnBufs& A, int* qhead, LAS int* pre, LAS int* tick, int tid, int lane, int wave) {
    const int nitems = AH * NB + pre[256];
    if (tid == 0) tick[0] = atomicAdd(qhead, 1);
    __syncthreads();
    int item = tick[0];
    while (item < nitems) {
        __syncthreads();
        if (tid == 0) tick[0] = atomicAdd(qhead, 1);
        if (item < AH * NB) moba_item2(lds, A, item >> 5, item & 31, true, 0, 0, tid, lane, wave);
        else { const int s = item - AH * NB; int lo_ = 0, hi_ = 256;
            while (hi_ - lo_ > 1) { const int mid = (lo_ + hi_) >> 1; if (pre[mid] <= s) lo_ = mid; else hi_ = mid; }
            moba_item2(lds, A, lo_ >> 5, lo_ & 31, false, s - pre[lo_], A.cnt[lo_], tid, lane, wave); }
        __syncthreads();
        item = tick[0];
    }
}

constexpr int RST = 72, SLOTB = 64 * RST * 2;
constexpr int NCH = S / 64;
__device__ __forceinline__ bf16x8 frag_rows(const LAS bf16* M, int r0, int k0, int c16, int g4) { return *(const LAS bf16x8*)(M + (r0 + c16) * RST + k0 + 8 * g4); }
__device__ __forceinline__ bf16x8 frag_cols(const LAS bf16* M, int c0, int k0, int c16, int g4) {
    const unsigned base = (unsigned)(size_t)M; const int tq = c16 >> 2, tp = c16 & 3;
    const s16x4 lo = tr_read4(base + ((k0 + 8 * g4 + tq) * RST + c0 + 4 * tp) * 2);
    const s16x4 hi = tr_read4(base + ((k0 + 8 * g4 + 4 + tq) * RST + c0 + 4 * tp) * 2);
    bf16x8 r; r[0] = lo[0]; r[1] = lo[1]; r[2] = lo[2]; r[3] = lo[3]; r[4] = hi[0]; r[5] = hi[1]; r[6] = hi[2]; r[7] = hi[3]; return r;
}
__device__ __forceinline__ void st_tile(LAS bf16* M, const f32x4 v, int r0, int c0, int c16, int g4) {
#pragma unroll
    for (int rg = 0; rg < 4; rg += 2) { const unsigned p = pk2(v[rg], v[rg + 1]); M[(r0 + 4 * g4 + rg) * RST + c0 + c16] = (bf16)(p & 0xffffu); M[(r0 + 4 * g4 + rg + 1) * RST + c0 + c16] = (bf16)(p >> 16); }
}
#define MFMA16(a, b, c) __builtin_amdgcn_mfma_f32_16x16x32_bf16(a, b, c, 0, 0, 0)

struct RwkvBufs { const float* rkv; const float* lw; const float* av; bf16* P; float* QmT; bf16* Rt; float* Yi; float* bonus; };

#define R1_BAR() do { asm volatile("s_waitcnt lgkmcnt(0)" ::: "memory"); __builtin_amdgcn_s_barrier(); asm volatile("" ::: "memory"); } while (0)
struct R1In { float lwv[8], av[8], rr[9], kr[9], vr[9]; };
__device__ __forceinline__ void rwkv_r1_load(R1In& I, const RwkvBufs& B, int head, int chunk, int lane, int wave) {
    const int ch = head * RN + lane; const int t0 = chunk * 64 + wave * 8;
#pragma unroll
    for (int i = 0; i < 8; ++i) { I.lwv[i] = B.lw[(size_t)(t0 + i) * RW + ch]; I.av[i] = B.av[(size_t)(t0 + i) * RW + ch]; }
#pragma unroll
    for (int i = 0; i < 9; ++i) { const int t = t0 - 1 + i; if (t >= 0) { const float* cr = B.rkv + (size_t)t * (3 * RW) + ch; I.rr[i] = cr[0]; I.kr[i] = cr[RW]; I.vr[i] = cr[2 * RW]; } else { I.rr[i] = 0.f; I.kr[i] = 0.f; I.vr[i] = 0.f; } }
}
__device__ __forceinline__ void rwkv_r1_unit(LAS unsigned char* lds, const RwkvBufs& B, const float* const* in, R1In& I, int head, int chunk, int nhead, int nchunk, int tid, int lane, int wave) {
    LAS bf16* sA = (LAS bf16*)(lds + 0 * SLOTB); LAS bf16* sB = (LAS bf16*)(lds + 1 * SLOTB); LAS bf16* sK = (LAS bf16*)(lds + 2 * SLOTB); LAS bf16* sR = (LAS bf16*)(lds + 3 * SLOTB); LAS bf16* sV = (LAS bf16*)(lds + 4 * SLOTB);
    LAS bf16* sM0 = (LAS bf16*)(lds + 5 * SLOTB); LAS bf16* sM1 = (LAS bf16*)(lds + 6 * SLOTB); LAS bf16* sT0 = (LAS bf16*)(lds + 7 * SLOTB); LAS bf16* sT1 = (LAS bf16*)(lds + 8 * SLOTB);
    LAS bf16* sLak = (LAS bf16*)(lds + 9 * SLOTB); LAS bf16* sMrb = (LAS bf16*)(lds + 10 * SLOTB); LAS bf16* sMrk = (LAS bf16*)(lds + 11 * SLOTB); LAS bf16* sX = (LAS bf16*)(lds + 12 * SLOTB);
    LAS bf16* sW = (LAS bf16*)(lds + 13 * SLOTB); LAS bf16* sU = (LAS bf16*)(lds + 14 * SLOTB);
    LAS float* cs = (LAS float*)(lds + 15 * SLOTB); LAS float* gC = cs + 512;
    const int c16 = lane & 15, g4 = lane >> 4;
    {
        const int ch = head * RN + lane; const int t0 = chunk * 64 + wave * 8;
        const float mur = in[9][ch], muk = in[10][ch], muv = in[11][ch], kkc = in[23][ch], kac = in[24][ch], rkc = in[25][ch];
        float run = 0.f;
#pragma unroll
        for (int i = 0; i < 8; ++i) run += I.lwv[i];
        cs[wave * 64 + lane] = run;
        R1_BAR();
        float off = 0.f;
        for (int w = 0; w < wave; ++w) off += cs[w * 64 + lane];
        float gcur = off;
#pragma unroll
        for (int i = 0; i < 8; ++i) {
            const int t = t0 + i;
            const float r0 = I.rr[i + 1], k0 = I.kr[i + 1], v0 = I.vr[i + 1], rp = I.rr[i], kp = I.kr[i], vp = I.vr[i];
            const float r = r0 + (rp - r0) * mur, kx = k0 + (kp - k0) * muk, vx = v0 + (vp - v0) * muv;
            const float a = I.av[i];
            float kk = kx * kkc; const float ss = wave_sum(kk * kk); kk = kk * __builtin_amdgcn_rcpf(fmaxf(sqrtf(ss), 1e-12f));
            const float kt = kx * (1.0f + (a - 1.0f) * kac);
            const float bn = wave_sum(r * kt * rkc);
            if (lane == 0) B.bonus[(size_t)t * RH + head] = bn;
            const float gprev = gcur; gcur += I.lwv[i];
            const float eg = __expf(gcur), egp = __expf(gprev), eng = __expf(-gcur);
            const int tl = wave * 8 + i;
            { const unsigned pab = pk2(-kk * egp, kk * a * eng), pkr = pk2(kt * eng, r * eg), pv_ = pk2(vx, vx);
              sA[tl * RST + lane] = (bf16)(pab & 0xffffu); sB[tl * RST + lane] = (bf16)(pab >> 16); sK[tl * RST + lane] = (bf16)(pkr & 0xffffu); sR[tl * RST + lane] = (bf16)(pkr >> 16); sV[tl * RST + lane] = (bf16)(pv_ & 0xffffu); }
        }
        if (wave == 7) gC[lane] = __expf(gcur);
    }
    if (nhead >= 0) rwkv_r1_load(I, B, nhead, nchunk, lane, wave);
    R1_BAR();
    const int mt = wave >> 1, ntb = 2 * (wave & 1);
    f32x4 Treg[2];
    for (int r14 = 0; r14 < 1 + REP_R1A; ++r14) {
        f32x4 ab[2], ak[2], rb[2], rk[2];
#pragma unroll
        for (int n = 0; n < 2; ++n) { ab[n] = (f32x4){0.f, 0.f, 0.f, 0.f}; ak[n] = ab[n]; rb[n] = ab[n]; rk[n] = ab[n]; }
#pragma unroll
        for (int s = 0; s < 2; ++s) { const bf16x8 aA = frag_rows(sA, 16 * mt, 32 * s, c16, g4), aR = frag_rows(sR, 16 * mt, 32 * s, c16, g4);
#pragma unroll
            for (int n = 0; n < 2; ++n) { const bf16x8 bB = frag_rows(sB, 16 * (ntb + n), 32 * s, c16, g4), bK = frag_rows(sK, 16 * (ntb + n), 32 * s, c16, g4);
                ab[n] = MFMA16(aA, bB, ab[n]); ak[n] = MFMA16(aA, bK, ak[n]); rb[n] = MFMA16(aR, bB, rb[n]); rk[n] = MFMA16(aR, bK, rk[n]); } }
#pragma unroll
        for (int n = 0; n < 2; ++n) { const int i = 16 * (ntb + n) + c16;
#pragma unroll
            for (int rg = 0; rg < 4; ++rg) { const int t = 16 * mt + 4 * g4 + rg; const bool lo = i < t, le = i <= t;
                ab[n][rg] = lo ? ab[n][rg] : 0.f; ak[n][rg] = lo ? ak[n][rg] : 0.f; rb[n][rg] = le ? rb[n][rg] : 0.f; rk[n][rg] = le ? rk[n][rg] : 0.f;
                Treg[n][rg] = ab[n][rg] + (i == t ? 1.0f : 0.f); }
            st_tile(sM0, ab[n], 16 * mt, 16 * (ntb + n), c16, g4); st_tile(sT0, Treg[n], 16 * mt, 16 * (ntb + n), c16, g4);
            st_tile(sLak, ak[n], 16 * mt, 16 * (ntb + n), c16, g4); st_tile(sMrb, rb[n], 16 * mt, 16 * (ntb + n), c16, g4); st_tile(sMrk, rk[n], 16 * mt, 16 * (ntb + n), c16, g4); }
    }
    R1_BAR();
    LAS bf16* Tc = sT0; LAS bf16* Tn = sT1; LAS bf16* Mc = sM0; LAS bf16* Mn = sM1;
    {
        f32x4 am[2] = {(f32x4){0.f, 0.f, 0.f, 0.f}, (f32x4){0.f, 0.f, 0.f, 0.f}}, ax[2] = {(f32x4){0.f, 0.f, 0.f, 0.f}, (f32x4){0.f, 0.f, 0.f, 0.f}};
#pragma unroll
        for (int s = 0; s < 2; ++s) { const bf16x8 aM = frag_rows(Mc, 16 * mt, 32 * s, c16, g4), aL = frag_rows(sLak, 16 * mt, 32 * s, c16, g4);
#pragma unroll
            for (int n = 0; n < 2; ++n) { am[n] = MFMA16(aM, frag_cols(Mc, 16 * (ntb + n), 32 * s, c16, g4), am[n]); ax[n] = MFMA16(aL, frag_cols(sV, 16 * (ntb + n), 32 * s, c16, g4), ax[n]); } }
#pragma unroll
        for (int n = 0; n < 2; ++n) { st_tile(Mn, am[n], 16 * mt, 16 * (ntb + n), c16, g4); st_tile(sX, ax[n], 16 * mt, 16 * (ntb + n), c16, g4); }
        R1_BAR();
        LAS bf16* t2 = Mc; Mc = Mn; Mn = t2;
    }
    for (int kround = 1; kround <= 5 + REP_R1NR; ++kround) {
        f32x4 am[2] = {(f32x4){0.f, 0.f, 0.f, 0.f}, (f32x4){0.f, 0.f, 0.f, 0.f}};
#pragma unroll
        for (int s = 0; s < 2; ++s) { const bf16x8 aT = frag_rows(Tc, 16 * mt, 32 * s, c16, g4), aM = frag_rows(Mc, 16 * mt, 32 * s, c16, g4);
#pragma unroll
            for (int n = 0; n < 2; ++n) { const bf16x8 bM = frag_cols(Mc, 16 * (ntb + n), 32 * s, c16, g4); Treg[n] = MFMA16(aT, bM, Treg[n]); am[n] = MFMA16(aM, bM, am[n]); } }
#pragma unroll
        for (int n = 0; n < 2; ++n) { st_tile(Tn, Treg[n], 16 * mt, 16 * (ntb + n), c16, g4); st_tile(Mn, am[n], 16 * mt, 16 * (ntb + n), c16, g4); }
        R1_BAR();
        LAS bf16* t1 = Tc; Tc = Tn; Tn = t1; LAS bf16* t2 = Mc; Mc = Mn; Mn = t2;
    }
    for (int rwu = 0; rwu < 1 + REP_R1B; ++rwu) {
        f32x4 aw[2] = {(f32x4){0.f, 0.f, 0.f, 0.f}, (f32x4){0.f, 0.f, 0.f, 0.f}}, au[2] = {(f32x4){0.f, 0.f, 0.f, 0.f}, (f32x4){0.f, 0.f, 0.f, 0.f}};
#pragma unroll
        for (int s = 0; s < 2; ++s) { const bf16x8 aT = frag_rows(Tc, 16 * mt, 32 * s, c16, g4);
#pragma unroll
            for (int n = 0; n < 2; ++n) { aw[n] = MFMA16(aT, frag_cols(sA, 16 * (ntb + n), 32 * s, c16, g4), aw[n]); au[n] = MFMA16(aT, frag_cols(sX, 16 * (ntb + n), 32 * s, c16, g4), au[n]); } }
#pragma unroll
        for (int n = 0; n < 2; ++n) { st_tile(sW, aw[n], 16 * mt, 16 * (ntb + n), c16, g4); st_tile(sU, au[n], 16 * mt, 16 * (ntb + n), c16, g4); }
    }
    R1_BAR();
    for (int rs8 = 0; rs8 < 1 + REP_R1C; ++rs8) {
        const size_t ub = (size_t)(head * NCH + chunk) * 4096;
        f32x4 pp[2], qq[2], rr[2], yy[2];
#pragma unroll
        for (int n = 0; n < 2; ++n) { pp[n] = (f32x4){0.f, 0.f, 0.f, 0.f}; qq[n] = pp[n]; rr[n] = pp[n]; yy[n] = pp[n]; }
#pragma unroll
        for (int s = 0; s < 2; ++s) {
            const bf16x8 cW = frag_cols(sW, 16 * mt, 32 * s, c16, g4), cB = frag_cols(sB, 16 * mt, 32 * s, c16, g4), cK = frag_cols(sK, 16 * mt, 32 * s, c16, g4), cU = frag_cols(sU, 16 * mt, 32 * s, c16, g4), cV = frag_cols(sV, 16 * mt, 32 * s, c16, g4);
#pragma unroll
            for (int n = 0; n < 2; ++n) { const int c0 = 16 * (ntb + n);
                const bf16x8 bB = frag_cols(sB, c0, 32 * s, c16, g4), bU = frag_cols(sU, c0, 32 * s, c16, g4), bV = frag_cols(sV, c0, 32 * s, c16, g4);
                const bf16x8 rMrb = frag_rows(sMrb, c0, 32 * s, c16, g4), rMrk = frag_rows(sMrk, c0, 32 * s, c16, g4);
                pp[n] = MFMA16(cW, bB, pp[n]);
                qq[n] = MFMA16(cB, bU, qq[n]); qq[n] = MFMA16(cK, bV, qq[n]);
                rr[n] = MFMA16(cW, rMrb, rr[n]);
                yy[n] = MFMA16(cU, rMrb, yy[n]); yy[n] = MFMA16(cV, rMrk, yy[n]); } }
#pragma unroll
        for (int n = 0; n < 2; ++n) { const int j = 16 * (ntb + n) + c16; const int i0 = 16 * mt + 4 * g4;
            {
                const float gc = gC[j]; float o[4];
#pragma unroll
                for (int rg = 0; rg < 4; ++rg) o[rg] = gc * (pp[n][rg] + ((i0 + rg) == j ? 1.0f : 0.f));
                u32x2 w; w.x = pk2(o[0], o[1]); w.y = pk2(o[2], o[3]); *(u32x2*)(B.P + ub + (size_t)j * 64 + i0) = w; }
            {
                f32x4 o;
#pragma unroll
                for (int rg = 0; rg < 4; ++rg) o[rg] = gC[i0 + rg] * qq[n][rg];
                *(f32x4*)(B.QmT + ub + (size_t)j * 64 + i0) = o; }
            {
                const u32x2 rb2 = *(const LAS u32x2*)(sR + j * RST + i0); float o[4];
                o[0] = rr[n][0] + __uint_as_float(rb2.x << 16); o[1] = rr[n][1] + __uint_as_float(rb2.x & 0xffff0000u); o[2] = rr[n][2] + __uint_as_float(rb2.y << 16); o[3] = rr[n][3] + __uint_as_float(rb2.y & 0xffff0000u);
                u32x2 w; w.x = pk2(o[0], o[1]); w.y = pk2(o[2], o[3]); *(u32x2*)(B.Rt + ub + (size_t)j * 64 + i0) = w; }
            *(f32x4*)(B.Yi + ub + (size_t)j * 64 + i0) = yy[n];
        }
    }
    R1_BAR();
}

constexpr int R2_PST = 136, R2_QST = 272, R2_QOFF = 64 * R2_PST, R2_SLOT = R2_QOFF + 16 * R2_QST;
__device__ __forceinline__ void rwkv_r2_wg(LAS unsigned char* lds, const bf16* __restrict__ P, const float* __restrict__ QmT, bf16* __restrict__ H0T, int head, int cg, int wave, int lane) {
    const int c16 = lane & 15, g4 = lane >> 4;
    const int lt = ((wave & 3) << 6) | lane;
#define R2_BAR() do { asm volatile("s_waitcnt lgkmcnt(0)" ::: "memory"); __builtin_amdgcn_s_barrier(); asm volatile("" ::: "memory"); } while (0)
    if (wave >= 4) {
        constexpr int NST = 8;
        u32x4 st[NST][3];
        auto gl = [&](int c, u32x4 (&r)[3]) { const size_t ub = (size_t)(head * NCH + c) * 4096;
            const u32x4* p = (const u32x4*)(P + ub); const u32x4* q = (const u32x4*)(QmT + ub + (size_t)(16 * cg) * 64);
            r[0] = p[lt]; r[1] = p[lt + 256]; r[2] = q[lt]; };
        auto lw = [&](int slot, const u32x4 (&r)[3]) { LAS unsigned char* s = lds + slot * R2_SLOT;
#pragma unroll
            for (int i = 0; i < 2; ++i) { const int idx = lt + 256 * i; LAS u32x2* d = (LAS u32x2*)(s + (idx >> 3) * R2_PST + (idx & 7) * 16); u32x2 a; a.x = r[i].x; a.y = r[i].y; u32x2 b; b.x = r[i].z; b.y = r[i].w; d[0] = a; d[1] = b; }
            *(LAS u32x4*)(s + R2_QOFF + (lt >> 4) * R2_QST + (lt & 15) * 16) = r[2]; };
#pragma unroll
        for (int j = 0; j < NST; ++j) gl(j, st[j]);
        lw(0, st[0]); gl(NST, st[0]);
        R2_BAR();
        for (int c4 = 0; c4 < NCH / NST; ++c4) {
#pragma unroll
            for (int j = 0; j < NST; ++j) { const int c = NST * c4 + j;
                if (c + 1 < NCH) lw((c + 1) & 1, st[(j + 1) % NST]);
                if (c + 1 + NST < NCH) gl(c + 1 + NST, st[(j + 1) % NST]);
                R2_BAR(); }
        }
    } else if (wave == 0) {
        f32x4 hacc[4];
#pragma unroll
        for (int m = 0; m < 4; ++m) hacc[m] = (f32x4){0.f, 0.f, 0.f, 0.f};
        R2_BAR();
        for (int c = 0; c < NCH; ++c) {
            const LAS unsigned char* s = lds + (c & 1) * R2_SLOT; const size_t ub = (size_t)(head * NCH + c) * 4096;
            bf16x8 af[4][2]; f32x4 qv[4];
#pragma unroll
            for (int m = 0; m < 4; ++m) { qv[m] = *(const LAS f32x4*)(s + R2_QOFF + c16 * R2_QST + (16 * m + 4 * g4) * 4);
#pragma unroll
                for (int sx = 0; sx < 2; ++sx) { const LAS unsigned char* pr = s + (16 * m + c16) * R2_PST + (32 * sx + 4 * g4) * 2; const u32x2 a = *(const LAS u32x2*)pr, b = *(const LAS u32x2*)(pr + 32);
                    u32x4 w; w.x = a.x; w.y = a.y; w.z = b.x; w.w = b.y; af[m][sx] = __builtin_bit_cast(bf16x8, w); } }
            bf16x8 bfr[2];
#pragma unroll
            for (int sx = 0; sx < 2; ++sx) { u32x4 w; w.x = pk2(hacc[2 * sx][0], hacc[2 * sx][1]); w.y = pk2(hacc[2 * sx][2], hacc[2 * sx][3]); w.z = pk2(hacc[2 * sx + 1][0], hacc[2 * sx + 1][1]); w.w = pk2(hacc[2 * sx + 1][2], hacc[2 * sx + 1][3]);
                bfr[sx] = __builtin_bit_cast(bf16x8, w);
                u32x2 h0; h0.x = w.x; h0.y = w.y; *(u32x2*)(H0T + ub + (size_t)(16 * cg + c16) * 64 + 16 * (2 * sx) + 4 * g4) = h0;
                u32x2 h1; h1.x = w.z; h1.y = w.w; *(u32x2*)(H0T + ub + (size_t)(16 * cg + c16) * 64 + 16 * (2 * sx + 1) + 4 * g4) = h1; }
#pragma unroll
            for (int m = 0; m < 4; ++m) { hacc[m] = MFMA16(af[m][0], bfr[0], qv[m]); hacc[m] = MFMA16(af[m][1], bfr[1], hacc[m]); }
            R2_BAR();
        }
    } else {
        for (int c = 0; c <= NCH; ++c) R2_BAR();
    }
#undef R2_BAR
}

__device__ __forceinline__ void rwkv_r3_wave(const RwkvBufs& B, const bf16* __restrict__ H0T, const float* const* in, const float* __restrict__ gv, bf16* __restrict__ ocat, int head, int chunk, int nt, int lane) {
    const int c16 = lane & 15, g4 = lane >> 4; const size_t ub = (size_t)(head * NCH + chunk) * 4096;
    const int t = chunk * 64 + 16 * nt + c16;
    bf16x8 rf[2], hf[4][2]; f32x4 y[4], gw[4], gb[4], muv[4], gg[4], v0[4], vp[4];
#pragma unroll
    for (int s = 0; s < 2; ++s) rf[s] = *(const bf16x8*)(B.Rt + ub + (size_t)(16 * nt + c16) * 64 + 32 * s + 8 * g4);
#pragma unroll
    for (int m = 0; m < 4; ++m) { y[m] = *(const f32x4*)(B.Yi + ub + (size_t)(16 * nt + c16) * 64 + 16 * m + 4 * g4);
#pragma unroll
        for (int s = 0; s < 2; ++s) hf[m][s] = *(const bf16x8*)(H0T + ub + (size_t)(16 * m + c16) * 64 + 32 * s + 8 * g4); }
    const float bn = B.bonus[(size_t)t * RH + head];
#pragma unroll
    for (int m = 0; m < 4; ++m) { const int ch = head * RN + 16 * m + 4 * g4;
        gw[m] = *(const f32x4*)(in[26] + ch); gb[m] = *(const f32x4*)(in[27] + ch); muv[m] = *(const f32x4*)(in[11] + ch); gg[m] = *(const f32x4*)(gv + (size_t)t * RW + ch);
        v0[m] = *(const f32x4*)(B.rkv + (size_t)t * (3 * RW) + 2 * RW + ch); vp[m] = (f32x4){0.f, 0.f, 0.f, 0.f}; if (t > 0) vp[m] = *(const f32x4*)(B.rkv + (size_t)(t - 1) * (3 * RW) + 2 * RW + ch); }
    float s1 = 0.f;
#pragma unroll
    for (int m = 0; m < 4; ++m) {
#pragma unroll
        for (int s = 0; s < 2; ++s) y[m] = MFMA16(hf[m][s], rf[s], y[m]);
        s1 += (y[m][0] + y[m][1]) + (y[m][2] + y[m][3]); }
    s1 += __shfl_xor(s1, 16); s1 += __shfl_xor(s1, 32);
    const float mean = s1 * (1.0f / 64.0f); float s2 = 0.f;
#pragma unroll
    for (int m = 0; m < 4; ++m) { y[m] = y[m] - mean; s2 += (y[m][0] * y[m][0] + y[m][1] * y[m][1]) + (y[m][2] * y[m][2] + y[m][3] * y[m][3]); }
    s2 += __shfl_xor(s2, 16); s2 += __shfl_xor(s2, 32);
    const float rstd = rsqrtf(s2 * (1.0f / 64.0f) + 64e-5f);
#pragma unroll
    for (int m = 0; m < 4; ++m) { const int ch = head * RN + 16 * m + 4 * g4;
        const f32x4 vx = v0[m] + (vp[m] - v0[m]) * muv[m];
        const f32x4 o = (y[m] * rstd * gw[m] + gb[m] + vx * bn) * gg[m];
        u32x2 w; w.x = pk2(o[0], o[1]); w.y = pk2(o[2], o[3]); *(u32x2*)(ocat + (size_t)t * (2 * RW) + RW + ch) = w; }
}
template <int WHICH> struct Lora2Order { static constexpr bool GATHER = false; const int* tok; int G, c;
    __device__ bool next(int i, pg8::Unit& u) const { const int L = i * G + c; if (L >= (S / 128) * 4) return false; u.pm = L >> 2; u.pn = WHICH * 4 + (L & 3); u.koff = WHICH * 512; u.koffB = 0; return true; }
    __device__ __forceinline__ void a_ready(const pg8::Unit&) const {}
    __device__ __forceinline__ void done(const pg8::Unit&) const {} };
template <int WHICH> struct EpiLora2 {
    static constexpr bool PERM = true, AFTER_DRAIN = false, MIDK = false;
    float* dst; const float* bias;
    __device__ __forceinline__ void operator()(const pg8::f32x4 (&acc)[2][2][4][2], const pg8::Unit& u, int wr, int wc, int fr, int fq) const {
        const int row0 = u.pm * 128 + wr * 64 + fr; const int col0 = (u.pn & 3) * 256 + wc * 32 + 8 * fq;
#pragma unroll
        for (int ai = 0; ai < 1; ++ai)
#pragma unroll
            for (int m = 0; m < 4; ++m) { float* p = dst + (size_t)(row0 + ai * 128 + m * 16) * RW + col0;
#pragma unroll
                for (int bj = 0; bj < 2; ++bj) { f32x4 v0 = acc[ai][bj][m][0], v1 = acc[ai][bj][m][1];
                    if (WHICH < 2) { const f32x4 b0 = *(const f32x4*)(bias + col0 + bj * 128), b1 = *(const f32x4*)(bias + col0 + bj * 128 + 4);
#pragma unroll
                        for (int j = 0; j < 4; ++j) { v0[j] = sigmoidf_(v0[j] + b0[j]); v1[j] = sigmoidf_(v1[j] + b1[j]); }
                        if (WHICH == 0) { v0 = v0 * -0.60653065971263342f; v1 = v1 * -0.60653065971263342f; } }
                    *(f32x4*)(p + bj * 128) = v0; *(f32x4*)(p + bj * 128 + 4) = v1; } }
    }
};

__global__ void __launch_bounds__(NTHR, 2) fwd(Args args) {
    extern __shared__ __attribute__((aligned(16))) unsigned char lds_raw[];
    LAS unsigned char* lds = (LAS unsigned char*)lds_raw;
    const int wave = __builtin_amdgcn_readfirstlane(threadIdx.x >> 6);
    const int G = gridDim.x, wg = blockIdx.x;
    unsigned char* ws = args.ws;
    unsigned* ctl = (unsigned*)(ws + WS_CTL);
    if (threadIdx.x < 4) ((LAS unsigned*)(lds + LDSCTL_OFF))[threadIdx.x] = 0u;
    __syncthreads();
    XcdBarrier bar = xcd_barrier_post(ctl + CW_BAR, (volatile LAS unsigned*)(lds + LDSCTL_OFF));
    const int lo = args.ph_lo, hi = args.ph_hi;
#define IN(k) (lo <= (k) && (k) < hi)
#define PH(k) for (int rep_ = 0; rep_ < ((k) == REP_PHASE ? 1 + REP_N : 1); ++rep_) if (IN(k))
#define SEAM(k) do { if (IN(k) && IN((k) + 1)) xcd_barrier(bar); } while (0)
    const int gw = wg * NWAVES + wave, NGW = G * NWAVES;

    const float* x = args.in[0];
    float* ada = (float*)(ws + WS_ADA); float* rope = (float*)(ws + WS_ROPE);
    bf16* h = (bf16*)(ws + WS_H); bf16* W1t = (bf16*)(ws + WS_W1T); bf16* Wupt = (bf16*)(ws + WS_WUPT); bf16* Wot = (bf16*)(ws + WS_WOT);
    unsigned char* Wgut = ws + WS_WGUT; unsigned char* Wdt = ws + WS_WDT;

    PH(0) { const int lane = lane_fresh(); const int tid = (wave << 6) | lane; (void)tid; (void)lane;
        {
            const float* c = args.in[1]; const float* w_ada = args.in[2]; const float* b_ada = args.in[3];
            LAS float* red = (LAS float*)lds;
            for (int u = wg; u < 6 * D / 64; u += G) {
                const int n = u * 64 + lane; float s = 0.f;
#pragma unroll 8
                for (int kq = wave; kq < D; kq += NWAVES) s += c[kq] * w_ada[(size_t)kq * (6 * D) + n];
                red[wave * 64 + lane] = s;
                __syncthreads();
                if (wave == 0) { float t = b_ada[n]; for (int w = 0; w < NWAVES; ++w) t += red[w * 64 + lane]; ada[n] = t; }
                __syncthreads();
            }
        }
        for (int i = wg * NTHR + tid; i < S * 16; i += G * NTHR) {
            const int pos = i >> 4, j = i & 15; const float inv = powf(500000.0f, -(float)j / 16.0f); const float ang = (float)pos * inv;
            rope[2 * i] = cosf(ang); rope[2 * i + 1] = sinf(ang);
        }
        for (int i = wg * NTHR + tid; i < 128 * D / 8; i += G * NTHR) ((u32x4*)(W1t + (size_t)(N1 - 128) * D))[i] = (u32x4){0u, 0u, 0u, 0u};
        {
            bf16* wrh = (bf16*)(ws + WS_WR); bf16* wrl = wrh + 80 * D; const float* w_rg = args.in[31]; const float* w_re = args.in[33];
            for (int i = wg * NTHR + tid; i < 80 * D; i += G * NTHR) { const int n = i / D, kq = i % D; const float v = n < NG ? w_rg[kq * NG + n] : (n < NG + NE ? w_re[kq * NE + n - NG] : 0.f);
                const bf16 hi = f2bf(v); wrh[i] = hi; wrl[i] = f2bf(v - bf2f(hi)); }
        }
        {
            bf16* wl2 = (bf16*)(ws + WS_WL2); const float* w_w2 = args.in[17]; const float* w_a2 = args.in[20]; const float* w_g2 = args.in[22];
            for (int i = wg * NTHR + tid; i < 3 * RW * 256; i += G * NTHR) { const int n = i >> 8, kq = i & 255, which = n / RW, cc = n % RW; float v = 0.f;
                if (which == 0) { if (kq < LW) v = w_w2[kq * RW + cc]; } else if (which == 1) { if (kq < LA) v = w_a2[kq * RW + cc]; } else v = w_g2[kq * RW + cc];
                wl2[i] = f2bf(v); }
        }
        LAS float* scr = (LAS float*)(lds + wave * 16384);
        constexpr int I_W = (D / 64) * (LW / 32), I_A = (D / 64) * (LA / 32), I_G = (D / 64) * (LG / 32);
        constexpr int NIT = 2 * (I_W + I_A + I_G);
        for (int it = gw; it < NIT; it += NGW) {
            int r = it, k0, n0;
            if (r < 2 * I_W) { const int md = 1 + r / I_W; item_kn(r % I_W, LW, k0, n0); tr_item(args.in[16], LW, k0, n0, W1t + (size_t)(INW + (md - 1) * LO + n0) * D + k0, D, args.in[12], md, scr, lane); continue; } r -= 2 * I_W;
            if (r < 2 * I_A) { const int md = 1 + r / I_A; item_kn(r % I_A, LA, k0, n0); tr_item(args.in[19], LA, k0, n0, W1t + (size_t)(INW + (md - 1) * LO + LW + n0) * D + k0, D, args.in[13], md, scr, lane); continue; } r -= 2 * I_A;
            const int md = 1 + r / I_G; item_kn(r % I_G, LG, k0, n0); tr_item(args.in[21], LG, k0, n0, W1t + (size_t)(INW + (md - 1) * LO + LW + LA + n0) * D + k0, D, args.in[14], md, scr, lane);
        }
        __syncthreads();
        {
            const int lr = tid >> 5, c4 = tid & 31, nl = lane & 15, kq = lane >> 4, ncol = 16 * wave + nl;
            f32x4 v[8]; int T = wg;
            if (T < CT_ALL) { const ConvTile t = conv_decode(T, args.in, ws);
#pragma unroll
                for (int i = 0; i < 8; ++i) v[i] = *(const f32x4*)(t.src + (size_t)(lr + 16 * i) * t.ldw + 4 * c4); }
            for (int itc = 0; T < CT_ALL; T += G, ++itc) {
                LAS float* buf = (LAS float*)(lds + (itc & 1) * 69632);
#pragma unroll
                for (int i = 0; i < 8; ++i) *(LAS f32x4*)(buf + conv_off(lr + 16 * i, 4 * c4)) = v[i];
                const ConvTile t = conv_decode(T, args.in, ws);
                if (T + G < CT_ALL) { const ConvTile tn = conv_decode(T + G, args.in, ws);
#pragma unroll
                    for (int i = 0; i < 8; ++i) v[i] = *(const f32x4*)(tn.src + (size_t)(lr + 16 * i) * tn.ldw + 4 * c4); }
                R1_BAR();
                float xv[32];
#pragma unroll
                for (int j = 0; j < 32; ++j) xv[j] = buf[conv_off(32 * kq + j, ncol)];
                if (t.kind) { unsigned char* d = t.dst + (size_t)ncol * t.rs + 32 * kq;
                    u32x4 o0, o1; o0.x = pk_fp8x4(xv[0], xv[1], xv[2], xv[3], t.sc); o0.y = pk_fp8x4(xv[4], xv[5], xv[6], xv[7], t.sc); o0.z = pk_fp8x4(xv[8], xv[9], xv[10], xv[11], t.sc); o0.w = pk_fp8x4(xv[12], xv[13], xv[14], xv[15], t.sc);
                    o1.x = pk_fp8x4(xv[16], xv[17], xv[18], xv[19], t.sc); o1.y = pk_fp8x4(xv[20], xv[21], xv[22], xv[23], t.sc); o1.z = pk_fp8x4(xv[24], xv[25], xv[26], xv[27], t.sc); o1.w = pk_fp8x4(xv[28], xv[29], xv[30], xv[31], t.sc);
                    *(u32x4*)d = o0; *(u32x4*)(d + 16) = o1; }
                else { unsigned char* d = t.dst + (size_t)ncol * t.rs + 64 * kq;
#pragma unroll
                    for (int q = 0; q < 4; ++q) { u32x4 o; o.x = pk2(xv[8 * q], xv[8 * q + 1]); o.y = pk2(xv[8 * q + 2], xv[8 * q + 3]); o.z = pk2(xv[8 * q + 4], xv[8 * q + 5]); o.w = pk2(xv[8 * q + 6], xv[8 * q + 7]); *(u32x4*)(d + 16 * q) = o; } }
            }
            __syncthreads();
        }
    }
    SEAM(0);
    PH(1) { const int lane = lane_fresh(); const int tid = (wave << 6) | lane; (void)tid; (void)lane;
        const float* g = args.in[4]; const float* sh1 = ada; const float* sc1 = ada + D;
        f32x4 gs[8], sh[8];
#pragma unroll
        for (int j = 0; j < 8; ++j) { const int c = 4 * lane + 256 * j; const f32x4 gg = *(const f32x4*)(g + c), ss = *(const f32x4*)(sc1 + c); gs[j] = gg * (ss + 1.0f); sh[j] = *(const f32x4*)(sh1 + c); }
        for (int rb = gw; rb < S; rb += 2 * NGW) {
            f32x4 v[2][8]; float s[2] = {0.f, 0.f};
#pragma unroll
            for (int q = 0; q < 2; ++q) { const f32x4* xr = (const f32x4*)(x + (size_t)(rb + q * NGW) * D) + lane;
#pragma unroll
                for (int j = 0; j < 8; ++j) v[q][j] = xr[64 * j]; }
#pragma unroll
            for (int q = 0; q < 2; ++q)
#pragma unroll
                for (int j = 0; j < 8; ++j) s[q] += (v[q][j].x * v[q][j].x + v[q][j].y * v[q][j].y) + (v[q][j].z * v[q][j].z + v[q][j].w * v[q][j].w);
            float r[2]; r[0] = rsqrtf(wave_sum(s[0]) * (1.0f / D) + 1e-6f); r[1] = rsqrtf(wave_sum(s[1]) * (1.0f / D) + 1e-6f);
#pragma unroll
            for (int q = 0; q < 2; ++q) { u32x2* o = (u32x2*)(h + (size_t)(rb + q * NGW) * D) + lane;
#pragma unroll
                for (int j = 0; j < 8; ++j) { const f32x4 t = v[q][j] * r[q] * gs[j] + sh[j]; u32x2 w; w.x = pk2(t.x, t.y); w.y = pk2(t.z, t.w); o[64 * j] = w; } }
        }
    }
    SEAM(1);
    PH(2) { const int lane = lane_fresh(); const int tid = (wave << 6) | lane; (void)tid; (void)lane;
        EpiProj E{(bf16*)(ws + WS_Q), (bf16*)(ws + WS_K), (bf16*)(ws + WS_V), (float*)(ws + WS_RKV), (bf16*)(ws + WS_GATE), (float*)(ws + WS_LORA), (float*)(ws + WS_LORAB), rope};
        { pg8::Gemm g{h, W1t, S, INW, D, D, D}; pg8::StaticOrder So; So.init(S, INW, G, wg);
          pg8::gemm_phase<EpiProj, pg8::StaticOrder, true, true>(lds, g, So, E); }
        { int ld_ = D; asm volatile("" : "+s"(ld_)); pg8::Gemm g{h, W1t, S, N1, AW, ld_, ld_}; LoraOrder So{nullptr, G, wg};
          pg8::gemm_phase<EpiProj, LoraOrder, true, true>(lds, g, So, E); }
    }
    SEAM(2);

    bf16* qb = (bf16*)(ws + WS_Q); bf16* kb = (bf16*)(ws + WS_K); bf16* vb = (bf16*)(ws + WS_V);
    bf16* kmh = (bf16*)(ws + WS_KMEAN); bf16* kml = kmh + AH * NB * AD;
    AttnBufs AB{qb, kb, vb, kmh, kml, (unsigned*)(ws + WS_AMASK), (int*)(ws + WS_ALIST), (int*)ctl + CW_ACNT, (bf16*)(ws + WS_APART), (float*)(ws + WS_AML)};
    PH(3) { const int lane = lane_fresh(); const int tid = (wave << 6) | lane; (void)tid; (void)lane;
        for (int hb = wg; hb < AH * NB; hb += G) { const int hd = hb / NB, bk = hb % NB; LAS float* red = (LAS float*)lds;
            float s0 = 0.f, s1 = 0.f; const unsigned* src = (const unsigned*)(kb + (size_t)(bk * MB + wave * 32) * AW + hd * AD) + lane;
#pragma unroll 8
            for (int r = 0; r < 32; ++r) { const unsigned w2 = src[(size_t)r * (AW / 2)]; s0 += __uint_as_float(w2 << 16); s1 += __uint_as_float(w2 & 0xffff0000u); }
            red[wave * 128 + 2 * lane] = s0; red[wave * 128 + 2 * lane + 1] = s1;
            __syncthreads();
            if (tid < AD) { float s = 0.f;
#pragma unroll
                for (int w = 0; w < 8; ++w) s += red[w * 128 + tid];
                s *= (1.0f / MB); const bf16 hi = f2bf(s); kmh[hb * AD + tid] = hi; kml[hb * AD + tid] = f2bf(s - bf2f(hi)); }
            __syncthreads();
        }
        {
            const float* lora = (const float*)(ws + WS_LORA); bf16* al2 = (bf16*)(ws + WS_AL2);
#pragma unroll 4
            for (int i = wg * NTHR + tid; i < S * 768; i += G * NTHR) { const int t = i / 768, j = i % 768, which = j >> 8, jj = j & 255; float v = 0.f;
                const int src = which == 0 ? jj : (which == 1 ? LW + jj : LW + LA + jj); const bool real = which == 2 || jj < LW;
                if (real) { const float* lb = (const float*)(ws + WS_LORAB); v = lora[(size_t)t * 1024 + src] + lb[(size_t)t * 1024 + src] + (t > 0 ? lora[(size_t)(t - 1) * 1024 + LO + src] + lb[(size_t)(t - 1) * 1024 + LO + src] : 0.f); if (which == 0) v = 1.0f - 2.0f / (1.0f + __expf(2.0f * v)); else if (which == 2) v = sigmoidf_(v); }
                al2[i] = f2bf(v); }
        }
    }
    SEAM(3);
    PH(4) { const int lane = lane_fresh(); const int tid = (wave << 6) | lane; (void)tid; (void)lane;
#define L2CALL(W, DST, BIAS, CID) { int lda_ = 768; asm volatile("" : "+s"(lda_)); pg8::Gemm g{(const bf16*)(ws + WS_AL2), (const bf16*)(ws + WS_WL2), S, 3 * RW, 256, lda_, 256}; \
            Lora2Order<W> So{nullptr, G, CID}; EpiLora2<W> E{DST, BIAS}; pg8::gemm_phase<EpiLora2<W>, Lora2Order<W>, true, true, 0, true>(lds, g, So, E); }
        L2CALL(0, (float*)(ws + WS_LW), args.in[15], wg)
        L2CALL(1, (float*)(ws + WS_A), args.in[18], wg)
        L2CALL(2, (float*)(ws + WS_G), nullptr, wg)
#undef L2CALL
        for (int u = wg; u < AH * 64; u += G) moba_select_unit(lds, AB, u >> 6, u & 63, tid, lane, wave);
    }
    SEAM(4);
    RwkvBufs RB{(const float*)(ws + WS_RKV), (const float*)(ws + WS_LW), (const float*)(ws + WS_A), (bf16*)(ws + WS_RWP), (float*)(ws + WS_RWQ), (bf16*)(ws + WS_RWR), (float*)(ws + WS_RWY), (float*)(ws + WS_RWB)};
    bf16* H0T = (bf16*)(ws + WS_RWH);
    PH(5) { const int lane = lane_fresh(); const int tid = (wave << 6) | lane; (void)tid; (void)lane; R1In I; if (wg < RH * NCH) rwkv_r1_load(I, RB, wg / NCH, wg % NCH, lane, wave);
        for (int u = wg; u < RH * NCH; u += G) { const int un = u + G; rwkv_r1_unit(lds, RB, args.in, I, u / NCH, u % NCH, un < RH * NCH ? un / NCH : -1, un % NCH, tid, lane, wave); } }
    SEAM(5);
    PH(7) { const int lane = lane_fresh(); const int tid = (wave << 6) | lane; (void)tid; (void)lane;
        if (wg < RH * 4) { for (int rsc = 0; rsc < 1 + REP_SCAN; ++rsc) { rwkv_r2_wg(lds, RB.P, RB.QmT, H0T, wg >> 2, wg & 3, wave, lane); __syncthreads(); } }
        LAS int* pre = (LAS int*)(lds + AT_ITEMS); LAS int* tick = pre + 260;
        if (tid < 256) pre[1 + tid] = (AB.cnt[tid] + 255) >> 8;
        __syncthreads();
        if (wave == 0) {
            int v0 = pre[1 + 4 * lane], v1 = pre[2 + 4 * lane], v2 = pre[3 + 4 * lane], v3 = pre[4 + 4 * lane]; v1 += v0; v2 += v1; v3 += v2; int tot = v3;
#pragma unroll
            for (int o = 1; o < 64; o <<= 1) { const int t = __shfl_up(tot, o); if (lane >= o) tot += t; }
            const int ex = tot - v3; pre[1 + 4 * lane] = ex + v0; pre[2 + 4 * lane] = ex + v1; pre[3 + 4 * lane] = ex + v2; pre[4 + 4 * lane] = ex + v3;
            if (lane == 0) pre[0] = 0; }
        __syncthreads();
        moba_items(lds, AB, (int*)ctl + CW_AQ + rep_, pre, tick, tid, lane, wave);
    }
    SEAM(7);
    PH(8) { const int lane = lane_fresh(); const int tid = (wave << 6) | lane; (void)tid; (void)lane; for (int u = wg * 2 + (wave >> 2); u < RH * NCH; u += 2 * G) rwkv_r3_wave(RB, H0T, args.in, (const float*)(ws + WS_G), (bf16*)(ws + WS_OCAT), u / NCH, u % NCH, wave & 3, lane);
#pragma unroll 2
        for (int i = wg * NTHR + tid; i < AH * S * 16; i += G * NTHR) { const int c8 = i & 15, hq = i >> 4, hh = hq / S, qq = hq % S;
            const unsigned mk = AB.mask[hq]; const f32x4 ml0 = *(const f32x4*)(AB.ml + (size_t)hq * 8), ml1 = *(const f32x4*)(AB.ml + (size_t)hq * 8 + 4);
            u32x4 pr[4];
#pragma unroll
            for (int s = 0; s < 4; ++s) pr[s] = *(const u32x4*)(AB.part + ((size_t)hq * 4 + s) * AD + 8 * c8);
            const int ns = 1 + __builtin_popcount(mk);
            const float m_[4] = {ml0[0], ml0[2], ml1[0], ml1[2]}, l_[4] = {ml0[1], ml0[3], ml1[1], ml1[3]};
            float mx = m_[0];
#pragma unroll
            for (int s = 1; s < 4; ++s) mx = (s < ns) ? fmaxf(mx, m_[s]) : mx;
            float wv[4]; float wsum = 0.f;
#pragma unroll
            for (int s = 0; s < 4; ++s) { wv[s] = s < ns ? l_[s] * __builtin_amdgcn_exp2f(m_[s] - mx) : 0.f; wsum += wv[s]; }
            const float inv = 1.0f / wsum; float o[8] = {0.f, 0.f, 0.f, 0.f, 0.f, 0.f, 0.f, 0.f};
#pragma unroll
            for (int s = 0; s < 4; ++s) { float pv[8]; unpack8(pr[s], pv); const float ws_ = wv[s] * inv;
#pragma unroll
                for (int j = 0; j < 8; ++j) o[j] += (s < ns) ? ws_ * pv[j] : 0.f; }
            u32x4 w; w.x = pk2(o[0], o[1]); w.y = pk2(o[2], o[3]); w.z = pk2(o[4], o[5]); w.w = pk2(o[6], o[7]);
            *(u32x4*)((bf16*)(ws + WS_OCAT) + (size_t)qq * (2 * AW) + hh * AD + 8 * c8) = w; }
    }
    SEAM(8);

    bf16* ocat = (bf16*)(ws + WS_OCAT); bf16* gate = (bf16*)(ws + WS_GATE); bf16* mix = (bf16*)(ws + WS_MIX); bf16* y = (bf16*)(ws + WS_Y); bf16* x1 = (bf16*)(ws + WS_X1);     unsigned char* h2 = ws + WS_H2;
    int* eidx = (int*)(ws + WS_ROUTE); float* ew = (float*)(ws + WS_ROUTE + 65536); int* slot = (int*)(ws + WS_ROUTE + 131072);
    int* tok = (int*)(ws + WS_TOK); int* tile_e = (int*)(ws + WS_TOK + 131072);
    unsigned char* xbuf = ws + WS_XBUF; unsigned char* hid = ws + WS_HID; bf16* ybuf = (bf16*)(ws + WS_YBUF);
    PH(9) { const int lane = lane_fresh(); const int tid = (wave << 6) | lane; (void)tid; (void)lane;
        pg8::Gemm g{ocat, Wupt, S, D, AW, D, D}; MixOrder So{nullptr, G, wg};
        EpiMix E{gate, mix};
        pg8::gemm_phase<EpiMix, MixOrder, true, true>(lds, g, So, E);
    }
    SEAM(9);
    PH(10) { const int lane = lane_fresh(); const int tid = (wave << 6) | lane; (void)tid; (void)lane;
        pg8::Gemm g{mix, Wot, S, D, D, D, D}; pg8::StaticOrder So; So.init(S, D, G, wg);
        EpiBf16P E{y, D};
        pg8::gemm_phase<EpiBf16P, pg8::StaticOrder, true, true>(lds, g, So, E);
    }
    SEAM(10);
    PH(11) { const int lane = lane_fresh(); const int tid = (wave << 6) | lane; (void)tid; (void)lane;
        const float* gpost = args.in[5]; const float* gpre2 = args.in[6]; const float* gt1 = ada + 2 * D; const float* sh2 = ada + 3 * D; const float* sc2 = ada + 4 * D;
        const bf16* wrh = (const bf16*)(ws + WS_WR); const bf16* wrl = wrh + 80 * D; const float* b_rg = args.in[32]; const float* b_re = args.in[34];
        LAS bf16* Ah = (LAS bf16*)lds; LAS bf16* Al = Ah + 16 * RS8; LAS float* Pp = (LAS float*)lds;
        LAS float* Lg = (LAS float*)(lds + 8 * 16 * 80 * 4);
        for (int unit = wg; unit < S / 16; unit += G) {
            {
                const int rl0 = wave * 2, row0 = unit * 16 + rl0;
                f32x4 v[2][8], xv[2][8]; float s[2] = {0.f, 0.f};
#pragma unroll
                for (int rr = 0; rr < 2; ++rr) { const u32x2* yr = (const u32x2*)(y + (size_t)(row0 + rr) * D) + lane; const f32x4* xr = (const f32x4*)(x + (size_t)(row0 + rr) * D) + lane;
#pragma unroll
                    for (int j = 0; j < 8; ++j) { const u32x2 yb = yr[64 * j]; v[rr][j] = (f32x4){__uint_as_float(yb.x << 16), __uint_as_float(yb.x & 0xffff0000u), __uint_as_float(yb.y << 16), __uint_as_float(yb.y & 0xffff0000u)}; xv[rr][j] = xr[64 * j]; } }
#pragma unroll
                for (int rr = 0; rr < 2; ++rr)
#pragma unroll
                    for (int j = 0; j < 8; ++j) s[rr] += (v[rr][j].x * v[rr][j].x + v[rr][j].y * v[rr][j].y) + (v[rr][j].z * v[rr][j].z + v[rr][j].w * v[rr][j].w);
                float r1[2]; r1[0] = rsqrtf(wave_sum(s[0]) * (1.0f / D) + 1e-6f); r1[1] = rsqrtf(wave_sum(s[1]) * (1.0f / D) + 1e-6f); s[0] = 0.f; s[1] = 0.f;
#pragma unroll
                for (int rr = 0; rr < 2; ++rr)
#pragma unroll
                    for (int j = 0; j < 8; ++j) { const int c = 4 * lane + 256 * j; const f32x4 t = xv[rr][j] + *(const f32x4*)(gt1 + c) * *(const f32x4*)(gpost + c) * (v[rr][j] * r1[rr]); v[rr][j] = t;
                        { u32x2 xb; xb.x = pk2(t.x, t.y); xb.y = pk2(t.z, t.w); ((u32x2*)(x1 + (size_t)(row0 + rr) * D))[lane + 64 * j] = xb; } s[rr] += (t.x * t.x + t.y * t.y) + (t.z * t.z + t.w * t.w); }
                float r2[2]; r2[0] = rsqrtf(wave_sum(s[0]) * (1.0f / D) + 1e-6f); r2[1] = rsqrtf(wave_sum(s[1]) * (1.0f / D) + 1e-6f);
#pragma unroll
                for (int rr = 0; rr < 2; ++rr)
#pragma unroll
                    for (int j = 0; j < 8; ++j) { const int c = 4 * lane + 256 * j; const f32x4 t = v[rr][j] * r2[rr] * (*(const f32x4*)(gpre2 + c) * (*(const f32x4*)(sc2 + c) + 1.0f)) + *(const f32x4*)(sh2 + c);
                        u32x2 wh; wh.x = pk2(t.x, t.y); wh.y = pk2(t.z, t.w);
                        u32x2 wl; wl.x = pk2(t.x - __uint_as_float(wh.x << 16), t.y - __uint_as_float(wh.x & 0xffff0000u)); wl.y = pk2(t.z - __uint_as_float(wh.y << 16), t.w - __uint_as_float(wh.y & 0xffff0000u));
                        ((unsigned*)(h2 + (size_t)(row0 + rr) * D))[lane + 64 * j] = pk_fp8x4(t.x, t.y, t.z, t.w, 8.0f);
                        *(LAS u32x2*)(Ah + (rl0 + rr) * RS8 + c) = wh; *(LAS u32x2*)(Al + (rl0 + rr) * RS8 + c) = wl; }
            }
            R1_BAR();
            f32x4 acc[5];
#pragma unroll
            for (int nt = 0; nt < 5; ++nt) acc[nt] = (f32x4){0.f, 0.f, 0.f, 0.f};
            for (int rmf = 0; rmf < 1 + REP_P11B; ++rmf) {
#pragma unroll
            for (int nt = 0; nt < 5; ++nt) acc[nt] = (f32x4){0.f, 0.f, 0.f, 0.f};
#pragma unroll 2
            for (int ks = 0; ks < 8; ++ks) {
                const int k0 = 256 * wave + 32 * ks + 8 * (lane >> 4);
                const bf16x8 ah = *(const LAS bf16x8*)(Ah + (lane & 15) * RS8 + k0), al = *(const LAS bf16x8*)(Al + (lane & 15) * RS8 + k0);
#pragma unroll
                for (int nt = 0; nt < 5; ++nt) { const bf16x8 bh = *(const bf16x8*)(wrh + (size_t)(16 * nt + (lane & 15)) * D + k0), bl = *(const bf16x8*)(wrl + (size_t)(16 * nt + (lane & 15)) * D + k0);
                    acc[nt] = __builtin_amdgcn_mfma_f32_16x16x32_bf16(ah, bh, acc[nt], 0, 0, 0);
                    acc[nt] = __builtin_amdgcn_mfma_f32_16x16x32_bf16(al, bh, acc[nt], 0, 0, 0);
                    acc[nt] = __builtin_amdgcn_mfma_f32_16x16x32_bf16(ah, bl, acc[nt], 0, 0, 0); }
            }
            }
            R1_BAR();
#pragma unroll
            for (int nt = 0; nt < 5; ++nt)
#pragma unroll
                for (int rg = 0; rg < 4; ++rg) Pp[(wave * 16 + 4 * (lane >> 4) + rg) * 80 + 16 * nt + (lane & 15)] = acc[nt][rg];
            R1_BAR();
            for (int i = tid; i < 16 * 72; i += NTHR) { const int r = i / 72, c = i % 72; float t = c < NG ? b_rg[c] : b_re[c - NG];
#pragma unroll
                for (int w = 0; w < 8; ++w) t += Pp[(w * 16 + r) * 80 + c];
                Lg[r * 72 + c] = t; }
            R1_BAR();
            if (tid < 16) {
                const LAS float* lg = Lg + tid * 72; const int row = unit * 16 + tid;
                float mx = lg[0]; int gi = 0; for (int j = 1; j < 8; ++j) if (lg[j] > mx) { mx = lg[j]; gi = j; }
                float sg = 0.f; for (int j = 0; j < 8; ++j) sg += __expf(lg[j] - mx);
                const float pg = 1.0f / sg;
                const LAS float* le = lg + 8 + gi * EPG;
                float m1 = le[0]; int i1 = 0; for (int j = 1; j < 8; ++j) if (le[j] > m1) { m1 = le[j]; i1 = j; }
                float m2 = -3e38f; int i2 = 0; for (int j = 0; j < 8; ++j) if (j != i1 && le[j] > m2) { m2 = le[j]; i2 = j; }
                const float e2 = __expf(m2 - m1); const float p1 = 1.0f / (1.0f + e2), p2 = e2 / (1.0f + e2);
                const int e1g = gi * EPG + i1, e2g = gi * EPG + i2;
                eidx[row * 2] = e1g; eidx[row * 2 + 1] = e2g; ew[row * 2] = pg * p1; ew[row * 2 + 1] = pg * p2;
                if (rep_ == 0) { atomicAdd((int*)ctl + CW_CNT + e1g, 1); atomicAdd((int*)ctl + CW_CNT + e2g, 1); }
            }
            R1_BAR();
        }
    }
    SEAM(11);
    PH(12) { const int lane = lane_fresh(); const int tid = (wave << 6) | lane; (void)tid; (void)lane;
        LAS int* offs = (LAS int*)lds;
        if (tid == 0) { int o = 0; for (int e = 0; e < NE; ++e) { offs[e] = o; const int nt = (((const int*)ctl)[CW_CNT + e] + 127) / 128; if (wg == 0) for (int t = 0; t < nt; ++t) tile_e[o / 128 + t] = e; o += nt * 128; }
            if (wg == 0) ((int*)ctl)[CW_NT] = o / 128; }
        __syncthreads();
        for (int p = wg * NTHR + tid; p < S * 2; p += G * NTHR) { const int e = eidx[p]; const int pos = atomicAdd((int*)ctl + CW_FILL + e, 1); const int row = offs[e] + pos; tok[row] = p >> 1; slot[p] = row; }
        if (wg == 0 && tid < NE) { const int cnt_ = ((const int*)ctl)[CW_CNT + tid]; const int end_ = ((cnt_ + 127) / 128) * 128; for (int r = cnt_; r < end_; ++r) tok[offs[tid] + r] = 0; }
    }
    SEAM(12);
    PH(13) { const int lane = lane_fresh(); const int tid = (wave << 6) | lane; (void)tid; (void)lane;
        const int ntl = ((const int*)ctl)[CW_NT];
        pg8::Gemm g{(const bf16*)h2, (const bf16*)Wgut, MAXROWS, NE * 1024, D / 2, D / 2, D / 2}; ExpertOrderT<true> So{tok, tile_e, ntl, 4, G, wg};
        EpiHid E{hid};
        pg8::gemm_phase<EpiHid, ExpertOrderT<true>, true, true, (124 << 8) | 119, true>(lds, g, So, E);
    }
    SEAM(13);
    PH(14) { const int lane = lane_fresh(); const int tid = (wave << 6) | lane; (void)tid; (void)lane;
        const int ntl = ((const int*)ctl)[CW_NT];
        pg8::Gemm g{(const bf16*)hid, (const bf16*)Wdt, MAXROWS, NE * D, FF / 2, FF / 2, FF / 2}; ExpertOrderT<false> So{nullptr, tile_e, ntl, 8, G, wg};
        EpiYbuf E{ybuf};
        pg8::gemm_phase<EpiYbuf, ExpertOrderT<false>, true, true, (124 << 8) | 120, true>(lds, g, So, E);
    }
    SEAM(14);
    PH(15) { const int lane = lane_fresh(); const int tid = (wave << 6) | lane; (void)tid; (void)lane;
        const float* gpost2 = args.in[7]; const float* gt2 = ada + 5 * D; float* out = args.out;
        for (int rb = gw; rb < S; rb += 2 * NGW) {
            int s0[2], s1[2]; float w0[2], w1[2]; const int rows[2] = {rb, rb + NGW};
#pragma unroll
            for (int q = 0; q < 2; ++q) { const int row = rows[q] < S ? rows[q] : rb; s0[q] = slot[row * 2]; s1[q] = slot[row * 2 + 1]; w0[q] = ew[row * 2]; w1[q] = ew[row * 2 + 1]; }
            u32x2 xb[2][8];
#pragma unroll
            for (int q = 0; q < 2; ++q) { const int row = rows[q] < S ? rows[q] : rb;
#pragma unroll
                for (int j = 0; j < 8; ++j) xb[q][j] = ((const u32x2*)(x1 + (size_t)row * D))[lane + 64 * j]; }
            f32x4 v[2][8]; float s[2] = {0.f, 0.f};
#pragma unroll
            for (int q = 0; q < 2; ++q) { const u32x2* y0 = (const u32x2*)(ybuf + (size_t)s0[q] * D) + lane; const u32x2* y1 = (const u32x2*)(ybuf + (size_t)s1[q] * D) + lane;
#pragma unroll
                for (int j = 0; j < 8; ++j) { const u32x2 a = y0[64 * j], b = y1[64 * j];
                    v[q][j].x = w0[q] * __uint_as_float(a.x << 16) + w1[q] * __uint_as_float(b.x << 16); v[q][j].y = w0[q] * __uint_as_float(a.x & 0xffff0000u) + w1[q] * __uint_as_float(b.x & 0xffff0000u);
                    v[q][j].z = w0[q] * __uint_as_float(a.y << 16) + w1[q] * __uint_as_float(b.y << 16); v[q][j].w = w0[q] * __uint_as_float(a.y & 0xffff0000u) + w1[q] * __uint_as_float(b.y & 0xffff0000u);
                    s[q] += (v[q][j].x * v[q][j].x + v[q][j].y * v[q][j].y) + (v[q][j].z * v[q][j].z + v[q][j].w * v[q][j].w); } }
            float r[2]; r[0] = rsqrtf(wave_sum(s[0]) * (1.0f / D) + 1e-6f); r[1] = rsqrtf(wave_sum(s[1]) * (1.0f / D) + 1e-6f);
#pragma unroll
            for (int q = 0; q < 2; ++q) if (rows[q] < S) {
#pragma unroll
                for (int j = 0; j < 8; ++j) { const int c = 4 * lane + 256 * j; const u32x2 xx = xb[q][j];
                    const f32x4 xf = (f32x4){__uint_as_float(xx.x << 16), __uint_as_float(xx.x & 0xffff0000u), __uint_as_float(xx.y << 16), __uint_as_float(xx.y & 0xffff0000u)};
                    ((f32x4*)(out + (size_t)rows[q] * D))[lane + 64 * j] = xf + *(const f32x4*)(gt2 + c) * (v[q][j] * r[q] * *(const f32x4*)(gpost2 + c)); } }
        }
    }
#undef IN
#undef SEAM
}
extern "C" void kernel_launch(void* const* d_in, const int* in_sizes, int n_in, void* d_out, int out_size, void* d_ws, size_t ws_size, hipStream_t stream) {
    static int grid = 0;
    if (grid == 0) {
        if (ws_size < WS_END || n_in != 38) { fprintf(stderr, "kernel_launch: unexpected workspace/inputs: %zu < %zu or n_in %d\n", ws_size, (size_t)WS_END, n_in); grid = -1; return; }
        int dev = 0, cus = 0;
        if (hipGetDevice(&dev) != hipSuccess || hipDeviceGetAttribute(&cus, hipDeviceAttributeMultiprocessorCount, dev) != hipSuccess) { fprintf(stderr, "device query failed\n"); grid = -1; return; }
        if (hipFuncSetAttribute((const void*)fwd, hipFuncAttributeMaxDynamicSharedMemorySize, LDS_BYTES) != hipSuccess) { fprintf(stderr, "hipFuncSetAttribute failed\n"); grid = -1; return; }
        grid = cus;
    }
    if (grid < 0) return;
    (void)hipMemsetAsync((char*)d_ws + WS_CTL, 0, 1 * MiB, stream);
    Args a{};
    for (int i = 0; i < 38; ++i) a.in[i] = (const float*)d_in[i];
    a.out = (float*)d_out; a.ws = (unsigned char*)d_ws;
#if N_LAUNCH_PER_PHASE
    for (int ph = 0; ph < 16; ++ph) { a.ph_lo = ph; a.ph_hi = ph + 1; hipLaunchKernelGGL(fwd, dim3(grid), dim3(NTHR), LDS_BYTES, stream, a); }
#else
    a.ph_lo = 0; a.ph_hi = 16; hipLaunchKernelGGL(fwd, dim3(grid), dim3(NTHR), LDS_BYTES, stream, a);
#endif
}
```

```cpp
#include <hip/hip_runtime.h>
#include <cstdio>
#include <cstdint>

typedef unsigned short bf16;
__device__ __forceinline__ float bf2f(bf16 b) { return __uint_as_float(((unsigned)b) << 16); }
__device__ __forceinline__ bf16 f2bf(float f) { unsigned u = __float_as_uint(f); u += 0x7fffu + ((u >> 16) & 1u); return (bf16)(u >> 16); }
__device__ __forceinline__ float sigmoidf_(float x) { return __builtin_amdgcn_rcpf(1.0f + __expf(-x)); }

#ifndef N_LAUNCH_PER_PHASE
#define N_LAUNCH_PER_PHASE 0
#endif
#ifndef REP_PHASE
#define REP_PHASE -1
#define REP_N 0
#endif
#ifndef REP_SCAN
#define REP_SCAN 0
#endif
#ifndef REP_P11A
#define REP_P11A 0
#endif
#ifndef REP_P11B
#define REP_P11B 0
#endif
#ifndef REP_R1A
#define REP_R1A 0
#define REP_R1B 0
#define REP_R1C 0
#endif
#ifndef REP_R1NR
#define REP_R1NR 0
#endif
#ifndef REP_R1S0
#define REP_R1S0 0
#endif
constexpr int S = 8192, D = 2048;
constexpr int AH = 8, AD = 128, AW = 1024, MB = 256, NB = S / MB;
constexpr int RH = 16, RN = 64, RW = 1024;
constexpr int LW = 96, LA = 96, LG = 256, LO = LW + LA + LG;
constexpr int INW = 3 * AW + 3 * RW + 2 * D;
constexpr int NE = 64, NG = 8, EPG = 8, FF = 512;
constexpr int MAXROWS = 32768;
constexpr int MAXTILES = MAXROWS / 256;

constexpr size_t MiB = 1u << 20;
constexpr size_t WS_CTL   = 0;
constexpr size_t WS_ADA   = 1 * MiB;
constexpr size_t WS_ROPE  = 2 * MiB;
constexpr size_t WS_KMEAN = 3 * MiB;
constexpr size_t WS_WL2   = 3 * MiB + 256 * 1024;
constexpr size_t WS_ROUTE = 5 * MiB;
constexpr size_t WS_TOK   = 6 * MiB;
constexpr size_t WS_WR    = 7 * MiB;
constexpr size_t WS_H     = 8 * MiB;
constexpr size_t WS_Q     = 40 * MiB;
constexpr size_t WS_K     = 56 * MiB;
constexpr size_t WS_V     = 72 * MiB;
constexpr size_t WS_RKV   = 88 * MiB;
constexpr size_t WS_GATE  = 184 * MiB;
constexpr size_t WS_LORA  = 248 * MiB;
constexpr size_t WS_LORAB = 424 * MiB;
constexpr size_t WS_AL2   = 280 * MiB;
constexpr size_t WS_LW    = 296 * MiB;
constexpr size_t WS_A     = 328 * MiB;
constexpr size_t WS_G     = 360 * MiB;
constexpr size_t WS_OCAT  = 392 * MiB;
constexpr size_t WS_MIX   = 424 * MiB;
constexpr size_t WS_Y     = 456 * MiB;
constexpr size_t WS_X1    = 520 * MiB;
constexpr size_t WS_H2    = 584 * MiB;
constexpr size_t WS_WUPT  = 616 * MiB;
constexpr size_t WS_WOT   = 624 * MiB;
constexpr size_t WS_WGUT  = 632 * MiB;
constexpr size_t WS_WDT   = 888 * MiB;
constexpr size_t WS_END   = 1016 * MiB;
constexpr size_t WS_W1T   = WS_Y;
constexpr size_t WS_ELIST = 16 * MiB;
constexpr size_t WS_XBUF  = WS_H;
constexpr size_t WS_HID   = 136 * MiB;
constexpr size_t WS_YBUF  = 168 * MiB;
constexpr size_t WS_ALIST = 8 * MiB, WS_AMASK = 12 * MiB, WS_AML = 13 * MiB, WS_APART = 248 * MiB;
constexpr size_t WS_RWP = 456 * MiB, WS_RWQ = 472 * MiB, WS_RWR = 504 * MiB, WS_RWY = 520 * MiB, WS_RWH = 552 * MiB, WS_RWB = 568 * MiB;
constexpr size_t WS_NR = WS_MIX, WS_NW = WS_NR + 32 * MiB, WS_NKT = WS_NR + 64 * MiB, WS_NV = WS_NR + 96 * MiB, WS_NKK = WS_NR + 128 * MiB, WS_NY = WS_NR + 160 * MiB;
constexpr size_t WS_MIXTMP = WS_Y;
constexpr size_t WS_GTMP = WS_Y;

constexpr int CW_CNT = 1024;
constexpr int CW_FILL = 1152;
constexpr int CW_OFF = 1280;
constexpr int CW_NT = 1408;
constexpr int CW_ACNT = 1536;
constexpr int CW_AQ = 1920;

namespace pg8 {
#define PG8_LAS __attribute__((address_space(3)))
typedef unsigned short bf16_t;
typedef short bf16x8 __attribute__((ext_vector_type(8)));
typedef float f32x4 __attribute__((ext_vector_type(4)));
typedef unsigned u32x4 __attribute__((ext_vector_type(4)));
typedef int i32x8_t __attribute__((ext_vector_type(8)));
template <bool IS8> struct FragSel { typedef bf16x8 T; static constexpr int NK = 2; };
template <> struct FragSel<true> { typedef i32x8_t T; static constexpr int NK = 1; };
template <int F8> struct FragT : FragSel<(F8 != 0)> {};
constexpr int BM = 256, BK = 64, HALF = 128, HTB = HALF * BK * 2  , STAGE_BYTES = 8 * HTB, NXCD = 8, WGM = 8;

__host__ __device__ __forceinline__ int lds_byte(int r, int c) { const int st = (r >> 4) * 2 + (c >> 5), rr = r & 15, cc = c & 31, ob = rr * 64 + cc * 2; return st * 1024 + (ob ^ (((ob >> 9) & 1) << 5)); }
__host__ __device__ __forceinline__ void stage_rc(int b, int& R, int& C) { const int st = b / 1024, sb = b % 1024, swz = sb ^ (((sb >> 9) & 1) << 5); R = (st >> 1) * 16 + swz / 64; C = (st & 1) * 32 + (swz % 64) / 2; }
__host__ __device__ __forceinline__ int perm32(int rho) { const int n = rho >> 4, i = rho & 15; return 8 * (i >> 2) + 4 * n + (i & 3); }

struct Unit { int pm, pn, koff, koffB; };
struct Gemm { const bf16_t* A; const bf16_t* Bt; int M, N, K, lda, ldb; };

struct StaticOrder {
    static constexpr bool GATHER = false; const int* tok = nullptr;
    int nM, nN, nwg, G, c;
    __host__ __device__ void init(int M, int N, int G_, int c_) { nM = M / BM; nN = N / BM; nwg = nM * nN; G = G_; c = c_; }
    __host__ __device__ bool next(int i, Unit& u) const {
        const long L = (long)i * G + c; if (L >= nwg) return false;
        int wgid = (int)L; { const int q = nwg / NXCD, r = nwg % NXCD, xcd = wgid % NXCD, off = wgid / NXCD; wgid = (xcd < r ? xcd * (q + 1) : r * (q + 1) + (xcd - r) * q) + off; }
        const int nig = WGM * nN, gid = wgid / nig, fm = gid * WGM, gsz = (nM - fm) < WGM ? (nM - fm) : WGM;
        u.pm = fm + ((wgid % nig) % gsz); u.pn = (wgid % nig) / gsz; u.koff = 0; u.koffB = 0; return true;
    }
    __device__ __forceinline__ void a_ready(const Unit&) const {}
    __device__ __forceinline__ void done(const Unit&) const {}
};

__device__ __forceinline__ unsigned cvt_pk_bf16(float lo, float hi) { unsigned r; asm volatile("v_cvt_pk_bf16_f32 %0, %1, %2" : "=v"(r) : "v"(lo), "v"(hi)); return r; }
template <class Epi, class Sched, bool ALIGN_EPI = false, bool SP2 = false, int F8 = 0, bool HM = false>
__device__ __forceinline__ void gemm_phase(PG8_LAS unsigned char* lds, const Gemm g, const Sched& S, const Epi& E) {
    int tid_ = threadIdx.x; asm volatile("" : "+v"(tid_));
    const int tid = tid_, wid = __builtin_amdgcn_readfirstlane(tid >> 6), lane = tid & 63, wr = wid >> 2, wc = wid & 3, fr = lane & 15, fq = lane >> 4;
    const int K = g.K, nt = K / BK;
    unsigned voffA[2], voffB[2], voffN[2] = {0u, 0u};
#pragma unroll
    for (int i = 0; i < 2; ++i) { int R, C; stage_rc(tid * 16 + i * 8192, R, C); const int Rb = Epi::PERM ? ((R & ~31) + perm32(R & 31)) : R;
        voffA[i] = (unsigned)(R * g.lda + C) * 2u; voffB[i] = (unsigned)(Rb * g.ldb + C) * 2u; }
    const size_t kstep = (size_t)(BK * 2);
    const size_t hstepA = HM ? (size_t)0 : (size_t)HALF * g.lda * 2, hstepB = (size_t)HALF * g.ldb * 2;
    const size_t tstepA = Sched::GATHER ? (size_t)0 : (HM ? 1 : 2) * (size_t)HALF * g.lda * 2, tstepB = 2 * hstepB;
    const unsigned ldsw = (unsigned)wid * 1024u;
    const int aoff = lds_byte(wr * 64 + fr, fq * 8), boff = lds_byte(wc * 32 + fr, fq * 8);
#define PG8_SA(b, h) (((b) * 2 + (h)) * HTB)
#define PG8_SB(b, h) ((4 + (b) * 2 + (h)) * HTB)
#define PG8_STAGE(bufoff, gbase, voff) do { _Pragma("unroll") for (int _i = 0; _i < 2; ++_i) \
        __builtin_amdgcn_global_load_lds((const unsigned*)((const char*)(gbase) + (voff)[_i]), (PG8_LAS unsigned*)(lds + (bufoff) + ldsw + _i * 8192), 16, 0, 0); } while (0)
#define PG8_CAT(lo, hi) __builtin_bit_cast(i32x8_t, __builtin_shufflevector(lo, hi, 0, 1, 2, 3, 4, 5, 6, 7, 8, 9, 10, 11, 12, 13, 14, 15))
#define PG8_RD(off) (*(const PG8_LAS bf16x8*)(lds + (off)))
#define PG8_LDA(dst, b, h) do { if constexpr (!(HM && (h) == 1)) _Pragma("unroll") for (int m = 0; m < 4; ++m) { if constexpr (F8 == 0) { _Pragma("unroll") for (int k = 0; k < 2; ++k) dst[m][k] = PG8_RD(PG8_SA(b, h) + aoff + m * 2048 + k * 1024); } \
        else dst[m][0] = PG8_CAT(PG8_RD(PG8_SA(b, h) + aoff + m * 2048), PG8_RD(PG8_SA(b, h) + aoff + m * 2048 + 1024)); } } while (0)
#define PG8_LDB(dst, b, h) do { _Pragma("unroll") for (int n = 0; n < 2; ++n) { if constexpr (F8 == 0) { _Pragma("unroll") for (int k = 0; k < 2; ++k) dst[n][k] = PG8_RD(PG8_SB(b, h) + boff + n * 2048 + k * 1024); } \
        else dst[n][0] = PG8_CAT(PG8_RD(PG8_SB(b, h) + boff + n * 2048), PG8_RD(PG8_SB(b, h) + boff + n * 2048 + 1024)); } } while (0)
#define PG8_MMA(ai, bj, At, Bt) do { __builtin_amdgcn_s_setprio(1); if constexpr (!(HM && (ai) == 1)) _Pragma("unroll") for (int m = 0; m < 4; ++m) _Pragma("unroll") for (int n = 0; n < 2; ++n) { \
        if constexpr (F8 == 0) { _Pragma("unroll") for (int k = 0; k < 2; ++k) acc[ai][bj][m][n] = __builtin_amdgcn_mfma_f32_16x16x32_bf16(Bt[n][k], At[m][k], acc[ai][bj][m][n], 0, 0, 0); } \
        else acc[ai][bj][m][n] = __builtin_amdgcn_mfma_scale_f32_16x16x128_f8f6f4(Bt[n][0], At[m][0], acc[ai][bj][m][n], 0, 0, 0, (F8 & 255) * 0x01010101, 0, ((F8 >> 8) & 255) * 0x01010101); } \
        __builtin_amdgcn_s_setprio(0); } while (0)
#define PG8_WAIT_V(n) asm volatile("s_waitcnt vmcnt(" #n ")" ::: "memory")
#define PG8_WAIT_L(n) asm volatile("s_waitcnt lgkmcnt(" #n ")" ::: "memory")
#define PG8_BAR __builtin_amdgcn_s_barrier()
#define PG8_SCHED __builtin_amdgcn_sched_barrier(0)
    Unit cur, nxt; int ui = 0;
    if (!S.next(0, cur)) return;
    f32x4 acc[2][2][4][2];
#pragma unroll
    for (int a = 0; a < 2; ++a)
#pragma unroll
        for (int b = 0; b < 2; ++b)
#pragma unroll
            for (int m = 0; m < 4; ++m)
#pragma unroll
                for (int n = 0; n < 2; ++n) acc[a][b][m][n] = (f32x4){0.f, 0.f, 0.f, 0.f};
    typename FragT<F8>::T At[4][FragT<F8>::NK], B0[2][FragT<F8>::NK], B1[2][FragT<F8>::NK];
    const char* cA = (const char*)g.A + (size_t)cur.pm * tstepA + cur.koff; const char* cB = (const char*)g.Bt + (size_t)cur.pn * tstepB + cur.koffB;
#define PG8_GVOFF(u, out) do { _Pragma("unroll") for (int i_ = 0; i_ < 2; ++i_) { int R_, C_; stage_rc(tid * 16 + i_ * 8192, R_, C_); out[i_] = ((unsigned)S.row_tok((u).pm, R_) * (unsigned)g.lda + (unsigned)C_) * 2u; } } while (0)
    if constexpr (Sched::GATHER) PG8_GVOFF(cur, voffA);
    S.a_ready(cur);
    if constexpr (SP2) {
        PG8_STAGE(PG8_SB(0, 0), cB, voffB); PG8_STAGE(PG8_SB(0, 1), cB + hstepB, voffB); PG8_STAGE(PG8_SA(0, 0), cA, voffA); PG8_STAGE(PG8_SA(0, 1), cA + hstepA, voffA);
        if (wr == 1) PG8_BAR;
        PG8_WAIT_V(2); PG8_BAR;
        PG8_STAGE(PG8_SB(1, 0), cB + kstep, voffB); PG8_STAGE(PG8_SA(1, 0), cA + kstep, voffA); PG8_STAGE(PG8_SB(1, 1), cB + hstepB + kstep, voffB);
        PG8_WAIT_V(6); PG8_BAR;
    } else {
        PG8_STAGE(PG8_SB(0, 0), cB, voffB); PG8_STAGE(PG8_SA(0, 0), cA, voffA); PG8_STAGE(PG8_SB(0, 1), cB + hstepB, voffB); PG8_STAGE(PG8_SA(0, 1), cA + hstepA, voffA);
        if (wr == 1) PG8_BAR;
        PG8_WAIT_V(4); PG8_BAR;
        PG8_STAGE(PG8_SB(1, 0), cB + kstep, voffB); PG8_STAGE(PG8_SA(1, 0), cA + kstep, voffA); PG8_STAGE(PG8_SB(1, 1), cB + hstepB + kstep, voffB);
        PG8_WAIT_V(6); PG8_BAR;
    }
    for (;;) {
        const bool has_next = S.next(ui + 1, nxt);
        if constexpr (Sched::GATHER) { if (has_next) PG8_GVOFF(nxt, voffN); }
        const char* nA = has_next ? (const char*)g.A + (size_t)nxt.pm * tstepA + nxt.koff : cA; const char* nB = has_next ? (const char*)g.Bt + (size_t)nxt.pn * tstepB + nxt.koffB : cB;
#pragma nounroll
        for (int t = 0; t < nt; t += 2) {
            const bool last = (t == nt - 2);
            const char* a1 = cA + (size_t)(t + 1) * kstep;
            const char* a2 = last ? nA : cA + (size_t)(t + 2) * kstep; const char* b2 = last ? nB : cB + (size_t)(t + 2) * kstep;
            const char* a3 = a2 + kstep; const char* b3 = b2 + kstep;
            unsigned vA2[2] = {voffA[0], voffA[1]}; if constexpr (Sched::GATHER) { if (last) { vA2[0] = voffN[0]; vA2[1] = voffN[1]; } }
            if (last && has_next) S.a_ready(nxt);
            if constexpr (SP2) {
            PG8_LDB(B0, 0, 0); PG8_LDB(B1, 0, 1); PG8_SCHED; PG8_LDA(At, 0, 0); PG8_STAGE(PG8_SA(1, 1), a1 + hstepA, voffA);
            PG8_WAIT_V(8); PG8_WAIT_L(0); PG8_BAR; PG8_MMA(0, 0, At, B0); PG8_MMA(0, 1, At, B1); PG8_BAR; PG8_SCHED;
            PG8_LDA(At, 0, 1); PG8_STAGE(PG8_SB(0, 0), b2, voffB); PG8_STAGE(PG8_SB(0, 1), b2 + hstepB, voffB); PG8_STAGE(PG8_SA(0, 0), a2, vA2);
            PG8_WAIT_V(8); PG8_WAIT_L(0); PG8_BAR; PG8_MMA(1, 0, At, B0); PG8_MMA(1, 1, At, B1); PG8_BAR; PG8_SCHED;
            PG8_LDB(B0, 1, 0); PG8_LDB(B1, 1, 1); PG8_SCHED; PG8_LDA(At, 1, 0); PG8_STAGE(PG8_SA(0, 1), a2 + hstepA, vA2);
            PG8_WAIT_V(8); PG8_WAIT_L(0); PG8_BAR; PG8_MMA(0, 0, At, B0); PG8_MMA(0, 1, At, B1); PG8_BAR; PG8_SCHED;
            PG8_LDA(At, 1, 1); PG8_STAGE(PG8_SB(1, 0), b3, voffB); PG8_STAGE(PG8_SB(1, 1), b3 + hstepB, voffB); PG8_STAGE(PG8_SA(1, 0), a3, vA2);
            PG8_WAIT_V(8); PG8_WAIT_L(0); PG8_BAR; PG8_MMA(1, 0, At, B0); PG8_MMA(1, 1, At, B1); PG8_BAR; PG8_SCHED;
            } else {
            PG8_LDB(B0, 0, 0); PG8_SCHED; PG8_LDA(At, 0, 0); PG8_STAGE(PG8_SA(1, 1), a1 + hstepA, voffA);
            PG8_WAIT_L(8); PG8_BAR; PG8_WAIT_L(0); PG8_MMA(0, 0, At, B0); PG8_BAR; PG8_SCHED;
            PG8_LDB(B1, 0, 1); PG8_STAGE(PG8_SB(0, 0), b2, voffB);
            PG8_BAR; PG8_WAIT_L(0); PG8_MMA(0, 1, At, B1); PG8_BAR;
            PG8_LDA(At, 0, 1); PG8_STAGE(PG8_SA(0, 0), a2, vA2);
            PG8_BAR; PG8_WAIT_L(0); PG8_MMA(1, 0, At, B0); PG8_BAR; PG8_SCHED;
            PG8_STAGE(PG8_SB(0, 1), b2 + hstepB, voffB);
            PG8_WAIT_V(6); PG8_BAR; PG8_MMA(1, 1, At, B1); PG8_BAR;
            PG8_LDB(B0, 1, 0); PG8_SCHED; PG8_LDA(At, 1, 0); PG8_STAGE(PG8_SA(0, 1), a2 + hstepA, vA2);
            PG8_WAIT_L(8); PG8_BAR; PG8_WAIT_L(0); PG8_MMA(0, 0, At, B0); PG8_BAR; PG8_SCHED;
            PG8_LDB(B1, 1, 1); PG8_STAGE(PG8_SB(1, 0), b3, voffB);
            PG8_BAR; PG8_WAIT_L(0); PG8_MMA(0, 1, At, B1); PG8_BAR;
            PG8_LDA(At, 1, 1); PG8_STAGE(PG8_SA(1, 0), a3, vA2);
            PG8_BAR; PG8_WAIT_L(0); PG8_MMA(1, 0, At, B0); PG8_BAR; PG8_SCHED;
            PG8_STAGE(PG8_SB(1, 1), b3 + hstepB, voffB);
            PG8_WAIT_V(6); PG8_BAR; PG8_MMA(1, 1, At, B1); PG8_BAR;
            }
        }
        if constexpr (ALIGN_EPI) { if (wr == 0) PG8_BAR; }
        if constexpr (!Epi::AFTER_DRAIN) { E(acc, cur, wr, wc, fr, fq); S.done(cur); }
        if (!has_next) break;
        {
#pragma unroll
        for (int a = 0; a < 2; ++a)
#pragma unroll
            for (int b = 0; b < 2; ++b)
#pragma unroll
                for (int m = 0; m < 4; ++m)
#pragma unroll
                    for (int n = 0; n < 2; ++n) acc[a][b][m][n] = (f32x4){0.f, 0.f, 0.f, 0.f};
        }
        cur = nxt; cA = nA; cB = nB; ++ui;
        if constexpr (Sched::GATHER) { voffA[0] = voffN[0]; voffA[1] = voffN[1]; }
        if constexpr (ALIGN_EPI) { if (wr == 1) PG8_BAR; }
    }
    PG8_WAIT_V(0);
    if constexpr (!ALIGN_EPI) { if (wr == 0) PG8_BAR; }
    PG8_BAR;
    if constexpr (Epi::AFTER_DRAIN) { E.fused(acc, cur, wr, wc, fr, fq, lds, wid, lane); S.done(cur); }
#undef PG8_SA
#undef PG8_SB
#undef PG8_STAGE
#undef PG8_LDA
#undef PG8_LDB
#undef PG8_MMA
#undef PG8_CAT
#undef PG8_GVOFF
#undef PG8_RD
#undef PG8_WAIT_V
#undef PG8_WAIT_L
#undef PG8_BAR
#undef PG8_SCHED
}
}

#define XB_TMO      128
#define XB_XCNT(j)  (256  + 64 * (j))
#define XB_XSUB(j)  (1280 + 64 * (j))
#define XB_XGEN(j)  (2304 + 64 * (j))
#define XB_TOP      3328
#define XB_TOPGEN   3392
#define XCD_BAR_WORDS 3456
#define XB_SPIN_CAP (1u << 18)
#define LAS __attribute__((address_space(3)))

__device__ __forceinline__ unsigned xb_ld(unsigned* p)              { return __hip_atomic_load(p, __ATOMIC_RELAXED, __HIP_MEMORY_SCOPE_AGENT); }
__device__ __forceinline__ unsigned xb_add(unsigned* p, unsigned v) { return __hip_atomic_fetch_add(p, v, __ATOMIC_RELAXED, __HIP_MEMORY_SCOPE_AGENT); }
__device__ __forceinline__ unsigned xb_xcc_id() { return (unsigned)__builtin_amdgcn_s_getreg((3 << 11) | 20) & 0xFu; }
#define XB_SPIN(cond, bar) do { unsigned _sp = 0; while (cond) { __builtin_amdgcn_s_sleep(1); \
    if ((++_sp & 255u) == 0u) { if (xb_ld(&(bar)[XB_TMO])) break; if (_sp > XB_SPIN_CAP) { atomicAdd(&(bar)[XB_TMO], 1u); break; } } } } while (0)

struct XcdBarrier {
    unsigned* bar; unsigned x;
    volatile LAS unsigned* st;
};

__device__ __forceinline__ XcdBarrier xcd_barrier_post(unsigned* bar, volatile LAS unsigned* st) {
    XcdBarrier b; b.bar = bar; b.x = xb_xcc_id(); b.st = st;
    if (threadIdx.x == 0) (void)xb_add(&bar[XB_XCNT(b.x)], 1u);
    return b;
}
__device__ __forceinline__ void xcd_barrier_complete(unsigned* bar, unsigned x, unsigned& nloc, unsigned& nx) {
    const unsigned G = gridDim.x * gridDim.y * gridDim.z;
    unsigned sum, cnt, mine, sp = 0u;
    for (;;) {
        sum = 0u; cnt = 0u; mine = 0u;
#pragma unroll
        for (unsigned j = 0; j < 16; ++j) { const unsigned c = xb_ld(&bar[XB_XCNT(j)]); sum += c; cnt += (c > 0u) ? 1u : 0u; mine = (j == x) ? c : mine; }
        if (sum == G) break;
        __builtin_amdgcn_s_sleep(1);
        if ((++sp & 255u) == 0u) { if (xb_ld(&bar[XB_TMO])) break; if (sp > XB_SPIN_CAP) { atomicAdd(&bar[XB_TMO], 1u); break; } }
    }
    nloc = mine > 0u ? mine : 1u; nx = cnt > 0u ? cnt : 1u;
}

__device__ __forceinline__ void xcd_barrier(const XcdBarrier& b) {
    asm volatile("s_waitcnt vmcnt(0)" ::: "memory");
    __syncthreads();
    if (threadIdx.x == 0) {
        unsigned* bar = b.bar;
        __builtin_amdgcn_s_waitcnt(0);
        unsigned nloc = b.st[0], nx = b.st[1];
        if (nloc == 0u) { xcd_barrier_complete(bar, b.x, nloc, nx); b.st[0] = nloc; b.st[1] = nx; }
        const unsigned old = xb_add(&bar[XB_XSUB(b.x)], 1u);
        const unsigned gen = old / nloc;
        if (old + 1u == (gen + 1u) * nloc) {
            __builtin_amdgcn_fence(__ATOMIC_RELEASE, "agent");
            asm volatile("s_waitcnt vmcnt(0)" ::: "memory");
            const unsigned og = xb_add(&bar[XB_TOP], 1u);
            const unsigned tg = og / nx;
            if (og + 1u == (tg + 1u) * nx) xb_add(&bar[XB_TOPGEN], 1u);
            else XB_SPIN(xb_ld(&bar[XB_TOPGEN]) == tg, bar);
            __builtin_amdgcn_fence(__ATOMIC_ACQUIRE, "agent");
            xb_add(&bar[XB_XGEN(b.x)], 1u);
            asm volatile("s_waitcnt vmcnt(0)" ::: "memory");
        } else {
            XB_SPIN(xb_ld(&bar[XB_XGEN(b.x)]) == gen, bar);
            __builtin_amdgcn_fence(__ATOMIC_ACQUIRE, "agent");
            asm volatile("s_waitcnt vmcnt(0)" ::: "memory");
        }
    }
    __syncthreads();
}

constexpr int NWAVES = 8, NTHR = 512;
constexpr int RING_BYTES = 131072;
constexpr int LDS_BYTES = 147456;
constexpr int RT_OFF = 131072;
constexpr int LDSCTL_OFF = LDS_BYTES - 16;
constexpr int CW_BAR = 4096;
typedef float f32x4 __attribute__((ext_vector_type(4)));
typedef unsigned u32x4 __attribute__((ext_vector_type(4)));
typedef unsigned u32x2 __attribute__((ext_vector_type(2)));
typedef short bf16x8 __attribute__((ext_vector_type(8)));
#define LDS_WAIT() asm volatile("s_waitcnt lgkmcnt(0)" ::: "memory")
typedef __bf16 bf16x2_t __attribute__((ext_vector_type(2)));
typedef float f32x2_t __attribute__((ext_vector_type(2)));
__device__ __forceinline__ unsigned pk2(float lo, float hi) { const f32x2_t v = {lo, hi}; return __builtin_bit_cast(unsigned, __builtin_convertvector(v, bf16x2_t)); }
__device__ __forceinline__ int lane_fresh() { int l; asm volatile("v_mbcnt_lo_u32_b32 %0, -1, 0\n\tv_mbcnt_hi_u32_b32 %0, -1, %0" : "=v"(l)); return l; }
#define DPP_ADD(v, ctrl) ((v) + __builtin_bit_cast(float, __builtin_amdgcn_update_dpp(0, __builtin_bit_cast(int, (v)), (ctrl), 0xf, 0xf, true)))
__device__ __forceinline__ float wave_sum(float v) {
    v = DPP_ADD(v, 0xB1);
    v = DPP_ADD(v, 0x4E);
    v = DPP_ADD(v, 0x141);
    v = DPP_ADD(v, 0x140);
    const int iv = __builtin_bit_cast(int, v);
    return (__builtin_bit_cast(float, __builtin_amdgcn_readlane(iv, 0)) + __builtin_bit_cast(float, __builtin_amdgcn_readlane(iv, 16)))
         + (__builtin_bit_cast(float, __builtin_amdgcn_readlane(iv, 32)) + __builtin_bit_cast(float, __builtin_amdgcn_readlane(iv, 48)));
}

constexpr int N1 = 11264;
struct Args { const float* in[38]; float* out; unsigned char* ws; int ph_lo, ph_hi; };

__device__ __forceinline__ void tr_item(const float* W, int ldw, int k0, int n0, bf16* dst, int ldd, const float* mu, int mode, LAS float* scr, int lane) {
    f32x4 v[8];
#pragma unroll
    for (int i = 0; i < 8; ++i) v[i] = *(const f32x4*)(W + (size_t)(k0 + 8 * i + (lane >> 3)) * ldw + n0 + 4 * (lane & 7));
#pragma unroll
    for (int i = 0; i < 8; ++i) { const int kk = 8 * i + (lane >> 3); f32x4 t = v[i];
        if (mode == 1) t = t * (1.0f - mu[k0 + kk]); else if (mode == 2) t = t * mu[k0 + kk];
        LAS float* s = scr + kk * 33 + 4 * (lane & 7); s[0] = t.x; s[1] = t.y; s[2] = t.z; s[3] = t.w; }
    LDS_WAIT(); asm volatile("" ::: "memory");
    const int c = lane & 7;
#pragma unroll
    for (int j = 0; j < 4; ++j) { const int n = (lane >> 3) + 8 * j; const LAS float* s = scr + (8 * c) * 33 + n;
        u32x4 o; o.x = pk2(s[0 * 33], s[1 * 33]); o.y = pk2(s[2 * 33], s[3 * 33]); o.z = pk2(s[4 * 33], s[5 * 33]); o.w = pk2(s[6 * 33], s[7 * 33]);
        *(u32x4*)(dst + (size_t)n * ldd + 8 * c) = o; }
    LDS_WAIT(); asm volatile("" ::: "memory");
}
__device__ __forceinline__ unsigned pk_fp8x4(float a, float b, float c, float d, float sc) {
    a = fminf(fmaxf(a * sc, -448.f), 448.f); b = fminf(fmaxf(b * sc, -448.f), 448.f); c = fminf(fmaxf(c * sc, -448.f), 448.f); d = fminf(fmaxf(d * sc, -448.f), 448.f);
    int p = __builtin_amdgcn_cvt_pk_fp8_f32(a, b, 0, false); p = __builtin_amdgcn_cvt_pk_fp8_f32(c, d, p, true); return (unsigned)p; }
__device__ __forceinline__ void tr_item8(const float* W, int ldw, int k0, int n0, unsigned char* dst, int ldd, float sc, LAS float* scr, int lane) {
    f32x4 v[8];
#pragma unroll
    for (int i = 0; i < 8; ++i) v[i] = *(const f32x4*)(W + (size_t)(k0 + 8 * i + (lane >> 3)) * ldw + n0 + 4 * (lane & 7));
#pragma unroll
    for (int i = 0; i < 8; ++i) { const int kk = 8 * i + (lane >> 3); LAS float* s = scr + kk * 33 + 4 * (lane & 7); s[0] = v[i].x; s[1] = v[i].y; s[2] = v[i].z; s[3] = v[i].w; }
    LDS_WAIT(); asm volatile("" ::: "memory");
    const int c = lane & 7;
#pragma unroll
    for (int j = 0; j < 4; ++j) { const int n = (lane >> 3) + 8 * j; const LAS float* s = scr + (8 * c) * 33 + n;
        u32x2 o; o.x = pk_fp8x4(s[0 * 33], s[1 * 33], s[2 * 33], s[3 * 33], sc); o.y = pk_fp8x4(s[4 * 33], s[5 * 33], s[6 * 33], s[7 * 33], sc);
        *(u32x2*)(dst + (size_t)n * ldd + 8 * c) = o; }
    LDS_WAIT(); asm volatile("" ::: "memory");
}

struct ConvTile { const float* src; int ldw; unsigned char* dst; int rs; int kind; float sc; };
constexpr int CT_IN = (D / 128) * (INW / 128), CT_UP = (AW / 128) * (D / 128), CT_O = (D / 128) * (D / 128), CT_EG = (D / 128) * (FF / 128), CT_ED = (FF / 128) * (D / 128);
constexpr int CT_ALL = CT_IN + 2 * CT_UP + CT_O + NE * (2 * CT_EG + CT_ED);
__device__ __forceinline__ ConvTile conv_decode(int T, const float* const* in, unsigned char* ws) {
    ConvTile t; int r = T;
    if (r < CT_IN) { const int kt = r / (INW / 128), nt = r % (INW / 128), k0 = 128 * kt, n0 = 128 * nt; int dr = n0;
        if (n0 >= 3 * AW + 3 * RW + D) { const int cc = n0 - (3 * AW + 3 * RW + D); dr = 3 * AW + 3 * RW + 256 * (cc / 128) + 128; }
        else if (n0 >= 3 * AW + 3 * RW) { const int cc = n0 - (3 * AW + 3 * RW); dr = 3 * AW + 3 * RW + 256 * (cc / 128); }
        t.src = in[8] + (size_t)k0 * INW + n0; t.ldw = INW; t.dst = ws + WS_W1T + ((size_t)dr * D + k0) * 2; t.rs = D * 2; t.kind = 0; t.sc = 1.f; return t; } r -= CT_IN;
    if (r < 2 * CT_UP) { const int which = r / CT_UP, q = r % CT_UP, kt = q / (D / 128), nt = q % (D / 128), k0 = 128 * kt, n0 = 128 * nt;
        t.src = in[28 + which] + (size_t)k0 * D + n0; t.ldw = D; t.dst = ws + WS_WUPT + ((size_t)n0 * D + which * AW + k0) * 2; t.rs = D * 2; t.kind = 0; t.sc = 1.f; return t; } r -= 2 * CT_UP;
    if (r < CT_O) { const int kt = r / (D / 128), nt = r % (D / 128), k0 = 128 * kt, n0 = 128 * nt;
        t.src = in[30] + (size_t)k0 * D + n0; t.ldw = D; t.dst = ws + WS_WOT + ((size_t)n0 * D + k0) * 2; t.rs = D * 2; t.kind = 0; t.sc = 1.f; return t; } r -= CT_O;
    const int e = r / (2 * CT_EG + CT_ED); r -= e * (2 * CT_EG + CT_ED);
    if (r < 2 * CT_EG) { const int up = r / CT_EG, q = r % CT_EG, kt = q / (FF / 128), nt = q % (FF / 128), k0 = 128 * kt;
        t.src = in[35 + up] + (size_t)e * D * FF + (size_t)k0 * FF + 128 * nt; t.ldw = FF; t.dst = ws + WS_WGUT + ((size_t)e * 1024 + 256 * nt + 128 * up) * D + k0; t.rs = D; t.kind = 1; t.sc = 256.f; return t; } r -= 2 * CT_EG;
    { const int kt = r / (D / 128), nt = r % (D / 128), k0 = 128 * kt, n0 = 128 * nt;
        t.src = in[37] + (size_t)e * FF * D + (size_t)k0 * D + n0; t.ldw = D; t.dst = ws + WS_WDT + ((size_t)e * D + n0) * FF + k0; t.rs = FF; t.kind = 1; t.sc = 128.f; return t; }
}
__device__ __forceinline__ int conv_off(int k, int n) { return k * 132 + 16 * (k >> 5) + n; }
__device__ __forceinline__ void item_kn(int it, int N, int& k0, int& n0) { const int nblk = N / 32; k0 = 64 * (it / nblk); n0 = 32 * (it % nblk); }

struct EpiProj {
    static constexpr bool PERM = true, AFTER_DRAIN = false, MIDK = false;
    bf16* q; bf16* k; bf16* v; float* rkv; bf16* gate; float* lora; float* lorab; const float* rope;
    __device__ __forceinline__ void operator()(const pg8::f32x4 (&acc)[2][2][4][2], const pg8::Unit& u, int wr, int wc, int fr, int fq) const {
        const int row0 = u.pm * 256 + wr * 64 + fr; const int pn = u.pn; const int colw = wc * 32 + 8 * fq;
        if (pn < 8) {
            bf16* base = (pn < 4 ? q : k) + (pn & 3) * 256 + colw;
            const float sgn = fq < 2 ? -1.0f : 1.0f;
#pragma unroll
            for (int ai = 0; ai < 2; ++ai)
#pragma unroll
                for (int m = 0; m < 4; ++m) { const int row = row0 + ai * 128 + m * 16;
                    f32x4 c0, c1, c2, c3;
                    if (wc == 0) { const float* rp = rope + ((size_t)row * 16 + 8 * (fq & 1)) * 2; c0 = *(const f32x4*)rp; c1 = *(const f32x4*)(rp + 4); c2 = *(const f32x4*)(rp + 8); c3 = *(const f32x4*)(rp + 12); }
#pragma unroll
                    for (int bj = 0; bj < 2; ++bj) { f32x4 v0 = acc[ai][bj][m][0], v1 = acc[ai][bj][m][1];
                        if (wc == 0) {
                            f32x4 p0, p1;
#pragma unroll
                            for (int j = 0; j < 4; ++j) { p0[j] = __shfl_xor(v0[j], 32) * sgn; p1[j] = __shfl_xor(v1[j], 32) * sgn; }
                            v0[0] = v0[0] * c0[0] + p0[0] * c0[1]; v0[1] = v0[1] * c0[2] + p0[1] * c0[3]; v0[2] = v0[2] * c1[0] + p0[2] * c1[1]; v0[3] = v0[3] * c1[2] + p0[3] * c1[3];
                            v1[0] = v1[0] * c2[0] + p1[0] * c2[1]; v1[1] = v1[1] * c2[2] + p1[1] * c2[3]; v1[2] = v1[2] * c3[0] + p1[2] * c3[1]; v1[3] = v1[3] * c3[2] + p1[3] * c3[3];
                        }
                        u32x4 w; w.x = pk2(v0[0], v0[1]); w.y = pk2(v0[2], v0[3]); w.z = pk2(v1[0], v1[1]); w.w = pk2(v1[2], v1[3]);
                        *(u32x4*)(base + (size_t)row * AW + bj * 128) = w; } }
        } else if (pn < 12) {
            bf16* base = v + (pn - 8) * 256 + colw;
#pragma unroll
            for (int ai = 0; ai < 2; ++ai)
#pragma unroll
                for (int m = 0; m < 4; ++m) { const int row = row0 + ai * 128 + m * 16;
#pragma unroll
                    for (int bj = 0; bj < 2; ++bj) { const f32x4 v0 = acc[ai][bj][m][0], v1 = acc[ai][bj][m][1];
                        u32x4 w; w.x = pk2(v0[0], v0[1]); w.y = pk2(v0[2], v0[3]); w.z = pk2(v1[0], v1[1]); w.w = pk2(v1[2], v1[3]);
                        *(u32x4*)(base + (size_t)row * AW + bj * 128) = w; } }
        } else if (pn < 24) {
            float* base = rkv + (pn - 12) * 256 + colw;
#pragma unroll
            for (int ai = 0; ai < 2; ++ai)
#pragma unroll
                for (int m = 0; m < 4; ++m) { const int row = row0 + ai * 128 + m * 16;
#pragma unroll
                    for (int bj = 0; bj < 2; ++bj) { float* p = base + (size_t)row * (3 * RW) + bj * 128; *(f32x4*)p = acc[ai][bj][m][0]; *(f32x4*)(p + 4) = acc[ai][bj][m][1]; } }
        } else if (pn < 40) {
            bf16* base = gate + (pn - 24) * 128 + colw;
#pragma unroll
            for (int ai = 0; ai < 2; ++ai)
#pragma unroll
                for (int m = 0; m < 4; ++m) { const int row = row0 + ai * 128 + m * 16;
                    const f32x4 a0 = acc[ai][0][m][0], a1 = acc[ai][0][m][1], r0 = acc[ai][1][m][0], r1 = acc[ai][1][m][1]; float ra[8], sr[8];
#pragma unroll
                    for (int j = 0; j < 4; ++j) { const float ea = __expf(-a0[j]), er = __expf(-r0[j]), ea1 = __expf(-a1[j]), er1 = __expf(-r1[j]);
                        sr[j] = __builtin_amdgcn_rcpf(1.0f + er); ra[j] = (1.0f + er) * __builtin_amdgcn_rcpf(1.0f + ea); sr[4 + j] = __builtin_amdgcn_rcpf(1.0f + er1); ra[4 + j] = (1.0f + er1) * __builtin_amdgcn_rcpf(1.0f + ea1); }
                    u32x4 w; w.x = pk2(ra[0], ra[1]); w.y = pk2(ra[2], ra[3]); w.z = pk2(ra[4], ra[5]); w.w = pk2(ra[6], ra[7]);
                    *(u32x4*)(base + (size_t)row * (2 * D)) = w;
                    w.x = pk2(sr[0], sr[1]); w.y = pk2(sr[2], sr[3]); w.z = pk2(sr[4], sr[5]); w.w = pk2(sr[6], sr[7]);
                    *(u32x4*)(base + (size_t)row * (2 * D) + D) = w; }
        } else {
            float* base = (u.koff ? lorab : lora) + (pn - 40) * 256 + colw;
#pragma unroll
            for (int ai = 0; ai < 2; ++ai)
#pragma unroll
                for (int m = 0; m < 4; ++m) { const int row = row0 + ai * 128 + m * 16;
#pragma unroll
                    for (int bj = 0; bj < 2; ++bj) { float* p = base + (size_t)row * 1024 + bj * 128; *(f32x4*)p = acc[ai][bj][m][0]; *(f32x4*)(p + 4) = acc[ai][bj][m][1]; } }
        }
    }
};


struct LoraOrder { static constexpr bool GATHER = false; const int* tok; int G, c;
    __device__ bool next(int i, pg8::Unit& u) const { const int L = i * G + c; if (L >= (S / 256) * 8) return false; u.pm = L >> 3; u.pn = 40 + ((L >> 1) & 3); u.koff = (L & 1) * AW * 2; u.koffB = u.koff; return true; }
    __device__ __forceinline__ void a_ready(const pg8::Unit&) const {}
    __device__ __forceinline__ void done(const pg8::Unit&) const {} };
__device__ __forceinline__ void unpack8(const u32x4 w, float (&f)[8]) {
    f[0] = __uint_as_float(w.x << 16); f[1] = __uint_as_float(w.x & 0xffff0000u); f[2] = __uint_as_float(w.y << 16); f[3] = __uint_as_float(w.y & 0xffff0000u);
    f[4] = __uint_as_float(w.z << 16); f[5] = __uint_as_float(w.z & 0xffff0000u); f[6] = __uint_as_float(w.w << 16); f[7] = __uint_as_float(w.w & 0xffff0000u);
}
struct EpiMix {
    static constexpr bool PERM = true, AFTER_DRAIN = false, MIDK = false;
    const bf16* gate; bf16* mix;
    __device__ __forceinline__ void operator()(const pg8::f32x4 (&acc)[2][2][4][2], const pg8::Unit& u, int wr, int wc, int fr, int fq) const {
        const int row0 = u.pm * 256 + wr * 64 + fr; const int col0 = u.pn * 256 + wc * 32 + 8 * fq;
        if (u.koff == 0) {
#pragma unroll
            for (int ai = 0; ai < 2; ++ai)
#pragma unroll
                for (int m = 0; m < 4; ++m) { const size_t row = row0 + ai * 128 + m * 16; const bf16* gp = gate + row * (2 * D) + col0;
#pragma unroll
                    for (int bj = 0; bj < 2; ++bj) { float ga[8]; unpack8(*(const u32x4*)(gp + bj * 128), ga); const pg8::f32x4 v0 = acc[ai][bj][m][0], v1 = acc[ai][bj][m][1];
                        u32x4 w; w.x = pk2(v0[0] * ga[0], v0[1] * ga[1]); w.y = pk2(v0[2] * ga[2], v0[3] * ga[3]); w.z = pk2(v1[0] * ga[4], v1[1] * ga[5]); w.w = pk2(v1[2] * ga[6], v1[3] * ga[7]);
                        *(u32x4*)(mix + row * D + col0 + bj * 128) = w; } }
        } else {
#pragma unroll
            for (int ai = 0; ai < 2; ++ai)
#pragma unroll
                for (int m = 0; m < 4; ++m) { const size_t row = row0 + ai * 128 + m * 16; const bf16* gp = gate + row * (2 * D) + D + col0;
#pragma unroll
                    for (int bj = 0; bj < 2; ++bj) { float gr[8], tp[8]; unpack8(*(const u32x4*)(gp + bj * 128), gr); unpack8(*(const u32x4*)(mix + row * D + col0 + bj * 128), tp); const pg8::f32x4 v0 = acc[ai][bj][m][0], v1 = acc[ai][bj][m][1];
                        u32x4 w; w.x = pk2((v0[0] + tp[0]) * gr[0], (v0[1] + tp[1]) * gr[1]); w.y = pk2((v0[2] + tp[2]) * gr[2], (v0[3] + tp[3]) * gr[3]);
                        w.z = pk2((v1[0] + tp[4]) * gr[4], (v1[1] + tp[5]) * gr[5]); w.w = pk2((v1[2] + tp[6]) * gr[6], (v1[3] + tp[7]) * gr[7]);
                        *(u32x4*)(mix + row * D + col0 + bj * 128) = w; } }
        }
    }
};
struct MixOrder {
    static constexpr bool GATHER = false; const int* tok; int G, c;
    __device__ bool next(int i, pg8::Unit& u) const { const int L = (i >> 1) * G + c; if (L >= (S / 256) * (D / 256)) return false; u.pm = L / (D / 256); u.pn = L % (D / 256); u.koff = (i & 1) * AW * 2; u.koffB = u.koff; return true; }
    __device__ __forceinline__ void a_ready(const pg8::Unit&) const {}
    __device__ __forceinline__ void done(const pg8::Unit&) const {}
};
struct EpiBf16P {
    static constexpr bool PERM = true, AFTER_DRAIN = false, MIDK = false;
    bf16* C; long ldc;
    __device__ __forceinline__ void operator()(const pg8::f32x4 (&acc)[2][2][4][2], const pg8::Unit& u, int wr, int wc, int fr, int fq) const {
        const int row0 = u.pm * 256 + wr * 64 + fr; const int col0 = u.pn * 256 + wc * 32 + 8 * fq;
#pragma unroll
        for (int ai = 0; ai < 2; ++ai)
#pragma unroll
            for (int m = 0; m < 4; ++m) { bf16* p = C + (size_t)(row0 + ai * 128 + m * 16) * ldc + col0;
#pragma unroll
                for (int bj = 0; bj < 2; ++bj) { const pg8::f32x4 v0 = acc[ai][bj][m][0], v1 = acc[ai][bj][m][1];
                    u32x4 w; w.x = pk2(v0[0], v0[1]); w.y = pk2(v0[2], v0[3]); w.z = pk2(v1[0], v1[1]); w.w = pk2(v1[2], v1[3]);
                    *(u32x4*)(p + bj * 128) = w; } }
    }
};
struct EpiF32P {
    static constexpr bool PERM = true, AFTER_DRAIN = false, MIDK = false;
    float* C; long ldc;
    __device__ __forceinline__ void operator()(const pg8::f32x4 (&acc)[2][2][4][2], const pg8::Unit& u, int wr, int wc, int fr, int fq) const {
        const int row0 = u.pm * 256 + wr * 64 + fr; const int col0 = u.pn * 256 + wc * 32 + 8 * fq;
#pragma unroll
        for (int ai = 0; ai < 2; ++ai)
#pragma unroll
            for (int m = 0; m < 4; ++m) { float* p = C + (size_t)(row0 + ai * 128 + m * 16) * ldc + col0;
#pragma unroll
                for (int bj = 0; bj < 2; ++bj) { *(f32x4*)(p + bj * 128) = acc[ai][bj][m][0]; *(f32x4*)(p + bj * 128 + 4) = acc[ai][bj][m][1]; } }
    }
};
template <bool GA> struct ExpertOrderT {
    static constexpr bool GATHER = GA; const int* elist;
    LAS const int* tb; int nj, G, c;
    __device__ bool next(int i, pg8::Unit& u) const { const int L = i * G + c; const int pm = L / nj; if (pm >= tb[512]) return false; u.pm = pm; u.pn = tb[128 + pm] * nj + (L % nj); u.koff = 0; u.koffB = 0; return true; }
    __device__ __forceinline__ int row_tok(int pm, int r) const { const int e = tb[128 + pm]; const int q = tb[320 + pm] + r; return q < tb[e] ? elist[e * S + q] : 0; }
    __device__ __forceinline__ void a_ready(const pg8::Unit&) const {}
    __device__ __forceinline__ void done(const pg8::Unit&) const {}
};
struct EpiHid {
    static constexpr bool PERM = true, AFTER_DRAIN = false, MIDK = false;
    unsigned char* hid;
    __device__ __forceinline__ void operator()(const pg8::f32x4 (&acc)[2][2][4][2], const pg8::Unit& u, int wr, int wc, int fr, int fq) const {
        const int row0 = u.pm * 128 + wr * 64 + fr; const int col0 = (u.pn & 3) * 128 + wc * 32 + 8 * fq;
#pragma unroll
        for (int ai = 0; ai < 1; ++ai)
#pragma unroll
            for (int m = 0; m < 4; ++m) { const pg8::f32x4 g0 = acc[ai][0][m][0], g1 = acc[ai][0][m][1], u0 = acc[ai][1][m][0], u1 = acc[ai][1][m][1]; float o[8];
#pragma unroll
                for (int j = 0; j < 4; ++j) { o[j] = g0[j] * sigmoidf_(g0[j]) * u0[j]; o[4 + j] = g1[j] * sigmoidf_(g1[j]) * u1[j]; }
                u32x2 w; w.x = pk_fp8x4(o[0], o[1], o[2], o[3], 8.0f); w.y = pk_fp8x4(o[4], o[5], o[6], o[7], 8.0f);
                *(u32x2*)(hid + (size_t)(row0 + ai * 128 + m * 16) * FF + col0) = w; }
    }
};
struct EpiYbuf {
    static constexpr bool PERM = true, AFTER_DRAIN = false, MIDK = false;
    bf16* ybuf;
    __device__ __forceinline__ void operator()(const pg8::f32x4 (&acc)[2][2][4][2], const pg8::Unit& u, int wr, int wc, int fr, int fq) const {
        const int row0 = u.pm * 128 + wr * 64 + fr; const int col0 = (u.pn & 7) * 256 + wc * 32 + 8 * fq;
#pragma unroll
        for (int ai = 0; ai < 1; ++ai)
#pragma unroll
            for (int m = 0; m < 4; ++m) { bf16* p = ybuf + (size_t)(row0 + ai * 128 + m * 16) * D + col0;
#pragma unroll
                for (int bj = 0; bj < 2; ++bj) { const pg8::f32x4 v0 = acc[ai][bj][m][0], v1 = acc[ai][bj][m][1];
                    u32x4 w; w.x = pk2(v0[0], v0[1]); w.y = pk2(v0[2], v0[3]); w.z = pk2(v1[0], v1[1]); w.w = pk2(v1[2], v1[3]);
                    *(u32x4*)(p + bj * 128) = w; } }
    }
};
constexpr int RS8 = D + 8;

typedef short s16x4 __attribute__((ext_vector_type(4)));
constexpr int KST = 136, VST = 144;
constexpr int KT_BYTES = 64 * KST * 2, VT_BYTES = 64 * VST * 2;
constexpr int AT_BUF = KT_BYTES + VT_BYTES;
constexpr int AT_G = 2 * AT_BUF;
constexpr int AT_HIST = AT_G + 8 * 2112;
constexpr int AT_ITEMS = AT_HIST + 256;
constexpr int LIST_PER_HEAD = 256 * 496;
__device__ __forceinline__ int list_off(int j) { return 256 * (31 * j - (j * (j - 1)) / 2); }
__device__ __forceinline__ s16x4 tr_read4(unsigned addr) { return __builtin_amdgcn_ds_read_tr16_b64_v4i16((LAS s16x4*)(size_t)addr); }

struct AttnBufs { const bf16* q; const bf16* k; const bf16* v; const bf16* kmh; const bf16* kml; unsigned* mask; int* list; int* cnt; bf16* part; float* ml; };

__device__ __forceinline__ void moba_select_unit(LAS unsigned char* lds, const AttnBufs& A, int head, int qt, int tid, int lane, int wave) {
    const int q0 = qt * 128, qblk = qt >> 1, g4 = lane >> 4, c16 = lane & 15; const int myq = q0 + wave * 16 + c16;
    LAS int* hist = (LAS int*)(lds + AT_HIST); LAS int* base = hist + 32;
    if (tid < 32) hist[tid] = 0;
    __syncthreads();
    unsigned msk = 0u; int lp0 = 0, lp1 = 0, lp2 = 0, b0 = 0, b1 = 0, b2 = 0, nsel = 0;
    if (qblk > 0) {
        bf16x8 qf[4];
#pragma unroll
        for (int ks = 0; ks < 4; ++ks) qf[ks] = *(const bf16x8*)(A.q + (size_t)myq * AW + head * AD + 32 * ks + 8 * g4);
        f32x4 gs[2] = {(f32x4){0.f, 0.f, 0.f, 0.f}, (f32x4){0.f, 0.f, 0.f, 0.f}};
#pragma unroll
        for (int mt = 0; mt < 2; ++mt)
#pragma unroll
            for (int ks = 0; ks < 4; ++ks) { const size_t o = (size_t)(head * NB + 16 * mt + c16) * AD + 32 * ks + 8 * g4;
                gs[mt] = __builtin_amdgcn_mfma_f32_16x16x32_bf16(*(const bf16x8*)(A.kmh + o), qf[ks], gs[mt], 0, 0, 0);
                gs[mt] = __builtin_amdgcn_mfma_f32_16x16x32_bf16(*(const bf16x8*)(A.kml + o), qf[ks], gs[mt], 0, 0, 0); }
        LAS float* G = (LAS float*)(lds + AT_G + wave * 2112);
#pragma unroll
        for (int mt = 0; mt < 2; ++mt)
#pragma unroll
            for (int rg = 0; rg < 4; ++rg) G[c16 * 33 + 16 * mt + 4 * g4 + rg] = gs[mt][rg];
        LDS_WAIT(); asm volatile("" ::: "memory");
        if (lane < 16) {
            nsel = qblk < 3 ? qblk : 3;
            float gvv[32];
#pragma unroll
            for (int n = 0; n < 32; ++n) gvv[n] = G[lane * 33 + n];
#pragma unroll
            for (int n = 0; n < 32; ++n) gvv[n] = n < qblk ? gvv[n] : -3e38f;
#pragma unroll
            for (int t = 0; t < 3; ++t) if (t < nsel) { float best = -3e38f; int bi = 0;
#pragma unroll
                for (int n = 0; n < 32; ++n) { const bool take = gvv[n] > best; best = take ? gvv[n] : best; bi = take ? n : bi; }
#pragma unroll
                for (int n = 0; n < 32; ++n) gvv[n] = (n == bi) ? -3e38f : gvv[n];
                msk |= 1u << bi;
                const int lp = atomicAdd((int*)&hist[bi], 1); if (t == 0) { lp0 = lp; b0 = bi; } else if (t == 1) { lp1 = lp; b1 = bi; } else { lp2 = lp; b2 = bi; } }
        }
    }
    if (lane < 16) A.mask[head * S + myq] = msk;
    __syncthreads();
    if (tid < 32) { const int hcount = hist[tid]; base[tid] = hcount > 0 ? atomicAdd(A.cnt + head * NB + tid, hcount) : 0; }
    __syncthreads();
    if (lane < 16) { int* lh = A.list + head * LIST_PER_HEAD;
        if (nsel > 0) lh[list_off(b0) + base[b0] + lp0] = myq;
        if (nsel > 1) lh[list_off(b1) + base[b1] + lp1] = myq;
        if (nsel > 2) lh[list_off(b2) + base[b2] + lp2] = myq; }
    __syncthreads();
}

__device__ __forceinline__ void moba_item2(LAS unsigned char* lds, const AttnBufs& A, int head, int kvb, bool own, int r, int cntj, int tid, int lane, int wave) {
    const int g4 = lane >> 4, c16 = lane & 15;
    int myq[2]; bool valid[2];
    if (own) { myq[0] = kvb * MB + wave * 32 + c16; myq[1] = myq[0] + 16; valid[0] = true; valid[1] = true; }
    else { const int* lp = A.list + head * LIST_PER_HEAD + list_off(kvb);
#pragma unroll
        for (int g = 0; g < 2; ++g) { const int e = r * 256 + wave * 32 + 16 * g + c16; valid[g] = e < cntj; myq[g] = lp[valid[g] ? e : 0]; } }
    const bool wave_valid = own || (r * 256 + wave * 32 < cntj);
    const int qfirst = kvb * MB + wave * 32;
    bf16x8 qf[2][4];
#pragma unroll
    for (int g = 0; g < 2; ++g)
#pragma unroll
        for (int ks = 0; ks < 4; ++ks) qf[g][ks] = *(const bf16x8*)(A.q + (size_t)myq[g] * AW + head * AD + 32 * ks + 8 * g4);
    f32x4 oacc[2][8];
#pragma unroll
    for (int g = 0; g < 2; ++g)
#pragma unroll
        for (int dt = 0; dt < 8; ++dt) oacc[g][dt] = (f32x4){0.f, 0.f, 0.f, 0.f};
    float mrun[2] = {-1e30f, -1e30f}, lrun[2] = {0.f, 0.f};
    const float sc2 = 0.08838834764831845f * 1.4426950408889634f;
    const int r0 = tid >> 4, ch = tid & 15;
    u32x4 kr[2], vr[2];
    const bf16* kg = A.k + (size_t)(kvb * MB + r0) * AW + head * AD + 8 * ch; const bf16* vg = A.v + (size_t)(kvb * MB + r0) * AW + head * AD + 8 * ch;
    LAS unsigned char* kst = lds + (r0 * KST + 8 * ch) * 2; LAS unsigned char* vst = lds + KT_BYTES + (r0 * VST + 8 * ch) * 2;
    const LAS unsigned char* kld = lds + (c16 * KST + 8 * g4) * 2; const LAS unsigned char* vld = lds + KT_BYTES + ((4 * g4 + (c16 >> 2)) * VST + 4 * (c16 & 3)) * 2;
#define GLD(it) do { kr[0] = *(const u32x4*)(kg + (size_t)(64 * (it)) * AW); kr[1] = *(const u32x4*)(kg + (size_t)(64 * (it) + 32) * AW); vr[0] = *(const u32x4*)(vg + (size_t)(64 * (it)) * AW); vr[1] = *(const u32x4*)(vg + (size_t)(64 * (it) + 32) * AW); } while (0)
#define LST(b) do { *(LAS u32x4*)(kst + (b) * AT_BUF) = kr[0]; *(LAS u32x4*)(kst + (b) * AT_BUF + 32 * KST * 2) = kr[1]; *(LAS u32x4*)(vst + (b) * AT_BUF) = vr[0]; *(LAS u32x4*)(vst + (b) * AT_BUF + 32 * VST * 2) = vr[1]; } while (0)
    GLD(0); LST(0);
    __syncthreads();
#pragma nounroll
    for (int it = 0; it < 4; ++it) {
        const int kp0 = kvb * MB + 64 * it; const int b = it & 1;
        if (it + 1 < 4) GLD(it + 1);
        if (wave_valid && (!own || kp0 <= qfirst + 31)) {
            const LAS unsigned char* Kb = kld + b * AT_BUF; const LAS unsigned char* vb = vld + b * AT_BUF;
            f32x4 st[2][4];
#pragma unroll
            for (int mt = 0; mt < 4; ++mt) { st[0][mt] = (f32x4){0.f, 0.f, 0.f, 0.f}; st[1][mt] = st[0][mt];
#pragma unroll
                for (int ks = 0; ks < 4; ++ks) { const bf16x8 kf = *(const LAS bf16x8*)(Kb + (16 * mt * KST + 32 * ks) * 2);
                    st[0][mt] = __builtin_amdgcn_mfma_f32_16x16x32_bf16(kf, qf[0][ks], st[0][mt], 0, 0, 0);
                    st[1][mt] = __builtin_amdgcn_mfma_f32_16x16x32_bf16(kf, qf[1][ks], st[1][mt], 0, 0, 0); } }
            bf16x8 pf[2][2];
#pragma unroll
            for (int g = 0; g < 2; ++g) {
                if (own && kp0 + 63 > qfirst + 16 * g) {
#pragma unroll
                    for (int mt = 0; mt < 4; ++mt)
#pragma unroll
                        for (int rg = 0; rg < 4; ++rg) { const int kpos = kp0 + 16 * mt + 4 * g4 + rg; st[g][mt][rg] = (kpos <= myq[g]) ? st[g][mt][rg] : -1e30f; }
                }
                float mloc = fmaxf(fmaxf(fmaxf(st[g][0][0], st[g][0][1]), fmaxf(st[g][0][2], st[g][0][3])), fmaxf(fmaxf(st[g][1][0], st[g][1][1]), fmaxf(st[g][1][2], st[g][1][3])));
                mloc = fmaxf(mloc, fmaxf(fmaxf(fmaxf(st[g][2][0], st[g][2][1]), fmaxf(st[g][2][2], st[g][2][3])), fmaxf(fmaxf(st[g][3][0], st[g][3][1]), fmaxf(st[g][3][2], st[g][3][3]))));
                mloc = fmaxf(mloc, __shfl_xor(mloc, 16)); mloc = fmaxf(mloc, __shfl_xor(mloc, 32));
                const float mnew = fmaxf(mrun[g], mloc * sc2); const float alpha = __builtin_amdgcn_exp2f(mrun[g] - mnew); mrun[g] = mnew;
                float psum = 0.f;
#pragma unroll
                for (int mt = 0; mt < 4; ++mt)
#pragma unroll
                    for (int rg = 0; rg < 4; ++rg) { const float p = __builtin_amdgcn_exp2f(fmaf(st[g][mt][rg], sc2, -mnew)); st[g][mt][rg] = p; psum += p; }
                lrun[g] = lrun[g] * alpha + psum;
#pragma unroll
                for (int dt = 0; dt < 8; ++dt) oacc[g][dt] = oacc[g][dt] * alpha;
#pragma unroll
                for (int s = 0; s < 2; ++s) { u32x4 w; w.x = pk2(st[g][2 * s][0], st[g][2 * s][1]); w.y = pk2(st[g][2 * s][2], st[g][2 * s][3]); w.z = pk2(st[g][2 * s + 1][0], st[g][2 * s + 1][1]); w.w = pk2(st[g][2 * s + 1][2], st[g][2 * s + 1][3]);
                    pf[g][s] = __builtin_bit_cast(bf16x8, w); }
            }
#pragma unroll
            for (int dt = 0; dt < 8; ++dt)
#pragma unroll
                for (int s = 0; s < 2; ++s) {
                    const s16x4 lo = __builtin_amdgcn_ds_read_tr16_b64_v4i16((LAS s16x4*)(vb + (32 * s * VST + 16 * dt) * 2));
                    const s16x4 hi = __builtin_amdgcn_ds_read_tr16_b64_v4i16((LAS s16x4*)(vb + ((32 * s + 16) * VST + 16 * dt) * 2));
                    bf16x8 vf; vf[0] = lo[0]; vf[1] = lo[1]; vf[2] = lo[2]; vf[3] = lo[3]; vf[4] = hi[0]; vf[5] = hi[1]; vf[6] = hi[2]; vf[7] = hi[3];
                    oacc[0][dt] = __builtin_amdgcn_mfma_f32_16x16x32_bf16(vf, pf[0][s], oacc[0][dt], 0, 0, 0);
                    oacc[1][dt] = __builtin_amdgcn_mfma_f32_16x16x32_bf16(vf, pf[1][s], oacc[1][dt], 0, 0, 0); }
        }
        if (it + 1 < 4) LST(b ^ 1);
        __syncthreads();
    }
#undef GLD
#undef LST
#pragma unroll
    for (int g = 0; g < 2; ++g) {
        float l = lrun[g]; l += __shfl_xor(l, 16); l += __shfl_xor(l, 32);
        if (valid[g] && wave_valid) {
            int slot = 0; if (!own) { const unsigned mk = A.mask[head * S + myq[g]]; slot = 1 + __builtin_popcount(mk & ((1u << kvb) - 1u)); }
            const size_t pidx = ((size_t)(head * S + myq[g])) * 4 + slot;
            const float inv = 1.0f / l;
            bf16* orow = A.part + pidx * AD + 4 * g4;
#pragma unroll
            for (int dt = 0; dt < 8; ++dt) { u32x2 w; w.x = pk2(oacc[g][dt][0] * inv, oacc[g][dt][1] * inv); w.y = pk2(oacc[g][dt][2] * inv, oacc[g][dt][3] * inv); *(u32x2*)(orow + 16 * dt) = w; }
            if (g4 == 0) { A.ml[pidx * 2] = mrun[g]; A.ml[pidx * 2 + 1] = l; }
        }
    }
}
__device__ __forceinline__ void moba_items(LAS unsigned char* lds, const AttnBufs& A, int* qhead, LAS int* pre, LAS int* tick, int tid, int lane, int wave) {
    const int nitems = AH * NB + pre[256];
    if (tid == 0) tick[0] = atomicAdd(qhead, 1);
    __syncthreads();
    int item = tick[0];
    while (item < nitems) {
        __syncthreads();
        if (tid == 0) tick[0] = atomicAdd(qhead, 1);
        if (item < AH * NB) moba_item2(lds, A, item >> 5, item & 31, true, 0, 0, tid, lane, wave);
        else { const int s = item - AH * NB; int lo_ = 0, hi_ = 256;
            while (hi_ - lo_ > 1) { const int mid = (lo_ + hi_) >> 1; if (pre[mid] <= s) lo_ = mid; else hi_ = mid; }
            moba_item2(lds, A, lo_ >> 5, lo_ & 31, false, s - pre[lo_], A.cnt[lo_], tid, lane, wave); }
        __syncthreads();
        item = tick[0];
    }
}

constexpr int RST = 72, SLOTB = 64 * RST * 2;
constexpr int NCH = S / 64;
__device__ __forceinline__ bf16x8 frag_rows(const LAS bf16* M, int r0, int k0, int c16, int g4) { return *(const LAS bf16x8*)(M + (r0 + c16) * RST + k0 + 8 * g4); }
__device__ __forceinline__ bf16x8 frag_cols(const LAS bf16* M, int c0, int k0, int c16, int g4) {
    const unsigned base = (unsigned)(size_t)M; const int tq = c16 >> 2, tp = c16 & 3;
    const s16x4 lo = tr_read4(base + ((k0 + 8 * g4 + tq) * RST + c0 + 4 * tp) * 2);
    const s16x4 hi = tr_read4(base + ((k0 + 8 * g4 + 4 + tq) * RST + c0 + 4 * tp) * 2);
    bf16x8 r; r[0] = lo[0]; r[1] = lo[1]; r[2] = lo[2]; r[3] = lo[3]; r[4] = hi[0]; r[5] = hi[1]; r[6] = hi[2]; r[7] = hi[3]; return r;
}
__device__ __forceinline__ void st_tile(LAS bf16* M, const f32x4 v, int r0, int c0, int c16, int g4) {
#pragma unroll
    for (int rg = 0; rg < 4; rg += 2) { const unsigned p = pk2(v[rg], v[rg + 1]); M[(r0 + 4 * g4 + rg) * RST + c0 + c16] = (bf16)(p & 0xffffu); M[(r0 + 4 * g4 + rg + 1) * RST + c0 + c16] = (bf16)(p >> 16); }
}
#define MFMA16(a, b, c) __builtin_amdgcn_mfma_f32_16x16x32_bf16(a, b, c, 0, 0, 0)

struct RwkvBufs { const float* rkv; const float* lw; const float* av; bf16* P; float* QmT; bf16* Rt; float* Yi; float* bonus; };

#define R1_BAR() do { asm volatile("s_waitcnt lgkmcnt(0)" ::: "memory"); __builtin_amdgcn_s_barrier(); asm volatile("" ::: "memory"); } while (0)
struct R1In { float lwv[8], av[8], rr[9], kr[9], vr[9]; };
__device__ __forceinline__ void rwkv_r1_load(R1In& I, const RwkvBufs& B, int head, int chunk, int lane, int wave) {
    const int ch = head * RN + lane; const int t0 = chunk * 64 + wave * 8;
#pragma unroll
    for (int i = 0; i < 8; ++i) { I.lwv[i] = B.lw[(size_t)(t0 + i) * RW + ch]; I.av[i] = B.av[(size_t)(t0 + i) * RW + ch]; }
#pragma unroll
    for (int i = 0; i < 9; ++i) { const int t = t0 - 1 + i; if (t >= 0) { const float* cr = B.rkv + (size_t)t * (3 * RW) + ch; I.rr[i] = cr[0]; I.kr[i] = cr[RW]; I.vr[i] = cr[2 * RW]; } else { I.rr[i] = 0.f; I.kr[i] = 0.f; I.vr[i] = 0.f; } }
}
__device__ __forceinline__ void rwkv_r1_unit(LAS unsigned char* lds, const RwkvBufs& B, const float* const* in, R1In& I, int head, int chunk, int nhead, int nchunk, int tid, int lane, int wave) {
    LAS bf16* sA = (LAS bf16*)(lds + 0 * SLOTB); LAS bf16* sB = (LAS bf16*)(lds + 1 * SLOTB); LAS bf16* sK = (LAS bf16*)(lds + 2 * SLOTB); LAS bf16* sR = (LAS bf16*)(lds + 3 * SLOTB); LAS bf16* sV = (LAS bf16*)(lds + 4 * SLOTB);
    LAS bf16* sM0 = (LAS bf16*)(lds + 5 * SLOTB); LAS bf16* sM1 = (LAS bf16*)(lds + 6 * SLOTB); LAS bf16* sT0 = (LAS bf16*)(lds + 7 * SLOTB); LAS bf16* sT1 = (LAS bf16*)(lds + 8 * SLOTB);
    LAS bf16* sLak = (LAS bf16*)(lds + 9 * SLOTB); LAS bf16* sMrb = (LAS bf16*)(lds + 10 * SLOTB); LAS bf16* sMrk = (LAS bf16*)(lds + 11 * SLOTB); LAS bf16* sX = (LAS bf16*)(lds + 12 * SLOTB);
    LAS bf16* sW = (LAS bf16*)(lds + 13 * SLOTB); LAS bf16* sU = (LAS bf16*)(lds + 14 * SLOTB);
    LAS float* cs = (LAS float*)(lds + 15 * SLOTB); LAS float* gC = cs + 512;
    const int c16 = lane & 15, g4 = lane >> 4;
    {
        const int ch = head * RN + lane; const int t0 = chunk * 64 + wave * 8;
        const float mur = in[9][ch], muk = in[10][ch], muv = in[11][ch], kkc = in[23][ch], kac = in[24][ch], rkc = in[25][ch];
        float run = 0.f;
#pragma unroll
        for (int i = 0; i < 8; ++i) run += I.lwv[i];
        cs[wave * 64 + lane] = run;
        R1_BAR();
        float off = 0.f;
        for (int w = 0; w < wave; ++w) off += cs[w * 64 + lane];
        float gcur = off;
#pragma unroll
        for (int i = 0; i < 8; ++i) {
            const int t = t0 + i;
            const float r0 = I.rr[i + 1], k0 = I.kr[i + 1], v0 = I.vr[i + 1], rp = I.rr[i], kp = I.kr[i], vp = I.vr[i];
            const float r = r0 + (rp - r0) * mur, kx = k0 + (kp - k0) * muk, vx = v0 + (vp - v0) * muv;
            const float a = I.av[i];
            float kk = kx * kkc; const float ss = wave_sum(kk * kk); kk = kk * __builtin_amdgcn_rcpf(fmaxf(sqrtf(ss), 1e-12f));
            const float kt = kx * (1.0f + (a - 1.0f) * kac);
            const float bn = wave_sum(r * kt * rkc);
            if (lane == 0) B.bonus[(size_t)t * RH + head] = bn;
            const float gprev = gcur; gcur += I.lwv[i];
            const float eg = __expf(gcur), egp = __expf(gprev), eng = __expf(-gcur);
            const int tl = wave * 8 + i;
            { const unsigned pab = pk2(-kk * egp, kk * a * eng), pkr = pk2(kt * eng, r * eg), pv_ = pk2(vx, vx);
              sA[tl * RST + lane] = (bf16)(pab & 0xffffu); sB[tl * RST + lane] = (bf16)(pab >> 16); sK[tl * RST + lane] = (bf16)(pkr & 0xffffu); sR[tl * RST + lane] = (bf16)(pkr >> 16); sV[tl * RST + lane] = (bf16)(pv_ & 0xffffu); }
        }
        if (wave == 7) gC[lane] = __expf(gcur);
    }
    if (nhead >= 0) rwkv_r1_load(I, B, nhead, nchunk, lane, wave);
    R1_BAR();
    const int mt = wave >> 1, ntb = 2 * (wave & 1);
    f32x4 Treg[2];
    for (int r14 = 0; r14 < 1 + REP_R1A; ++r14) {
        f32x4 ab[2], ak[2], rb[2], rk[2];
#pragma unroll
        for (int n = 0; n < 2; ++n) { ab[n] = (f32x4){0.f, 0.f, 0.f, 0.f}; ak[n] = ab[n]; rb[n] = ab[n]; rk[n] = ab[n]; }
#pragma unroll
        for (int s = 0; s < 2; ++s) { const bf16x8 aA = frag_rows(sA, 16 * mt, 32 * s, c16, g4), aR = frag_rows(sR, 16 * mt, 32 * s, c16, g4);
#pragma unroll
            for (int n = 0; n < 2; ++n) { const bf16x8 bB = frag_rows(sB, 16 * (ntb + n), 32 * s, c16, g4), bK = frag_rows(sK, 16 * (ntb + n), 32 * s, c16, g4);
                ab[n] = MFMA16(aA, bB, ab[n]); ak[n] = MFMA16(aA, bK, ak[n]); rb[n] = MFMA16(aR, bB, rb[n]); rk[n] = MFMA16(aR, bK, rk[n]); } }
#pragma unroll
        for (int n = 0; n < 2; ++n) { const int i = 16 * (ntb + n) + c16;
#pragma unroll
            for (int rg = 0; rg < 4; ++rg) { const int t = 16 * mt + 4 * g4 + rg; const bool lo = i < t, le = i <= t;
                ab[n][rg] = lo ? ab[n][rg] : 0.f; ak[n][rg] = lo ? ak[n][rg] : 0.f; rb[n][rg] = le ? rb[n][rg] : 0.f; rk[n][rg] = le ? rk[n][rg] : 0.f;
                Treg[n][rg] = ab[n][rg] + (i == t ? 1.0f : 0.f); }
            st_tile(sM0, ab[n], 16 * mt, 16 * (ntb + n), c16, g4); st_tile(sT0, Treg[n], 16 * mt, 16 * (ntb + n), c16, g4);
            st_tile(sLak, ak[n], 16 * mt, 16 * (ntb + n), c16, g4); st_tile(sMrb, rb[n], 16 * mt, 16 * (ntb + n), c16, g4); st_tile(sMrk, rk[n], 16 * mt, 16 * (ntb + n), c16, g4); }
    }
    R1_BAR();
    LAS bf16* Tc = sT0; LAS bf16* Tn = sT1; LAS bf16* Mc = sM0; LAS bf16* Mn = sM1;
    {
        f32x4 am[2] = {(f32x4){0.f, 0.f, 0.f, 0.f}, (f32x4){0.f, 0.f, 0.f, 0.f}}, ax[2] = {(f32x4){0.f, 0.f, 0.f, 0.f}, (f32x4){0.f, 0.f, 0.f, 0.f}};
#pragma unroll
        for (int s = 0; s < 2; ++s) { const bf16x8 aM = frag_rows(Mc, 16 * mt, 32 * s, c16, g4), aL = frag_rows(sLak, 16 * mt, 32 * s, c16, g4);
#pragma unroll
            for (int n = 0; n < 2; ++n) { am[n] = MFMA16(aM, frag_cols(Mc, 16 * (ntb + n), 32 * s, c16, g4), am[n]); ax[n] = MFMA16(aL, frag_cols(sV, 16 * (ntb + n), 32 * s, c16, g4), ax[n]); } }
#pragma unroll
        for (int n = 0; n < 2; ++n) { st_tile(Mn, am[n], 16 * mt, 16 * (ntb + n), c16, g4); st_tile(sX, ax[n], 16 * mt, 16 * (ntb + n), c16, g4); }
        R1_BAR();
        LAS bf16* t2 = Mc; Mc = Mn; Mn = t2;
    }
    for (int kround = 1; kround <= 5 + REP_R1NR; ++kround) {
        f32x4 am[2] = {(f32x4){0.f, 0.f, 0.f, 0.f}, (f32x4){0.f, 0.f, 0.f, 0.f}};
#pragma unroll
        for (int s = 0; s < 2; ++s) { const bf16x8 aT = frag_rows(Tc, 16 * mt, 32 * s, c16, g4), aM = frag_rows(Mc, 16 * mt, 32 * s, c16, g4);
#pragma unroll
            for (int n = 0; n < 2; ++n) { const bf16x8 bM = frag_cols(Mc, 16 * (ntb + n), 32 * s, c16, g4); Treg[n] = MFMA16(aT, bM, Treg[n]); am[n] = MFMA16(aM, bM, am[n]); } }
#pragma unroll
        for (int n = 0; n < 2; ++n) { st_tile(Tn, Treg[n], 16 * mt, 16 * (ntb + n), c16, g4); st_tile(Mn, am[n], 16 * mt, 16 * (ntb + n), c16, g4); }
        R1_BAR();
        LAS bf16* t1 = Tc; Tc = Tn; Tn = t1; LAS bf16* t2 = Mc; Mc = Mn; Mn = t2;
    }
    for (int rwu = 0; rwu < 1 + REP_R1B; ++rwu) {
        f32x4 aw[2] = {(f32x4){0.f, 0.f, 0.f, 0.f}, (f32x4){0.f, 0.f, 0.f, 0.f}}, au[2] = {(f32x4){0.f, 0.f, 0.f, 0.f}, (f32x4){0.f, 0.f, 0.f, 0.f}};
#pragma unroll
        for (int s = 0; s < 2; ++s) { const bf16x8 aT = frag_rows(Tc, 16 * mt, 32 * s, c16, g4);
#pragma unroll
            for (int n = 0; n < 2; ++n) { aw[n] = MFMA16(aT, frag_cols(sA, 16 * (ntb + n), 32 * s, c16, g4), aw[n]); au[n] = MFMA16(aT, frag_cols(sX, 16 * (ntb + n), 32 * s, c16, g4), au[n]); } }
#pragma unroll
        for (int n = 0; n < 2; ++n) { st_tile(sW, aw[n], 16 * mt, 16 * (ntb + n), c16, g4); st_tile(sU, au[n], 16 * mt, 16 * (ntb + n), c16, g4); }
    }
    R1_BAR();
    for (int rs8 = 0; rs8 < 1 + REP_R1C; ++rs8) {
        const size_t ub = (size_t)(head * NCH + chunk) * 4096;
        f32x4 pp[2], qq[2], rr[2], yy[2];
#pragma unroll
        for (int n = 0; n < 2; ++n) { pp[n] = (f32x4){0.f, 0.f, 0.f, 0.f}; qq[n] = pp[n]; rr[n] = pp[n]; yy[n] = pp[n]; }
#pragma unroll
        for (int s = 0; s < 2; ++s) {
            const bf16x8 cW = frag_cols(sW, 16 * mt, 32 * s, c16, g4), cB = frag_cols(sB, 16 * mt, 32 * s, c16, g4), cK = frag_cols(sK, 16 * mt, 32 * s, c16, g4), cU = frag_cols(sU, 16 * mt, 32 * s, c16, g4), cV = frag_cols(sV, 16 * mt, 32 * s, c16, g4);
#pragma unroll
            for (int n = 0; n < 2; ++n) { const int c0 = 16 * (ntb + n);
                const bf16x8 bB = frag_cols(sB, c0, 32 * s, c16, g4), bU = frag_cols(sU, c0, 32 * s, c16, g4), bV = frag_cols(sV, c0, 32 * s, c16, g4);
                const bf16x8 rMrb = frag_rows(sMrb, c0, 32 * s, c16, g4), rMrk = frag_rows(sMrk, c0, 32 * s, c16, g4);
                pp[n] = MFMA16(cW, bB, pp[n]);
                qq[n] = MFMA16(cB, bU, qq[n]); qq[n] = MFMA16(cK, bV, qq[n]);
                rr[n] = MFMA16(cW, rMrb, rr[n]);
                yy[n] = MFMA16(cU, rMrb, yy[n]); yy[n] = MFMA16(cV, rMrk, yy[n]); } }
#pragma unroll
        for (int n = 0; n < 2; ++n) { const int j = 16 * (ntb + n) + c16; const int i0 = 16 * mt + 4 * g4;
            {
                const float gc = gC[j]; float o[4];
#pragma unroll
                for (int rg = 0; rg < 4; ++rg) o[rg] = gc * (pp[n][rg] + ((i0 + rg) == j ? 1.0f : 0.f));
                u32x2 w; w.x = pk2(o[0], o[1]); w.y = pk2(o[2], o[3]); *(u32x2*)(B.P + ub + (size_t)j * 64 + i0) = w; }
            {
                f32x4 o;
#pragma unroll
                for (int rg = 0; rg < 4; ++rg) o[rg] = gC[i0 + rg] * qq[n][rg];
                *(f32x4*)(B.QmT + ub + (size_t)j * 64 + i0) = o; }
            {
                const u32x2 rb2 = *(const LAS u32x2*)(sR + j * RST + i0); float o[4];
                o[0] = rr[n][0] + __uint_as_float(rb2.x << 16); o[1] = rr[n][1] + __uint_as_float(rb2.x & 0xffff0000u); o[2] = rr[n][2] + __uint_as_float(rb2.y << 16); o[3] = rr[n][3] + __uint_as_float(rb2.y & 0xffff0000u);
                u32x2 w; w.x = pk2(o[0], o[1]); w.y = pk2(o[2], o[3]); *(u32x2*)(B.Rt + ub + (size_t)j * 64 + i0) = w; }
            *(f32x4*)(B.Yi + ub + (size_t)j * 64 + i0) = yy[n];
        }
    }
    R1_BAR();
}

constexpr int R2_PST = 136, R2_QST = 272, R2_QOFF = 64 * R2_PST, R2_SLOT = R2_QOFF + 16 * R2_QST;
__device__ __forceinline__ void rwkv_r2_wg(LAS unsigned char* lds, const bf16* __restrict__ P, const float* __restrict__ QmT, bf16* __restrict__ H0T, int head, int cg, int wave, int lane) {
    const int c16 = lane & 15, g4 = lane >> 4;
    const int lt = ((wave & 3) << 6) | lane;
#define R2_BAR() do { asm volatile("s_waitcnt lgkmcnt(0)" ::: "memory"); __builtin_amdgcn_s_barrier(); asm volatile("" ::: "memory"); } while (0)
    if (wave >= 4) {
        constexpr int NST = 8;
        u32x4 st[NST][3];
        auto gl = [&](int c, u32x4 (&r)[3]) { const size_t ub = (size_t)(head * NCH + c) * 4096;
            const u32x4* p = (const u32x4*)(P + ub); const u32x4* q = (const u32x4*)(QmT + ub + (size_t)(16 * cg) * 64);
            r[0] = p[lt]; r[1] = p[lt + 256]; r[2] = q[lt]; };
        auto lw = [&](int slot, const u32x4 (&r)[3]) { LAS unsigned char* s = lds + slot * R2_SLOT;
#pragma unroll
            for (int i = 0; i < 2; ++i) { const int idx = lt + 256 * i; LAS u32x2* d = (LAS u32x2*)(s + (idx >> 3) * R2_PST + (idx & 7) * 16); u32x2 a; a.x = r[i].x; a.y = r[i].y; u32x2 b; b.x = r[i].z; b.y = r[i].w; d[0] = a; d[1] = b; }
            *(LAS u32x4*)(s + R2_QOFF + (lt >> 4) * R2_QST + (lt & 15) * 16) = r[2]; };
#pragma unroll
        for (int j = 0; j < NST; ++j) gl(j, st[j]);
        lw(0, st[0]); gl(NST, st[0]);
        R2_BAR();
        for (int c4 = 0; c4 < NCH / NST; ++c4) {
#pragma unroll
            for (int j = 0; j < NST; ++j) { const int c = NST * c4 + j;
                if (c + 1 < NCH) lw((c + 1) & 1, st[(j + 1) % NST]);
                if (c + 1 + NST < NCH) gl(c + 1 + NST, st[(j + 1) % NST]);
                R2_BAR(); }
        }
    } else if (wave == 0) {
        f32x4 hacc[4];
#pragma unroll
        for (int m = 0; m < 4; ++m) hacc[m] = (f32x4){0.f, 0.f, 0.f, 0.f};
        R2_BAR();
        for (int c = 0; c < NCH; ++c) {
            const LAS unsigned char* s = lds + (c & 1) * R2_SLOT; const size_t ub = (size_t)(head * NCH + c) * 4096;
            bf16x8 af[4][2]; f32x4 qv[4];
#pragma unroll
            for (int m = 0; m < 4; ++m) { qv[m] = *(const LAS f32x4*)(s + R2_QOFF + c16 * R2_QST + (16 * m + 4 * g4) * 4);
#pragma unroll
                for (int sx = 0; sx < 2; ++sx) { const LAS unsigned char* pr = s + (16 * m + c16) * R2_PST + (32 * sx + 4 * g4) * 2; const u32x2 a = *(const LAS u32x2*)pr, b = *(const LAS u32x2*)(pr + 32);
                    u32x4 w; w.x = a.x; w.y = a.y; w.z = b.x; w.w = b.y; af[m][sx] = __builtin_bit_cast(bf16x8, w); } }
            bf16x8 bfr[2];
#pragma unroll
            for (int sx = 0; sx < 2; ++sx) { u32x4 w; w.x = pk2(hacc[2 * sx][0], hacc[2 * sx][1]); w.y = pk2(hacc[2 * sx][2], hacc[2 * sx][3]); w.z = pk2(hacc[2 * sx + 1][0], hacc[2 * sx + 1][1]); w.w = pk2(hacc[2 * sx + 1][2], hacc[2 * sx + 1][3]);
                bfr[sx] = __builtin_bit_cast(bf16x8, w);
                u32x2 h0; h0.x = w.x; h0.y = w.y; *(u32x2*)(H0T + ub + (size_t)(16 * cg + c16) * 64 + 16 * (2 * sx) + 4 * g4) = h0;
                u32x2 h1; h1.x = w.z; h1.y = w.w; *(u32x2*)(H0T + ub + (size_t)(16 * cg + c16) * 64 + 16 * (2 * sx + 1) + 4 * g4) = h1; }
#pragma unroll
            for (int m = 0; m < 4; ++m) { hacc[m] = MFMA16(af[m][0], bfr[0], qv[m]); hacc[m] = MFMA16(af[m][1], bfr[1], hacc[m]); }
            R2_BAR();
        }
    } else {
        for (int c = 0; c <= NCH; ++c) R2_BAR();
    }
#undef R2_BAR
}

__device__ __forceinline__ void rwkv_r3_wave(const RwkvBufs& B, const bf16* __restrict__ H0T, const float* const* in, const float* __restrict__ gv, bf16* __restrict__ ocat, int head, int chunk, int nt, int lane) {
    const int c16 = lane & 15, g4 = lane >> 4; const size_t ub = (size_t)(head * NCH + chunk) * 4096;
    const int t = chunk * 64 + 16 * nt + c16;
    bf16x8 rf[2], hf[4][2]; f32x4 y[4], gw[4], gb[4], muv[4], gg[4], v0[4], vp[4];
#pragma unroll
    for (int s = 0; s < 2; ++s) rf[s] = *(const bf16x8*)(B.Rt + ub + (size_t)(16 * nt + c16) * 64 + 32 * s + 8 * g4);
#pragma unroll
    for (int m = 0; m < 4; ++m) { y[m] = *(const f32x4*)(B.Yi + ub + (size_t)(16 * nt + c16) * 64 + 16 * m + 4 * g4);
#pragma unroll
        for (int s = 0; s < 2; ++s) hf[m][s] = *(const bf16x8*)(H0T + ub + (size_t)(16 * m + c16) * 64 + 32 * s + 8 * g4); }
    const float bn = B.bonus[(size_t)t * RH + head];
#pragma unroll
    for (int m = 0; m < 4; ++m) { const int ch = head * RN + 16 * m + 4 * g4;
        gw[m] = *(const f32x4*)(in[26] + ch); gb[m] = *(const f32x4*)(in[27] + ch); muv[m] = *(const f32x4*)(in[11] + ch); gg[m] = *(const f32x4*)(gv + (size_t)t * RW + ch);
        v0[m] = *(const f32x4*)(B.rkv + (size_t)t * (3 * RW) + 2 * RW + ch); vp[m] = (f32x4){0.f, 0.f, 0.f, 0.f}; if (t > 0) vp[m] = *(const f32x4*)(B.rkv + (size_t)(t - 1) * (3 * RW) + 2 * RW + ch); }
    float s1 = 0.f;
#pragma unroll
    for (int m = 0; m < 4; ++m) {
#pragma unroll
        for (int s = 0; s < 2; ++s) y[m] = MFMA16(hf[m][s], rf[s], y[m]);
        s1 += (y[m][0] + y[m][1]) + (y[m][2] + y[m][3]); }
    s1 += __shfl_xor(s1, 16); s1 += __shfl_xor(s1, 32);
    const float mean = s1 * (1.0f / 64.0f); float s2 = 0.f;
#pragma unroll
    for (int m = 0; m < 4; ++m) { y[m] = y[m] - mean; s2 += (y[m][0] * y[m][0] + y[m][1] * y[m][1]) + (y[m][2] * y[m][2] + y[m][3] * y[m][3]); }
    s2 += __shfl_xor(s2, 16); s2 += __shfl_xor(s2, 32);
    const float rstd = rsqrtf(s2 * (1.0f / 64.0f) + 64e-5f);
#pragma unroll
    for (int m = 0; m < 4; ++m) { const int ch = head * RN + 16 * m + 4 * g4;
        const f32x4 vx = v0[m] + (vp[m] - v0[m]) * muv[m];
        const f32x4 o = (y[m] * rstd * gw[m] + gb[m] + vx * bn) * gg[m];
        u32x2 w; w.x = pk2(o[0], o[1]); w.y = pk2(o[2], o[3]); *(u32x2*)(ocat + (size_t)t * (2 * RW) + RW + ch) = w; }
}
template <int WHICH> struct Lora2Order { static constexpr bool GATHER = false; const int* tok; int G, c;
    __device__ bool next(int i, pg8::Unit& u) const { const int L = i * G + c; if (L >= (S / 128) * 4) return false; u.pm = L >> 2; u.pn = WHICH * 4 + (L & 3); u.koff = WHICH * 512; u.koffB = 0; return true; }
    __device__ __forceinline__ void a_ready(const pg8::Unit&) const {}
    __device__ __forceinline__ void done(const pg8::Unit&) const {} };
template <int WHICH> struct EpiLora2 {
    static constexpr bool PERM = true, AFTER_DRAIN = false, MIDK = false;
    float* dst; const float* bias;
    __device__ __forceinline__ void operator()(const pg8::f32x4 (&acc)[2][2][4][2], const pg8::Unit& u, int wr, int wc, int fr, int fq) const {
        const int row0 = u.pm * 128 + wr * 64 + fr; const int col0 = (u.pn & 3) * 256 + wc * 32 + 8 * fq;
#pragma unroll
        for (int ai = 0; ai < 1; ++ai)
#pragma unroll
            for (int m = 0; m < 4; ++m) { float* p = dst + (size_t)(row0 + ai * 128 + m * 16) * RW + col0;
#pragma unroll
                for (int bj = 0; bj < 2; ++bj) { f32x4 v0 = acc[ai][bj][m][0], v1 = acc[ai][bj][m][1];
                    if (WHICH < 2) { const f32x4 b0 = *(const f32x4*)(bias + col0 + bj * 128), b1 = *(const f32x4*)(bias + col0 + bj * 128 + 4);
#pragma unroll
                        for (int j = 0; j < 4; ++j) { v0[j] = sigmoidf_(v0[j] + b0[j]); v1[j] = sigmoidf_(v1[j] + b1[j]); }
                        if (WHICH == 0) { v0 = v0 * -0.60653065971263342f; v1 = v1 * -0.60653065971263342f; } }
                    *(f32x4*)(p + bj * 128) = v0; *(f32x4*)(p + bj * 128 + 4) = v1; } }
    }
};

__global__ void __launch_bounds__(NTHR, 2) fwd(Args args) {
    extern __shared__ __attribute__((aligned(16))) unsigned char lds_raw[];
    LAS unsigned char* lds = (LAS unsigned char*)lds_raw;
    const int wave = __builtin_amdgcn_readfirstlane(threadIdx.x >> 6);
    const int G = gridDim.x, wg = blockIdx.x;
    unsigned char* ws = args.ws;
    unsigned* ctl = (unsigned*)(ws + WS_CTL);
    if (threadIdx.x < 4) ((LAS unsigned*)(lds + LDSCTL_OFF))[threadIdx.x] = 0u;
    __syncthreads();
    XcdBarrier bar = xcd_barrier_post(ctl + CW_BAR, (volatile LAS unsigned*)(lds + LDSCTL_OFF));
    const int lo = args.ph_lo, hi = args.ph_hi;
#define IN(k) (lo <= (k) && (k) < hi)
#define PH(k) for (int rep_ = 0; rep_ < ((k) == REP_PHASE ? 1 + REP_N : 1); ++rep_) if (IN(k))
#define SEAM(k) do { if (IN(k) && IN((k) + 1)) xcd_barrier(bar); } while (0)
#define ROUTE_TABLE() do { LAS int* tb_ = (LAS int*)(lds + RT_OFF); \
        if (tid < 64) { const int c_ = ((const int*)ctl)[CW_CNT + tid]; const int nt_ = (c_ + 127) >> 7; int o_ = nt_; \
            _Pragma("unroll") for (int d_ = 1; d_ < 64; d_ <<= 1) { const int t_ = __shfl_up(o_, d_); if (tid >= d_) o_ += t_; } \
            const int first_ = o_ - nt_; tb_[tid] = c_; tb_[64 + tid] = first_ * 128; \
            for (int t_ = 0; t_ < nt_; ++t_) { tb_[128 + first_ + t_] = tid; tb_[320 + first_ + t_] = t_ * 128; } \
            if (tid == 63) tb_[512] = o_; } \
        __syncthreads(); } while (0)
    const int gw = wg * NWAVES + wave, NGW = G * NWAVES;

    const float* x = args.in[0];
    float* ada = (float*)(ws + WS_ADA); float* rope = (float*)(ws + WS_ROPE);
    bf16* h = (bf16*)(ws + WS_H); bf16* W1t = (bf16*)(ws + WS_W1T); bf16* Wupt = (bf16*)(ws + WS_WUPT); bf16* Wot = (bf16*)(ws + WS_WOT);
    unsigned char* Wgut = ws + WS_WGUT; unsigned char* Wdt = ws + WS_WDT;

    PH(0) { const int lane = lane_fresh(); const int tid = (wave << 6) | lane; (void)tid; (void)lane;
        {
            const float* c = args.in[1]; const float* w_ada = args.in[2]; const float* b_ada = args.in[3];
            LAS float* red = (LAS float*)lds;
            for (int u = wg; u < 6 * D / 64; u += G) {
                const int n = u * 64 + lane; float s = 0.f;
#pragma unroll 8
                for (int kq = wave; kq < D; kq += NWAVES) s += c[kq] * w_ada[(size_t)kq * (6 * D) + n];
                red[wave * 64 + lane] = s;
                __syncthreads();
                if (wave == 0) { float t = b_ada[n]; for (int w = 0; w < NWAVES; ++w) t += red[w * 64 + lane]; ada[n] = t; }
                __syncthreads();
            }
        }
        for (int i = wg * NTHR + tid; i < S * 16; i += G * NTHR) {
            const int pos = i >> 4, j = i & 15; const float inv = powf(500000.0f, -(float)j / 16.0f); const float ang = (float)pos * inv;
            rope[2 * i] = cosf(ang); rope[2 * i + 1] = sinf(ang);
        }
        for (int i = wg * NTHR + tid; i < 128 * D / 8; i += G * NTHR) ((u32x4*)(W1t + (size_t)(N1 - 128) * D))[i] = (u32x4){0u, 0u, 0u, 0u};
        {
            bf16* wrh = (bf16*)(ws + WS_WR); bf16* wrl = wrh + 80 * D; const float* w_rg = args.in[31]; const float* w_re = args.in[33];
            for (int i = wg * NTHR + tid; i < 80 * D; i += G * NTHR) { const int n = i / D, kq = i % D; const float v = n < NG ? w_rg[kq * NG + n] : (n < NG + NE ? w_re[kq * NE + n - NG] : 0.f);
                const bf16 hi = f2bf(v); wrh[i] = hi; wrl[i] = f2bf(v - bf2f(hi)); }
        }
        {
            bf16* wl2 = (bf16*)(ws + WS_WL2); const float* w_w2 = args.in[17]; const float* w_a2 = args.in[20]; const float* w_g2 = args.in[22];
            for (int i = wg * NTHR + tid; i < 3 * RW * 256; i += G * NTHR) { const int n = i >> 8, kq = i & 255, which = n / RW, cc = n % RW; float v = 0.f;
                if (which == 0) { if (kq < LW) v = w_w2[kq * RW + cc]; } else if (which == 1) { if (kq < LA) v = w_a2[kq * RW + cc]; } else v = w_g2[kq * RW + cc];
                wl2[i] = f2bf(v); }
        }
        LAS float* scr = (LAS float*)(lds + wave * 16384);
        constexpr int I_W = (D / 64) * (LW / 32), I_A = (D / 64) * (LA / 32), I_G = (D / 64) * (LG / 32);
        constexpr int NIT = 2 * (I_W + I_A + I_G);
        for (int it = gw; it < NIT; it += NGW) {
            int r = it, k0, n0;
            if (r < 2 * I_W) { const int md = 1 + r / I_W; item_kn(r % I_W, LW, k0, n0); tr_item(args.in[16], LW, k0, n0, W1t + (size_t)(INW + (md - 1) * LO + n0) * D + k0, D, args.in[12], md, scr, lane); continue; } r -= 2 * I_W;
            if (r < 2 * I_A) { const int md = 1 + r / I_A; item_kn(r % I_A, LA, k0, n0); tr_item(args.in[19], LA, k0, n0, W1t + (size_t)(INW + (md - 1) * LO + LW + n0) * D + k0, D, args.in[13], md, scr, lane); continue; } r -= 2 * I_A;
            const int md = 1 + r / I_G; item_kn(r % I_G, LG, k0, n0); tr_item(args.in[21], LG, k0, n0, W1t + (size_t)(INW + (md - 1) * LO + LW + LA + n0) * D + k0, D, args.in[14], md, scr, lane);
        }
        __syncthreads();
        {
            const int lr = tid >> 5, c4 = tid & 31, nl = lane & 15, kq = lane >> 4, ncol = 16 * wave + nl;
            f32x4 v[8]; int T = wg;
            if (T < CT_ALL) { const ConvTile t = conv_decode(T, args.in, ws);
#pragma unroll
                for (int i = 0; i < 8; ++i) v[i] = *(const f32x4*)(t.src + (size_t)(lr + 16 * i) * t.ldw + 4 * c4); }
            for (int itc = 0; T < CT_ALL; T += G, ++itc) {
                LAS float* buf = (LAS float*)(lds + (itc & 1) * 69632);
#pragma unroll
                for (int i = 0; i < 8; ++i) *(LAS f32x4*)(buf + conv_off(lr + 16 * i, 4 * c4)) = v[i];
                const ConvTile t = conv_decode(T, args.in, ws);
                if (T + G < CT_ALL) { const ConvTile tn = conv_decode(T + G, args.in, ws);
#pragma unroll
                    for (int i = 0; i < 8; ++i) v[i] = *(const f32x4*)(tn.src + (size_t)(lr + 16 * i) * tn.ldw + 4 * c4); }
                R1_BAR();
                float xv[32];
#pragma unroll
                for (int j = 0; j < 32; ++j) xv[j] = buf[conv_off(32 * kq + j, ncol)];
                if (t.kind) { unsigned char* d = t.dst + (size_t)ncol * t.rs + 32 * kq;
                    u32x4 o0, o1; o0.x = pk_fp8x4(xv[0], xv[1], xv[2], xv[3], t.sc); o0.y = pk_fp8x4(xv[4], xv[5], xv[6], xv[7], t.sc); o0.z = pk_fp8x4(xv[8], xv[9], xv[10], xv[11], t.sc); o0.w = pk_fp8x4(xv[12], xv[13], xv[14], xv[15], t.sc);
                    o1.x = pk_fp8x4(xv[16], xv[17], xv[18], xv[19], t.sc); o1.y = pk_fp8x4(xv[20], xv[21], xv[22], xv[23], t.sc); o1.z = pk_fp8x4(xv[24], xv[25], xv[26], xv[27], t.sc); o1.w = pk_fp8x4(xv[28], xv[29], xv[30], xv[31], t.sc);
                    *(u32x4*)d = o0; *(u32x4*)(d + 16) = o1; }
                else { unsigned char* d = t.dst + (size_t)ncol * t.rs + 64 * kq;
#pragma unroll
                    for (int q = 0; q < 4; ++q) { u32x4 o; o.x = pk2(xv[8 * q], xv[8 * q + 1]); o.y = pk2(xv[8 * q + 2], xv[8 * q + 3]); o.z = pk2(xv[8 * q + 4], xv[8 * q + 5]); o.w = pk2(xv[8 * q + 6], xv[8 * q + 7]); *(u32x4*)(d + 16 * q) = o; } }
            }
            __syncthreads();
        }
    }
    SEAM(0);
    PH(1) { const int lane = lane_fresh(); const int tid = (wave << 6) | lane; (void)tid; (void)lane;
        const float* g = args.in[4]; const float* sh1 = ada; const float* sc1 = ada + D;
        f32x4 gs[8], sh[8];
#pragma unroll
        for (int j = 0; j < 8; ++j) { const int c = 4 * lane + 256 * j; const f32x4 gg = *(const f32x4*)(g + c), ss = *(const f32x4*)(sc1 + c); gs[j] = gg * (ss + 1.0f); sh[j] = *(const f32x4*)(sh1 + c); }
        for (int rb = gw; rb < S; rb += 2 * NGW) {
            f32x4 v[2][8]; float s[2] = {0.f, 0.f};
#pragma unroll
            for (int q = 0; q < 2; ++q) { const f32x4* xr = (const f32x4*)(x + (size_t)(rb + q * NGW) * D) + lane;
#pragma unroll
                for (int j = 0; j < 8; ++j) v[q][j] = xr[64 * j]; }
#pragma unroll
            for (int q = 0; q < 2; ++q)
#pragma unroll
                for (int j = 0; j < 8; ++j) s[q] += (v[q][j].x * v[q][j].x + v[q][j].y * v[q][j].y) + (v[q][j].z * v[q][j].z + v[q][j].w * v[q][j].w);
            float r[2]; r[0] = rsqrtf(wave_sum(s[0]) * (1.0f / D) + 1e-6f); r[1] = rsqrtf(wave_sum(s[1]) * (1.0f / D) + 1e-6f);
#pragma unroll
            for (int q = 0; q < 2; ++q) { u32x2* o = (u32x2*)(h + (size_t)(rb + q * NGW) * D) + lane;
#pragma unroll
                for (int j = 0; j < 8; ++j) { const f32x4 t = v[q][j] * r[q] * gs[j] + sh[j]; u32x2 w; w.x = pk2(t.x, t.y); w.y = pk2(t.z, t.w); o[64 * j] = w; } }
        }
    }
    SEAM(1);
    PH(2) { const int lane = lane_fresh(); const int tid = (wave << 6) | lane; (void)tid; (void)lane;
        EpiProj E{(bf16*)(ws + WS_Q), (bf16*)(ws + WS_K), (bf16*)(ws + WS_V), (float*)(ws + WS_RKV), (bf16*)(ws + WS_GATE), (float*)(ws + WS_LORA), (float*)(ws + WS_LORAB), rope};
        { pg8::Gemm g{h, W1t, S, INW, D, D, D}; pg8::StaticOrder So; So.init(S, INW, G, wg);
          pg8::gemm_phase<EpiProj, pg8::StaticOrder, true, true>(lds, g, So, E); }
        { int ld_ = D; asm volatile("" : "+s"(ld_)); pg8::Gemm g{h, W1t, S, N1, AW, ld_, ld_}; LoraOrder So{nullptr, G, wg};
          pg8::gemm_phase<EpiProj, LoraOrder, true, true>(lds, g, So, E); }
    }
    SEAM(2);

    bf16* qb = (bf16*)(ws + WS_Q); bf16* kb = (bf16*)(ws + WS_K); bf16* vb = (bf16*)(ws + WS_V);
    bf16* kmh = (bf16*)(ws + WS_KMEAN); bf16* kml = kmh + AH * NB * AD;
    AttnBufs AB{qb, kb, vb, kmh, kml, (unsigned*)(ws + WS_AMASK), (int*)(ws + WS_ALIST), (int*)ctl + CW_ACNT, (bf16*)(ws + WS_APART), (float*)(ws + WS_AML)};
    PH(3) { const int lane = lane_fresh(); const int tid = (wave << 6) | lane; (void)tid; (void)lane;
        for (int hb = wg; hb < AH * NB; hb += G) { const int hd = hb / NB, bk = hb % NB; LAS float* red = (LAS float*)lds;
            float s0 = 0.f, s1 = 0.f; const unsigned* src = (const unsigned*)(kb + (size_t)(bk * MB + wave * 32) * AW + hd * AD) + lane;
#pragma unroll 8
            for (int r = 0; r < 32; ++r) { const unsigned w2 = src[(size_t)r * (AW / 2)]; s0 += __uint_as_float(w2 << 16); s1 += __uint_as_float(w2 & 0xffff0000u); }
            red[wave * 128 + 2 * lane] = s0; red[wave * 128 + 2 * lane + 1] = s1;
            __syncthreads();
            if (tid < AD) { float s = 0.f;
#pragma unroll
                for (int w = 0; w < 8; ++w) s += red[w * 128 + tid];
                s *= (1.0f / MB); const bf16 hi = f2bf(s); kmh[hb * AD + tid] = hi; kml[hb * AD + tid] = f2bf(s - bf2f(hi)); }
            __syncthreads();
        }
        {
            const float* lora = (const float*)(ws + WS_LORA); bf16* al2 = (bf16*)(ws + WS_AL2);
#pragma unroll 4
            for (int i = wg * NTHR + tid; i < S * 768; i += G * NTHR) { const int t = i / 768, j = i % 768, which = j >> 8, jj = j & 255; float v = 0.f;
                const int src = which == 0 ? jj : (which == 1 ? LW + jj : LW + LA + jj); const bool real = which == 2 || jj < LW;
                if (real) { const float* lb = (const float*)(ws + WS_LORAB); v = lora[(size_t)t * 1024 + src] + lb[(size_t)t * 1024 + src] + (t > 0 ? lora[(size_t)(t - 1) * 1024 + LO + src] + lb[(size_t)(t - 1) * 1024 + LO + src] : 0.f); if (which == 0) v = 1.0f - 2.0f / (1.0f + __expf(2.0f * v)); else if (which == 2) v = sigmoidf_(v); }
                al2[i] = f2bf(v); }
        }
    }
    SEAM(3);
    PH(4) { const int lane = lane_fresh(); const int tid = (wave << 6) | lane; (void)tid; (void)lane;
#define L2CALL(W, DST, BIAS, CID) { int lda_ = 768; asm volatile("" : "+s"(lda_)); pg8::Gemm g{(const bf16*)(ws + WS_AL2), (const bf16*)(ws + WS_WL2), S, 3 * RW, 256, lda_, 256}; \
            Lora2Order<W> So{nullptr, G, CID}; EpiLora2<W> E{DST, BIAS}; pg8::gemm_phase<EpiLora2<W>, Lora2Order<W>, true, true, 0, true>(lds, g, So, E); }
        L2CALL(0, (float*)(ws + WS_LW), args.in[15], wg)
        L2CALL(1, (float*)(ws + WS_A), args.in[18], wg)
        L2CALL(2, (float*)(ws + WS_G), nullptr, wg)
#undef L2CALL
        for (int u = wg; u < AH * 64; u += G) moba_select_unit(lds, AB, u >> 6, u & 63, tid, lane, wave);
    }
    SEAM(4);
    RwkvBufs RB{(const float*)(ws + WS_RKV), (const float*)(ws + WS_LW), (const float*)(ws + WS_A), (bf16*)(ws + WS_RWP), (float*)(ws + WS_RWQ), (bf16*)(ws + WS_RWR), (float*)(ws + WS_RWY), (float*)(ws + WS_RWB)};
    bf16* H0T = (bf16*)(ws + WS_RWH);
    PH(5) { const int lane = lane_fresh(); const int tid = (wave << 6) | lane; (void)tid; (void)lane; R1In I; if (wg < RH * NCH) rwkv_r1_load(I, RB, wg / NCH, wg % NCH, lane, wave);
        for (int u = wg; u < RH * NCH; u += G) { const int un = u + G; rwkv_r1_unit(lds, RB, args.in, I, u / NCH, u % NCH, un < RH * NCH ? un / NCH : -1, un % NCH, tid, lane, wave); } }
    SEAM(5);
    PH(7) { const int lane = lane_fresh(); const int tid = (wave << 6) | lane; (void)tid; (void)lane;
        if (wg < RH * 4) { for (int rsc = 0; rsc < 1 + REP_SCAN; ++rsc) { rwkv_r2_wg(lds, RB.P, RB.QmT, H0T, wg >> 2, wg & 3, wave, lane); __syncthreads(); } }
        LAS int* pre = (LAS int*)(lds + AT_ITEMS); LAS int* tick = pre + 260;
        if (tid < 256) pre[1 + tid] = (AB.cnt[tid] + 255) >> 8;
        __syncthreads();
        if (wave == 0) {
            int v0 = pre[1 + 4 * lane], v1 = pre[2 + 4 * lane], v2 = pre[3 + 4 * lane], v3 = pre[4 + 4 * lane]; v1 += v0; v2 += v1; v3 += v2; int tot = v3;
#pragma unroll
            for (int o = 1; o < 64; o <<= 1) { const int t = __shfl_up(tot, o); if (lane >= o) tot += t; }
            const int ex = tot - v3; pre[1 + 4 * lane] = ex + v0; pre[2 + 4 * lane] = ex + v1; pre[3 + 4 * lane] = ex + v2; pre[4 + 4 * lane] = ex + v3;
            if (lane == 0) pre[0] = 0; }
        __syncthreads();
        moba_items(lds, AB, (int*)ctl + CW_AQ + rep_, pre, tick, tid, lane, wave);
    }
    SEAM(7);
    PH(8) { const int lane = lane_fresh(); const int tid = (wave << 6) | lane; (void)tid; (void)lane; for (int u = wg * 2 + (wave >> 2); u < RH * NCH; u += 2 * G) rwkv_r3_wave(RB, H0T, args.in, (const float*)(ws + WS_G), (bf16*)(ws + WS_OCAT), u / NCH, u % NCH, wave & 3, lane);
#pragma unroll 2
        for (int i = wg * NTHR + tid; i < AH * S * 16; i += G * NTHR) { const int c8 = i & 15, hq = i >> 4, hh = hq / S, qq = hq % S;
            const unsigned mk = AB.mask[hq]; const f32x4 ml0 = *(const f32x4*)(AB.ml + (size_t)hq * 8), ml1 = *(const f32x4*)(AB.ml + (size_t)hq * 8 + 4);
            u32x4 pr[4];
#pragma unroll
            for (int s = 0; s < 4; ++s) pr[s] = *(const u32x4*)(AB.part + ((size_t)hq * 4 + s) * AD + 8 * c8);
            const int ns = 1 + __builtin_popcount(mk);
            const float m_[4] = {ml0[0], ml0[2], ml1[0], ml1[2]}, l_[4] = {ml0[1], ml0[3], ml1[1], ml1[3]};
            float mx = m_[0];
#pragma unroll
            for (int s = 1; s < 4; ++s) mx = (s < ns) ? fmaxf(mx, m_[s]) : mx;
            float wv[4]; float wsum = 0.f;
#pragma unroll
            for (int s = 0; s < 4; ++s) { wv[s] = s < ns ? l_[s] * __builtin_amdgcn_exp2f(m_[s] - mx) : 0.f; wsum += wv[s]; }
            const float inv = 1.0f / wsum; float o[8] = {0.f, 0.f, 0.f, 0.f, 0.f, 0.f, 0.f, 0.f};
#pragma unroll
            for (int s = 0; s < 4; ++s) { float pv[8]; unpack8(pr[s], pv); const float ws_ = wv[s] * inv;
#pragma unroll
                for (int j = 0; j < 8; ++j) o[j] += (s < ns) ? ws_ * pv[j] : 0.f; }
            u32x4 w; w.x = pk2(o[0], o[1]); w.y = pk2(o[2], o[3]); w.z = pk2(o[4], o[5]); w.w = pk2(o[6], o[7]);
            *(u32x4*)((bf16*)(ws + WS_OCAT) + (size_t)qq * (2 * AW) + hh * AD + 8 * c8) = w; }
    }
    SEAM(8);

    bf16* ocat = (bf16*)(ws + WS_OCAT); bf16* gate = (bf16*)(ws + WS_GATE); bf16* mix = (bf16*)(ws + WS_MIX); bf16* y = (bf16*)(ws + WS_Y); bf16* x1 = (bf16*)(ws + WS_X1);     unsigned char* h2 = ws + WS_H2;
    float* ew = (float*)(ws + WS_ROUTE + 65536); int* slot = (int*)(ws + WS_ROUTE + 131072);
    int* elist = (int*)(ws + WS_ELIST);
    unsigned char* xbuf = ws + WS_XBUF; unsigned char* hid = ws + WS_HID; bf16* ybuf = (bf16*)(ws + WS_YBUF);
    PH(9) { const int lane = lane_fresh(); const int tid = (wave << 6) | lane; (void)tid; (void)lane;
        pg8::Gemm g{ocat, Wupt, S, D, AW, D, D}; MixOrder So{nullptr, G, wg};
        EpiMix E{gate, mix};
        pg8::gemm_phase<EpiMix, MixOrder, true, true>(lds, g, So, E);
    }
    SEAM(9);
    PH(10) { const int lane = lane_fresh(); const int tid = (wave << 6) | lane; (void)tid; (void)lane;
        pg8::Gemm g{mix, Wot, S, D, D, D, D}; pg8::StaticOrder So; So.init(S, D, G, wg);
        EpiBf16P E{y, D};
        pg8::gemm_phase<EpiBf16P, pg8::StaticOrder, true, true>(lds, g, So, E);
    }
    SEAM(10);
    PH(11) { const int lane = lane_fresh(); const int tid = (wave << 6) | lane; (void)tid; (void)lane;
        const float* gpost = args.in[5]; const float* gpre2 = args.in[6]; const float* gt1 = ada + 2 * D; const float* sh2 = ada + 3 * D; const float* sc2 = ada + 4 * D;
        const bf16* wrh = (const bf16*)(ws + WS_WR); const bf16* wrl = wrh + 80 * D; const float* b_rg = args.in[32]; const float* b_re = args.in[34];
        LAS bf16* Ah = (LAS bf16*)lds; LAS bf16* Al = Ah + 16 * RS8; LAS float* Pp = (LAS float*)lds;
        LAS float* Lg = (LAS float*)(lds + 8 * 16 * 80 * 4);
        for (int unit = wg; unit < S / 16; unit += G) {
            {
                const int rl0 = wave * 2, row0 = unit * 16 + rl0;
                f32x4 v[2][8], xv[2][8]; float s[2] = {0.f, 0.f};
#pragma unroll
                for (int rr = 0; rr < 2; ++rr) { const u32x2* yr = (const u32x2*)(y + (size_t)(row0 + rr) * D) + lane; const f32x4* xr = (const f32x4*)(x + (size_t)(row0 + rr) * D) + lane;
#pragma unroll
                    for (int j = 0; j < 8; ++j) { const u32x2 yb = yr[64 * j]; v[rr][j] = (f32x4){__uint_as_float(yb.x << 16), __uint_as_float(yb.x & 0xffff0000u), __uint_as_float(yb.y << 16), __uint_as_float(yb.y & 0xffff0000u)}; xv[rr][j] = xr[64 * j]; } }
#pragma unroll
                for (int rr = 0; rr < 2; ++rr)
#pragma unroll
                    for (int j = 0; j < 8; ++j) s[rr] += (v[rr][j].x * v[rr][j].x + v[rr][j].y * v[rr][j].y) + (v[rr][j].z * v[rr][j].z + v[rr][j].w * v[rr][j].w);
                float r1[2]; r1[0] = rsqrtf(wave_sum(s[0]) * (1.0f / D) + 1e-6f); r1[1] = rsqrtf(wave_sum(s[1]) * (1.0f / D) + 1e-6f); s[0] = 0.f; s[1] = 0.f;
#pragma unroll
                for (int rr = 0; rr < 2; ++rr)
#pragma unroll
                    for (int j = 0; j < 8; ++j) { const int c = 4 * lane + 256 * j; const f32x4 t = xv[rr][j] + *(const f32x4*)(gt1 + c) * *(const f32x4*)(gpost + c) * (v[rr][j] * r1[rr]); v[rr][j] = t;
                        { u32x2 xb; xb.x = pk2(t.x, t.y); xb.y = pk2(t.z, t.w); ((u32x2*)(x1 + (size_t)(row0 + rr) * D))[lane + 64 * j] = xb; } s[rr] += (t.x * t.x + t.y * t.y) + (t.z * t.z + t.w * t.w); }
                float r2[2]; r2[0] = rsqrtf(wave_sum(s[0]) * (1.0f / D) + 1e-6f); r2[1] = rsqrtf(wave_sum(s[1]) * (1.0f / D) + 1e-6f);
#pragma unroll
                for (int rr = 0; rr < 2; ++rr)
#pragma unroll
                    for (int j = 0; j < 8; ++j) { const int c = 4 * lane + 256 * j; const f32x4 t = v[rr][j] * r2[rr] * (*(const f32x4*)(gpre2 + c) * (*(const f32x4*)(sc2 + c) + 1.0f)) + *(const f32x4*)(sh2 + c);
                        u32x2 wh; wh.x = pk2(t.x, t.y); wh.y = pk2(t.z, t.w);
                        u32x2 wl; wl.x = pk2(t.x - __uint_as_float(wh.x << 16), t.y - __uint_as_float(wh.x & 0xffff0000u)); wl.y = pk2(t.z - __uint_as_float(wh.y << 16), t.w - __uint_as_float(wh.y & 0xffff0000u));
                        ((unsigned*)(h2 + (size_t)(row0 + rr) * D))[lane + 64 * j] = pk_fp8x4(t.x, t.y, t.z, t.w, 8.0f);
                        *(LAS u32x2*)(Ah + (rl0 + rr) * RS8 + c) = wh; *(LAS u32x2*)(Al + (rl0 + rr) * RS8 + c) = wl; }
            }
            R1_BAR();
            f32x4 acc[5];
#pragma unroll
            for (int nt = 0; nt < 5; ++nt) acc[nt] = (f32x4){0.f, 0.f, 0.f, 0.f};
            for (int rmf = 0; rmf < 1 + REP_P11B; ++rmf) {
#pragma unroll
            for (int nt = 0; nt < 5; ++nt) acc[nt] = (f32x4){0.f, 0.f, 0.f, 0.f};
#pragma unroll 2
            for (int ks = 0; ks < 8; ++ks) {
                const int k0 = 256 * wave + 32 * ks + 8 * (lane >> 4);
                const bf16x8 ah = *(const LAS bf16x8*)(Ah + (lane & 15) * RS8 + k0), al = *(const LAS bf16x8*)(Al + (lane & 15) * RS8 + k0);
#pragma unroll
                for (int nt = 0; nt < 5; ++nt) { const bf16x8 bh = *(const bf16x8*)(wrh + (size_t)(16 * nt + (lane & 15)) * D + k0), bl = *(const bf16x8*)(wrl + (size_t)(16 * nt + (lane & 15)) * D + k0);
                    acc[nt] = __builtin_amdgcn_mfma_f32_16x16x32_bf16(ah, bh, acc[nt], 0, 0, 0);
                    acc[nt] = __builtin_amdgcn_mfma_f32_16x16x32_bf16(al, bh, acc[nt], 0, 0, 0);
                    acc[nt] = __builtin_amdgcn_mfma_f32_16x16x32_bf16(ah, bl, acc[nt], 0, 0, 0); }
            }
            }
            R1_BAR();
#pragma unroll
            for (int nt = 0; nt < 5; ++nt)
#pragma unroll
                for (int rg = 0; rg < 4; ++rg) Pp[(wave * 16 + 4 * (lane >> 4) + rg) * 80 + 16 * nt + (lane & 15)] = acc[nt][rg];
            R1_BAR();
            for (int i = tid; i < 16 * 72; i += NTHR) { const int r = i / 72, c = i % 72; float t = c < NG ? b_rg[c] : b_re[c - NG];
#pragma unroll
                for (int w = 0; w < 8; ++w) t += Pp[(w * 16 + r) * 80 + c];
                Lg[r * 72 + c] = t; }
            R1_BAR();
            if (tid < 16) {
                const LAS float* lg = Lg + tid * 72; const int row = unit * 16 + tid;
                float mx = lg[0]; int gi = 0; for (int j = 1; j < 8; ++j) if (lg[j] > mx) { mx = lg[j]; gi = j; }
                float sg = 0.f; for (int j = 0; j < 8; ++j) sg += __expf(lg[j] - mx);
                const float pg = 1.0f / sg;
                const LAS float* le = lg + 8 + gi * EPG;
                float m1 = le[0]; int i1 = 0; for (int j = 1; j < 8; ++j) if (le[j] > m1) { m1 = le[j]; i1 = j; }
                float m2 = -3e38f; int i2 = 0; for (int j = 0; j < 8; ++j) if (j != i1 && le[j] > m2) { m2 = le[j]; i2 = j; }
                const float e2 = __expf(m2 - m1); const float p1 = 1.0f / (1.0f + e2), p2 = e2 / (1.0f + e2);
                const int e1g = gi * EPG + i1, e2g = gi * EPG + i2;
                ew[row * 2] = pg * p1; ew[row * 2 + 1] = pg * p2;
                if (rep_ == 0) {
                    const int q1 = atomicAdd((int*)ctl + CW_CNT + e1g, 1), q2 = atomicAdd((int*)ctl + CW_CNT + e2g, 1);
                    elist[e1g * S + q1] = row; elist[e2g * S + q2] = row; slot[row * 2] = (e1g << 16) | q1; slot[row * 2 + 1] = (e2g << 16) | q2; }
            }
            R1_BAR();
        }
    }
    SEAM(11);
    PH(13) { const int lane = lane_fresh(); const int tid = (wave << 6) | lane; (void)tid; (void)lane;
        ROUTE_TABLE();
        pg8::Gemm g{(const bf16*)h2, (const bf16*)Wgut, MAXROWS, NE * 1024, D / 2, D / 2, D / 2}; ExpertOrderT<true> So{elist, (LAS const int*)(lds + RT_OFF), 4, G, wg};
        EpiHid E{hid};
        pg8::gemm_phase<EpiHid, ExpertOrderT<true>, true, true, (124 << 8) | 119, true>(lds, g, So, E);
    }
    SEAM(13);
    PH(14) { const int lane = lane_fresh(); const int tid = (wave << 6) | lane; (void)tid; (void)lane;
        if (args.ph_lo == 14) ROUTE_TABLE();
        pg8::Gemm g{(const bf16*)hid, (const bf16*)Wdt, MAXROWS, NE * D, FF / 2, FF / 2, FF / 2}; ExpertOrderT<false> So{nullptr, (LAS const int*)(lds + RT_OFF), 8, G, wg};
        EpiYbuf E{ybuf};
        pg8::gemm_phase<EpiYbuf, ExpertOrderT<false>, true, true, (124 << 8) | 120, true>(lds, g, So, E);
    }
    SEAM(14);
    PH(15) { const int lane = lane_fresh(); const int tid = (wave << 6) | lane; (void)tid; (void)lane;
        const float* gpost2 = args.in[7]; const float* gt2 = ada + 5 * D; float* out = args.out;
        if (args.ph_lo == 15) ROUTE_TABLE();
        LAS const int* tb = (LAS const int*)(lds + RT_OFF);
        for (int rb = gw; rb < S; rb += 2 * NGW) {
            int s0[2], s1[2]; float w0[2], w1[2]; const int rows[2] = {rb, rb + NGW};
#pragma unroll
            for (int q = 0; q < 2; ++q) { const int row = rows[q] < S ? rows[q] : rb; const int v0 = slot[row * 2], v1 = slot[row * 2 + 1]; s0[q] = tb[64 + (v0 >> 16)] + (v0 & 0xffff); s1[q] = tb[64 + (v1 >> 16)] + (v1 & 0xffff); w0[q] = ew[row * 2]; w1[q] = ew[row * 2 + 1]; }
            u32x2 xb[2][8];
#pragma unroll
            for (int q = 0; q < 2; ++q) { const int row = rows[q] < S ? rows[q] : rb;
#pragma unroll
                for (int j = 0; j < 8; ++j) xb[q][j] = ((const u32x2*)(x1 + (size_t)row * D))[lane + 64 * j]; }
            f32x4 v[2][8]; float s[2] = {0.f, 0.f};
#pragma unroll
            for (int q = 0; q < 2; ++q) { const u32x2* y0 = (const u32x2*)(ybuf + (size_t)s0[q] * D) + lane; const u32x2* y1 = (const u32x2*)(ybuf + (size_t)s1[q] * D) + lane;
#pragma unroll
                for (int j = 0; j < 8; ++j) { const u32x2 a = y0[64 * j], b = y1[64 * j];
                    v[q][j].x = w0[q] * __uint_as_float(a.x << 16) + w1[q] * __uint_as_float(b.x << 16); v[q][j].y = w0[q] * __uint_as_float(a.x & 0xffff0000u) + w1[q] * __uint_as_float(b.x & 0xffff0000u);
                    v[q][j].z = w0[q] * __uint_as_float(a.y << 16) + w1[q] * __uint_as_float(b.y << 16); v[q][j].w = w0[q] * __uint_as_float(a.y & 0xffff0000u) + w1[q] * __uint_as_float(b.y & 0xffff0000u);
                    s[q] += (v[q][j].x * v[q][j].x + v[q][j].y * v[q][j].y) + (v[q][j].z * v[q][j].z + v[q][j].w * v[q][j].w); } }
            float r[2]; r[0] = rsqrtf(wave_sum(s[0]) * (1.0f / D) + 1e-6f); r[1] = rsqrtf(wave_sum(s[1]) * (1.0f / D) + 1e-6f);
#pragma unroll
            for (int q = 0; q < 2; ++q) if (rows[q] < S) {
#pragma unroll
                for (int j = 0; j < 8; ++j) { const int c = 4 * lane + 256 * j; const u32x2 xx = xb[q][j];
                    const f32x4 xf = (f32x4){__uint_as_float(xx.x << 16), __uint_as_float(xx.x & 0xffff0000u), __uint_as_float(xx.y << 16), __uint_as_float(xx.y & 0xffff0000u)};
                    ((f32x4*)(out + (size_t)rows[q] * D))[lane + 64 * j] = xf + *(const f32x4*)(gt2 + c) * (v[q][j] * r[q] * *(const f32x4*)(gpost2 + c)); } }
        }
    }
#undef IN
#undef SEAM
}
extern "C" void kernel_launch(void* const* d_in, const int* in_sizes, int n_in, void* d_out, int out_size, void* d_ws, size_t ws_size, hipStream_t stream) {
    static int grid = 0;
    if (grid == 0) {
        if (ws_size < WS_END || n_in != 38) { fprintf(stderr, "kernel_launch: unexpected workspace/inputs: %zu < %zu or n_in %d\n", ws_size, (size_t)WS_END, n_in); grid = -1; return; }
        int dev = 0, cus = 0;
        if (hipGetDevice(&dev) != hipSuccess || hipDeviceGetAttribute(&cus, hipDeviceAttributeMultiprocessorCount, dev) != hipSuccess) { fprintf(stderr, "device query failed\n"); grid = -1; return; }
        if (hipFuncSetAttribute((const void*)fwd, hipFuncAttributeMaxDynamicSharedMemorySize, LDS_BYTES) != hipSuccess) { fprintf(stderr, "hipFuncSetAttribute failed\n"); grid = -1; return; }
        grid = cus;
    }
    if (grid < 0) return;
    (void)hipMemsetAsync((char*)d_ws + WS_CTL, 0, 1 * MiB, stream);
    Args a{};
    for (int i = 0; i < 38; ++i) a.in[i] = (const float*)d_in[i];
    a.out = (float*)d_out; a.ws = (unsigned char*)d_ws;
#if N_LAUNCH_PER_PHASE
    for (int ph = 0; ph < 16; ++ph) { a.ph_lo = ph; a.ph_hi = ph + 1; hipLaunchKernelGGL(fwd, dim3(grid), dim3(NTHR), LDS_BYTES, stream, a); }
#else
    a.ph_lo = 0; a.ph_hi = 16; hipLaunchKernelGGL(fwd, dim3(grid), dim3(NTHR), LDS_BYTES, stream, a);
#endif
}
```

```cpp
#include <hip/hip_runtime.h>
#include <cstdio>
#include <cstdint>

typedef unsigned short bf16;
__device__ __forceinline__ float bf2f(bf16 b) { return __uint_as_float(((unsigned)b) << 16); }
__device__ __forceinline__ bf16 f2bf(float f) { unsigned u = __float_as_uint(f); u += 0x7fffu + ((u >> 16) & 1u); return (bf16)(u >> 16); }
__device__ __forceinline__ float sigmoidf_(float x) { return __builtin_amdgcn_rcpf(1.0f + __expf(-x)); }

#ifndef N_LAUNCH_PER_PHASE
#define N_LAUNCH_PER_PHASE 0
#endif
#ifndef REP_PHASE
#define REP_PHASE -1
#define REP_N 0
#endif
#ifndef REP_SCAN
#define REP_SCAN 0
#endif
#ifndef REP_P11A
#define REP_P11A 0
#endif
#ifndef REP_P11B
#define REP_P11B 0
#endif
#ifndef REP_R1A
#define REP_R1A 0
#define REP_R1B 0
#define REP_R1C 0
#endif
#ifndef REP_R1NR
#define REP_R1NR 0
#endif
#ifndef REP_R1S0
#define REP_R1S0 0
#endif
constexpr int S = 8192, D = 2048;
constexpr int AH = 8, AD = 128, AW = 1024, MB = 256, NB = S / MB;
constexpr int RH = 16, RN = 64, RW = 1024;
constexpr int LW = 96, LA = 96, LG = 256, LO = LW + LA + LG;
constexpr int INW = 3 * AW + 3 * RW + 2 * D;
constexpr int NE = 64, NG = 8, EPG = 8, FF = 512;
constexpr int MAXROWS = 32768;
constexpr int MAXTILES = MAXROWS / 256;

constexpr size_t MiB = 1u << 20;
constexpr size_t WS_CTL   = 0;
constexpr size_t WS_ADA   = 1 * MiB;
constexpr size_t WS_ROPE  = 2 * MiB;
constexpr size_t WS_KMEAN = 3 * MiB;
constexpr size_t WS_WL2   = 3 * MiB + 256 * 1024;
constexpr size_t WS_ROUTE = 5 * MiB;
constexpr size_t WS_TOK   = 6 * MiB;
constexpr size_t WS_WR    = 7 * MiB;
constexpr size_t WS_H     = 8 * MiB;
constexpr size_t WS_Q     = 40 * MiB;
constexpr size_t WS_K     = 56 * MiB;
constexpr size_t WS_V     = 72 * MiB;
constexpr size_t WS_RKV   = 88 * MiB;
constexpr size_t WS_GATE  = 184 * MiB;
constexpr size_t WS_LORA  = 248 * MiB;
constexpr size_t WS_LORAB = 424 * MiB;
constexpr size_t WS_AL2   = 280 * MiB;
constexpr size_t WS_LW    = 296 * MiB;
constexpr size_t WS_A     = 328 * MiB;
constexpr size_t WS_G     = 360 * MiB;
constexpr size_t WS_OCAT  = 392 * MiB;
constexpr size_t WS_MIX   = 424 * MiB;
constexpr size_t WS_Y     = 456 * MiB;
constexpr size_t WS_X1    = 520 * MiB;
constexpr size_t WS_H2    = 584 * MiB;
constexpr size_t WS_WUPT  = 616 * MiB;
constexpr size_t WS_WOT   = 624 * MiB;
constexpr size_t WS_WGUT  = 632 * MiB;
constexpr size_t WS_WDT   = 888 * MiB;
constexpr size_t WS_END   = 1016 * MiB;
constexpr size_t WS_W1T   = WS_Y;
constexpr size_t WS_ELIST = 16 * MiB;
constexpr size_t WS_XBUF  = WS_H;
constexpr size_t WS_HID   = 136 * MiB;
constexpr size_t WS_YBUF  = 168 * MiB;
constexpr size_t WS_ALIST = 8 * MiB, WS_AMASK = 12 * MiB, WS_AML = 13 * MiB, WS_APART = 248 * MiB;
constexpr size_t WS_RWP = 456 * MiB, WS_RWQ = 472 * MiB, WS_RWR = 504 * MiB, WS_RWY = 520 * MiB, WS_RWH = 552 * MiB, WS_RWB = 568 * MiB;
constexpr size_t WS_NR = WS_MIX, WS_NW = WS_NR + 32 * MiB, WS_NKT = WS_NR + 64 * MiB, WS_NV = WS_NR + 96 * MiB, WS_NKK = WS_NR + 128 * MiB, WS_NY = WS_NR + 160 * MiB;
constexpr size_t WS_MIXTMP = WS_Y;
constexpr size_t WS_GTMP = WS_Y;

constexpr int CW_CNT = 1024;
constexpr int CW_FILL = 1152;
constexpr int CW_OFF = 1280;
constexpr int CW_ADA = 1408;
constexpr int CW_ACNT = 1536;
constexpr int CW_AQ = 1920;

namespace pg8 {
#define PG8_LAS __attribute__((address_space(3)))
typedef unsigned short bf16_t;
typedef short bf16x8 __attribute__((ext_vector_type(8)));
typedef float f32x4 __attribute__((ext_vector_type(4)));
typedef unsigned u32x4 __attribute__((ext_vector_type(4)));
typedef int i32x8_t __attribute__((ext_vector_type(8)));
template <bool IS8> struct FragSel { typedef bf16x8 T; static constexpr int NK = 2; };
template <> struct FragSel<true> { typedef i32x8_t T; static constexpr int NK = 1; };
template <int F8> struct FragT : FragSel<(F8 != 0)> {};
constexpr int BM = 256, BK = 64, HALF = 128, HTB = HALF * BK * 2  , STAGE_BYTES = 8 * HTB, NXCD = 8, WGM = 8;

__host__ __device__ __forceinline__ int lds_byte(int r, int c) { const int st = (r >> 4) * 2 + (c >> 5), rr = r & 15, cc = c & 31, ob = rr * 64 + cc * 2; return st * 1024 + (ob ^ (((ob >> 9) & 1) << 5)); }
__host__ __device__ __forceinline__ void stage_rc(int b, int& R, int& C) { const int st = b / 1024, sb = b % 1024, swz = sb ^ (((sb >> 9) & 1) << 5); R = (st >> 1) * 16 + swz / 64; C = (st & 1) * 32 + (swz % 64) / 2; }
__host__ __device__ __forceinline__ int perm32(int rho) { const int n = rho >> 4, i = rho & 15; return 8 * (i >> 2) + 4 * n + (i & 3); }

struct Unit { int pm, pn, koff, koffB; };
struct Gemm { const bf16_t* A; const bf16_t* Bt; int M, N, K, lda, ldb; };

struct StaticOrder {
    static constexpr bool GATHER = false; const int* tok = nullptr;
    int nM, nN, nwg, G, c;
    __host__ __device__ void init(int M, int N, int G_, int c_) { nM = M / BM; nN = N / BM; nwg = nM * nN; G = G_; c = c_; }
    __host__ __device__ bool next(int i, Unit& u) const {
        const long L = (long)i * G + c; if (L >= nwg) return false;
        int wgid = (int)L; { const int q = nwg / NXCD, r = nwg % NXCD, xcd = wgid % NXCD, off = wgid / NXCD; wgid = (xcd < r ? xcd * (q + 1) : r * (q + 1) + (xcd - r) * q) + off; }
        const int nig = WGM * nN, gid = wgid / nig, fm = gid * WGM, gsz = (nM - fm) < WGM ? (nM - fm) : WGM;
        u.pm = fm + ((wgid % nig) % gsz); u.pn = (wgid % nig) / gsz; u.koff = 0; u.koffB = 0; return true;
    }
    __device__ __forceinline__ void a_ready(const Unit&) const {}
    __device__ __forceinline__ void done(const Unit&) const {}
};

__device__ __forceinline__ unsigned cvt_pk_bf16(float lo, float hi) { unsigned r; asm volatile("v_cvt_pk_bf16_f32 %0, %1, %2" : "=v"(r) : "v"(lo), "v"(hi)); return r; }
template <class Epi, class Sched, bool ALIGN_EPI = false, bool SP2 = false, int F8 = 0, bool HM = false>
__device__ __forceinline__ void gemm_phase(PG8_LAS unsigned char* lds, const Gemm g, const Sched& S, const Epi& E) {
    int tid_ = threadIdx.x; asm volatile("" : "+v"(tid_));
    const int tid = tid_, wid = __builtin_amdgcn_readfirstlane(tid >> 6), lane = tid & 63, wr = wid >> 2, wc = wid & 3, fr = lane & 15, fq = lane >> 4;
    const int K = g.K, nt = K / BK;
    unsigned voffA[2], voffB[2], voffN[2] = {0u, 0u};
#pragma unroll
    for (int i = 0; i < 2; ++i) { int R, C; stage_rc(tid * 16 + i * 8192, R, C); const int Rb = Epi::PERM ? ((R & ~31) + perm32(R & 31)) : R;
        voffA[i] = (unsigned)(R * g.lda + C) * 2u; voffB[i] = (unsigned)(Rb * g.ldb + C) * 2u; }
    const size_t kstep = (size_t)(BK * 2);
    const size_t hstepA = HM ? (size_t)0 : (size_t)HALF * g.lda * 2, hstepB = (size_t)HALF * g.ldb * 2;
    const size_t tstepA = Sched::GATHER ? (size_t)0 : (HM ? 1 : 2) * (size_t)HALF * g.lda * 2, tstepB = 2 * hstepB;
    const unsigned ldsw = (unsigned)wid * 1024u;
    const int aoff = lds_byte(wr * 64 + fr, fq * 8), boff = lds_byte(wc * 32 + fr, fq * 8);
#define PG8_SA(b, h) (((b) * 2 + (h)) * HTB)
#define PG8_SB(b, h) ((4 + (b) * 2 + (h)) * HTB)
#define PG8_STAGE(bufoff, gbase, voff) do { _Pragma("unroll") for (int _i = 0; _i < 2; ++_i) \
        __builtin_amdgcn_global_load_lds((const unsigned*)((const char*)(gbase) + (voff)[_i]), (PG8_LAS unsigned*)(lds + (bufoff) + ldsw + _i * 8192), 16, 0, 0); } while (0)
#define PG8_CAT(lo, hi) __builtin_bit_cast(i32x8_t, __builtin_shufflevector(lo, hi, 0, 1, 2, 3, 4, 5, 6, 7, 8, 9, 10, 11, 12, 13, 14, 15))
#define PG8_RD(off) (*(const PG8_LAS bf16x8*)(lds + (off)))
#define PG8_LDA(dst, b, h) do { if constexpr (!(HM && (h) == 1)) _Pragma("unroll") for (int m = 0; m < 4; ++m) { if constexpr (F8 == 0) { _Pragma("unroll") for (int k = 0; k < 2; ++k) dst[m][k] = PG8_RD(PG8_SA(b, h) + aoff + m * 2048 + k * 1024); } \
        else dst[m][0] = PG8_CAT(PG8_RD(PG8_SA(b, h) + aoff + m * 2048), PG8_RD(PG8_SA(b, h) + aoff + m * 2048 + 1024)); } } while (0)
#define PG8_LDB(dst, b, h) do { _Pragma("unroll") for (int n = 0; n < 2; ++n) { if constexpr (F8 == 0) { _Pragma("unroll") for (int k = 0; k < 2; ++k) dst[n][k] = PG8_RD(PG8_SB(b, h) + boff + n * 2048 + k * 1024); } \
        else dst[n][0] = PG8_CAT(PG8_RD(PG8_SB(b, h) + boff + n * 2048), PG8_RD(PG8_SB(b, h) + boff + n * 2048 + 1024)); } } while (0)
#define PG8_MMA(ai, bj, At, Bt) do { __builtin_amdgcn_s_setprio(1); if constexpr (!(HM && (ai) == 1)) _Pragma("unroll") for (int m = 0; m < 4; ++m) _Pragma("unroll") for (int n = 0; n < 2; ++n) { \
        if constexpr (F8 == 0) { _Pragma("unroll") for (int k = 0; k < 2; ++k) acc[ai][bj][m][n] = __builtin_amdgcn_mfma_f32_16x16x32_bf16(Bt[n][k], At[m][k], acc[ai][bj][m][n], 0, 0, 0); } \
        else acc[ai][bj][m][n] = __builtin_amdgcn_mfma_scale_f32_16x16x128_f8f6f4(Bt[n][0], At[m][0], acc[ai][bj][m][n], 0, 0, 0, (F8 & 255) * 0x01010101, 0, ((F8 >> 8) & 255) * 0x01010101); } \
        __builtin_amdgcn_s_setprio(0); } while (0)
#define PG8_WAIT_V(n) asm volatile("s_waitcnt vmcnt(" #n ")" ::: "memory")
#define PG8_WAIT_L(n) asm volatile("s_waitcnt lgkmcnt(" #n ")" ::: "memory")
#define PG8_BAR __builtin_amdgcn_s_barrier()
#define PG8_SCHED __builtin_amdgcn_sched_barrier(0)
    Unit cur, nxt; int ui = 0;
    if (!S.next(0, cur)) return;
    f32x4 acc[2][2][4][2];
#pragma unroll
    for (int a = 0; a < 2; ++a)
#pragma unroll
        for (int b = 0; b < 2; ++b)
#pragma unroll
            for (int m = 0; m < 4; ++m)
#pragma unroll
                for (int n = 0; n < 2; ++n) acc[a][b][m][n] = (f32x4){0.f, 0.f, 0.f, 0.f};
    typename FragT<F8>::T At[4][FragT<F8>::NK], B0[2][FragT<F8>::NK], B1[2][FragT<F8>::NK];
    const char* cA = (const char*)g.A + (size_t)cur.pm * tstepA + cur.koff; const char* cB = (const char*)g.Bt + (size_t)cur.pn * tstepB + cur.koffB;
#define PG8_GVOFF(u, out) do { _Pragma("unroll") for (int i_ = 0; i_ < 2; ++i_) { int R_, C_; stage_rc(tid * 16 + i_ * 8192, R_, C_); out[i_] = ((unsigned)S.row_tok((u).pm, R_) * (unsigned)g.lda + (unsigned)C_) * 2u; } } while (0)
    if constexpr (Sched::GATHER) PG8_GVOFF(cur, voffA);
    S.a_ready(cur);
    if constexpr (SP2) {
        PG8_STAGE(PG8_SB(0, 0), cB, voffB); PG8_STAGE(PG8_SB(0, 1), cB + hstepB, voffB); PG8_STAGE(PG8_SA(0, 0), cA, voffA); PG8_STAGE(PG8_SA(0, 1), cA + hstepA, voffA);
        if (wr == 1) PG8_BAR;
        PG8_WAIT_V(2); PG8_BAR;
        PG8_STAGE(PG8_SB(1, 0), cB + kstep, voffB); PG8_STAGE(PG8_SA(1, 0), cA + kstep, voffA); PG8_STAGE(PG8_SB(1, 1), cB + hstepB + kstep, voffB);
        PG8_WAIT_V(6); PG8_BAR;
    } else {
        PG8_STAGE(PG8_SB(0, 0), cB, voffB); PG8_STAGE(PG8_SA(0, 0), cA, voffA); PG8_STAGE(PG8_SB(0, 1), cB + hstepB, voffB); PG8_STAGE(PG8_SA(0, 1), cA + hstepA, voffA);
        if (wr == 1) PG8_BAR;
        PG8_WAIT_V(4); PG8_BAR;
        PG8_STAGE(PG8_SB(1, 0), cB + kstep, voffB); PG8_STAGE(PG8_SA(1, 0), cA + kstep, voffA); PG8_STAGE(PG8_SB(1, 1), cB + hstepB + kstep, voffB);
        PG8_WAIT_V(6); PG8_BAR;
    }
    for (;;) {
        const bool has_next = S.next(ui + 1, nxt);
        if constexpr (Sched::GATHER) { if (has_next) PG8_GVOFF(nxt, voffN); }
        const char* nA = has_next ? (const char*)g.A + (size_t)nxt.pm * tstepA + nxt.koff : cA; const char* nB = has_next ? (const char*)g.Bt + (size_t)nxt.pn * tstepB + nxt.koffB : cB;
#pragma nounroll
        for (int t = 0; t < nt; t += 2) {
            const bool last = (t == nt - 2);
            const char* a1 = cA + (size_t)(t + 1) * kstep;
            const char* a2 = last ? nA : cA + (size_t)(t + 2) * kstep; const char* b2 = last ? nB : cB + (size_t)(t + 2) * kstep;
            const char* a3 = a2 + kstep; const char* b3 = b2 + kstep;
            unsigned vA2[2] = {voffA[0], voffA[1]}; if constexpr (Sched::GATHER) { if (last) { vA2[0] = voffN[0]; vA2[1] = voffN[1]; } }
            if (last && has_next) S.a_ready(nxt);
            if constexpr (SP2) {
            PG8_LDB(B0, 0, 0); PG8_LDB(B1, 0, 1); PG8_SCHED; PG8_LDA(At, 0, 0); PG8_STAGE(PG8_SA(1, 1), a1 + hstepA, voffA);
            PG8_WAIT_V(8); PG8_WAIT_L(0); PG8_BAR; PG8_MMA(0, 0, At, B0); PG8_MMA(0, 1, At, B1); PG8_BAR; PG8_SCHED;
            PG8_LDA(At, 0, 1); PG8_STAGE(PG8_SB(0, 0), b2, voffB); PG8_STAGE(PG8_SB(0, 1), b2 + hstepB, voffB); PG8_STAGE(PG8_SA(0, 0), a2, vA2);
            PG8_WAIT_V(8); PG8_WAIT_L(0); PG8_BAR; PG8_MMA(1, 0, At, B0); PG8_MMA(1, 1, At, B1); PG8_BAR; PG8_SCHED;
            PG8_LDB(B0, 1, 0); PG8_LDB(B1, 1, 1); PG8_SCHED; PG8_LDA(At, 1, 0); PG8_STAGE(PG8_SA(0, 1), a2 + hstepA, vA2);
            PG8_WAIT_V(8); PG8_WAIT_L(0); PG8_BAR; PG8_MMA(0, 0, At, B0); PG8_MMA(0, 1, At, B1); PG8_BAR; PG8_SCHED;
            PG8_LDA(At, 1, 1); PG8_STAGE(PG8_SB(1, 0), b3, voffB); PG8_STAGE(PG8_SB(1, 1), b3 + hstepB, voffB); PG8_STAGE(PG8_SA(1, 0), a3, vA2);
            PG8_WAIT_V(8); PG8_WAIT_L(0); PG8_BAR; PG8_MMA(1, 0, At, B0); PG8_MMA(1, 1, At, B1); PG8_BAR; PG8_SCHED;
            } else {
            PG8_LDB(B0, 0, 0); PG8_SCHED; PG8_LDA(At, 0, 0); PG8_STAGE(PG8_SA(1, 1), a1 + hstepA, voffA);
            PG8_WAIT_L(8); PG8_BAR; PG8_WAIT_L(0); PG8_MMA(0, 0, At, B0); PG8_BAR; PG8_SCHED;
            PG8_LDB(B1, 0, 1); PG8_STAGE(PG8_SB(0, 0), b2, voffB);
            PG8_BAR; PG8_WAIT_L(0); PG8_MMA(0, 1, At, B1); PG8_BAR;
            PG8_LDA(At, 0, 1); PG8_STAGE(PG8_SA(0, 0), a2, vA2);
            PG8_BAR; PG8_WAIT_L(0); PG8_MMA(1, 0, At, B0); PG8_BAR; PG8_SCHED;
            PG8_STAGE(PG8_SB(0, 1), b2 + hstepB, voffB);
            PG8_WAIT_V(6); PG8_BAR; PG8_MMA(1, 1, At, B1); PG8_BAR;
            PG8_LDB(B0, 1, 0); PG8_SCHED; PG8_LDA(At, 1, 0); PG8_STAGE(PG8_SA(0, 1), a2 + hstepA, vA2);
            PG8_WAIT_L(8); PG8_BAR; PG8_WAIT_L(0); PG8_MMA(0, 0, At, B0); PG8_BAR; PG8_SCHED;
            PG8_LDB(B1, 1, 1); PG8_STAGE(PG8_SB(1, 0), b3, voffB);
            PG8_BAR; PG8_WAIT_L(0); PG8_MMA(0, 1, At, B1); PG8_BAR;
            PG8_LDA(At, 1, 1); PG8_STAGE(PG8_SA(1, 0), a3, vA2);
            PG8_BAR; PG8_WAIT_L(0); PG8_MMA(1, 0, At, B0); PG8_BAR; PG8_SCHED;
            PG8_STAGE(PG8_SB(1, 1), b3 + hstepB, voffB);
            PG8_WAIT_V(6); PG8_BAR; PG8_MMA(1, 1, At, B1); PG8_BAR;
            }
        }
        if constexpr (ALIGN_EPI) { if (wr == 0) PG8_BAR; }
        if constexpr (!Epi::AFTER_DRAIN) { E(acc, cur, wr, wc, fr, fq); S.done(cur); }
        if (!has_next) break;
        {
#pragma unroll
        for (int a = 0; a < 2; ++a)
#pragma unroll
            for (int b = 0; b < 2; ++b)
#pragma unroll
                for (int m = 0; m < 4; ++m)
#pragma unroll
                    for (int n = 0; n < 2; ++n) acc[a][b][m][n] = (f32x4){0.f, 0.f, 0.f, 0.f};
        }
        cur = nxt; cA = nA; cB = nB; ++ui;
        if constexpr (Sched::GATHER) { voffA[0] = voffN[0]; voffA[1] = voffN[1]; }
        if constexpr (ALIGN_EPI) { if (wr == 1) PG8_BAR; }
    }
    PG8_WAIT_V(0);
    if constexpr (!ALIGN_EPI) { if (wr == 0) PG8_BAR; }
    PG8_BAR;
    if constexpr (Epi::AFTER_DRAIN) { E.fused(acc, cur, wr, wc, fr, fq, lds, wid, lane); S.done(cur); }
#undef PG8_SA
#undef PG8_SB
#undef PG8_STAGE
#undef PG8_LDA
#undef PG8_LDB
#undef PG8_MMA
#undef PG8_CAT
#undef PG8_GVOFF
#undef PG8_RD
#undef PG8_WAIT_V
#undef PG8_WAIT_L
#undef PG8_BAR
#undef PG8_SCHED
}
}

#define XB_TMO      128
#define XB_XCNT(j)  (256  + 64 * (j))
#define XB_XSUB(j)  (1280 + 64 * (j))
#define XB_XGEN(j)  (2304 + 64 * (j))
#define XB_TOP      3328
#define XB_TOPGEN   3392
#define XCD_BAR_WORDS 3456
#define XB_SPIN_CAP (1u << 18)
#define LAS __attribute__((address_space(3)))

__device__ __forceinline__ unsigned xb_ld(unsigned* p)              { return __hip_atomic_load(p, __ATOMIC_RELAXED, __HIP_MEMORY_SCOPE_AGENT); }
__device__ __forceinline__ unsigned xb_add(unsigned* p, unsigned v) { return __hip_atomic_fetch_add(p, v, __ATOMIC_RELAXED, __HIP_MEMORY_SCOPE_AGENT); }
__device__ __forceinline__ unsigned xb_xcc_id() { return (unsigned)__builtin_amdgcn_s_getreg((3 << 11) | 20) & 0xFu; }
#define XB_SPIN(cond, bar) do { unsigned _sp = 0; while (cond) { __builtin_amdgcn_s_sleep(1); \
    if ((++_sp & 255u) == 0u) { if (xb_ld(&(bar)[XB_TMO])) break; if (_sp > XB_SPIN_CAP) { atomicAdd(&(bar)[XB_TMO], 1u); break; } } } } while (0)

struct XcdBarrier {
    unsigned* bar; unsigned x;
    volatile LAS unsigned* st;
};

__device__ __forceinline__ XcdBarrier xcd_barrier_post(unsigned* bar, volatile LAS unsigned* st) {
    XcdBarrier b; b.bar = bar; b.x = xb_xcc_id(); b.st = st;
    if (threadIdx.x == 0) (void)xb_add(&bar[XB_XCNT(b.x)], 1u);
    return b;
}
__device__ __forceinline__ void xcd_barrier_complete(unsigned* bar, unsigned x, unsigned& nloc, unsigned& nx) {
    const unsigned G = gridDim.x * gridDim.y * gridDim.z;
    unsigned sum, cnt, mine, sp = 0u;
    for (;;) {
        sum = 0u; cnt = 0u; mine = 0u;
#pragma unroll
        for (unsigned j = 0; j < 16; ++j) { const unsigned c = xb_ld(&bar[XB_XCNT(j)]); sum += c; cnt += (c > 0u) ? 1u : 0u; mine = (j == x) ? c : mine; }
        if (sum == G) break;
        __builtin_amdgcn_s_sleep(1);
        if ((++sp & 255u) == 0u) { if (xb_ld(&bar[XB_TMO])) break; if (sp > XB_SPIN_CAP) { atomicAdd(&bar[XB_TMO], 1u); break; } }
    }
    nloc = mine > 0u ? mine : 1u; nx = cnt > 0u ? cnt : 1u;
}

__device__ __forceinline__ void xcd_barrier(const XcdBarrier& b) {
    asm volatile("s_waitcnt vmcnt(0)" ::: "memory");
    __syncthreads();
    if (threadIdx.x == 0) {
        unsigned* bar = b.bar;
        __builtin_amdgcn_s_waitcnt(0);
        unsigned nloc = b.st[0], nx = b.st[1];
        if (nloc == 0u) { xcd_barrier_complete(bar, b.x, nloc, nx); b.st[0] = nloc; b.st[1] = nx; }
        const unsigned old = xb_add(&bar[XB_XSUB(b.x)], 1u);
        const unsigned gen = old / nloc;
        if (old + 1u == (gen + 1u) * nloc) {
            __builtin_amdgcn_fence(__ATOMIC_RELEASE, "agent");
            asm volatile("s_waitcnt vmcnt(0)" ::: "memory");
            const unsigned og = xb_add(&bar[XB_TOP], 1u);
            const unsigned tg = og / nx;
            if (og + 1u == (tg + 1u) * nx) xb_add(&bar[XB_TOPGEN], 1u);
            else XB_SPIN(xb_ld(&bar[XB_TOPGEN]) == tg, bar);
            __builtin_amdgcn_fence(__ATOMIC_ACQUIRE, "agent");
            xb_add(&bar[XB_XGEN(b.x)], 1u);
            asm volatile("s_waitcnt vmcnt(0)" ::: "memory");
        } else {
            XB_SPIN(xb_ld(&bar[XB_XGEN(b.x)]) == gen, bar);
            __builtin_amdgcn_fence(__ATOMIC_ACQUIRE, "agent");
            asm volatile("s_waitcnt vmcnt(0)" ::: "memory");
        }
    }
    __syncthreads();
}

constexpr int NWAVES = 8, NTHR = 512;
constexpr int RING_BYTES = 131072;
constexpr int LDS_BYTES = 147456;
constexpr int RT_OFF = 131072;
constexpr int LDSCTL_OFF = LDS_BYTES - 16;
constexpr int CW_BAR = 4096;
typedef float f32x4 __attribute__((ext_vector_type(4)));
typedef unsigned u32x4 __attribute__((ext_vector_type(4)));
typedef unsigned u32x2 __attribute__((ext_vector_type(2)));
typedef short bf16x8 __attribute__((ext_vector_type(8)));
#define LDS_WAIT() asm volatile("s_waitcnt lgkmcnt(0)" ::: "memory")
typedef __bf16 bf16x2_t __attribute__((ext_vector_type(2)));
typedef float f32x2_t __attribute__((ext_vector_type(2)));
__device__ __forceinline__ unsigned pk2(float lo, float hi) { const f32x2_t v = {lo, hi}; return __builtin_bit_cast(unsigned, __builtin_convertvector(v, bf16x2_t)); }
__device__ __forceinline__ int lane_fresh() { int l; asm volatile("v_mbcnt_lo_u32_b32 %0, -1, 0\n\tv_mbcnt_hi_u32_b32 %0, -1, %0" : "=v"(l)); return l; }
#define DPP_ADD(v, ctrl) ((v) + __builtin_bit_cast(float, __builtin_amdgcn_update_dpp(0, __builtin_bit_cast(int, (v)), (ctrl), 0xf, 0xf, true)))
__device__ __forceinline__ float wave_sum(float v) {
    v = DPP_ADD(v, 0xB1);
    v = DPP_ADD(v, 0x4E);
    v = DPP_ADD(v, 0x141);
    v = DPP_ADD(v, 0x140);
    const int iv = __builtin_bit_cast(int, v);
    return (__builtin_bit_cast(float, __builtin_amdgcn_readlane(iv, 0)) + __builtin_bit_cast(float, __builtin_amdgcn_readlane(iv, 16)))
         + (__builtin_bit_cast(float, __builtin_amdgcn_readlane(iv, 32)) + __builtin_bit_cast(float, __builtin_amdgcn_readlane(iv, 48)));
}

constexpr int N1 = 11264;
struct Args { const float* in[38]; float* out; unsigned char* ws; int ph_lo, ph_hi; };

__device__ __forceinline__ void tr_item(const float* W, int ldw, int k0, int n0, bf16* dst, int ldd, const float* mu, int mode, LAS float* scr, int lane) {
    f32x4 v[8];
#pragma unroll
    for (int i = 0; i < 8; ++i) v[i] = *(const f32x4*)(W + (size_t)(k0 + 8 * i + (lane >> 3)) * ldw + n0 + 4 * (lane & 7));
#pragma unroll
    for (int i = 0; i < 8; ++i) { const int kk = 8 * i + (lane >> 3); f32x4 t = v[i];
        if (mode == 1) t = t * (1.0f - mu[k0 + kk]); else if (mode == 2) t = t * mu[k0 + kk];
        LAS float* s = scr + kk * 33 + 4 * (lane & 7); s[0] = t.x; s[1] = t.y; s[2] = t.z; s[3] = t.w; }
    LDS_WAIT(); asm volatile("" ::: "memory");
    const int c = lane & 7;
#pragma unroll
    for (int j = 0; j < 4; ++j) { const int n = (lane >> 3) + 8 * j; const LAS float* s = scr + (8 * c) * 33 + n;
        u32x4 o; o.x = pk2(s[0 * 33], s[1 * 33]); o.y = pk2(s[2 * 33], s[3 * 33]); o.z = pk2(s[4 * 33], s[5 * 33]); o.w = pk2(s[6 * 33], s[7 * 33]);
        *(u32x4*)(dst + (size_t)n * ldd + 8 * c) = o; }
    LDS_WAIT(); asm volatile("" ::: "memory");
}
__device__ __forceinline__ unsigned pk_fp8x4(float a, float b, float c, float d, float sc) {
    a = fminf(fmaxf(a * sc, -448.f), 448.f); b = fminf(fmaxf(b * sc, -448.f), 448.f); c = fminf(fmaxf(c * sc, -448.f), 448.f); d = fminf(fmaxf(d * sc, -448.f), 448.f);
    int p = __builtin_amdgcn_cvt_pk_fp8_f32(a, b, 0, false); p = __builtin_amdgcn_cvt_pk_fp8_f32(c, d, p, true); return (unsigned)p; }
__device__ __forceinline__ void tr_item8(const float* W, int ldw, int k0, int n0, unsigned char* dst, int ldd, float sc, LAS float* scr, int lane) {
    f32x4 v[8];
#pragma unroll
    for (int i = 0; i < 8; ++i) v[i] = *(const f32x4*)(W + (size_t)(k0 + 8 * i + (lane >> 3)) * ldw + n0 + 4 * (lane & 7));
#pragma unroll
    for (int i = 0; i < 8; ++i) { const int kk = 8 * i + (lane >> 3); LAS float* s = scr + kk * 33 + 4 * (lane & 7); s[0] = v[i].x; s[1] = v[i].y; s[2] = v[i].z; s[3] = v[i].w; }
    LDS_WAIT(); asm volatile("" ::: "memory");
    const int c = lane & 7;
#pragma unroll
    for (int j = 0; j < 4; ++j) { const int n = (lane >> 3) + 8 * j; const LAS float* s = scr + (8 * c) * 33 + n;
        u32x2 o; o.x = pk_fp8x4(s[0 * 33], s[1 * 33], s[2 * 33], s[3 * 33], sc); o.y = pk_fp8x4(s[4 * 33], s[5 * 33], s[6 * 33], s[7 * 33], sc);
        *(u32x2*)(dst + (size_t)n * ldd + 8 * c) = o; }
    LDS_WAIT(); asm volatile("" ::: "memory");
}

struct ConvTile { const float* src; int ldw; unsigned char* dst; int rs; int kind; float sc; };
constexpr int CT_IN = (D / 128) * (INW / 128), CT_UP = (AW / 128) * (D / 128), CT_O = (D / 128) * (D / 128), CT_EG = (D / 128) * (FF / 128), CT_ED = (FF / 128) * (D / 128);
constexpr int CT_ALL = CT_IN + 2 * CT_UP + CT_O + NE * (2 * CT_EG + CT_ED);
__device__ __forceinline__ ConvTile conv_decode(int T, const float* const* in, unsigned char* ws) {
    ConvTile t; int r = T;
    if (r < CT_IN) { const int kt = r / (INW / 128), nt = r % (INW / 128), k0 = 128 * kt, n0 = 128 * nt; int dr = n0;
        if (n0 >= 3 * AW + 3 * RW + D) { const int cc = n0 - (3 * AW + 3 * RW + D); dr = 3 * AW + 3 * RW + 256 * (cc / 128) + 128; }
        else if (n0 >= 3 * AW + 3 * RW) { const int cc = n0 - (3 * AW + 3 * RW); dr = 3 * AW + 3 * RW + 256 * (cc / 128); }
        t.src = in[8] + (size_t)k0 * INW + n0; t.ldw = INW; t.dst = ws + WS_W1T + ((size_t)dr * D + k0) * 2; t.rs = D * 2; t.kind = 0; t.sc = 1.f; return t; } r -= CT_IN;
    if (r < 2 * CT_UP) { const int which = r / CT_UP, q = r % CT_UP, kt = q / (D / 128), nt = q % (D / 128), k0 = 128 * kt, n0 = 128 * nt;
        t.src = in[28 + which] + (size_t)k0 * D + n0; t.ldw = D; t.dst = ws + WS_WUPT + ((size_t)n0 * D + which * AW + k0) * 2; t.rs = D * 2; t.kind = 0; t.sc = 1.f; return t; } r -= 2 * CT_UP;
    if (r < CT_O) { const int kt = r / (D / 128), nt = r % (D / 128), k0 = 128 * kt, n0 = 128 * nt;
        t.src = in[30] + (size_t)k0 * D + n0; t.ldw = D; t.dst = ws + WS_WOT + ((size_t)n0 * D + k0) * 2; t.rs = D * 2; t.kind = 0; t.sc = 1.f; return t; } r -= CT_O;
    const int e = r / (2 * CT_EG + CT_ED); r -= e * (2 * CT_EG + CT_ED);
    if (r < 2 * CT_EG) { const int up = r / CT_EG, q = r % CT_EG, kt = q / (FF / 128), nt = q % (FF / 128), k0 = 128 * kt;
        t.src = in[35 + up] + (size_t)e * D * FF + (size_t)k0 * FF + 128 * nt; t.ldw = FF; t.dst = ws + WS_WGUT + ((size_t)e * 1024 + 256 * nt + 128 * up) * D + k0; t.rs = D; t.kind = 1; t.sc = 256.f; return t; } r -= 2 * CT_EG;
    { const int kt = r / (D / 128), nt = r % (D / 128), k0 = 128 * kt, n0 = 128 * nt;
        t.src = in[37] + (size_t)e * FF * D + (size_t)k0 * D + n0; t.ldw = D; t.dst = ws + WS_WDT + ((size_t)e * D + n0) * FF + k0; t.rs = FF; t.kind = 1; t.sc = 128.f; return t; }
}
__device__ __forceinline__ int conv_off(int k, int n) { return k * 132 + 16 * (k >> 5) + n; }
__device__ __forceinline__ void item_kn(int it, int N, int& k0, int& n0) { const int nblk = N / 32; k0 = 64 * (it / nblk); n0 = 32 * (it % nblk); }

struct EpiProj {
    static constexpr bool PERM = true, AFTER_DRAIN = false, MIDK = false;
    bf16* q; bf16* k; bf16* v; float* rkv; bf16* gate; float* lora; float* lorab; const float* rope;
    __device__ __forceinline__ void operator()(const pg8::f32x4 (&acc)[2][2][4][2], const pg8::Unit& u, int wr, int wc, int fr, int fq) const {
        const int row0 = u.pm * 256 + wr * 64 + fr; const int pn = u.pn; const int colw = wc * 32 + 8 * fq;
        if (pn < 8) {
            bf16* base = (pn < 4 ? q : k) + (pn & 3) * 256 + colw;
            const float sgn = fq < 2 ? -1.0f : 1.0f;
#pragma unroll
            for (int ai = 0; ai < 2; ++ai)
#pragma unroll
                for (int m = 0; m < 4; ++m) { const int row = row0 + ai * 128 + m * 16;
                    f32x4 c0, c1, c2, c3;
                    if (wc == 0) { const float* rp = rope + ((size_t)row * 16 + 8 * (fq & 1)) * 2; c0 = *(const f32x4*)rp; c1 = *(const f32x4*)(rp + 4); c2 = *(const f32x4*)(rp + 8); c3 = *(const f32x4*)(rp + 12); }
#pragma unroll
                    for (int bj = 0; bj < 2; ++bj) { f32x4 v0 = acc[ai][bj][m][0], v1 = acc[ai][bj][m][1];
                        if (wc == 0) {
                            f32x4 p0, p1;
#pragma unroll
                            for (int j = 0; j < 4; ++j) { p0[j] = __shfl_xor(v0[j], 32) * sgn; p1[j] = __shfl_xor(v1[j], 32) * sgn; }
                            v0[0] = v0[0] * c0[0] + p0[0] * c0[1]; v0[1] = v0[1] * c0[2] + p0[1] * c0[3]; v0[2] = v0[2] * c1[0] + p0[2] * c1[1]; v0[3] = v0[3] * c1[2] + p0[3] * c1[3];
                            v1[0] = v1[0] * c2[0] + p1[0] * c2[1]; v1[1] = v1[1] * c2[2] + p1[1] * c2[3]; v1[2] = v1[2] * c3[0] + p1[2] * c3[1]; v1[3] = v1[3] * c3[2] + p1[3] * c3[3];
                        }
                        u32x4 w; w.x = pk2(v0[0], v0[1]); w.y = pk2(v0[2], v0[3]); w.z = pk2(v1[0], v1[1]); w.w = pk2(v1[2], v1[3]);
                        *(u32x4*)(base + (size_t)row * AW + bj * 128) = w; } }
        } else if (pn < 12) {
            bf16* base = v + (pn - 8) * 256 + colw;
#pragma unroll
            for (int ai = 0; ai < 2; ++ai)
#pragma unroll
                for (int m = 0; m < 4; ++m) { const int row = row0 + ai * 128 + m * 16;
#pragma unroll
                    for (int bj = 0; bj < 2; ++bj) { const f32x4 v0 = acc[ai][bj][m][0], v1 = acc[ai][bj][m][1];
                        u32x4 w; w.x = pk2(v0[0], v0[1]); w.y = pk2(v0[2], v0[3]); w.z = pk2(v1[0], v1[1]); w.w = pk2(v1[2], v1[3]);
                        *(u32x4*)(base + (size_t)row * AW + bj * 128) = w; } }
        } else if (pn < 24) {
            float* base = rkv + (pn - 12) * 256 + colw;
#pragma unroll
            for (int ai = 0; ai < 2; ++ai)
#pragma unroll
                for (int m = 0; m < 4; ++m) { const int row = row0 + ai * 128 + m * 16;
#pragma unroll
                    for (int bj = 0; bj < 2; ++bj) { float* p = base + (size_t)row * (3 * RW) + bj * 128; *(f32x4*)p = acc[ai][bj][m][0]; *(f32x4*)(p + 4) = acc[ai][bj][m][1]; } }
        } else if (pn < 40) {
            bf16* base = gate + (pn - 24) * 128 + colw;
#pragma unroll
            for (int ai = 0; ai < 2; ++ai)
#pragma unroll
                for (int m = 0; m < 4; ++m) { const int row = row0 + ai * 128 + m * 16;
                    const f32x4 a0 = acc[ai][0][m][0], a1 = acc[ai][0][m][1], r0 = acc[ai][1][m][0], r1 = acc[ai][1][m][1]; float ra[8], sr[8];
#pragma unroll
                    for (int j = 0; j < 4; ++j) { const float ea = __expf(-a0[j]), er = __expf(-r0[j]), ea1 = __expf(-a1[j]), er1 = __expf(-r1[j]);
                        sr[j] = __builtin_amdgcn_rcpf(1.0f + er); ra[j] = (1.0f + er) * __builtin_amdgcn_rcpf(1.0f + ea); sr[4 + j] = __builtin_amdgcn_rcpf(1.0f + er1); ra[4 + j] = (1.0f + er1) * __builtin_amdgcn_rcpf(1.0f + ea1); }
                    u32x4 w; w.x = pk2(ra[0], ra[1]); w.y = pk2(ra[2], ra[3]); w.z = pk2(ra[4], ra[5]); w.w = pk2(ra[6], ra[7]);
                    *(u32x4*)(base + (size_t)row * (2 * D)) = w;
                    w.x = pk2(sr[0], sr[1]); w.y = pk2(sr[2], sr[3]); w.z = pk2(sr[4], sr[5]); w.w = pk2(sr[6], sr[7]);
                    *(u32x4*)(base + (size_t)row * (2 * D) + D) = w; }
        } else {
            float* base = (u.koff ? lorab : lora) + (pn - 40) * 256 + colw;
#pragma unroll
            for (int ai = 0; ai < 2; ++ai)
#pragma unroll
                for (int m = 0; m < 4; ++m) { const int row = row0 + ai * 128 + m * 16;
#pragma unroll
                    for (int bj = 0; bj < 2; ++bj) { float* p = base + (size_t)row * 1024 + bj * 128; *(f32x4*)p = acc[ai][bj][m][0]; *(f32x4*)(p + 4) = acc[ai][bj][m][1]; } }
        }
    }
};


struct LoraOrder { static constexpr bool GATHER = false; const int* tok; int G, c;
    __device__ bool next(int i, pg8::Unit& u) const { const int L = i * G + c; if (L >= (S / 256) * 8) return false; u.pm = L >> 3; u.pn = 40 + ((L >> 1) & 3); u.koff = (L & 1) * AW * 2; u.koffB = u.koff; return true; }
    __device__ __forceinline__ void a_ready(const pg8::Unit&) const {}
    __device__ __forceinline__ void done(const pg8::Unit&) const {} };
__device__ __forceinline__ void unpack8(const u32x4 w, float (&f)[8]) {
    f[0] = __uint_as_float(w.x << 16); f[1] = __uint_as_float(w.x & 0xffff0000u); f[2] = __uint_as_float(w.y << 16); f[3] = __uint_as_float(w.y & 0xffff0000u);
    f[4] = __uint_as_float(w.z << 16); f[5] = __uint_as_float(w.z & 0xffff0000u); f[6] = __uint_as_float(w.w << 16); f[7] = __uint_as_float(w.w & 0xffff0000u);
}
struct EpiMix {
    static constexpr bool PERM = true, AFTER_DRAIN = false, MIDK = false;
    const bf16* gate; bf16* mix;
    __device__ __forceinline__ void operator()(const pg8::f32x4 (&acc)[2][2][4][2], const pg8::Unit& u, int wr, int wc, int fr, int fq) const {
        const int row0 = u.pm * 256 + wr * 64 + fr; const int col0 = u.pn * 256 + wc * 32 + 8 * fq;
        if (u.koff == 0) {
#pragma unroll
            for (int ai = 0; ai < 2; ++ai)
#pragma unroll
                for (int m = 0; m < 4; ++m) { const size_t row = row0 + ai * 128 + m * 16; const bf16* gp = gate + row * (2 * D) + col0;
#pragma unroll
                    for (int bj = 0; bj < 2; ++bj) { float ga[8]; unpack8(*(const u32x4*)(gp + bj * 128), ga); const pg8::f32x4 v0 = acc[ai][bj][m][0], v1 = acc[ai][bj][m][1];
                        u32x4 w; w.x = pk2(v0[0] * ga[0], v0[1] * ga[1]); w.y = pk2(v0[2] * ga[2], v0[3] * ga[3]); w.z = pk2(v1[0] * ga[4], v1[1] * ga[5]); w.w = pk2(v1[2] * ga[6], v1[3] * ga[7]);
                        *(u32x4*)(mix + row * D + col0 + bj * 128) = w; } }
        } else {
#pragma unroll
            for (int ai = 0; ai < 2; ++ai)
#pragma unroll
                for (int m = 0; m < 4; ++m) { const size_t row = row0 + ai * 128 + m * 16; const bf16* gp = gate + row * (2 * D) + D + col0;
#pragma unroll
                    for (int bj = 0; bj < 2; ++bj) { float gr[8], tp[8]; unpack8(*(const u32x4*)(gp + bj * 128), gr); unpack8(*(const u32x4*)(mix + row * D + col0 + bj * 128), tp); const pg8::f32x4 v0 = acc[ai][bj][m][0], v1 = acc[ai][bj][m][1];
                        u32x4 w; w.x = pk2((v0[0] + tp[0]) * gr[0], (v0[1] + tp[1]) * gr[1]); w.y = pk2((v0[2] + tp[2]) * gr[2], (v0[3] + tp[3]) * gr[3]);
                        w.z = pk2((v1[0] + tp[4]) * gr[4], (v1[1] + tp[5]) * gr[5]); w.w = pk2((v1[2] + tp[6]) * gr[6], (v1[3] + tp[7]) * gr[7]);
                        *(u32x4*)(mix + row * D + col0 + bj * 128) = w; } }
        }
    }
};
struct MixOrder {
    static constexpr bool GATHER = false; const int* tok; int G, c;
    __device__ bool next(int i, pg8::Unit& u) const { const int L = (i >> 1) * G + c; if (L >= (S / 256) * (D / 256)) return false; u.pm = L / (D / 256); u.pn = L % (D / 256); u.koff = (i & 1) * AW * 2; u.koffB = u.koff; return true; }
    __device__ __forceinline__ void a_ready(const pg8::Unit&) const {}
    __device__ __forceinline__ void done(const pg8::Unit&) const {}
};
struct EpiBf16P {
    static constexpr bool PERM = true, AFTER_DRAIN = false, MIDK = false;
    bf16* C; long ldc;
    __device__ __forceinline__ void operator()(const pg8::f32x4 (&acc)[2][2][4][2], const pg8::Unit& u, int wr, int wc, int fr, int fq) const {
        const int row0 = u.pm * 256 + wr * 64 + fr; const int col0 = u.pn * 256 + wc * 32 + 8 * fq;
#pragma unroll
        for (int ai = 0; ai < 2; ++ai)
#pragma unroll
            for (int m = 0; m < 4; ++m) { bf16* p = C + (size_t)(row0 + ai * 128 + m * 16) * ldc + col0;
#pragma unroll
                for (int bj = 0; bj < 2; ++bj) { const pg8::f32x4 v0 = acc[ai][bj][m][0], v1 = acc[ai][bj][m][1];
                    u32x4 w; w.x = pk2(v0[0], v0[1]); w.y = pk2(v0[2], v0[3]); w.z = pk2(v1[0], v1[1]); w.w = pk2(v1[2], v1[3]);
                    *(u32x4*)(p + bj * 128) = w; } }
    }
};
struct EpiF32P {
    static constexpr bool PERM = true, AFTER_DRAIN = false, MIDK = false;
    float* C; long ldc;
    __device__ __forceinline__ void operator()(const pg8::f32x4 (&acc)[2][2][4][2], const pg8::Unit& u, int wr, int wc, int fr, int fq) const {
        const int row0 = u.pm * 256 + wr * 64 + fr; const int col0 = u.pn * 256 + wc * 32 + 8 * fq;
#pragma unroll
        for (int ai = 0; ai < 2; ++ai)
#pragma unroll
            for (int m = 0; m < 4; ++m) { float* p = C + (size_t)(row0 + ai * 128 + m * 16) * ldc + col0;
#pragma unroll
                for (int bj = 0; bj < 2; ++bj) { *(f32x4*)(p + bj * 128) = acc[ai][bj][m][0]; *(f32x4*)(p + bj * 128 + 4) = acc[ai][bj][m][1]; } }
    }
};
template <bool GA> struct ExpertOrderT {
    static constexpr bool GATHER = GA; const int* elist;
    LAS const int* tb; int nj, G, c;
    __device__ bool next(int i, pg8::Unit& u) const { const int L = i * G + c; const int pm = L / nj; if (pm >= tb[512]) return false; u.pm = pm; u.pn = tb[128 + pm] * nj + (L % nj); u.koff = 0; u.koffB = 0; return true; }
    __device__ __forceinline__ int row_tok(int pm, int r) const { const int e = tb[128 + pm]; const int q = tb[320 + pm] + r; return q < tb[e] ? elist[e * S + q] : 0; }
    __device__ __forceinline__ void a_ready(const pg8::Unit&) const {}
    __device__ __forceinline__ void done(const pg8::Unit&) const {}
};
struct EpiHid {
    static constexpr bool PERM = true, AFTER_DRAIN = false, MIDK = false;
    unsigned char* hid;
    __device__ __forceinline__ void operator()(const pg8::f32x4 (&acc)[2][2][4][2], const pg8::Unit& u, int wr, int wc, int fr, int fq) const {
        const int row0 = u.pm * 128 + wr * 64 + fr; const int col0 = (u.pn & 3) * 128 + wc * 32 + 8 * fq;
#pragma unroll
        for (int ai = 0; ai < 1; ++ai)
#pragma unroll
            for (int m = 0; m < 4; ++m) { const pg8::f32x4 g0 = acc[ai][0][m][0], g1 = acc[ai][0][m][1], u0 = acc[ai][1][m][0], u1 = acc[ai][1][m][1]; float o[8];
#pragma unroll
                for (int j = 0; j < 4; ++j) { o[j] = g0[j] * sigmoidf_(g0[j]) * u0[j]; o[4 + j] = g1[j] * sigmoidf_(g1[j]) * u1[j]; }
                u32x2 w; w.x = pk_fp8x4(o[0], o[1], o[2], o[3], 8.0f); w.y = pk_fp8x4(o[4], o[5], o[6], o[7], 8.0f);
                *(u32x2*)(hid + (size_t)(row0 + ai * 128 + m * 16) * FF + col0) = w; }
    }
};
struct EpiYbuf {
    static constexpr bool PERM = true, AFTER_DRAIN = false, MIDK = false;
    bf16* ybuf;
    __device__ __forceinline__ void operator()(const pg8::f32x4 (&acc)[2][2][4][2], const pg8::Unit& u, int wr, int wc, int fr, int fq) const {
        const int row0 = u.pm * 128 + wr * 64 + fr; const int col0 = (u.pn & 7) * 256 + wc * 32 + 8 * fq;
#pragma unroll
        for (int ai = 0; ai < 1; ++ai)
#pragma unroll
            for (int m = 0; m < 4; ++m) { bf16* p = ybuf + (size_t)(row0 + ai * 128 + m * 16) * D + col0;
#pragma unroll
                for (int bj = 0; bj < 2; ++bj) { const pg8::f32x4 v0 = acc[ai][bj][m][0], v1 = acc[ai][bj][m][1];
                    u32x4 w; w.x = pk2(v0[0], v0[1]); w.y = pk2(v0[2], v0[3]); w.z = pk2(v1[0], v1[1]); w.w = pk2(v1[2], v1[3]);
                    *(u32x4*)(p + bj * 128) = w; } }
    }
};
constexpr int RS8 = D + 8;

typedef short s16x4 __attribute__((ext_vector_type(4)));
constexpr int KST = 136, VST = 144;
constexpr int KT_BYTES = 64 * KST * 2, VT_BYTES = 64 * VST * 2;
constexpr int AT_BUF = KT_BYTES + VT_BYTES;
constexpr int AT_G = 2 * AT_BUF;
constexpr int AT_HIST = AT_G + 8 * 2112;
constexpr int AT_ITEMS = AT_HIST + 256;
constexpr int LIST_PER_HEAD = 256 * 496;
__device__ __forceinline__ int list_off(int j) { return 256 * (31 * j - (j * (j - 1)) / 2); }
__device__ __forceinline__ s16x4 tr_read4(unsigned addr) { return __builtin_amdgcn_ds_read_tr16_b64_v4i16((LAS s16x4*)(size_t)addr); }

struct AttnBufs { const bf16* q; const bf16* k; const bf16* v; const bf16* kmh; const bf16* kml; unsigned* mask; int* list; int* cnt; bf16* part; float* ml; };

__device__ __forceinline__ void moba_select_unit(LAS unsigned char* lds, const AttnBufs& A, int head, int qt, int tid, int lane, int wave) {
    const int q0 = qt * 128, qblk = qt >> 1, g4 = lane >> 4, c16 = lane & 15; const int myq = q0 + wave * 16 + c16;
    LAS int* hist = (LAS int*)(lds + AT_HIST); LAS int* base = hist + 32;
    if (tid < 32) hist[tid] = 0;
    __syncthreads();
    unsigned msk = 0u; int lp0 = 0, lp1 = 0, lp2 = 0, b0 = 0, b1 = 0, b2 = 0, nsel = 0;
    if (qblk > 0) {
        bf16x8 qf[4];
#pragma unroll
        for (int ks = 0; ks < 4; ++ks) qf[ks] = *(const bf16x8*)(A.q + (size_t)myq * AW + head * AD + 32 * ks + 8 * g4);
        f32x4 gs[2] = {(f32x4){0.f, 0.f, 0.f, 0.f}, (f32x4){0.f, 0.f, 0.f, 0.f}};
#pragma unroll
        for (int mt = 0; mt < 2; ++mt)
#pragma unroll
            for (int ks = 0; ks < 4; ++ks) { const size_t o = (size_t)(head * NB + 16 * mt + c16) * AD + 32 * ks + 8 * g4;
                gs[mt] = __builtin_amdgcn_mfma_f32_16x16x32_bf16(*(const bf16x8*)(A.kmh + o), qf[ks], gs[mt], 0, 0, 0);
                gs[mt] = __builtin_amdgcn_mfma_f32_16x16x32_bf16(*(const bf16x8*)(A.kml + o), qf[ks], gs[mt], 0, 0, 0); }
        LAS float* G = (LAS float*)(lds + AT_G + wave * 2112);
#pragma unroll
        for (int mt = 0; mt < 2; ++mt)
#pragma unroll
            for (int rg = 0; rg < 4; ++rg) G[c16 * 33 + 16 * mt + 4 * g4 + rg] = gs[mt][rg];
        LDS_WAIT(); asm volatile("" ::: "memory");
        if (lane < 16) {
            nsel = qblk < 3 ? qblk : 3;
            float gvv[32];
#pragma unroll
            for (int n = 0; n < 32; ++n) gvv[n] = G[lane * 33 + n];
#pragma unroll
            for (int n = 0; n < 32; ++n) gvv[n] = n < qblk ? gvv[n] : -3e38f;
#pragma unroll
            for (int t = 0; t < 3; ++t) if (t < nsel) { float best = -3e38f; int bi = 0;
#pragma unroll
                for (int n = 0; n < 32; ++n) { const bool take = gvv[n] > best; best = take ? gvv[n] : best; bi = take ? n : bi; }
#pragma unroll
                for (int n = 0; n < 32; ++n) gvv[n] = (n == bi) ? -3e38f : gvv[n];
                msk |= 1u << bi;
                const int lp = atomicAdd((int*)&hist[bi], 1); if (t == 0) { lp0 = lp; b0 = bi; } else if (t == 1) { lp1 = lp; b1 = bi; } else { lp2 = lp; b2 = bi; } }
        }
    }
    if (lane < 16) A.mask[head * S + myq] = msk;
    __syncthreads();
    if (tid < 32) { const int hcount = hist[tid]; base[tid] = hcount > 0 ? atomicAdd(A.cnt + head * NB + tid, hcount) : 0; }
    __syncthreads();
    if (lane < 16) { int* lh = A.list + head * LIST_PER_HEAD;
        if (nsel > 0) lh[list_off(b0) + base[b0] + lp0] = myq;
        if (nsel > 1) lh[list_off(b1) + base[b1] + lp1] = myq;
        if (nsel > 2) lh[list_off(b2) + base[b2] + lp2] = myq; }
    __syncthreads();
}

__device__ __forceinline__ void moba_item2(LAS unsigned char* lds, const AttnBufs& A, int head, int kvb, bool own, int r, int cntj, int tid, int lane, int wave) {
    const int g4 = lane >> 4, c16 = lane & 15;
    int myq[2]; bool valid[2];
    if (own) { myq[0] = kvb * MB + wave * 32 + c16; myq[1] = myq[0] + 16; valid[0] = true; valid[1] = true; }
    else { const int* lp = A.list + head * LIST_PER_HEAD + list_off(kvb);
#pragma unroll
        for (int g = 0; g < 2; ++g) { const int e = r * 256 + wave * 32 + 16 * g + c16; valid[g] = e < cntj; myq[g] = lp[valid[g] ? e : 0]; } }
    const bool wave_valid = own || (r * 256 + wave * 32 < cntj);
    const int qfirst = kvb * MB + wave * 32;
    bf16x8 qf[2][4];
#pragma unroll
    for (int g = 0; g < 2; ++g)
#pragma unroll
        for (int ks = 0; ks < 4; ++ks) qf[g][ks] = *(const bf16x8*)(A.q + (size_t)myq[g] * AW + head * AD + 32 * ks + 8 * g4);
    f32x4 oacc[2][8];
#pragma unroll
    for (int g = 0; g < 2; ++g)
#pragma unroll
        for (int dt = 0; dt < 8; ++dt) oacc[g][dt] = (f32x4){0.f, 0.f, 0.f, 0.f};
    float mrun[2] = {-1e30f, -1e30f}, lrun[2] = {0.f, 0.f};
    const float sc2 = 0.08838834764831845f * 1.4426950408889634f;
    const int r0 = tid >> 4, ch = tid & 15;
    u32x4 kr[2], vr[2];
    const bf16* kg = A.k + (size_t)(kvb * MB + r0) * AW + head * AD + 8 * ch; const bf16* vg = A.v + (size_t)(kvb * MB + r0) * AW + head * AD + 8 * ch;
    LAS unsigned char* kst = lds + (r0 * KST + 8 * ch) * 2; LAS unsigned char* vst = lds + KT_BYTES + (r0 * VST + 8 * ch) * 2;
    const LAS unsigned char* kld = lds + (c16 * KST + 8 * g4) * 2; const LAS unsigned char* vld = lds + KT_BYTES + ((4 * g4 + (c16 >> 2)) * VST + 4 * (c16 & 3)) * 2;
#define GLD(it) do { kr[0] = *(const u32x4*)(kg + (size_t)(64 * (it)) * AW); kr[1] = *(const u32x4*)(kg + (size_t)(64 * (it) + 32) * AW); vr[0] = *(const u32x4*)(vg + (size_t)(64 * (it)) * AW); vr[1] = *(const u32x4*)(vg + (size_t)(64 * (it) + 32) * AW); } while (0)
#define LST(b) do { *(LAS u32x4*)(kst + (b) * AT_BUF) = kr[0]; *(LAS u32x4*)(kst + (b) * AT_BUF + 32 * KST * 2) = kr[1]; *(LAS u32x4*)(vst + (b) * AT_BUF) = vr[0]; *(LAS u32x4*)(vst + (b) * AT_BUF + 32 * VST * 2) = vr[1]; } while (0)
    GLD(0); LST(0);
    __syncthreads();
#pragma nounroll
    for (int it = 0; it < 4; ++it) {
        const int kp0 = kvb * MB + 64 * it; const int b = it & 1;
        if (it + 1 < 4) GLD(it + 1);
        if (wave_valid && (!own || kp0 <= qfirst + 31)) {
            const LAS unsigned char* Kb = kld + b * AT_BUF; const LAS unsigned char* vb = vld + b * AT_BUF;
            f32x4 st[2][4];
#pragma unroll
            for (int mt = 0; mt < 4; ++mt) { st[0][mt] = (f32x4){0.f, 0.f, 0.f, 0.f}; st[1][mt] = st[0][mt];
#pragma unroll
                for (int ks = 0; ks < 4; ++ks) { const bf16x8 kf = *(const LAS bf16x8*)(Kb + (16 * mt * KST + 32 * ks) * 2);
                    st[0][mt] = __builtin_amdgcn_mfma_f32_16x16x32_bf16(kf, qf[0][ks], st[0][mt], 0, 0, 0);
                    st[1][mt] = __builtin_amdgcn_mfma_f32_16x16x32_bf16(kf, qf[1][ks], st[1][mt], 0, 0, 0); } }
            bf16x8 pf[2][2];
#pragma unroll
            for (int g = 0; g < 2; ++g) {
                if (own && kp0 + 63 > qfirst + 16 * g) {
#pragma unroll
                    for (int mt = 0; mt < 4; ++mt)
#pragma unroll
                        for (int rg = 0; rg < 4; ++rg) { const int kpos = kp0 + 16 * mt + 4 * g4 + rg; st[g][mt][rg] = (kpos <= myq[g]) ? st[g][mt][rg] : -1e30f; }
                }
                float mloc = fmaxf(fmaxf(fmaxf(st[g][0][0], st[g][0][1]), fmaxf(st[g][0][2], st[g][0][3])), fmaxf(fmaxf(st[g][1][0], st[g][1][1]), fmaxf(st[g][1][2], st[g][1][3])));
                mloc = fmaxf(mloc, fmaxf(fmaxf(fmaxf(st[g][2][0], st[g][2][1]), fmaxf(st[g][2][2], st[g][2][3])), fmaxf(fmaxf(st[g][3][0], st[g][3][1]), fmaxf(st[g][3][2], st[g][3][3]))));
                mloc = fmaxf(mloc, __shfl_xor(mloc, 16)); mloc = fmaxf(mloc, __shfl_xor(mloc, 32));
                const float mnew = fmaxf(mrun[g], mloc * sc2); const float alpha = __builtin_amdgcn_exp2f(mrun[g] - mnew); mrun[g] = mnew;
                float psum = 0.f;
#pragma unroll
                for (int mt = 0; mt < 4; ++mt)
#pragma unroll
                    for (int rg = 0; rg < 4; ++rg) { const float p = __builtin_amdgcn_exp2f(fmaf(st[g][mt][rg], sc2, -mnew)); st[g][mt][rg] = p; psum += p; }
                lrun[g] = lrun[g] * alpha + psum;
#pragma unroll
                for (int dt = 0; dt < 8; ++dt) oacc[g][dt] = oacc[g][dt] * alpha;
#pragma unroll
                for (int s = 0; s < 2; ++s) { u32x4 w; w.x = pk2(st[g][2 * s][0], st[g][2 * s][1]); w.y = pk2(st[g][2 * s][2], st[g][2 * s][3]); w.z = pk2(st[g][2 * s + 1][0], st[g][2 * s + 1][1]); w.w = pk2(st[g][2 * s + 1][2], st[g][2 * s + 1][3]);
                    pf[g][s] = __builtin_bit_cast(bf16x8, w); }
            }
#pragma unroll
            for (int dt = 0; dt < 8; ++dt)
#pragma unroll
                for (int s = 0; s < 2; ++s) {
                    const s16x4 lo = __builtin_amdgcn_ds_read_tr16_b64_v4i16((LAS s16x4*)(vb + (32 * s * VST + 16 * dt) * 2));
                    const s16x4 hi = __builtin_amdgcn_ds_read_tr16_b64_v4i16((LAS s16x4*)(vb + ((32 * s + 16) * VST + 16 * dt) * 2));
                    bf16x8 vf; vf[0] = lo[0]; vf[1] = lo[1]; vf[2] = lo[2]; vf[3] = lo[3]; vf[4] = hi[0]; vf[5] = hi[1]; vf[6] = hi[2]; vf[7] = hi[3];
                    oacc[0][dt] = __builtin_amdgcn_mfma_f32_16x16x32_bf16(vf, pf[0][s], oacc[0][dt], 0, 0, 0);
                    oacc[1][dt] = __builtin_amdgcn_mfma_f32_16x16x32_bf16(vf, pf[1][s], oacc[1][dt], 0, 0, 0); }
        }
        if (it + 1 < 4) LST(b ^ 1);
        __syncthreads();
    }
#undef GLD
#undef LST
#pragma unroll
    for (int g = 0; g < 2; ++g) {
        float l = lrun[g]; l += __shfl_xor(l, 16); l += __shfl_xor(l, 32);
        if (valid[g] && wave_valid) {
            int slot = 0; if (!own) { const unsigned mk = A.mask[head * S + myq[g]]; slot = 1 + __builtin_popcount(mk & ((1u << kvb) - 1u)); }
            const size_t pidx = ((size_t)(head * S + myq[g])) * 4 + slot;
            const float inv = 1.0f / l;
            bf16* orow = A.part + pidx * AD + 4 * g4;
#pragma unroll
            for (int dt = 0; dt < 8; ++dt) { u32x2 w; w.x = pk2(oacc[g][dt][0] * inv, oacc[g][dt][1] * inv); w.y = pk2(oacc[g][dt][2] * inv, oacc[g][dt][3] * inv); *(u32x2*)(orow + 16 * dt) = w; }
            if (g4 == 0) { A.ml[pidx * 2] = mrun[g]; A.ml[pidx * 2 + 1] = l; }
        }
    }
}
__device__ __forceinline__ void moba_items(LAS unsigned char* lds, const AttnBufs& A, int* qhead, LAS int* pre, LAS int* tick, int tid, int lane, int wave) {
    const int nitems = AH * NB + pre[256];
    if (tid == 0) tick[0] = atomicAdd(qhead, 1);
    __syncthreads();
    int item = tick[0];
    while (item < nitems) {
        __syncthreads();
        if (tid == 0) tick[0] = atomicAdd(qhead, 1);
        if (item < AH * NB) moba_item2(lds, A, item >> 5, item & 31, true, 0, 0, tid, lane, wave);
        else { const int s = item - AH * NB; int lo_ = 0, hi_ = 256;
            while (hi_ - lo_ > 1) { const int mid = (lo_ + hi_) >> 1; if (pre[mid] <= s) lo_ = mid; else hi_ = mid; }
            moba_item2(lds, A, lo_ >> 5, lo_ & 31, false, s - pre[lo_], A.cnt[lo_], tid, lane, wave); }
        __syncthreads();
        item = tick[0];
    }
}

constexpr int RST = 72, SLOTB = 64 * RST * 2;
constexpr int NCH = S / 64;
__device__ __forceinline__ bf16x8 frag_rows(const LAS bf16* M, int r0, int k0, int c16, int g4) { return *(const LAS bf16x8*)(M + (r0 + c16) * RST + k0 + 8 * g4); }
__device__ __forceinline__ bf16x8 frag_cols(const LAS bf16* M, int c0, int k0, int c16, int g4) {
    const unsigned base = (unsigned)(size_t)M; const int tq = c16 >> 2, tp = c16 & 3;
    const s16x4 lo = tr_read4(base + ((k0 + 8 * g4 + tq) * RST + c0 + 4 * tp) * 2);
    const s16x4 hi = tr_read4(base + ((k0 + 8 * g4 + 4 + tq) * RST + c0 + 4 * tp) * 2);
    bf16x8 r; r[0] = lo[0]; r[1] = lo[1]; r[2] = lo[2]; r[3] = lo[3]; r[4] = hi[0]; r[5] = hi[1]; r[6] = hi[2]; r[7] = hi[3]; return r;
}
__device__ __forceinline__ void st_tile(LAS bf16* M, const f32x4 v, int r0, int c0, int c16, int g4) {
#pragma unroll
    for (int rg = 0; rg < 4; rg += 2) { const unsigned p = pk2(v[rg], v[rg + 1]); M[(r0 + 4 * g4 + rg) * RST + c0 + c16] = (bf16)(p & 0xffffu); M[(r0 + 4 * g4 + rg + 1) * RST + c0 + c16] = (bf16)(p >> 16); }
}
#define MFMA16(a, b, c) __builtin_amdgcn_mfma_f32_16x16x32_bf16(a, b, c, 0, 0, 0)

struct RwkvBufs { const float* rkv; const float* lw; const float* av; bf16* P; float* QmT; bf16* Rt; float* Yi; float* bonus; };

#define R1_BAR() do { asm volatile("s_waitcnt lgkmcnt(0)" ::: "memory"); __builtin_amdgcn_s_barrier(); asm volatile("" ::: "memory"); } while (0)
struct R1In { float lwv[8], av[8], rr[9], kr[9], vr[9]; };
__device__ __forceinline__ void rwkv_r1_load(R1In& I, const RwkvBufs& B, int head, int chunk, int lane, int wave) {
    const int ch = head * RN + lane; const int t0 = chunk * 64 + wave * 8;
#pragma unroll
    for (int i = 0; i < 8; ++i) { I.lwv[i] = B.lw[(size_t)(t0 + i) * RW + ch]; I.av[i] = B.av[(size_t)(t0 + i) * RW + ch]; }
#pragma unroll
    for (int i = 0; i < 9; ++i) { const int t = t0 - 1 + i; if (t >= 0) { const float* cr = B.rkv + (size_t)t * (3 * RW) + ch; I.rr[i] = cr[0]; I.kr[i] = cr[RW]; I.vr[i] = cr[2 * RW]; } else { I.rr[i] = 0.f; I.kr[i] = 0.f; I.vr[i] = 0.f; } }
}
__device__ __forceinline__ void rwkv_r1_unit(LAS unsigned char* lds, const RwkvBufs& B, const float* const* in, R1In& I, int head, int chunk, int nhead, int nchunk, int tid, int lane, int wave) {
    LAS bf16* sA = (LAS bf16*)(lds + 0 * SLOTB); LAS bf16* sB = (LAS bf16*)(lds + 1 * SLOTB); LAS bf16* sK = (LAS bf16*)(lds + 2 * SLOTB); LAS bf16* sR = (LAS bf16*)(lds + 3 * SLOTB); LAS bf16* sV = (LAS bf16*)(lds + 4 * SLOTB);
    LAS bf16* sM0 = (LAS bf16*)(lds + 5 * SLOTB); LAS bf16* sM1 = (LAS bf16*)(lds + 6 * SLOTB); LAS bf16* sT0 = (LAS bf16*)(lds + 7 * SLOTB); LAS bf16* sT1 = (LAS bf16*)(lds + 8 * SLOTB);
    LAS bf16* sLak = (LAS bf16*)(lds + 9 * SLOTB); LAS bf16* sMrb = (LAS bf16*)(lds + 10 * SLOTB); LAS bf16* sMrk = (LAS bf16*)(lds + 11 * SLOTB); LAS bf16* sX = (LAS bf16*)(lds + 12 * SLOTB);
    LAS bf16* sW = (LAS bf16*)(lds + 13 * SLOTB); LAS bf16* sU = (LAS bf16*)(lds + 14 * SLOTB);
    LAS float* cs = (LAS float*)(lds + 15 * SLOTB); LAS float* gC = cs + 512;
    const int c16 = lane & 15, g4 = lane >> 4;
    {
        const int ch = head * RN + lane; const int t0 = chunk * 64 + wave * 8;
        const float mur = in[9][ch], muk = in[10][ch], muv = in[11][ch], kkc = in[23][ch], kac = in[24][ch], rkc = in[25][ch];
        float run = 0.f;
#pragma unroll
        for (int i = 0; i < 8; ++i) run += I.lwv[i];
        cs[wave * 64 + lane] = run;
        R1_BAR();
        float off = 0.f;
        for (int w = 0; w < wave; ++w) off += cs[w * 64 + lane];
        float gcur = off;
#pragma unroll
        for (int i = 0; i < 8; ++i) {
            const int t = t0 + i;
            const float r0 = I.rr[i + 1], k0 = I.kr[i + 1], v0 = I.vr[i + 1], rp = I.rr[i], kp = I.kr[i], vp = I.vr[i];
            const float r = r0 + (rp - r0) * mur, kx = k0 + (kp - k0) * muk, vx = v0 + (vp - v0) * muv;
            const float a = I.av[i];
            float kk = kx * kkc; const float ss = wave_sum(kk * kk); kk = kk * __builtin_amdgcn_rcpf(fmaxf(sqrtf(ss), 1e-12f));
            const float kt = kx * (1.0f + (a - 1.0f) * kac);
            const float bn = wave_sum(r * kt * rkc);
            if (lane == 0) B.bonus[(size_t)t * RH + head] = bn;
            const float gprev = gcur; gcur += I.lwv[i];
            const float eg = __expf(gcur), egp = __expf(gprev), eng = __expf(-gcur);
            const int tl = wave * 8 + i;
            { const unsigned pab = pk2(-kk * egp, kk * a * eng), pkr = pk2(kt * eng, r * eg), pv_ = pk2(vx, vx);
              sA[tl * RST + lane] = (bf16)(pab & 0xffffu); sB[tl * RST + lane] = (bf16)(pab >> 16); sK[tl * RST + lane] = (bf16)(pkr & 0xffffu); sR[tl * RST + lane] = (bf16)(pkr >> 16); sV[tl * RST + lane] = (bf16)(pv_ & 0xffffu); }
        }
        if (wave == 7) gC[lane] = __expf(gcur);
    }
    if (nhead >= 0) rwkv_r1_load(I, B, nhead, nchunk, lane, wave);
    R1_BAR();
    const int mt = wave >> 1, ntb = 2 * (wave & 1);
    f32x4 Treg[2];
    for (int r14 = 0; r14 < 1 + REP_R1A; ++r14) {
        f32x4 ab[2], ak[2], rb[2], rk[2];
#pragma unroll
        for (int n = 0; n < 2; ++n) { ab[n] = (f32x4){0.f, 0.f, 0.f, 0.f}; ak[n] = ab[n]; rb[n] = ab[n]; rk[n] = ab[n]; }
#pragma unroll
        for (int s = 0; s < 2; ++s) { const bf16x8 aA = frag_rows(sA, 16 * mt, 32 * s, c16, g4), aR = frag_rows(sR, 16 * mt, 32 * s, c16, g4);
#pragma unroll
            for (int n = 0; n < 2; ++n) { const bf16x8 bB = frag_rows(sB, 16 * (ntb + n), 32 * s, c16, g4), bK = frag_rows(sK, 16 * (ntb + n), 32 * s, c16, g4);
                ab[n] = MFMA16(aA, bB, ab[n]); ak[n] = MFMA16(aA, bK, ak[n]); rb[n] = MFMA16(aR, bB, rb[n]); rk[n] = MFMA16(aR, bK, rk[n]); } }
#pragma unroll
        for (int n = 0; n < 2; ++n) { const int i = 16 * (ntb + n) + c16;
#pragma unroll
            for (int rg = 0; rg < 4; ++rg) { const int t = 16 * mt + 4 * g4 + rg; const bool lo = i < t, le = i <= t;
                ab[n][rg] = lo ? ab[n][rg] : 0.f; ak[n][rg] = lo ? ak[n][rg] : 0.f; rb[n][rg] = le ? rb[n][rg] : 0.f; rk[n][rg] = le ? rk[n][rg] : 0.f;
                Treg[n][rg] = ab[n][rg] + (i == t ? 1.0f : 0.f); }
            st_tile(sM0, ab[n], 16 * mt, 16 * (ntb + n), c16, g4); st_tile(sT0, Treg[n], 16 * mt, 16 * (ntb + n), c16, g4);
            st_tile(sLak, ak[n], 16 * mt, 16 * (ntb + n), c16, g4); st_tile(sMrb, rb[n], 16 * mt, 16 * (ntb + n), c16, g4); st_tile(sMrk, rk[n], 16 * mt, 16 * (ntb + n), c16, g4); }
    }
    R1_BAR();
    LAS bf16* Tc = sT0; LAS bf16* Tn = sT1; LAS bf16* Mc = sM0; LAS bf16* Mn = sM1;
    {
        f32x4 am[2] = {(f32x4){0.f, 0.f, 0.f, 0.f}, (f32x4){0.f, 0.f, 0.f, 0.f}}, ax[2] = {(f32x4){0.f, 0.f, 0.f, 0.f}, (f32x4){0.f, 0.f, 0.f, 0.f}};
#pragma unroll
        for (int s = 0; s < 2; ++s) { const bf16x8 aM = frag_rows(Mc, 16 * mt, 32 * s, c16, g4), aL = frag_rows(sLak, 16 * mt, 32 * s, c16, g4);
#pragma unroll
            for (int n = 0; n < 2; ++n) { am[n] = MFMA16(aM, frag_cols(Mc, 16 * (ntb + n), 32 * s, c16, g4), am[n]); ax[n] = MFMA16(aL, frag_cols(sV, 16 * (ntb + n), 32 * s, c16, g4), ax[n]); } }
#pragma unroll
        for (int n = 0; n < 2; ++n) { st_tile(Mn, am[n], 16 * mt, 16 * (ntb + n), c16, g4); st_tile(sX, ax[n], 16 * mt, 16 * (ntb + n), c16, g4); }
        R1_BAR();
        LAS bf16* t2 = Mc; Mc = Mn; Mn = t2;
    }
    for (int kround = 1; kround <= 5 + REP_R1NR; ++kround) {
        f32x4 am[2] = {(f32x4){0.f, 0.f, 0.f, 0.f}, (f32x4){0.f, 0.f, 0.f, 0.f}};
#pragma unroll
        for (int s = 0; s < 2; ++s) { const bf16x8 aT = frag_rows(Tc, 16 * mt, 32 * s, c16, g4), aM = frag_rows(Mc, 16 * mt, 32 * s, c16, g4);
#pragma unroll
            for (int n = 0; n < 2; ++n) { const bf16x8 bM = frag_cols(Mc, 16 * (ntb + n), 32 * s, c16, g4); Treg[n] = MFMA16(aT, bM, Treg[n]); am[n] = MFMA16(aM, bM, am[n]); } }
#pragma unroll
        for (int n = 0; n < 2; ++n) { st_tile(Tn, Treg[n], 16 * mt, 16 * (ntb + n), c16, g4); st_tile(Mn, am[n], 16 * mt, 16 * (ntb + n), c16, g4); }
        R1_BAR();
        LAS bf16* t1 = Tc; Tc = Tn; Tn = t1; LAS bf16* t2 = Mc; Mc = Mn; Mn = t2;
    }
    for (int rwu = 0; rwu < 1 + REP_R1B; ++rwu) {
        f32x4 aw[2] = {(f32x4){0.f, 0.f, 0.f, 0.f}, (f32x4){0.f, 0.f, 0.f, 0.f}}, au[2] = {(f32x4){0.f, 0.f, 0.f, 0.f}, (f32x4){0.f, 0.f, 0.f, 0.f}};
#pragma unroll
        for (int s = 0; s < 2; ++s) { const bf16x8 aT = frag_rows(Tc, 16 * mt, 32 * s, c16, g4);
#pragma unroll
            for (int n = 0; n < 2; ++n) { aw[n] = MFMA16(aT, frag_cols(sA, 16 * (ntb + n), 32 * s, c16, g4), aw[n]); au[n] = MFMA16(aT, frag_cols(sX, 16 * (ntb + n), 32 * s, c16, g4), au[n]); } }
#pragma unroll
        for (int n = 0; n < 2; ++n) { st_tile(sW, aw[n], 16 * mt, 16 * (ntb + n), c16, g4); st_tile(sU, au[n], 16 * mt, 16 * (ntb + n), c16, g4); }
    }
    R1_BAR();
    for (int rs8 = 0; rs8 < 1 + REP_R1C; ++rs8) {
        const size_t ub = (size_t)(head * NCH + chunk) * 4096;
        f32x4 pp[2], qq[2], rr[2], yy[2];
#pragma unroll
        for (int n = 0; n < 2; ++n) { pp[n] = (f32x4){0.f, 0.f, 0.f, 0.f}; qq[n] = pp[n]; rr[n] = pp[n]; yy[n] = pp[n]; }
#pragma unroll
        for (int s = 0; s < 2; ++s) {
            const bf16x8 cW = frag_cols(sW, 16 * mt, 32 * s, c16, g4), cB = frag_cols(sB, 16 * mt, 32 * s, c16, g4), cK = frag_cols(sK, 16 * mt, 32 * s, c16, g4), cU = frag_cols(sU, 16 * mt, 32 * s, c16, g4), cV = frag_cols(sV, 16 * mt, 32 * s, c16, g4);
#pragma unroll
            for (int n = 0; n < 2; ++n) { const int c0 = 16 * (ntb + n);
                const bf16x8 bB = frag_cols(sB, c0, 32 * s, c16, g4), bU = frag_cols(sU, c0, 32 * s, c16, g4), bV = frag_cols(sV, c0, 32 * s, c16, g4);
                const bf16x8 rMrb = frag_rows(sMrb, c0, 32 * s, c16, g4), rMrk = frag_rows(sMrk, c0, 32 * s, c16, g4);
                pp[n] = MFMA16(cW, bB, pp[n]);
                qq[n] = MFMA16(cB, bU, qq[n]); qq[n] = MFMA16(cK, bV, qq[n]);
                rr[n] = MFMA16(cW, rMrb, rr[n]);
                yy[n] = MFMA16(cU, rMrb, yy[n]); yy[n] = MFMA16(cV, rMrk, yy[n]); } }
#pragma unroll
        for (int n = 0; n < 2; ++n) { const int j = 16 * (ntb + n) + c16; const int i0 = 16 * mt + 4 * g4;
            {
                const float gc = gC[j]; float o[4];
#pragma unroll
                for (int rg = 0; rg < 4; ++rg) o[rg] = gc * (pp[n][rg] + ((i0 + rg) == j ? 1.0f : 0.f));
                u32x2 w; w.x = pk2(o[0], o[1]); w.y = pk2(o[2], o[3]); *(u32x2*)(B.P + ub + (size_t)j * 64 + i0) = w; }
            {
                f32x4 o;
#pragma unroll
                for (int rg = 0; rg < 4; ++rg) o[rg] = gC[i0 + rg] * qq[n][rg];
                *(f32x4*)(B.QmT + ub + (size_t)j * 64 + i0) = o; }
            {
                const u32x2 rb2 = *(const LAS u32x2*)(sR + j * RST + i0); float o[4];
                o[0] = rr[n][0] + __uint_as_float(rb2.x << 16); o[1] = rr[n][1] + __uint_as_float(rb2.x & 0xffff0000u); o[2] = rr[n][2] + __uint_as_float(rb2.y << 16); o[3] = rr[n][3] + __uint_as_float(rb2.y & 0xffff0000u);
                u32x2 w; w.x = pk2(o[0], o[1]); w.y = pk2(o[2], o[3]); *(u32x2*)(B.Rt + ub + (size_t)j * 64 + i0) = w; }
            *(f32x4*)(B.Yi + ub + (size_t)j * 64 + i0) = yy[n];
        }
    }
    R1_BAR();
}

constexpr int R2_PST = 136, R2_QST = 272, R2_QOFF = 64 * R2_PST, R2_SLOT = R2_QOFF + 16 * R2_QST;
__device__ __forceinline__ void rwkv_r2_wg(LAS unsigned char* lds, const bf16* __restrict__ P, const float* __restrict__ QmT, bf16* __restrict__ H0T, int head, int cg, int wave, int lane) {
    const int c16 = lane & 15, g4 = lane >> 4;
    const int lt = ((wave & 3) << 6) | lane;
#define R2_BAR() do { asm volatile("s_waitcnt lgkmcnt(0)" ::: "memory"); __builtin_amdgcn_s_barrier(); asm volatile("" ::: "memory"); } while (0)
    if (wave >= 4) {
        constexpr int NST = 8;
        u32x4 st[NST][3];
        auto gl = [&](int c, u32x4 (&r)[3]) { const size_t ub = (size_t)(head * NCH + c) * 4096;
            const u32x4* p = (const u32x4*)(P + ub); const u32x4* q = (const u32x4*)(QmT + ub + (size_t)(16 * cg) * 64);
            r[0] = p[lt]; r[1] = p[lt + 256]; r[2] = q[lt]; };
        auto lw = [&](int slot, const u32x4 (&r)[3]) { LAS unsigned char* s = lds + slot * R2_SLOT;
#pragma unroll
            for (int i = 0; i < 2; ++i) { const int idx = lt + 256 * i; LAS u32x2* d = (LAS u32x2*)(s + (idx >> 3) * R2_PST + (idx & 7) * 16); u32x2 a; a.x = r[i].x; a.y = r[i].y; u32x2 b; b.x = r[i].z; b.y = r[i].w; d[0] = a; d[1] = b; }
            *(LAS u32x4*)(s + R2_QOFF + (lt >> 4) * R2_QST + (lt & 15) * 16) = r[2]; };
#pragma unroll
        for (int j = 0; j < NST; ++j) gl(j, st[j]);
        lw(0, st[0]); gl(NST, st[0]);
        R2_BAR();
        for (int c4 = 0; c4 < NCH / NST; ++c4) {
#pragma unroll
            for (int j = 0; j < NST; ++j) { const int c = NST * c4 + j;
                if (c + 1 < NCH) lw((c + 1) & 1, st[(j + 1) % NST]);
                if (c + 1 + NST < NCH) gl(c + 1 + NST, st[(j + 1) % NST]);
                R2_BAR(); }
        }
    } else if (wave == 0) {
        f32x4 hacc[4];
#pragma unroll
        for (int m = 0; m < 4; ++m) hacc[m] = (f32x4){0.f, 0.f, 0.f, 0.f};
        R2_BAR();
        for (int c = 0; c < NCH; ++c) {
            const LAS unsigned char* s = lds + (c & 1) * R2_SLOT; const size_t ub = (size_t)(head * NCH + c) * 4096;
            bf16x8 af[4][2]; f32x4 qv[4];
#pragma unroll
            for (int m = 0; m < 4; ++m) { qv[m] = *(const LAS f32x4*)(s + R2_QOFF + c16 * R2_QST + (16 * m + 4 * g4) * 4);
#pragma unroll
                for (int sx = 0; sx < 2; ++sx) { const LAS unsigned char* pr = s + (16 * m + c16) * R2_PST + (32 * sx + 4 * g4) * 2; const u32x2 a = *(const LAS u32x2*)pr, b = *(const LAS u32x2*)(pr + 32);
                    u32x4 w; w.x = a.x; w.y = a.y; w.z = b.x; w.w = b.y; af[m][sx] = __builtin_bit_cast(bf16x8, w); } }
            bf16x8 bfr[2];
#pragma unroll
            for (int sx = 0; sx < 2; ++sx) { u32x4 w; w.x = pk2(hacc[2 * sx][0], hacc[2 * sx][1]); w.y = pk2(hacc[2 * sx][2], hacc[2 * sx][3]); w.z = pk2(hacc[2 * sx + 1][0], hacc[2 * sx + 1][1]); w.w = pk2(hacc[2 * sx + 1][2], hacc[2 * sx + 1][3]);
                bfr[sx] = __builtin_bit_cast(bf16x8, w);
                u32x2 h0; h0.x = w.x; h0.y = w.y; *(u32x2*)(H0T + ub + (size_t)(16 * cg + c16) * 64 + 16 * (2 * sx) + 4 * g4) = h0;
                u32x2 h1; h1.x = w.z; h1.y = w.w; *(u32x2*)(H0T + ub + (size_t)(16 * cg + c16) * 64 + 16 * (2 * sx + 1) + 4 * g4) = h1; }
#pragma unroll
            for (int m = 0; m < 4; ++m) { hacc[m] = MFMA16(af[m][0], bfr[0], qv[m]); hacc[m] = MFMA16(af[m][1], bfr[1], hacc[m]); }
            R2_BAR();
        }
    } else {
        for (int c = 0; c <= NCH; ++c) R2_BAR();
    }
#undef R2_BAR
}

__device__ __forceinline__ void rwkv_r3_wave(const RwkvBufs& B, const bf16* __restrict__ H0T, const float* const* in, const float* __restrict__ gv, bf16* __restrict__ ocat, int head, int chunk, int nt, int lane) {
    const int c16 = lane & 15, g4 = lane >> 4; const size_t ub = (size_t)(head * NCH + chunk) * 4096;
    const int t = chunk * 64 + 16 * nt + c16;
    bf16x8 rf[2], hf[4][2]; f32x4 y[4], gw[4], gb[4], muv[4], gg[4], v0[4], vp[4];
#pragma unroll
    for (int s = 0; s < 2; ++s) rf[s] = *(const bf16x8*)(B.Rt + ub + (size_t)(16 * nt + c16) * 64 + 32 * s + 8 * g4);
#pragma unroll
    for (int m = 0; m < 4; ++m) { y[m] = *(const f32x4*)(B.Yi + ub + (size_t)(16 * nt + c16) * 64 + 16 * m + 4 * g4);
#pragma unroll
        for (int s = 0; s < 2; ++s) hf[m][s] = *(const bf16x8*)(H0T + ub + (size_t)(16 * m + c16) * 64 + 32 * s + 8 * g4); }
    const float bn = B.bonus[(size_t)t * RH + head];
#pragma unroll
    for (int m = 0; m < 4; ++m) { const int ch = head * RN + 16 * m + 4 * g4;
        gw[m] = *(const f32x4*)(in[26] + ch); gb[m] = *(const f32x4*)(in[27] + ch); muv[m] = *(const f32x4*)(in[11] + ch); gg[m] = *(const f32x4*)(gv + (size_t)t * RW + ch);
        v0[m] = *(const f32x4*)(B.rkv + (size_t)t * (3 * RW) + 2 * RW + ch); vp[m] = (f32x4){0.f, 0.f, 0.f, 0.f}; if (t > 0) vp[m] = *(const f32x4*)(B.rkv + (size_t)(t - 1) * (3 * RW) + 2 * RW + ch); }
    float s1 = 0.f;
#pragma unroll
    for (int m = 0; m < 4; ++m) {
#pragma unroll
        for (int s = 0; s < 2; ++s) y[m] = MFMA16(hf[m][s], rf[s], y[m]);
        s1 += (y[m][0] + y[m][1]) + (y[m][2] + y[m][3]); }
    s1 += __shfl_xor(s1, 16); s1 += __shfl_xor(s1, 32);
    const float mean = s1 * (1.0f / 64.0f); float s2 = 0.f;
#pragma unroll
    for (int m = 0; m < 4; ++m) { y[m] = y[m] - mean; s2 += (y[m][0] * y[m][0] + y[m][1] * y[m][1]) + (y[m][2] * y[m][2] + y[m][3] * y[m][3]); }
    s2 += __shfl_xor(s2, 16); s2 += __shfl_xor(s2, 32);
    const float rstd = rsqrtf(s2 * (1.0f / 64.0f) + 64e-5f);
#pragma unroll
    for (int m = 0; m < 4; ++m) { const int ch = head * RN + 16 * m + 4 * g4;
        const f32x4 vx = v0[m] + (vp[m] - v0[m]) * muv[m];
        const f32x4 o = (y[m] * rstd * gw[m] + gb[m] + vx * bn) * gg[m];
        u32x2 w; w.x = pk2(o[0], o[1]); w.y = pk2(o[2], o[3]); *(u32x2*)(ocat + (size_t)t * (2 * RW) + RW + ch) = w; }
}
template <int WHICH> struct Lora2Order { static constexpr bool GATHER = false; const int* tok; int G, c;
    __device__ bool next(int i, pg8::Unit& u) const { const int L = i * G + c; if (L >= (S / 128) * 4) return false; u.pm = L >> 2; u.pn = WHICH * 4 + (L & 3); u.koff = WHICH * 512; u.koffB = 0; return true; }
    __device__ __forceinline__ void a_ready(const pg8::Unit&) const {}
    __device__ __forceinline__ void done(const pg8::Unit&) const {} };
template <int WHICH> struct EpiLora2 {
    static constexpr bool PERM = true, AFTER_DRAIN = false, MIDK = false;
    float* dst; const float* bias;
    __device__ __forceinline__ void operator()(const pg8::f32x4 (&acc)[2][2][4][2], const pg8::Unit& u, int wr, int wc, int fr, int fq) const {
        const int row0 = u.pm * 128 + wr * 64 + fr; const int col0 = (u.pn & 3) * 256 + wc * 32 + 8 * fq;
#pragma unroll
        for (int ai = 0; ai < 1; ++ai)
#pragma unroll
            for (int m = 0; m < 4; ++m) { float* p = dst + (size_t)(row0 + ai * 128 + m * 16) * RW + col0;
#pragma unroll
                for (int bj = 0; bj < 2; ++bj) { f32x4 v0 = acc[ai][bj][m][0], v1 = acc[ai][bj][m][1];
                    if (WHICH < 2) { const f32x4 b0 = *(const f32x4*)(bias + col0 + bj * 128), b1 = *(const f32x4*)(bias + col0 + bj * 128 + 4);
#pragma unroll
                        for (int j = 0; j < 4; ++j) { v0[j] = sigmoidf_(v0[j] + b0[j]); v1[j] = sigmoidf_(v1[j] + b1[j]); }
                        if (WHICH == 0) { v0 = v0 * -0.60653065971263342f; v1 = v1 * -0.60653065971263342f; } }
                    *(f32x4*)(p + bj * 128) = v0; *(f32x4*)(p + bj * 128 + 4) = v1; } }
    }
};

__global__ void __launch_bounds__(NTHR, 2) fwd(Args args) {
    extern __shared__ __attribute__((aligned(16))) unsigned char lds_raw[];
    LAS unsigned char* lds = (LAS unsigned char*)lds_raw;
    const int wave = __builtin_amdgcn_readfirstlane(threadIdx.x >> 6);
    const int G = gridDim.x, wg = blockIdx.x;
    unsigned char* ws = args.ws;
    unsigned* ctl = (unsigned*)(ws + WS_CTL);
    if (threadIdx.x < 4) ((LAS unsigned*)(lds + LDSCTL_OFF))[threadIdx.x] = 0u;
    __syncthreads();
    XcdBarrier bar = xcd_barrier_post(ctl + CW_BAR, (volatile LAS unsigned*)(lds + LDSCTL_OFF));
    const int lo = args.ph_lo, hi = args.ph_hi;
#define IN(k) (lo <= (k) && (k) < hi)
#define PH(k) for (int rep_ = 0; rep_ < ((k) == REP_PHASE ? 1 + REP_N : 1); ++rep_) if (IN(k))
#define SEAM(k) do { if (IN(k) && IN((k) + 1)) xcd_barrier(bar); } while (0)
#define ROUTE_TABLE() do { LAS int* tb_ = (LAS int*)(lds + RT_OFF); \
        if (tid < 64) { const int c_ = ((const int*)ctl)[CW_CNT + tid]; const int nt_ = (c_ + 127) >> 7; int o_ = nt_; \
            _Pragma("unroll") for (int d_ = 1; d_ < 64; d_ <<= 1) { const int t_ = __shfl_up(o_, d_); if (tid >= d_) o_ += t_; } \
            const int first_ = o_ - nt_; tb_[tid] = c_; tb_[64 + tid] = first_ * 128; \
            for (int t_ = 0; t_ < nt_; ++t_) { tb_[128 + first_ + t_] = tid; tb_[320 + first_ + t_] = t_ * 128; } \
            if (tid == 63) tb_[512] = o_; } \
        __syncthreads(); } while (0)
    const int gw = wg * NWAVES + wave, NGW = G * NWAVES;

    const float* x = args.in[0];
    float* ada = (float*)(ws + WS_ADA); float* rope = (float*)(ws + WS_ROPE);
    bf16* h = (bf16*)(ws + WS_H); bf16* W1t = (bf16*)(ws + WS_W1T); bf16* Wupt = (bf16*)(ws + WS_WUPT); bf16* Wot = (bf16*)(ws + WS_WOT);
    unsigned char* Wgut = ws + WS_WGUT; unsigned char* Wdt = ws + WS_WDT;

    PH(0) { const int lane = lane_fresh(); const int tid = (wave << 6) | lane; (void)tid; (void)lane;
        {
            const float* c = args.in[1]; const float* w_ada = args.in[2]; const float* b_ada = args.in[3];
            LAS float* red = (LAS float*)lds;
            for (int u = wg; u < 6 * D / 64; u += G) {
                const int n = u * 64 + lane; float s = 0.f;
#pragma unroll 8
                for (int kq = wave; kq < D; kq += NWAVES) s += c[kq] * w_ada[(size_t)kq * (6 * D) + n];
                red[wave * 64 + lane] = s;
                __syncthreads();
                if (wave == 0) { float t = b_ada[n]; for (int w = 0; w < NWAVES; ++w) t += red[w * 64 + lane];
                    __hip_atomic_store(ada + n, t, __ATOMIC_RELAXED, __HIP_MEMORY_SCOPE_AGENT);
                    asm volatile("s_waitcnt vmcnt(0)" ::: "memory");
                    if (lane == 0) (void)xb_add(ctl + CW_ADA, 1u); }
                __syncthreads();
            }
        }
        for (int i = wg * NTHR + tid; i < S * 16; i += G * NTHR) {
            const int pos = i >> 4, j = i & 15; const float inv = powf(500000.0f, -(float)j / 16.0f); const float ang = (float)pos * inv;
            rope[2 * i] = cosf(ang); rope[2 * i + 1] = sinf(ang);
        }
        for (int i = wg * NTHR + tid; i < 128 * D / 8; i += G * NTHR) ((u32x4*)(W1t + (size_t)(N1 - 128) * D))[i] = (u32x4){0u, 0u, 0u, 0u};
        {
            bf16* wrh = (bf16*)(ws + WS_WR); bf16* wrl = wrh + 80 * D; const float* w_rg = args.in[31]; const float* w_re = args.in[33];
            for (int i = wg * NTHR + tid; i < 80 * D; i += G * NTHR) { const int n = i / D, kq = i % D; const float v = n < NG ? w_rg[kq * NG + n] : (n < NG + NE ? w_re[kq * NE + n - NG] : 0.f);
                const bf16 hi = f2bf(v); wrh[i] = hi; wrl[i] = f2bf(v - bf2f(hi)); }
        }
        {
            bf16* wl2 = (bf16*)(ws + WS_WL2); const float* w_w2 = args.in[17]; const float* w_a2 = args.in[20]; const float* w_g2 = args.in[22];
            for (int i = wg * NTHR + tid; i < 3 * RW * 256; i += G * NTHR) { const int n = i >> 8, kq = i & 255, which = n / RW, cc = n % RW; float v = 0.f;
                if (which == 0) { if (kq < LW) v = w_w2[kq * RW + cc]; } else if (which == 1) { if (kq < LA) v = w_a2[kq * RW + cc]; } else v = w_g2[kq * RW + cc];
                wl2[i] = f2bf(v); }
        }
        LAS float* scr = (LAS float*)(lds + wave * 16384);
        constexpr int I_W = (D / 64) * (LW / 32), I_A = (D / 64) * (LA / 32), I_G = (D / 64) * (LG / 32);
        constexpr int NIT = 2 * (I_W + I_A + I_G);
        for (int it = gw; it < NIT; it += NGW) {
            int r = it, k0, n0;
            if (r < 2 * I_W) { const int md = 1 + r / I_W; item_kn(r % I_W, LW, k0, n0); tr_item(args.in[16], LW, k0, n0, W1t + (size_t)(INW + (md - 1) * LO + n0) * D + k0, D, args.in[12], md, scr, lane); continue; } r -= 2 * I_W;
            if (r < 2 * I_A) { const int md = 1 + r / I_A; item_kn(r % I_A, LA, k0, n0); tr_item(args.in[19], LA, k0, n0, W1t + (size_t)(INW + (md - 1) * LO + LW + n0) * D + k0, D, args.in[13], md, scr, lane); continue; } r -= 2 * I_A;
            const int md = 1 + r / I_G; item_kn(r % I_G, LG, k0, n0); tr_item(args.in[21], LG, k0, n0, W1t + (size_t)(INW + (md - 1) * LO + LW + LA + n0) * D + k0, D, args.in[14], md, scr, lane);
        }
        __syncthreads();
        {
            const int lr = tid >> 5, c4 = tid & 31, nl = lane & 15, kq = lane >> 4, ncol = 16 * wave + nl;
            f32x4 v[8]; int T = wg;
            if (T < CT_ALL) { const ConvTile t = conv_decode(T, args.in, ws);
#pragma unroll
                for (int i = 0; i < 8; ++i) v[i] = *(const f32x4*)(t.src + (size_t)(lr + 16 * i) * t.ldw + 4 * c4); }
            for (int itc = 0; T < CT_ALL; T += G, ++itc) {
                LAS float* buf = (LAS float*)(lds + (itc & 1) * 69632);
#pragma unroll
                for (int i = 0; i < 8; ++i) *(LAS f32x4*)(buf + conv_off(lr + 16 * i, 4 * c4)) = v[i];
                const ConvTile t = conv_decode(T, args.in, ws);
                if (T + G < CT_ALL) { const ConvTile tn = conv_decode(T + G, args.in, ws);
#pragma unroll
                    for (int i = 0; i < 8; ++i) v[i] = *(const f32x4*)(tn.src + (size_t)(lr + 16 * i) * tn.ldw + 4 * c4); }
                R1_BAR();
                float xv[32];
#pragma unroll
                for (int j = 0; j < 32; ++j) xv[j] = buf[conv_off(32 * kq + j, ncol)];
                if (t.kind) { unsigned char* d = t.dst + (size_t)ncol * t.rs + 32 * kq;
                    u32x4 o0, o1; o0.x = pk_fp8x4(xv[0], xv[1], xv[2], xv[3], t.sc); o0.y = pk_fp8x4(xv[4], xv[5], xv[6], xv[7], t.sc); o0.z = pk_fp8x4(xv[8], xv[9], xv[10], xv[11], t.sc); o0.w = pk_fp8x4(xv[12], xv[13], xv[14], xv[15], t.sc);
                    o1.x = pk_fp8x4(xv[16], xv[17], xv[18], xv[19], t.sc); o1.y = pk_fp8x4(xv[20], xv[21], xv[22], xv[23], t.sc); o1.z = pk_fp8x4(xv[24], xv[25], xv[26], xv[27], t.sc); o1.w = pk_fp8x4(xv[28], xv[29], xv[30], xv[31], t.sc);
                    *(u32x4*)d = o0; *(u32x4*)(d + 16) = o1; }
                else { unsigned char* d = t.dst + (size_t)ncol * t.rs + 64 * kq;
#pragma unroll
                    for (int q = 0; q < 4; ++q) { u32x4 o; o.x = pk2(xv[8 * q], xv[8 * q + 1]); o.y = pk2(xv[8 * q + 2], xv[8 * q + 3]); o.z = pk2(xv[8 * q + 4], xv[8 * q + 5]); o.w = pk2(xv[8 * q + 6], xv[8 * q + 7]); *(u32x4*)(d + 16 * q) = o; } }
            }
            __syncthreads();
        }
        {
            if (tid == 0) { XB_SPIN(xb_ld(ctl + CW_ADA) < (unsigned)(6 * D / 64), bar.bar); __builtin_amdgcn_fence(__ATOMIC_ACQUIRE, "agent"); asm volatile("s_waitcnt vmcnt(0)" ::: "memory"); }
            __syncthreads();
        const float* g = args.in[4]; const float* sh1 = ada; const float* sc1 = ada + D;
        f32x4 gs[8], sh[8];
#pragma unroll
        for (int j = 0; j < 8; ++j) { const int c = 4 * lane + 256 * j; const f32x4 gg = *(const f32x4*)(g + c), ss = *(const f32x4*)(sc1 + c); gs[j] = gg * (ss + 1.0f); sh[j] = *(const f32x4*)(sh1 + c); }
        for (int rb = gw; rb < S; rb += 2 * NGW) {
            f32x4 v[2][8]; float s[2] = {0.f, 0.f};
#pragma unroll
            for (int q = 0; q < 2; ++q) { const f32x4* xr = (const f32x4*)(x + (size_t)(rb + q * NGW) * D) + lane;
#pragma unroll
                for (int j = 0; j < 8; ++j) v[q][j] = xr[64 * j]; }
#pragma unroll
            for (int q = 0; q < 2; ++q)
#pragma unroll
                for (int j = 0; j < 8; ++j) s[q] += (v[q][j].x * v[q][j].x + v[q][j].y * v[q][j].y) + (v[q][j].z * v[q][j].z + v[q][j].w * v[q][j].w);
            float r[2]; r[0] = rsqrtf(wave_sum(s[0]) * (1.0f / D) + 1e-6f); r[1] = rsqrtf(wave_sum(s[1]) * (1.0f / D) + 1e-6f);
#pragma unroll
            for (int q = 0; q < 2; ++q) { u32x2* o = (u32x2*)(h + (size_t)(rb + q * NGW) * D) + lane;
#pragma unroll
                for (int j = 0; j < 8; ++j) { const f32x4 t = v[q][j] * r[q] * gs[j] + sh[j]; u32x2 w; w.x = pk2(t.x, t.y); w.y = pk2(t.z, t.w); o[64 * j] = w; } }
        }

        }
    }
    SEAM(0);
    PH(2) { const int lane = lane_fresh(); const int tid = (wave << 6) | lane; (void)tid; (void)lane;
        EpiProj E{(bf16*)(ws + WS_Q), (bf16*)(ws + WS_K), (bf16*)(ws + WS_V), (float*)(ws + WS_RKV), (bf16*)(ws + WS_GATE), (float*)(ws + WS_LORA), (float*)(ws + WS_LORAB), rope};
        { pg8::Gemm g{h, W1t, S, INW, D, D, D}; pg8::StaticOrder So; So.init(S, INW, G, wg);
          pg8::gemm_phase<EpiProj, pg8::StaticOrder, true, true>(lds, g, So, E); }
        { int ld_ = D; asm volatile("" : "+s"(ld_)); pg8::Gemm g{h, W1t, S, N1, AW, ld_, ld_}; LoraOrder So{nullptr, G, wg};
          pg8::gemm_phase<EpiProj, LoraOrder, true, true>(lds, g, So, E); }
    }
    SEAM(2);

    bf16* qb = (bf16*)(ws + WS_Q); bf16* kb = (bf16*)(ws + WS_K); bf16* vb = (bf16*)(ws + WS_V);
    bf16* kmh = (bf16*)(ws + WS_KMEAN); bf16* kml = kmh + AH * NB * AD;
    AttnBufs AB{qb, kb, vb, kmh, kml, (unsigned*)(ws + WS_AMASK), (int*)(ws + WS_ALIST), (int*)ctl + CW_ACNT, (bf16*)(ws + WS_APART), (float*)(ws + WS_AML)};
    PH(3) { const int lane = lane_fresh(); const int tid = (wave << 6) | lane; (void)tid; (void)lane;
        for (int hb = wg; hb < AH * NB; hb += G) { const int hd = hb / NB, bk = hb % NB; LAS float* red = (LAS float*)lds;
            float s0 = 0.f, s1 = 0.f; const unsigned* src = (const unsigned*)(kb + (size_t)(bk * MB + wave * 32) * AW + hd * AD) + lane;
#pragma unroll 8
            for (int r = 0; r < 32; ++r) { const unsigned w2 = src[(size_t)r * (AW / 2)]; s0 += __uint_as_float(w2 << 16); s1 += __uint_as_float(w2 & 0xffff0000u); }
            red[wave * 128 + 2 * lane] = s0; red[wave * 128 + 2 * lane + 1] = s1;
            __syncthreads();
            if (tid < AD) { float s = 0.f;
#pragma unroll
                for (int w = 0; w < 8; ++w) s += red[w * 128 + tid];
                s *= (1.0f / MB); const bf16 hi = f2bf(s); kmh[hb * AD + tid] = hi; kml[hb * AD + tid] = f2bf(s - bf2f(hi)); }
            __syncthreads();
        }
        {
            const float* lora = (const float*)(ws + WS_LORA); bf16* al2 = (bf16*)(ws + WS_AL2);
#pragma unroll 4
            for (int i = wg * NTHR + tid; i < S * 768; i += G * NTHR) { const int t = i / 768, j = i % 768, which = j >> 8, jj = j & 255; float v = 0.f;
                const int src = which == 0 ? jj : (which == 1 ? LW + jj : LW + LA + jj); const bool real = which == 2 || jj < LW;
                if (real) { const float* lb = (const float*)(ws + WS_LORAB); v = lora[(size_t)t * 1024 + src] + lb[(size_t)t * 1024 + src] + (t > 0 ? lora[(size_t)(t - 1) * 1024 + LO + src] + lb[(size_t)(t - 1) * 1024 + LO + src] : 0.f); if (which == 0) v = 1.0f - 2.0f / (1.0f + __expf(2.0f * v)); else if (which == 2) v = sigmoidf_(v); }
                al2[i] = f2bf(v); }
        }
    }
    SEAM(3);
    PH(4) { const int lane = lane_fresh(); const int tid = (wave << 6) | lane; (void)tid; (void)lane;
#define L2CALL(W, DST, BIAS, CID) { int lda_ = 768; asm volatile("" : "+s"(lda_)); pg8::Gemm g{(const bf16*)(ws + WS_AL2), (const bf16*)(ws + WS_WL2), S, 3 * RW, 256, lda_, 256}; \
            Lora2Order<W> So{nullptr, G, CID}; EpiLora2<W> E{DST, BIAS}; pg8::gemm_phase<EpiLora2<W>, Lora2Order<W>, true, true, 0, true>(lds, g, So, E); }
        L2CALL(0, (float*)(ws + WS_LW), args.in[15], wg)
        L2CALL(1, (float*)(ws + WS_A), args.in[18], wg)
        L2CALL(2, (float*)(ws + WS_G), nullptr, wg)
#undef L2CALL
        for (int u = wg; u < AH * 64; u += G) moba_select_unit(lds, AB, u >> 6, u & 63, tid, lane, wave);
    }
    SEAM(4);
    RwkvBufs RB{(const float*)(ws + WS_RKV), (const float*)(ws + WS_LW), (const float*)(ws + WS_A), (bf16*)(ws + WS_RWP), (float*)(ws + WS_RWQ), (bf16*)(ws + WS_RWR), (float*)(ws + WS_RWY), (float*)(ws + WS_RWB)};
    bf16* H0T = (bf16*)(ws + WS_RWH);
    PH(5) { const int lane = lane_fresh(); const int tid = (wave << 6) | lane; (void)tid; (void)lane; R1In I; if (wg < RH * NCH) rwkv_r1_load(I, RB, wg / NCH, wg % NCH, lane, wave);
        for (int u = wg; u < RH * NCH; u += G) { const int un = u + G; rwkv_r1_unit(lds, RB, args.in, I, u / NCH, u % NCH, un < RH * NCH ? un / NCH : -1, un % NCH, tid, lane, wave); } }
    SEAM(5);
    PH(7) { const int lane = lane_fresh(); const int tid = (wave << 6) | lane; (void)tid; (void)lane;
        if (wg < RH * 4) { for (int rsc = 0; rsc < 1 + REP_SCAN; ++rsc) { rwkv_r2_wg(lds, RB.P, RB.QmT, H0T, wg >> 2, wg & 3, wave, lane); __syncthreads(); } }
        LAS int* pre = (LAS int*)(lds + AT_ITEMS); LAS int* tick = pre + 260;
        if (tid < 256) pre[1 + tid] = (AB.cnt[tid] + 255) >> 8;
        __syncthreads();
        if (wave == 0) {
            int v0 = pre[1 + 4 * lane], v1 = pre[2 + 4 * lane], v2 = pre[3 + 4 * lane], v3 = pre[4 + 4 * lane]; v1 += v0; v2 += v1; v3 += v2; int tot = v3;
#pragma unroll
            for (int o = 1; o < 64; o <<= 1) { const int t = __shfl_up(tot, o); if (lane >= o) tot += t; }
            const int ex = tot - v3; pre[1 + 4 * lane] = ex + v0; pre[2 + 4 * lane] = ex + v1; pre[3 + 4 * lane] = ex + v2; pre[4 + 4 * lane] = ex + v3;
            if (lane == 0) pre[0] = 0; }
        __syncthreads();
        moba_items(lds, AB, (int*)ctl + CW_AQ + rep_, pre, tick, tid, lane, wave);
    }
    SEAM(7);
    PH(8) { const int lane = lane_fresh(); const int tid = (wave << 6) | lane; (void)tid; (void)lane; for (int u = wg * 2 + (wave >> 2); u < RH * NCH; u += 2 * G) rwkv_r3_wave(RB, H0T, args.in, (const float*)(ws + WS_G), (bf16*)(ws + WS_OCAT), u / NCH, u % NCH, wave & 3, lane);
#pragma unroll 2
        for (int i = wg * NTHR + tid; i < AH * S * 16; i += G * NTHR) { const int c8 = i & 15, hq = i >> 4, hh = hq / S, qq = hq % S;
            const unsigned mk = AB.mask[hq]; const f32x4 ml0 = *(const f32x4*)(AB.ml + (size_t)hq * 8), ml1 = *(const f32x4*)(AB.ml + (size_t)hq * 8 + 4);
            u32x4 pr[4];
#pragma unroll
            for (int s = 0; s < 4; ++s) pr[s] = *(const u32x4*)(AB.part + ((size_t)hq * 4 + s) * AD + 8 * c8);
            const int ns = 1 + __builtin_popcount(mk);
            const float m_[4] = {ml0[0], ml0[2], ml1[0], ml1[2]}, l_[4] = {ml0[1], ml0[3], ml1[1], ml1[3]};
            float mx = m_[0];
#pragma unroll
            for (int s = 1; s < 4; ++s) mx = (s < ns) ? fmaxf(mx, m_[s]) : mx;
            float wv[4]; float wsum = 0.f;
#pragma unroll
            for (int s = 0; s < 4; ++s) { wv[s] = s < ns ? l_[s] * __builtin_amdgcn_exp2f(m_[s] - mx) : 0.f; wsum += wv[s]; }
            const float inv = 1.0f / wsum; float o[8] = {0.f, 0.f, 0.f, 0.f, 0.f, 0.f, 0.f, 0.f};
#pragma unroll
            for (int s = 0; s < 4; ++s) { float pv[8]; unpack8(pr[s], pv); const float ws_ = wv[s] * inv;
#pragma unroll
                for (int j = 0; j < 8; ++j) o[j] += (s < ns) ? ws_ * pv[j] : 0.f; }
            u32x4 w; w.x = pk2(o[0], o[1]); w.y = pk2(o[2], o[3]); w.z = pk2(o[4], o[5]); w.w = pk2(o[6], o[7]);
            *(u32x4*)((bf16*)(ws + WS_OCAT) + (size_t)qq * (2 * AW) + hh * AD + 8 * c8) = w; }
    }
    SEAM(8);

    bf16* ocat = (bf16*)(ws + WS_OCAT); bf16* gate = (bf16*)(ws + WS_GATE); bf16* mix = (bf16*)(ws + WS_MIX); bf16* y = (bf16*)(ws + WS_Y); bf16* x1 = (bf16*)(ws + WS_X1);     unsigned char* h2 = ws + WS_H2;
    float* ew = (float*)(ws + WS_ROUTE + 65536); int* slot = (int*)(ws + WS_ROUTE + 131072);
    int* elist = (int*)(ws + WS_ELIST);
    unsigned char* xbuf = ws + WS_XBUF; unsigned char* hid = ws + WS_HID; bf16* ybuf = (bf16*)(ws + WS_YBUF);
    PH(9) { const int lane = lane_fresh(); const int tid = (wave << 6) | lane; (void)tid; (void)lane;
        pg8::Gemm g{ocat, Wupt, S, D, AW, D, D}; MixOrder So{nullptr, G, wg};
        EpiMix E{gate, mix};
        pg8::gemm_phase<EpiMix, MixOrder, true, true>(lds, g, So, E);
    }
    SEAM(9);
    PH(10) { const int lane = lane_fresh(); const int tid = (wave << 6) | lane; (void)tid; (void)lane;
        pg8::Gemm g{mix, Wot, S, D, D, D, D}; pg8::StaticOrder So; So.init(S, D, G, wg);
        EpiBf16P E{y, D};
        pg8::gemm_phase<EpiBf16P, pg8::StaticOrder, true, true>(lds, g, So, E);
    }
    SEAM(10);
    PH(11) { const int lane = lane_fresh(); const int tid = (wave << 6) | lane; (void)tid; (void)lane;
        const float* gpost = args.in[5]; const float* gpre2 = args.in[6]; const float* gt1 = ada + 2 * D; const float* sh2 = ada + 3 * D; const float* sc2 = ada + 4 * D;
        const bf16* wrh = (const bf16*)(ws + WS_WR); const bf16* wrl = wrh + 80 * D; const float* b_rg = args.in[32]; const float* b_re = args.in[34];
        LAS bf16* Ah = (LAS bf16*)lds; LAS bf16* Al = Ah + 16 * RS8; LAS float* Pp = (LAS float*)lds;
        LAS float* Lg = (LAS float*)(lds + 8 * 16 * 80 * 4);
        for (int unit = wg; unit < S / 16; unit += G) {
            {
                const int rl0 = wave * 2, row0 = unit * 16 + rl0;
                f32x4 v[2][8], xv[2][8]; float s[2] = {0.f, 0.f};
#pragma unroll
                for (int rr = 0; rr < 2; ++rr) { const u32x2* yr = (const u32x2*)(y + (size_t)(row0 + rr) * D) + lane; const f32x4* xr = (const f32x4*)(x + (size_t)(row0 + rr) * D) + lane;
#pragma unroll
                    for (int j = 0; j < 8; ++j) { const u32x2 yb = yr[64 * j]; v[rr][j] = (f32x4){__uint_as_float(yb.x << 16), __uint_as_float(yb.x & 0xffff0000u), __uint_as_float(yb.y << 16), __uint_as_float(yb.y & 0xffff0000u)}; xv[rr][j] = xr[64 * j]; } }
#pragma unroll
                for (int rr = 0; rr < 2; ++rr)
#pragma unroll
                    for (int j = 0; j < 8; ++j) s[rr] += (v[rr][j].x * v[rr][j].x + v[rr][j].y * v[rr][j].y) + (v[rr][j].z * v[rr][j].z + v[rr][j].w * v[rr][j].w);
                float r1[2]; r1[0] = rsqrtf(wave_sum(s[0]) * (1.0f / D) + 1e-6f); r1[1] = rsqrtf(wave_sum(s[1]) * (1.0f / D) + 1e-6f); s[0] = 0.f; s[1] = 0.f;
#pragma unroll
                for (int rr = 0; rr < 2; ++rr)
#pragma unroll
                    for (int j = 0; j < 8; ++j) { const int c = 4 * lane + 256 * j; const f32x4 t = xv[rr][j] + *(const f32x4*)(gt1 + c) * *(const f32x4*)(gpost + c) * (v[rr][j] * r1[rr]); v[rr][j] = t;
                        { u32x2 xb; xb.x = pk2(t.x, t.y); xb.y = pk2(t.z, t.w); ((u32x2*)(x1 + (size_t)(row0 + rr) * D))[lane + 64 * j] = xb; } s[rr] += (t.x * t.x + t.y * t.y) + (t.z * t.z + t.w * t.w); }
                float r2[2]; r2[0] = rsqrtf(wave_sum(s[0]) * (1.0f / D) + 1e-6f); r2[1] = rsqrtf(wave_sum(s[1]) * (1.0f / D) + 1e-6f);
#pragma unroll
                for (int rr = 0; rr < 2; ++rr)
#pragma unroll
                    for (int j = 0; j < 8; ++j) { const int c = 4 * lane + 256 * j; const f32x4 t = v[rr][j] * r2[rr] * (*(const f32x4*)(gpre2 + c) * (*(const f32x4*)(sc2 + c) + 1.0f)) + *(const f32x4*)(sh2 + c);
                        u32x2 wh; wh.x = pk2(t.x, t.y); wh.y = pk2(t.z, t.w);
                        u32x2 wl; wl.x = pk2(t.x - __uint_as_float(wh.x << 16), t.y - __uint_as_float(wh.x & 0xffff0000u)); wl.y = pk2(t.z - __uint_as_float(wh.y << 16), t.w - __uint_as_float(wh.y & 0xffff0000u));
                        ((unsigned*)(h2 + (size_t)(row0 + rr) * D))[lane + 64 * j] = pk_fp8x4(t.x, t.y, t.z, t.w, 8.0f);
                        *(LAS u32x2*)(Ah + (rl0 + rr) * RS8 + c) = wh; *(LAS u32x2*)(Al + (rl0 + rr) * RS8 + c) = wl; }
            }
            R1_BAR();
            f32x4 acc[5];
#pragma unroll
            for (int nt = 0; nt < 5; ++nt) acc[nt] = (f32x4){0.f, 0.f, 0.f, 0.f};
            for (int rmf = 0; rmf < 1 + REP_P11B; ++rmf) {
#pragma unroll
            for (int nt = 0; nt < 5; ++nt) acc[nt] = (f32x4){0.f, 0.f, 0.f, 0.f};
#pragma unroll 2
            for (int ks = 0; ks < 8; ++ks) {
                const int k0 = 256 * wave + 32 * ks + 8 * (lane >> 4);
                const bf16x8 ah = *(const LAS bf16x8*)(Ah + (lane & 15) * RS8 + k0), al = *(const LAS bf16x8*)(Al + (lane & 15) * RS8 + k0);
#pragma unroll
                for (int nt = 0; nt < 5; ++nt) { const bf16x8 bh = *(const bf16x8*)(wrh + (size_t)(16 * nt + (lane & 15)) * D + k0), bl = *(const bf16x8*)(wrl + (size_t)(16 * nt + (lane & 15)) * D + k0);
                    acc[nt] = __builtin_amdgcn_mfma_f32_16x16x32_bf16(ah, bh, acc[nt], 0, 0, 0);
                    acc[nt] = __builtin_amdgcn_mfma_f32_16x16x32_bf16(al, bh, acc[nt], 0, 0, 0);
                    acc[nt] = __builtin_amdgcn_mfma_f32_16x16x32_bf16(ah, bl, acc[nt], 0, 0, 0); }
            }
            }
            R1_BAR();
#pragma unroll
            for (int nt = 0; nt < 5; ++nt)
#pragma unroll
                for (int rg = 0; rg < 4; ++rg) Pp[(wave * 16 + 4 * (lane >> 4) + rg) * 80 + 16 * nt + (lane & 15)] = acc[nt][rg];
            R1_BAR();
            for (int i = tid; i < 16 * 72; i += NTHR) { const int r = i / 72, c = i % 72; float t = c < NG ? b_rg[c] : b_re[c - NG];
#pragma unroll
                for (int w = 0; w < 8; ++w) t += Pp[(w * 16 + r) * 80 + c];
                Lg[r * 72 + c] = t; }
            R1_BAR();
            if (tid < 16) {
                const LAS float* lg = Lg + tid * 72; const int row = unit * 16 + tid;
                float mx = lg[0]; int gi = 0; for (int j = 1; j < 8; ++j) if (lg[j] > mx) { mx = lg[j]; gi = j; }
                float sg = 0.f; for (int j = 0; j < 8; ++j) sg += __expf(lg[j] - mx);
                const float pg = 1.0f / sg;
                const LAS float* le = lg + 8 + gi * EPG;
                float m1 = le[0]; int i1 = 0; for (int j = 1; j < 8; ++j) if (le[j] > m1) { m1 = le[j]; i1 = j; }
                float m2 = -3e38f; int i2 = 0; for (int j = 0; j < 8; ++j) if (j != i1 && le[j] > m2) { m2 = le[j]; i2 = j; }
                const float e2 = __expf(m2 - m1); const float p1 = 1.0f / (1.0f + e2), p2 = e2 / (1.0f + e2);
                const int e1g = gi * EPG + i1, e2g = gi * EPG + i2;
                ew[row * 2] = pg * p1; ew[row * 2 + 1] = pg * p2;
                if (rep_ == 0) {
                    const int q1 = atomicAdd((int*)ctl + CW_CNT + e1g, 1), q2 = atomicAdd((int*)ctl + CW_CNT + e2g, 1);
                    elist[e1g * S + q1] = row; elist[e2g * S + q2] = row; slot[row * 2] = (e1g << 16) | q1; slot[row * 2 + 1] = (e2g << 16) | q2; }
            }
            R1_BAR();
        }
    }
    SEAM(11);
    PH(13) { const int lane = lane_fresh(); const int tid = (wave << 6) | lane; (void)tid; (void)lane;
        ROUTE_TABLE();
        pg8::Gemm g{(const bf16*)h2, (const bf16*)Wgut, MAXROWS, NE * 1024, D / 2, D / 2, D / 2}; ExpertOrderT<true> So{elist, (LAS const int*)(lds + RT_OFF), 4, G, wg};
        EpiHid E{hid};
        pg8::gemm_phase<EpiHid, ExpertOrderT<true>, true, true, (124 << 8) | 119, true>(lds, g, So, E);
    }
    SEAM(13);
    PH(14) { const int lane = lane_fresh(); const int tid = (wave << 6) | lane; (void)tid; (void)lane;
        if (args.ph_lo == 14) ROUTE_TABLE();
        pg8::Gemm g{(const bf16*)hid, (const bf16*)Wdt, MAXROWS, NE * D, FF / 2, FF / 2, FF / 2}; ExpertOrderT<false> So{nullptr, (LAS const int*)(lds + RT_OFF), 8, G, wg};
        EpiYbuf E{ybuf};
        pg8::gemm_phase<EpiYbuf, ExpertOrderT<false>, true, true, (124 << 8) | 120, true>(lds, g, So, E);
    }
    SEAM(14);
    PH(15) { const int lane = lane_fresh(); const int tid = (wave << 6) | lane; (void)tid; (void)lane;
        const float* gpost2 = args.in[7]; const float* gt2 = ada + 5 * D; float* out = args.out;
        if (args.ph_lo == 15) ROUTE_TABLE();
        LAS const int* tb = (LAS const int*)(lds + RT_OFF);
        for (int rb = gw; rb < S; rb += 2 * NGW) {
            int s0[2], s1[2]; float w0[2], w1[2]; const int rows[2] = {rb, rb + NGW};
#pragma unroll
            for (int q = 0; q < 2; ++q) { const int row = rows[q] < S ? rows[q] : rb; const int v0 = slot[row * 2], v1 = slot[row * 2 + 1]; s0[q] = tb[64 + (v0 >> 16)] + (v0 & 0xffff); s1[q] = tb[64 + (v1 >> 16)] + (v1 & 0xffff); w0[q] = ew[row * 2]; w1[q] = ew[row * 2 + 1]; }
            u32x2 xb[2][8];
#pragma unroll
            for (int q = 0; q < 2; ++q) { const int row = rows[q] < S ? rows[q] : rb;
#pragma unroll
                for (int j = 0; j < 8; ++j) xb[q][j] = ((const u32x2*)(x1 + (size_t)row * D))[lane + 64 * j]; }
            f32x4 v[2][8]; float s[2] = {0.f, 0.f};
#pragma unroll
            for (int q = 0; q < 2; ++q) { const u32x2* y0 = (const u32x2*)(ybuf + (size_t)s0[q] * D) + lane; const u32x2* y1 = (const u32x2*)(ybuf + (size_t)s1[q] * D) + lane;
#pragma unroll
                for (int j = 0; j < 8; ++j) { const u32x2 a = y0[64 * j], b = y1[64 * j];
                    v[q][j].x = w0[q] * __uint_as_float(a.x << 16) + w1[q] * __uint_as_float(b.x << 16); v[q][j].y = w0[q] * __uint_as_float(a.x & 0xffff0000u) + w1[q] * __uint_as_float(b.x & 0xffff0000u);
                    v[q][j].z = w0[q] * __uint_as_float(a.y << 16) + w1[q] * __uint_as_float(b.y << 16); v[q][j].w = w0[q] * __uint_as_float(a.y & 0xffff0000u) + w1[q] * __uint_as_float(b.y & 0xffff0000u);
                    s[q] += (v[q][j].x * v[q][j].x + v[q][j].y * v[q][j].y) + (v[q][j].z * v[q][j].z + v[q][j].w * v[q][j].w); } }
            float r[2]; r[0] = rsqrtf(wave_sum(s[0]) * (1.0f / D) + 1e-6f); r[1] = rsqrtf(wave_sum(s[1]) * (1.0f / D) + 1e-6f);
#pragma unroll
            for (int q = 0; q < 2; ++q) if (rows[q] < S) {
#pragma unroll
                for (int j = 0; j < 8; ++j) { const int c = 4 * lane + 256 * j; const u32x2 xx = xb[q][j];
                    const f32x4 xf = (f32x4){__uint_as_float(xx.x << 16), __uint_as_float(xx.x & 0xffff0000u), __uint_as_float(xx.y << 16), __uint_as_float(xx.y & 0xffff0000u)};
                    ((f32x4*)(out + (size_t)rows[q] * D))[lane + 64 * j] = xf + *(const f32x4*)(gt2 + c) * (v[q][j] * r[q] * *(const f32x4*)(gpost2 + c)); } }
        }
    }
#undef IN
#undef SEAM
}
extern "C" void kernel_launch(void* const* d_in, const int* in_sizes, int n_in, void* d_out, int out_size, void* d_ws, size_t ws_size, hipStream_t stream) {
    static int grid = 0;
    if (grid == 0) {
        if (ws_size < WS_END || n_in != 38) { fprintf(stderr, "kernel_launch: unexpected workspace/inputs: %zu < %zu or n_in %d\n", ws_size, (size_t)WS_END, n_in); grid = -1; return; }
        int dev = 0, cus = 0;
        if (hipGetDevice(&dev) != hipSuccess || hipDeviceGetAttribute(&cus, hipDeviceAttributeMultiprocessorCount, dev) != hipSuccess) { fprintf(stderr, "device query failed\n"); grid = -1; return; }
        if (hipFuncSetAttribute((const void*)fwd, hipFuncAttributeMaxDynamicSharedMemorySize, LDS_BYTES) != hipSuccess) { fprintf(stderr, "hipFuncSetAttribute failed\n"); grid = -1; return; }
        grid = cus;
    }
    if (grid < 0) return;
    (void)hipMemsetAsync((char*)d_ws + WS_CTL, 0, 1 * MiB, stream);
    Args a{};
    for (int i = 0; i < 38; ++i) a.in[i] = (const float*)d_in[i];
    a.out = (float*)d_out; a.ws = (unsigned char*)d_ws;
#if N_LAUNCH_PER_PHASE
    for (int ph = 0; ph < 16; ++ph) { a.ph_lo = ph; a.ph_hi = ph + 1; hipLaunchKernelGGL(fwd, dim3(grid), dim3(NTHR), LDS_BYTES, stream, a); }
#else
    a.ph_lo = 0; a.ph_hi = 16; hipLaunchKernelGGL(fwd, dim3(grid), dim3(NTHR), LDS_BYTES, stream, a);
#endif
}
```

```cpp
#include <hip/hip_runtime.h>
#include <cstdio>
#include <cstdint>

typedef unsigned short bf16;
__device__ __forceinline__ float bf2f(bf16 b) { return __uint_as_float(((unsigned)b) << 16); }
__device__ __forceinline__ bf16 f2bf(float f) { unsigned u = __float_as_uint(f); u += 0x7fffu + ((u >> 16) & 1u); return (bf16)(u >> 16); }
__device__ __forceinline__ float sigmoidf_(float x) { return __builtin_amdgcn_rcpf(1.0f + __expf(-x)); }

#ifndef N_LAUNCH_PER_PHASE
#define N_LAUNCH_PER_PHASE 0
#endif
#ifndef REP_PHASE
#define REP_PHASE -1
#define REP_N 0
#endif
#ifndef REP_SCAN
#define REP_SCAN 0
#endif
#ifndef REP_P11A
#define REP_P11A 0
#endif
#ifndef REP_P11B
#define REP_P11B 0
#endif
#ifndef REP_R1A
#define REP_R1A 0
#define REP_R1B 0
#define REP_R1C 0
#endif
#ifndef REP_R1NR
#define REP_R1NR 0
#endif
#ifndef REP_R1S0
#define REP_R1S0 0
#endif
constexpr int S = 8192, D = 2048;
constexpr int AH = 8, AD = 128, AW = 1024, MB = 256, NB = S / MB;
constexpr int RH = 16, RN = 64, RW = 1024;
constexpr int LW = 96, LA = 96, LG = 256, LO = LW + LA + LG;
constexpr int INW = 3 * AW + 3 * RW + 2 * D;
constexpr int NE = 64, NG = 8, EPG = 8, FF = 512;
constexpr int MAXROWS = 32768;
constexpr int MAXTILES = MAXROWS / 256;

constexpr size_t MiB = 1u << 20;
constexpr size_t WS_CTL   = 0;
constexpr size_t WS_ADA   = 1 * MiB;
constexpr size_t WS_ROPE  = 2 * MiB;
constexpr size_t WS_KMEAN = 3 * MiB;
constexpr size_t WS_WL2   = 3 * MiB + 256 * 1024;
constexpr size_t WS_ROUTE = 5 * MiB;
constexpr size_t WS_TOK   = 6 * MiB;
constexpr size_t WS_WR    = 7 * MiB;
constexpr size_t WS_H     = 8 * MiB;
constexpr size_t WS_Q     = 40 * MiB;
constexpr size_t WS_K     = 56 * MiB;
constexpr size_t WS_V     = 72 * MiB;
constexpr size_t WS_RKV   = 88 * MiB;
constexpr size_t WS_GATE  = 184 * MiB;
constexpr size_t WS_LORA  = 248 * MiB;
constexpr size_t WS_LORAB = 424 * MiB;
constexpr size_t WS_AL2   = 280 * MiB;
constexpr size_t WS_LW    = 296 * MiB;
constexpr size_t WS_A     = 328 * MiB;
constexpr size_t WS_G     = 360 * MiB;
constexpr size_t WS_OCAT  = 392 * MiB;
constexpr size_t WS_MIX   = 424 * MiB;
constexpr size_t WS_Y     = 456 * MiB;
constexpr size_t WS_X1    = 520 * MiB;
constexpr size_t WS_H2    = 584 * MiB;
constexpr size_t WS_WUPT  = 616 * MiB;
constexpr size_t WS_WOT   = 624 * MiB;
constexpr size_t WS_WGUT  = 632 * MiB;
constexpr size_t WS_WDT   = 888 * MiB;
constexpr size_t WS_END   = 1016 * MiB;
constexpr size_t WS_W1T   = WS_Y;
constexpr size_t WS_ELIST = 16 * MiB;
constexpr size_t WS_XBUF  = WS_H;
constexpr size_t WS_HID   = 136 * MiB;
constexpr size_t WS_YBUF  = 168 * MiB;
constexpr size_t WS_ALIST = 8 * MiB, WS_AMASK = 12 * MiB, WS_AML = 13 * MiB, WS_APART = 248 * MiB;
constexpr size_t WS_RWP = 456 * MiB, WS_RWQ = 472 * MiB, WS_RWR = 504 * MiB, WS_RWY = 520 * MiB, WS_RWH = 552 * MiB, WS_RWB = 568 * MiB;
constexpr size_t WS_NR = WS_MIX, WS_NW = WS_NR + 32 * MiB, WS_NKT = WS_NR + 64 * MiB, WS_NV = WS_NR + 96 * MiB, WS_NKK = WS_NR + 128 * MiB, WS_NY = WS_NR + 160 * MiB;
constexpr size_t WS_MIXTMP = WS_Y;
constexpr size_t WS_GTMP = WS_Y;

constexpr int CW_CNT = 16384, CNT_STR = 1088;
constexpr int CW_FILL = 1152;
constexpr int CW_OFF = 1280;
constexpr int CW_ADA = 1408;
constexpr int CW_ACNT = 90112, ACNT_STR = 576;
constexpr int CW_AQ = 1920;

namespace pg8 {
#define PG8_LAS __attribute__((address_space(3)))
typedef unsigned short bf16_t;
typedef short bf16x8 __attribute__((ext_vector_type(8)));
typedef float f32x4 __attribute__((ext_vector_type(4)));
typedef unsigned u32x4 __attribute__((ext_vector_type(4)));
typedef int i32x8_t __attribute__((ext_vector_type(8)));
template <bool IS8> struct FragSel { typedef bf16x8 T; static constexpr int NK = 2; };
template <> struct FragSel<true> { typedef i32x8_t T; static constexpr int NK = 1; };
template <int F8> struct FragT : FragSel<(F8 != 0)> {};
constexpr int BM = 256, BK = 64, HALF = 128, HTB = HALF * BK * 2  , STAGE_BYTES = 8 * HTB, NXCD = 8, WGM = 8;

__host__ __device__ __forceinline__ int lds_byte(int r, int c) { const int st = (r >> 4) * 2 + (c >> 5), rr = r & 15, cc = c & 31, ob = rr * 64 + cc * 2; return st * 1024 + (ob ^ (((ob >> 9) & 1) << 5)); }
__host__ __device__ __forceinline__ void stage_rc(int b, int& R, int& C) { const int st = b / 1024, sb = b % 1024, swz = sb ^ (((sb >> 9) & 1) << 5); R = (st >> 1) * 16 + swz / 64; C = (st & 1) * 32 + (swz % 64) / 2; }
__host__ __device__ __forceinline__ int perm32(int rho) { const int n = rho >> 4, i = rho & 15; return 8 * (i >> 2) + 4 * n + (i & 3); }

struct Unit { int pm, pn, koff, koffB; };
struct Gemm { const bf16_t* A; const bf16_t* Bt; int M, N, K, lda, ldb; };

struct StaticOrder {
    static constexpr bool GATHER = false; const int* tok = nullptr;
    int nM, nN, nwg, G, c;
    __host__ __device__ void init(int M, int N, int G_, int c_) { nM = M / BM; nN = N / BM; nwg = nM * nN; G = G_; c = c_; }
    __host__ __device__ bool next(int i, Unit& u) const {
        const long L = (long)i * G + c; if (L >= nwg) return false;
        int wgid = (int)L; { const int q = nwg / NXCD, r = nwg % NXCD, xcd = wgid % NXCD, off = wgid / NXCD; wgid = (xcd < r ? xcd * (q + 1) : r * (q + 1) + (xcd - r) * q) + off; }
        const int nig = WGM * nN, gid = wgid / nig, fm = gid * WGM, gsz = (nM - fm) < WGM ? (nM - fm) : WGM;
        u.pm = fm + ((wgid % nig) % gsz); u.pn = (wgid % nig) / gsz; u.koff = 0; u.koffB = 0; return true;
    }
    __device__ __forceinline__ void a_ready(const Unit&) const {}
    __device__ __forceinline__ void done(const Unit&) const {}
};

__device__ __forceinline__ unsigned cvt_pk_bf16(float lo, float hi) { unsigned r; asm volatile("v_cvt_pk_bf16_f32 %0, %1, %2" : "=v"(r) : "v"(lo), "v"(hi)); return r; }
template <class Epi, class Sched, bool ALIGN_EPI = false, bool SP2 = false, int F8 = 0, bool HM = false>
__device__ __forceinline__ void gemm_phase(PG8_LAS unsigned char* lds, const Gemm g, const Sched& S, const Epi& E) {
    int tid_ = threadIdx.x; asm volatile("" : "+v"(tid_));
    const int tid = tid_, wid = __builtin_amdgcn_readfirstlane(tid >> 6), lane = tid & 63, wr = wid >> 2, wc = wid & 3, fr = lane & 15, fq = lane >> 4;
    const int K = g.K, nt = K / BK;
    unsigned voffA[2], voffB[2], voffN[2] = {0u, 0u};
#pragma unroll
    for (int i = 0; i < 2; ++i) { int R, C; stage_rc(tid * 16 + i * 8192, R, C); const int Rb = Epi::PERM ? ((R & ~31) + perm32(R & 31)) : R;
        voffA[i] = (unsigned)(R * g.lda + C) * 2u; voffB[i] = (unsigned)(Rb * g.ldb + C) * 2u; }
    const size_t kstep = (size_t)(BK * 2);
    const size_t hstepA = HM ? (size_t)0 : (size_t)HALF * g.lda * 2, hstepB = (size_t)HALF * g.ldb * 2;
    const size_t tstepA = Sched::GATHER ? (size_t)0 : (HM ? 1 : 2) * (size_t)HALF * g.lda * 2, tstepB = 2 * hstepB;
    const unsigned ldsw = (unsigned)wid * 1024u;
    const int aoff = lds_byte(wr * 64 + fr, fq * 8), boff = lds_byte(wc * 32 + fr, fq * 8);
#define PG8_SA(b, h) (((b) * 2 + (h)) * HTB)
#define PG8_SB(b, h) ((4 + (b) * 2 + (h)) * HTB)
#define PG8_STAGE(bufoff, gbase, voff) do { _Pragma("unroll") for (int _i = 0; _i < 2; ++_i) \
        __builtin_amdgcn_global_load_lds((const unsigned*)((const char*)(gbase) + (voff)[_i]), (PG8_LAS unsigned*)(lds + (bufoff) + ldsw + _i * 8192), 16, 0, 0); } while (0)
#define PG8_CAT(lo, hi) __builtin_bit_cast(i32x8_t, __builtin_shufflevector(lo, hi, 0, 1, 2, 3, 4, 5, 6, 7, 8, 9, 10, 11, 12, 13, 14, 15))
#define PG8_RD(off) (*(const PG8_LAS bf16x8*)(lds + (off)))
#define PG8_LDA(dst, b, h) do { if constexpr (!(HM && (h) == 1)) _Pragma("unroll") for (int m = 0; m < 4; ++m) { if constexpr (F8 == 0) { _Pragma("unroll") for (int k = 0; k < 2; ++k) dst[m][k] = PG8_RD(PG8_SA(b, h) + aoff + m * 2048 + k * 1024); } \
        else dst[m][0] = PG8_CAT(PG8_RD(PG8_SA(b, h) + aoff + m * 2048), PG8_RD(PG8_SA(b, h) + aoff + m * 2048 + 1024)); } } while (0)
#define PG8_LDB(dst, b, h) do { _Pragma("unroll") for (int n = 0; n < 2; ++n) { if constexpr (F8 == 0) { _Pragma("unroll") for (int k = 0; k < 2; ++k) dst[n][k] = PG8_RD(PG8_SB(b, h) + boff + n * 2048 + k * 1024); } \
        else dst[n][0] = PG8_CAT(PG8_RD(PG8_SB(b, h) + boff + n * 2048), PG8_RD(PG8_SB(b, h) + boff + n * 2048 + 1024)); } } while (0)
#define PG8_MMA(ai, bj, At, Bt) do { __builtin_amdgcn_s_setprio(1); if constexpr (!(HM && (ai) == 1)) _Pragma("unroll") for (int m = 0; m < 4; ++m) _Pragma("unroll") for (int n = 0; n < 2; ++n) { \
        if constexpr (F8 == 0) { _Pragma("unroll") for (int k = 0; k < 2; ++k) acc[ai][bj][m][n] = __builtin_amdgcn_mfma_f32_16x16x32_bf16(Bt[n][k], At[m][k], acc[ai][bj][m][n], 0, 0, 0); } \
        else acc[ai][bj][m][n] = __builtin_amdgcn_mfma_scale_f32_16x16x128_f8f6f4(Bt[n][0], At[m][0], acc[ai][bj][m][n], 0, 0, 0, (F8 & 255) * 0x01010101, 0, ((F8 >> 8) & 255) * 0x01010101); } \
        __builtin_amdgcn_s_setprio(0); } while (0)
#define PG8_WAIT_V(n) asm volatile("s_waitcnt vmcnt(" #n ")" ::: "memory")
#define PG8_WAIT_L(n) asm volatile("s_waitcnt lgkmcnt(" #n ")" ::: "memory")
#define PG8_BAR __builtin_amdgcn_s_barrier()
#define PG8_SCHED __builtin_amdgcn_sched_barrier(0)
    Unit cur, nxt; int ui = 0;
    if (!S.next(0, cur)) return;
    f32x4 acc[2][2][4][2];
#pragma unroll
    for (int a = 0; a < 2; ++a)
#pragma unroll
        for (int b = 0; b < 2; ++b)
#pragma unroll
            for (int m = 0; m < 4; ++m)
#pragma unroll
                for (int n = 0; n < 2; ++n) acc[a][b][m][n] = (f32x4){0.f, 0.f, 0.f, 0.f};
    typename FragT<F8>::T At[4][FragT<F8>::NK], B0[2][FragT<F8>::NK], B1[2][FragT<F8>::NK];
    const char* cA = (const char*)g.A + (size_t)cur.pm * tstepA + cur.koff; const char* cB = (const char*)g.Bt + (size_t)cur.pn * tstepB + cur.koffB;
#define PG8_GVOFF(u, out) do { _Pragma("unroll") for (int i_ = 0; i_ < 2; ++i_) { int R_, C_; stage_rc(tid * 16 + i_ * 8192, R_, C_); out[i_] = ((unsigned)S.row_tok((u).pm, R_) * (unsigned)g.lda + (unsigned)C_) * 2u; } } while (0)
    if constexpr (Sched::GATHER) PG8_GVOFF(cur, voffA);
    S.a_ready(cur);
    if constexpr (SP2) {
        PG8_STAGE(PG8_SB(0, 0), cB, voffB); PG8_STAGE(PG8_SB(0, 1), cB + hstepB, voffB); PG8_STAGE(PG8_SA(0, 0), cA, voffA); PG8_STAGE(PG8_SA(0, 1), cA + hstepA, voffA);
        if (wr == 1) PG8_BAR;
        PG8_WAIT_V(2); PG8_BAR;
        PG8_STAGE(PG8_SB(1, 0), cB + kstep, voffB); PG8_STAGE(PG8_SA(1, 0), cA + kstep, voffA); PG8_STAGE(PG8_SB(1, 1), cB + hstepB + kstep, voffB);
        PG8_WAIT_V(6); PG8_BAR;
    } else {
        PG8_STAGE(PG8_SB(0, 0), cB, voffB); PG8_STAGE(PG8_SA(0, 0), cA, voffA); PG8_STAGE(PG8_SB(0, 1), cB + hstepB, voffB); PG8_STAGE(PG8_SA(0, 1), cA + hstepA, voffA);
        if (wr == 1) PG8_BAR;
        PG8_WAIT_V(4); PG8_BAR;
        PG8_STAGE(PG8_SB(1, 0), cB + kstep, voffB); PG8_STAGE(PG8_SA(1, 0), cA + kstep, voffA); PG8_STAGE(PG8_SB(1, 1), cB + hstepB + kstep, voffB);
        PG8_WAIT_V(6); PG8_BAR;
    }
    for (;;) {
        const bool has_next = S.next(ui + 1, nxt);
        if constexpr (Sched::GATHER) { if (has_next) PG8_GVOFF(nxt, voffN); }
        const char* nA = has_next ? (const char*)g.A + (size_t)nxt.pm * tstepA + nxt.koff : cA; const char* nB = has_next ? (const char*)g.Bt + (size_t)nxt.pn * tstepB + nxt.koffB : cB;
#pragma nounroll
        for (int t = 0; t < nt; t += 2) {
            const bool last = (t == nt - 2);
            const char* a1 = cA + (size_t)(t + 1) * kstep;
            const char* a2 = last ? nA : cA + (size_t)(t + 2) * kstep; const char* b2 = last ? nB : cB + (size_t)(t + 2) * kstep;
            const char* a3 = a2 + kstep; const char* b3 = b2 + kstep;
            unsigned vA2[2] = {voffA[0], voffA[1]}; if constexpr (Sched::GATHER) { if (last) { vA2[0] = voffN[0]; vA2[1] = voffN[1]; } }
            if (last && has_next) S.a_ready(nxt);
            if constexpr (SP2) {
            PG8_LDB(B0, 0, 0); PG8_LDB(B1, 0, 1); PG8_SCHED; PG8_LDA(At, 0, 0); PG8_STAGE(PG8_SA(1, 1), a1 + hstepA, voffA);
            PG8_WAIT_V(8); PG8_WAIT_L(0); PG8_BAR; PG8_MMA(0, 0, At, B0); PG8_MMA(0, 1, At, B1); PG8_BAR; PG8_SCHED;
            PG8_LDA(At, 0, 1); PG8_STAGE(PG8_SB(0, 0), b2, voffB); PG8_STAGE(PG8_SB(0, 1), b2 + hstepB, voffB); PG8_STAGE(PG8_SA(0, 0), a2, vA2);
            PG8_WAIT_V(8); PG8_WAIT_L(0); PG8_BAR; PG8_MMA(1, 0, At, B0); PG8_MMA(1, 1, At, B1); PG8_BAR; PG8_SCHED;
            PG8_LDB(B0, 1, 0); PG8_LDB(B1, 1, 1); PG8_SCHED; PG8_LDA(At, 1, 0); PG8_STAGE(PG8_SA(0, 1), a2 + hstepA, vA2);
            PG8_WAIT_V(8); PG8_WAIT_L(0); PG8_BAR; PG8_MMA(0, 0, At, B0); PG8_MMA(0, 1, At, B1); PG8_BAR; PG8_SCHED;
            PG8_LDA(At, 1, 1); PG8_STAGE(PG8_SB(1, 0), b3, voffB); PG8_STAGE(PG8_SB(1, 1), b3 + hstepB, voffB); PG8_STAGE(PG8_SA(1, 0), a3, vA2);
            PG8_WAIT_V(8); PG8_WAIT_L(0); PG8_BAR; PG8_MMA(1, 0, At, B0); PG8_MMA(1, 1, At, B1); PG8_BAR; PG8_SCHED;
            } else {
            PG8_LDB(B0, 0, 0); PG8_SCHED; PG8_LDA(At, 0, 0); PG8_STAGE(PG8_SA(1, 1), a1 + hstepA, voffA);
            PG8_WAIT_L(8); PG8_BAR; PG8_WAIT_L(0); PG8_MMA(0, 0, At, B0); PG8_BAR; PG8_SCHED;
            PG8_LDB(B1, 0, 1); PG8_STAGE(PG8_SB(0, 0), b2, voffB);
            PG8_BAR; PG8_WAIT_L(0); PG8_MMA(0, 1, At, B1); PG8_BAR;
            PG8_LDA(At, 0, 1); PG8_STAGE(PG8_SA(0, 0), a2, vA2);
            PG8_BAR; PG8_WAIT_L(0); PG8_MMA(1, 0, At, B0); PG8_BAR; PG8_SCHED;
            PG8_STAGE(PG8_SB(0, 1), b2 + hstepB, voffB);
            PG8_WAIT_V(6); PG8_BAR; PG8_MMA(1, 1, At, B1); PG8_BAR;
            PG8_LDB(B0, 1, 0); PG8_SCHED; PG8_LDA(At, 1, 0); PG8_STAGE(PG8_SA(0, 1), a2 + hstepA, vA2);
            PG8_WAIT_L(8); PG8_BAR; PG8_WAIT_L(0); PG8_MMA(0, 0, At, B0); PG8_BAR; PG8_SCHED;
            PG8_LDB(B1, 1, 1); PG8_STAGE(PG8_SB(1, 0), b3, voffB);
            PG8_BAR; PG8_WAIT_L(0); PG8_MMA(0, 1, At, B1); PG8_BAR;
            PG8_LDA(At, 1, 1); PG8_STAGE(PG8_SA(1, 0), a3, vA2);
            PG8_BAR; PG8_WAIT_L(0); PG8_MMA(1, 0, At, B0); PG8_BAR; PG8_SCHED;
            PG8_STAGE(PG8_SB(1, 1), b3 + hstepB, voffB);
            PG8_WAIT_V(6); PG8_BAR; PG8_MMA(1, 1, At, B1); PG8_BAR;
            }
        }
        if constexpr (ALIGN_EPI) { if (wr == 0) PG8_BAR; }
        if constexpr (!Epi::AFTER_DRAIN) { E(acc, cur, wr, wc, fr, fq); S.done(cur); }
        if (!has_next) break;
        {
#pragma unroll
        for (int a = 0; a < 2; ++a)
#pragma unroll
            for (int b = 0; b < 2; ++b)
#pragma unroll
                for (int m = 0; m < 4; ++m)
#pragma unroll
                    for (int n = 0; n < 2; ++n) acc[a][b][m][n] = (f32x4){0.f, 0.f, 0.f, 0.f};
        }
        cur = nxt; cA = nA; cB = nB; ++ui;
        if constexpr (Sched::GATHER) { voffA[0] = voffN[0]; voffA[1] = voffN[1]; }
        if constexpr (ALIGN_EPI) { if (wr == 1) PG8_BAR; }
    }
    PG8_WAIT_V(0);
    if constexpr (!ALIGN_EPI) { if (wr == 0) PG8_BAR; }
    PG8_BAR;
    if constexpr (Epi::AFTER_DRAIN) { E.fused(acc, cur, wr, wc, fr, fq, lds, wid, lane); S.done(cur); }
#undef PG8_SA
#undef PG8_SB
#undef PG8_STAGE
#undef PG8_LDA
#undef PG8_LDB
#undef PG8_MMA
#undef PG8_CAT
#undef PG8_GVOFF
#undef PG8_RD
#undef PG8_WAIT_V
#undef PG8_WAIT_L
#undef PG8_BAR
#undef PG8_SCHED
}
}

#define XB_TMO      128
#define XB_XCNT(j)  (256  + 64 * (j))
#define XB_XSUB(j)  (1280 + 64 * (j))
#define XB_XGEN(j)  (2304 + 64 * (j))
#define XB_TOP      3328
#define XB_TOPGEN   3392
#define XCD_BAR_WORDS 3456
#define XB_SPIN_CAP (1u << 18)
#define LAS __attribute__((address_space(3)))

__device__ __forceinline__ unsigned xb_ld(unsigned* p)              { return __hip_atomic_load(p, __ATOMIC_RELAXED, __HIP_MEMORY_SCOPE_AGENT); }
__device__ __forceinline__ unsigned xb_add(unsigned* p, unsigned v) { return __hip_atomic_fetch_add(p, v, __ATOMIC_RELAXED, __HIP_MEMORY_SCOPE_AGENT); }
__device__ __forceinline__ unsigned xb_xcc_id() { return (unsigned)__builtin_amdgcn_s_getreg((3 << 11) | 20) & 0xFu; }
#define XB_SPIN(cond, bar) do { unsigned _sp = 0; while (cond) { __builtin_amdgcn_s_sleep(1); \
    if ((++_sp & 255u) == 0u) { if (xb_ld(&(bar)[XB_TMO])) break; if (_sp > XB_SPIN_CAP) { atomicAdd(&(bar)[XB_TMO], 1u); break; } } } } while (0)

struct XcdBarrier {
    unsigned* bar; unsigned x;
    volatile LAS unsigned* st;
};

__device__ __forceinline__ XcdBarrier xcd_barrier_post(unsigned* bar, volatile LAS unsigned* st) {
    XcdBarrier b; b.bar = bar; b.x = xb_xcc_id(); b.st = st;
    if (threadIdx.x == 0) (void)xb_add(&bar[XB_XCNT(b.x)], 1u);
    return b;
}
__device__ __forceinline__ void xcd_barrier_complete(unsigned* bar, unsigned x, unsigned& nloc, unsigned& nx) {
    const unsigned G = gridDim.x * gridDim.y * gridDim.z;
    unsigned sum, cnt, mine, sp = 0u;
    for (;;) {
        sum = 0u; cnt = 0u; mine = 0u;
#pragma unroll
        for (unsigned j = 0; j < 16; ++j) { const unsigned c = xb_ld(&bar[XB_XCNT(j)]); sum += c; cnt += (c > 0u) ? 1u : 0u; mine = (j == x) ? c : mine; }
        if (sum == G) break;
        __builtin_amdgcn_s_sleep(1);
        if ((++sp & 255u) == 0u) { if (xb_ld(&bar[XB_TMO])) break; if (sp > XB_SPIN_CAP) { atomicAdd(&bar[XB_TMO], 1u); break; } }
    }
    nloc = mine > 0u ? mine : 1u; nx = cnt > 0u ? cnt : 1u;
}

__device__ __forceinline__ void xcd_barrier(const XcdBarrier& b) {
    asm volatile("s_waitcnt vmcnt(0)" ::: "memory");
    __syncthreads();
    if (threadIdx.x == 0) {
        unsigned* bar = b.bar;
        __builtin_amdgcn_s_waitcnt(0);
        unsigned nloc = b.st[0], nx = b.st[1];
        if (nloc == 0u) { xcd_barrier_complete(bar, b.x, nloc, nx); b.st[0] = nloc; b.st[1] = nx; }
        const unsigned old = xb_add(&bar[XB_XSUB(b.x)], 1u);
        const unsigned gen = old / nloc;
        if (old + 1u == (gen + 1u) * nloc) {
            __builtin_amdgcn_fence(__ATOMIC_RELEASE, "agent");
            asm volatile("s_waitcnt vmcnt(0)" ::: "memory");
            const unsigned og = xb_add(&bar[XB_TOP], 1u);
            const unsigned tg = og / nx;
            if (og + 1u == (tg + 1u) * nx) xb_add(&bar[XB_TOPGEN], 1u);
            else XB_SPIN(xb_ld(&bar[XB_TOPGEN]) == tg, bar);
            __builtin_amdgcn_fence(__ATOMIC_ACQUIRE, "agent");
            xb_add(&bar[XB_XGEN(b.x)], 1u);
            asm volatile("s_waitcnt vmcnt(0)" ::: "memory");
        } else {
            XB_SPIN(xb_ld(&bar[XB_XGEN(b.x)]) == gen, bar);
            __builtin_amdgcn_fence(__ATOMIC_ACQUIRE, "agent");
            asm volatile("s_waitcnt vmcnt(0)" ::: "memory");
        }
    }
    __syncthreads();
}

constexpr int NWAVES = 8, NTHR = 512;
constexpr int RING_BYTES = 131072;
constexpr int LDS_BYTES = 147456;
constexpr int RT_OFF = 131072;
constexpr int LDSCTL_OFF = LDS_BYTES - 16;
constexpr int CW_BAR = 4096;
typedef float f32x4 __attribute__((ext_vector_type(4)));
typedef unsigned u32x4 __attribute__((ext_vector_type(4)));
typedef unsigned u32x2 __attribute__((ext_vector_type(2)));
typedef short bf16x8 __attribute__((ext_vector_type(8)));
#define LDS_WAIT() asm volatile("s_waitcnt lgkmcnt(0)" ::: "memory")
typedef __bf16 bf16x2_t __attribute__((ext_vector_type(2)));
typedef float f32x2_t __attribute__((ext_vector_type(2)));
__device__ __forceinline__ unsigned pk2(float lo, float hi) { const f32x2_t v = {lo, hi}; return __builtin_bit_cast(unsigned, __builtin_convertvector(v, bf16x2_t)); }
__device__ __forceinline__ int lane_fresh() { int l; asm volatile("v_mbcnt_lo_u32_b32 %0, -1, 0\n\tv_mbcnt_hi_u32_b32 %0, -1, %0" : "=v"(l)); return l; }
#define DPP_ADD(v, ctrl) ((v) + __builtin_bit_cast(float, __builtin_amdgcn_update_dpp(0, __builtin_bit_cast(int, (v)), (ctrl), 0xf, 0xf, true)))
__device__ __forceinline__ float wave_sum(float v) {
    v = DPP_ADD(v, 0xB1);
    v = DPP_ADD(v, 0x4E);
    v = DPP_ADD(v, 0x141);
    v = DPP_ADD(v, 0x140);
    const int iv = __builtin_bit_cast(int, v);
    return (__builtin_bit_cast(float, __builtin_amdgcn_readlane(iv, 0)) + __builtin_bit_cast(float, __builtin_amdgcn_readlane(iv, 16)))
         + (__builtin_bit_cast(float, __builtin_amdgcn_readlane(iv, 32)) + __builtin_bit_cast(float, __builtin_amdgcn_readlane(iv, 48)));
}

constexpr int N1 = 11264;
struct Args { const float* in[38]; float* out; unsigned char* ws; int ph_lo, ph_hi; };

__device__ __forceinline__ void tr_item(const float* W, int ldw, int k0, int n0, bf16* dst, int ldd, const float* mu, int mode, LAS float* scr, int lane) {
    f32x4 v[8];
#pragma unroll
    for (int i = 0; i < 8; ++i) v[i] = *(const f32x4*)(W + (size_t)(k0 + 8 * i + (lane >> 3)) * ldw + n0 + 4 * (lane & 7));
#pragma unroll
    for (int i = 0; i < 8; ++i) { const int kk = 8 * i + (lane >> 3); f32x4 t = v[i];
        if (mode == 1) t = t * (1.0f - mu[k0 + kk]); else if (mode == 2) t = t * mu[k0 + kk];
        LAS float* s = scr + kk * 33 + 4 * (lane & 7); s[0] = t.x; s[1] = t.y; s[2] = t.z; s[3] = t.w; }
    LDS_WAIT(); asm volatile("" ::: "memory");
    const int c = lane & 7;
#pragma unroll
    for (int j = 0; j < 4; ++j) { const int n = (lane >> 3) + 8 * j; const LAS float* s = scr + (8 * c) * 33 + n;
        u32x4 o; o.x = pk2(s[0 * 33], s[1 * 33]); o.y = pk2(s[2 * 33], s[3 * 33]); o.z = pk2(s[4 * 33], s[5 * 33]); o.w = pk2(s[6 * 33], s[7 * 33]);
        *(u32x4*)(dst + (size_t)n * ldd + 8 * c) = o; }
    LDS_WAIT(); asm volatile("" ::: "memory");
}
__device__ __forceinline__ unsigned pk_fp8x4(float a, float b, float c, float d, float sc) {
    a = fminf(fmaxf(a * sc, -448.f), 448.f); b = fminf(fmaxf(b * sc, -448.f), 448.f); c = fminf(fmaxf(c * sc, -448.f), 448.f); d = fminf(fmaxf(d * sc, -448.f), 448.f);
    int p = __builtin_amdgcn_cvt_pk_fp8_f32(a, b, 0, false); p = __builtin_amdgcn_cvt_pk_fp8_f32(c, d, p, true); return (unsigned)p; }
__device__ __forceinline__ void tr_item8(const float* W, int ldw, int k0, int n0, unsigned char* dst, int ldd, float sc, LAS float* scr, int lane) {
    f32x4 v[8];
#pragma unroll
    for (int i = 0; i < 8; ++i) v[i] = *(const f32x4*)(W + (size_t)(k0 + 8 * i + (lane >> 3)) * ldw + n0 + 4 * (lane & 7));
#pragma unroll
    for (int i = 0; i < 8; ++i) { const int kk = 8 * i + (lane >> 3); LAS float* s = scr + kk * 33 + 4 * (lane & 7); s[0] = v[i].x; s[1] = v[i].y; s[2] = v[i].z; s[3] = v[i].w; }
    LDS_WAIT(); asm volatile("" ::: "memory");
    const int c = lane & 7;
#pragma unroll
    for (int j = 0; j < 4; ++j) { const int n = (lane >> 3) + 8 * j; const LAS float* s = scr + (8 * c) * 33 + n;
        u32x2 o; o.x = pk_fp8x4(s[0 * 33], s[1 * 33], s[2 * 33], s[3 * 33], sc); o.y = pk_fp8x4(s[4 * 33], s[5 * 33], s[6 * 33], s[7 * 33], sc);
        *(u32x2*)(dst + (size_t)n * ldd + 8 * c) = o; }
    LDS_WAIT(); asm volatile("" ::: "memory");
}

struct ConvTile { const float* src; int ldw; unsigned char* dst; int rs; int kind; float sc; };
constexpr int CT_IN = (D / 128) * (INW / 128), CT_UP = (AW / 128) * (D / 128), CT_O = (D / 128) * (D / 128), CT_EG = (D / 128) * (FF / 128), CT_ED = (FF / 128) * (D / 128);
constexpr int CT_ALL = CT_IN + 2 * CT_UP + CT_O + NE * (2 * CT_EG + CT_ED);
__device__ __forceinline__ ConvTile conv_decode(int T, const float* const* in, unsigned char* ws) {
    ConvTile t; int r = T;
    if (r < CT_IN) { const int kt = r / (INW / 128), nt = r % (INW / 128), k0 = 128 * kt, n0 = 128 * nt; int dr = n0;
        if (n0 >= 3 * AW + 3 * RW + D) { const int cc = n0 - (3 * AW + 3 * RW + D); dr = 3 * AW + 3 * RW + 256 * (cc / 128) + 128; }
        else if (n0 >= 3 * AW + 3 * RW) { const int cc = n0 - (3 * AW + 3 * RW); dr = 3 * AW + 3 * RW + 256 * (cc / 128); }
        t.src = in[8] + (size_t)k0 * INW + n0; t.ldw = INW; t.dst = ws + WS_W1T + ((size_t)dr * D + k0) * 2; t.rs = D * 2; t.kind = 0; t.sc = 1.f; return t; } r -= CT_IN;
    if (r < 2 * CT_UP) { const int which = r / CT_UP, q = r % CT_UP, kt = q / (D / 128), nt = q % (D / 128), k0 = 128 * kt, n0 = 128 * nt;
        t.src = in[28 + which] + (size_t)k0 * D + n0; t.ldw = D; t.dst = ws + WS_WUPT + ((size_t)n0 * D + which * AW + k0) * 2; t.rs = D * 2; t.kind = 0; t.sc = 1.f; return t; } r -= 2 * CT_UP;
    if (r < CT_O) { const int kt = r / (D / 128), nt = r % (D / 128), k0 = 128 * kt, n0 = 128 * nt;
        t.src = in[30] + (size_t)k0 * D + n0; t.ldw = D; t.dst = ws + WS_WOT + ((size_t)n0 * D + k0) * 2; t.rs = D * 2; t.kind = 0; t.sc = 1.f; return t; } r -= CT_O;
    const int e = r / (2 * CT_EG + CT_ED); r -= e * (2 * CT_EG + CT_ED);
    if (r < 2 * CT_EG) { const int up = r / CT_EG, q = r % CT_EG, kt = q / (FF / 128), nt = q % (FF / 128), k0 = 128 * kt;
        t.src = in[35 + up] + (size_t)e * D * FF + (size_t)k0 * FF + 128 * nt; t.ldw = FF; t.dst = ws + WS_WGUT + ((size_t)e * 1024 + 256 * nt + 128 * up) * D + k0; t.rs = D; t.kind = 1; t.sc = 256.f; return t; } r -= 2 * CT_EG;
    { const int kt = r / (D / 128), nt = r % (D / 128), k0 = 128 * kt, n0 = 128 * nt;
        t.src = in[37] + (size_t)e * FF * D + (size_t)k0 * D + n0; t.ldw = D; t.dst = ws + WS_WDT + ((size_t)e * D + n0) * FF + k0; t.rs = FF; t.kind = 1; t.sc = 128.f; return t; }
}
__device__ __forceinline__ int conv_off(int k, int n) { return k * 132 + 16 * (k >> 5) + n; }
__device__ __forceinline__ void item_kn(int it, int N, int& k0, int& n0) { const int nblk = N / 32; k0 = 64 * (it / nblk); n0 = 32 * (it % nblk); }

struct EpiProj {
    static constexpr bool PERM = true, AFTER_DRAIN = false, MIDK = false;
    bf16* q; bf16* k; bf16* v; float* rkv; bf16* gate; float* lora; float* lorab; const float* rope;
    __device__ __forceinline__ void operator()(const pg8::f32x4 (&acc)[2][2][4][2], const pg8::Unit& u, int wr, int wc, int fr, int fq) const {
        const int row0 = u.pm * 256 + wr * 64 + fr; const int pn = u.pn; const int colw = wc * 32 + 8 * fq;
        if (pn < 8) {
            bf16* base = (pn < 4 ? q : k) + (pn & 3) * 256 + colw;
            const float sgn = fq < 2 ? -1.0f : 1.0f;
#pragma unroll
            for (int ai = 0; ai < 2; ++ai)
#pragma unroll
                for (int m = 0; m < 4; ++m) { const int row = row0 + ai * 128 + m * 16;
                    f32x4 c0, c1, c2, c3;
                    if (wc == 0) { const float* rp = rope + ((size_t)row * 16 + 8 * (fq & 1)) * 2; c0 = *(const f32x4*)rp; c1 = *(const f32x4*)(rp + 4); c2 = *(const f32x4*)(rp + 8); c3 = *(const f32x4*)(rp + 12); }
#pragma unroll
                    for (int bj = 0; bj < 2; ++bj) { f32x4 v0 = acc[ai][bj][m][0], v1 = acc[ai][bj][m][1];
                        if (wc == 0) {
                            f32x4 p0, p1;
#pragma unroll
                            for (int j = 0; j < 4; ++j) { p0[j] = __shfl_xor(v0[j], 32) * sgn; p1[j] = __shfl_xor(v1[j], 32) * sgn; }
                            v0[0] = v0[0] * c0[0] + p0[0] * c0[1]; v0[1] = v0[1] * c0[2] + p0[1] * c0[3]; v0[2] = v0[2] * c1[0] + p0[2] * c1[1]; v0[3] = v0[3] * c1[2] + p0[3] * c1[3];
                            v1[0] = v1[0] * c2[0] + p1[0] * c2[1]; v1[1] = v1[1] * c2[2] + p1[1] * c2[3]; v1[2] = v1[2] * c3[0] + p1[2] * c3[1]; v1[3] = v1[3] * c3[2] + p1[3] * c3[3];
                        }
                        u32x4 w; w.x = pk2(v0[0], v0[1]); w.y = pk2(v0[2], v0[3]); w.z = pk2(v1[0], v1[1]); w.w = pk2(v1[2], v1[3]);
                        *(u32x4*)(base + (size_t)row * AW + bj * 128) = w; } }
        } else if (pn < 12) {
            bf16* base = v + (pn - 8) * 256 + colw;
#pragma unroll
            for (int ai = 0; ai < 2; ++ai)
#pragma unroll
                for (int m = 0; m < 4; ++m) { const int row = row0 + ai * 128 + m * 16;
#pragma unroll
                    for (int bj = 0; bj < 2; ++bj) { const f32x4 v0 = acc[ai][bj][m][0], v1 = acc[ai][bj][m][1];
                        u32x4 w; w.x = pk2(v0[0], v0[1]); w.y = pk2(v0[2], v0[3]); w.z = pk2(v1[0], v1[1]); w.w = pk2(v1[2], v1[3]);
                        *(u32x4*)(base + (size_t)row * AW + bj * 128) = w; } }
        } else if (pn < 24) {
            float* base = rkv + (pn - 12) * 256 + colw;
#pragma unroll
            for (int ai = 0; ai < 2; ++ai)
#pragma unroll
                for (int m = 0; m < 4; ++m) { const int row = row0 + ai * 128 + m * 16;
#pragma unroll
                    for (int bj = 0; bj < 2; ++bj) { float* p = base + (size_t)row * (3 * RW) + bj * 128; *(f32x4*)p = acc[ai][bj][m][0]; *(f32x4*)(p + 4) = acc[ai][bj][m][1]; } }
        } else if (pn < 40) {
            bf16* base = gate + (pn - 24) * 128 + colw;
#pragma unroll
            for (int ai = 0; ai < 2; ++ai)
#pragma unroll
                for (int m = 0; m < 4; ++m) { const int row = row0 + ai * 128 + m * 16;
                    const f32x4 a0 = acc[ai][0][m][0], a1 = acc[ai][0][m][1], r0 = acc[ai][1][m][0], r1 = acc[ai][1][m][1]; float ra[8], sr[8];
#pragma unroll
                    for (int j = 0; j < 4; ++j) { const float ea = __expf(-a0[j]), er = __expf(-r0[j]), ea1 = __expf(-a1[j]), er1 = __expf(-r1[j]);
                        sr[j] = __builtin_amdgcn_rcpf(1.0f + er); ra[j] = (1.0f + er) * __builtin_amdgcn_rcpf(1.0f + ea); sr[4 + j] = __builtin_amdgcn_rcpf(1.0f + er1); ra[4 + j] = (1.0f + er1) * __builtin_amdgcn_rcpf(1.0f + ea1); }
                    u32x4 w; w.x = pk2(ra[0], ra[1]); w.y = pk2(ra[2], ra[3]); w.z = pk2(ra[4], ra[5]); w.w = pk2(ra[6], ra[7]);
                    *(u32x4*)(base + (size_t)row * (2 * D)) = w;
                    w.x = pk2(sr[0], sr[1]); w.y = pk2(sr[2], sr[3]); w.z = pk2(sr[4], sr[5]); w.w = pk2(sr[6], sr[7]);
                    *(u32x4*)(base + (size_t)row * (2 * D) + D) = w; }
        } else {
            float* base = (u.koff ? lorab : lora) + (pn - 40) * 256 + colw;
#pragma unroll
            for (int ai = 0; ai < 2; ++ai)
#pragma unroll
                for (int m = 0; m < 4; ++m) { const int row = row0 + ai * 128 + m * 16;
#pragma unroll
                    for (int bj = 0; bj < 2; ++bj) { float* p = base + (size_t)row * 1024 + bj * 128; *(f32x4*)p = acc[ai][bj][m][0]; *(f32x4*)(p + 4) = acc[ai][bj][m][1]; } }
        }
    }
};


struct LoraOrder { static constexpr bool GATHER = false; const int* tok; int G, c;
    __device__ bool next(int i, pg8::Unit& u) const { const int L = i * G + c; if (L >= (S / 256) * 8) return false; u.pm = L >> 3; u.pn = 40 + ((L >> 1) & 3); u.koff = (L & 1) * AW * 2; u.koffB = u.koff; return true; }
    __device__ __forceinline__ void a_ready(const pg8::Unit&) const {}
    __device__ __forceinline__ void done(const pg8::Unit&) const {} };
__device__ __forceinline__ void unpack8(const u32x4 w, float (&f)[8]) {
    f[0] = __uint_as_float(w.x << 16); f[1] = __uint_as_float(w.x & 0xffff0000u); f[2] = __uint_as_float(w.y << 16); f[3] = __uint_as_float(w.y & 0xffff0000u);
    f[4] = __uint_as_float(w.z << 16); f[5] = __uint_as_float(w.z & 0xffff0000u); f[6] = __uint_as_float(w.w << 16); f[7] = __uint_as_float(w.w & 0xffff0000u);
}
struct EpiMix {
    static constexpr bool PERM = true, AFTER_DRAIN = false, MIDK = false;
    const bf16* gate; bf16* mix;
    __device__ __forceinline__ void operator()(const pg8::f32x4 (&acc)[2][2][4][2], const pg8::Unit& u, int wr, int wc, int fr, int fq) const {
        const int row0 = u.pm * 256 + wr * 64 + fr; const int col0 = u.pn * 256 + wc * 32 + 8 * fq;
        if (u.koff == 0) {
#pragma unroll
            for (int ai = 0; ai < 2; ++ai)
#pragma unroll
                for (int m = 0; m < 4; ++m) { const size_t row = row0 + ai * 128 + m * 16; const bf16* gp = gate + row * (2 * D) + col0;
#pragma unroll
                    for (int bj = 0; bj < 2; ++bj) { float ga[8]; unpack8(*(const u32x4*)(gp + bj * 128), ga); const pg8::f32x4 v0 = acc[ai][bj][m][0], v1 = acc[ai][bj][m][1];
                        u32x4 w; w.x = pk2(v0[0] * ga[0], v0[1] * ga[1]); w.y = pk2(v0[2] * ga[2], v0[3] * ga[3]); w.z = pk2(v1[0] * ga[4], v1[1] * ga[5]); w.w = pk2(v1[2] * ga[6], v1[3] * ga[7]);
                        *(u32x4*)(mix + row * D + col0 + bj * 128) = w; } }
        } else {
#pragma unroll
            for (int ai = 0; ai < 2; ++ai)
#pragma unroll
                for (int m = 0; m < 4; ++m) { const size_t row = row0 + ai * 128 + m * 16; const bf16* gp = gate + row * (2 * D) + D + col0;
#pragma unroll
                    for (int bj = 0; bj < 2; ++bj) { float gr[8], tp[8]; unpack8(*(const u32x4*)(gp + bj * 128), gr); unpack8(*(const u32x4*)(mix + row * D + col0 + bj * 128), tp); const pg8::f32x4 v0 = acc[ai][bj][m][0], v1 = acc[ai][bj][m][1];
                        u32x4 w; w.x = pk2((v0[0] + tp[0]) * gr[0], (v0[1] + tp[1]) * gr[1]); w.y = pk2((v0[2] + tp[2]) * gr[2], (v0[3] + tp[3]) * gr[3]);
                        w.z = pk2((v1[0] + tp[4]) * gr[4], (v1[1] + tp[5]) * gr[5]); w.w = pk2((v1[2] + tp[6]) * gr[6], (v1[3] + tp[7]) * gr[7]);
                        *(u32x4*)(mix + row * D + col0 + bj * 128) = w; } }
        }
    }
};
struct MixOrder {
    static constexpr bool GATHER = false; const int* tok; int G, c;
    __device__ bool next(int i, pg8::Unit& u) const { const int L = (i >> 1) * G + c; if (L >= (S / 256) * (D / 256)) return false; u.pm = L / (D / 256); u.pn = L % (D / 256); u.koff = (i & 1) * AW * 2; u.koffB = u.koff; return true; }
    __device__ __forceinline__ void a_ready(const pg8::Unit&) const {}
    __device__ __forceinline__ void done(const pg8::Unit&) const {}
};
struct EpiBf16P {
    static constexpr bool PERM = true, AFTER_DRAIN = false, MIDK = false;
    bf16* C; long ldc;
    __device__ __forceinline__ void operator()(const pg8::f32x4 (&acc)[2][2][4][2], const pg8::Unit& u, int wr, int wc, int fr, int fq) const {
        const int row0 = u.pm * 256 + wr * 64 + fr; const int col0 = u.pn * 256 + wc * 32 + 8 * fq;
#pragma unroll
        for (int ai = 0; ai < 2; ++ai)
#pragma unroll
            for (int m = 0; m < 4; ++m) { bf16* p = C + (size_t)(row0 + ai * 128 + m * 16) * ldc + col0;
#pragma unroll
                for (int bj = 0; bj < 2; ++bj) { const pg8::f32x4 v0 = acc[ai][bj][m][0], v1 = acc[ai][bj][m][1];
                    u32x4 w; w.x = pk2(v0[0], v0[1]); w.y = pk2(v0[2], v0[3]); w.z = pk2(v1[0], v1[1]); w.w = pk2(v1[2], v1[3]);
                    *(u32x4*)(p + bj * 128) = w; } }
    }
};
struct EpiF32P {
    static constexpr bool PERM = true, AFTER_DRAIN = false, MIDK = false;
    float* C; long ldc;
    __device__ __forceinline__ void operator()(const pg8::f32x4 (&acc)[2][2][4][2], const pg8::Unit& u, int wr, int wc, int fr, int fq) const {
        const int row0 = u.pm * 256 + wr * 64 + fr; const int col0 = u.pn * 256 + wc * 32 + 8 * fq;
#pragma unroll
        for (int ai = 0; ai < 2; ++ai)
#pragma unroll
            for (int m = 0; m < 4; ++m) { float* p = C + (size_t)(row0 + ai * 128 + m * 16) * ldc + col0;
#pragma unroll
                for (int bj = 0; bj < 2; ++bj) { *(f32x4*)(p + bj * 128) = acc[ai][bj][m][0]; *(f32x4*)(p + bj * 128 + 4) = acc[ai][bj][m][1]; } }
    }
};
template <bool GA> struct ExpertOrderT {
    static constexpr bool GATHER = GA; const int* elist;
    LAS const int* tb; int nj, G, c;
    __device__ bool next(int i, pg8::Unit& u) const { const int L = i * G + c; const int pm = L / nj; if (pm >= tb[512]) return false; u.pm = pm; u.pn = tb[128 + pm] * nj + (L % nj); u.koff = 0; u.koffB = 0; return true; }
    __device__ __forceinline__ int row_tok(int pm, int r) const { const int e = tb[128 + pm]; const int q = tb[320 + pm] + r; return q < tb[e] ? elist[e * S + q] : 0; }
    __device__ __forceinline__ void a_ready(const pg8::Unit&) const {}
    __device__ __forceinline__ void done(const pg8::Unit&) const {}
};
struct EpiHid {
    static constexpr bool PERM = true, AFTER_DRAIN = false, MIDK = false;
    unsigned char* hid;
    __device__ __forceinline__ void operator()(const pg8::f32x4 (&acc)[2][2][4][2], const pg8::Unit& u, int wr, int wc, int fr, int fq) const {
        const int row0 = u.pm * 128 + wr * 64 + fr; const int col0 = (u.pn & 3) * 128 + wc * 32 + 8 * fq;
#pragma unroll
        for (int ai = 0; ai < 1; ++ai)
#pragma unroll
            for (int m = 0; m < 4; ++m) { const pg8::f32x4 g0 = acc[ai][0][m][0], g1 = acc[ai][0][m][1], u0 = acc[ai][1][m][0], u1 = acc[ai][1][m][1]; float o[8];
#pragma unroll
                for (int j = 0; j < 4; ++j) { o[j] = g0[j] * sigmoidf_(g0[j]) * u0[j]; o[4 + j] = g1[j] * sigmoidf_(g1[j]) * u1[j]; }
                u32x2 w; w.x = pk_fp8x4(o[0], o[1], o[2], o[3], 8.0f); w.y = pk_fp8x4(o[4], o[5], o[6], o[7], 8.0f);
                *(u32x2*)(hid + (size_t)(row0 + ai * 128 + m * 16) * FF + col0) = w; }
    }
};
struct EpiYbuf {
    static constexpr bool PERM = true, AFTER_DRAIN = false, MIDK = false;
    bf16* ybuf;
    __device__ __forceinline__ void operator()(const pg8::f32x4 (&acc)[2][2][4][2], const pg8::Unit& u, int wr, int wc, int fr, int fq) const {
        const int row0 = u.pm * 128 + wr * 64 + fr; const int col0 = (u.pn & 7) * 256 + wc * 32 + 8 * fq;
#pragma unroll
        for (int ai = 0; ai < 1; ++ai)
#pragma unroll
            for (int m = 0; m < 4; ++m) { bf16* p = ybuf + (size_t)(row0 + ai * 128 + m * 16) * D + col0;
#pragma unroll
                for (int bj = 0; bj < 2; ++bj) { const pg8::f32x4 v0 = acc[ai][bj][m][0], v1 = acc[ai][bj][m][1];
                    u32x4 w; w.x = pk2(v0[0], v0[1]); w.y = pk2(v0[2], v0[3]); w.z = pk2(v1[0], v1[1]); w.w = pk2(v1[2], v1[3]);
                    *(u32x4*)(p + bj * 128) = w; } }
    }
};
constexpr int RS8 = D + 8;

typedef short s16x4 __attribute__((ext_vector_type(4)));
constexpr int KST = 136, VST = 144;
constexpr int KT_BYTES = 64 * KST * 2, VT_BYTES = 64 * VST * 2;
constexpr int AT_BUF = KT_BYTES + VT_BYTES;
constexpr int AT_G = 2 * AT_BUF;
constexpr int AT_HIST = AT_G + 8 * 2112;
constexpr int AT_ITEMS = AT_HIST + 256;
constexpr int LIST_PER_HEAD = 256 * 496;
__device__ __forceinline__ int list_off(int j) { return 256 * (31 * j - (j * (j - 1)) / 2); }
__device__ __forceinline__ s16x4 tr_read4(unsigned addr) { return __builtin_amdgcn_ds_read_tr16_b64_v4i16((LAS s16x4*)(size_t)addr); }

struct AttnBufs { const bf16* q; const bf16* k; const bf16* v; const bf16* kmh; const bf16* kml; unsigned* mask; int* list; int* cnt; bf16* part; float* ml; };

__device__ __forceinline__ void moba_select_unit(LAS unsigned char* lds, const AttnBufs& A, int head, int qt, int tid, int lane, int wave) {
    const int q0 = qt * 128, qblk = qt >> 1, g4 = lane >> 4, c16 = lane & 15; const int myq = q0 + wave * 16 + c16;
    LAS int* hist = (LAS int*)(lds + AT_HIST); LAS int* base = hist + 32;
    if (tid < 32) hist[tid] = 0;
    __syncthreads();
    unsigned msk = 0u; int lp0 = 0, lp1 = 0, lp2 = 0, b0 = 0, b1 = 0, b2 = 0, nsel = 0;
    if (qblk > 0) {
        bf16x8 qf[4];
#pragma unroll
        for (int ks = 0; ks < 4; ++ks) qf[ks] = *(const bf16x8*)(A.q + (size_t)myq * AW + head * AD + 32 * ks + 8 * g4);
        f32x4 gs[2] = {(f32x4){0.f, 0.f, 0.f, 0.f}, (f32x4){0.f, 0.f, 0.f, 0.f}};
#pragma unroll
        for (int mt = 0; mt < 2; ++mt)
#pragma unroll
            for (int ks = 0; ks < 4; ++ks) { const size_t o = (size_t)(head * NB + 16 * mt + c16) * AD + 32 * ks + 8 * g4;
                gs[mt] = __builtin_amdgcn_mfma_f32_16x16x32_bf16(*(const bf16x8*)(A.kmh + o), qf[ks], gs[mt], 0, 0, 0);
                gs[mt] = __builtin_amdgcn_mfma_f32_16x16x32_bf16(*(const bf16x8*)(A.kml + o), qf[ks], gs[mt], 0, 0, 0); }
        LAS float* G = (LAS float*)(lds + AT_G + wave * 2112);
#pragma unroll
        for (int mt = 0; mt < 2; ++mt)
#pragma unroll
            for (int rg = 0; rg < 4; ++rg) G[c16 * 33 + 16 * mt + 4 * g4 + rg] = gs[mt][rg];
        LDS_WAIT(); asm volatile("" ::: "memory");
        if (lane < 16) {
            nsel = qblk < 3 ? qblk : 3;
            float gvv[32];
#pragma unroll
            for (int n = 0; n < 32; ++n) gvv[n] = G[lane * 33 + n];
#pragma unroll
            for (int n = 0; n < 32; ++n) gvv[n] = n < qblk ? gvv[n] : -3e38f;
#pragma unroll
            for (int t = 0; t < 3; ++t) if (t < nsel) { float best = -3e38f; int bi = 0;
#pragma unroll
                for (int n = 0; n < 32; ++n) { const bool take = gvv[n] > best; best = take ? gvv[n] : best; bi = take ? n : bi; }
#pragma unroll
                for (int n = 0; n < 32; ++n) gvv[n] = (n == bi) ? -3e38f : gvv[n];
                msk |= 1u << bi;
                const int lp = atomicAdd((int*)&hist[bi], 1); if (t == 0) { lp0 = lp; b0 = bi; } else if (t == 1) { lp1 = lp; b1 = bi; } else { lp2 = lp; b2 = bi; } }
        }
    }
    if (lane < 16) A.mask[head * S + myq] = msk;
    __syncthreads();
    if (tid < 32) { const int hcount = hist[tid]; base[tid] = hcount > 0 ? atomicAdd(A.cnt + (head * NB + tid) * ACNT_STR, hcount) : 0; }
    __syncthreads();
    if (lane < 16) { int* lh = A.list + head * LIST_PER_HEAD;
        if (nsel > 0) lh[list_off(b0) + base[b0] + lp0] = myq;
        if (nsel > 1) lh[list_off(b1) + base[b1] + lp1] = myq;
        if (nsel > 2) lh[list_off(b2) + base[b2] + lp2] = myq; }
    __syncthreads();
}

__device__ __forceinline__ void moba_item2(LAS unsigned char* lds, const AttnBufs& A, int head, int kvb, bool own, int r, int cntj, int tid, int lane, int wave) {
    const int g4 = lane >> 4, c16 = lane & 15;
    int myq[2]; bool valid[2];
    if (own) { myq[0] = kvb * MB + wave * 32 + c16; myq[1] = myq[0] + 16; valid[0] = true; valid[1] = true; }
    else { const int* lp = A.list + head * LIST_PER_HEAD + list_off(kvb);
#pragma unroll
        for (int g = 0; g < 2; ++g) { const int e = r * 256 + wave * 32 + 16 * g + c16; valid[g] = e < cntj; myq[g] = lp[valid[g] ? e : 0]; } }
    const bool wave_valid = own || (r * 256 + wave * 32 < cntj);
    const int qfirst = kvb * MB + wave * 32;
    bf16x8 qf[2][4];
#pragma unroll
    for (int g = 0; g < 2; ++g)
#pragma unroll
        for (int ks = 0; ks < 4; ++ks) qf[g][ks] = *(const bf16x8*)(A.q + (size_t)myq[g] * AW + head * AD + 32 * ks + 8 * g4);
    f32x4 oacc[2][8];
#pragma unroll
    for (int g = 0; g < 2; ++g)
#pragma unroll
        for (int dt = 0; dt < 8; ++dt) oacc[g][dt] = (f32x4){0.f, 0.f, 0.f, 0.f};
    float mrun[2] = {-1e30f, -1e30f}, lrun[2] = {0.f, 0.f};
    const float sc2 = 0.08838834764831845f * 1.4426950408889634f;
    const int r0 = tid >> 4, ch = tid & 15;
    u32x4 kr[2], vr[2];
    const bf16* kg = A.k + (size_t)(kvb * MB + r0) * AW + head * AD + 8 * ch; const bf16* vg = A.v + (size_t)(kvb * MB + r0) * AW + head * AD + 8 * ch;
    LAS unsigned char* kst = lds + (r0 * KST + 8 * ch) * 2; LAS unsigned char* vst = lds + KT_BYTES + (r0 * VST + 8 * ch) * 2;
    const LAS unsigned char* kld = lds + (c16 * KST + 8 * g4) * 2; const LAS unsigned char* vld = lds + KT_BYTES + ((4 * g4 + (c16 >> 2)) * VST + 4 * (c16 & 3)) * 2;
#define GLD(it) do { kr[0] = *(const u32x4*)(kg + (size_t)(64 * (it)) * AW); kr[1] = *(const u32x4*)(kg + (size_t)(64 * (it) + 32) * AW); vr[0] = *(const u32x4*)(vg + (size_t)(64 * (it)) * AW); vr[1] = *(const u32x4*)(vg + (size_t)(64 * (it) + 32) * AW); } while (0)
#define LST(b) do { *(LAS u32x4*)(kst + (b) * AT_BUF) = kr[0]; *(LAS u32x4*)(kst + (b) * AT_BUF + 32 * KST * 2) = kr[1]; *(LAS u32x4*)(vst + (b) * AT_BUF) = vr[0]; *(LAS u32x4*)(vst + (b) * AT_BUF + 32 * VST * 2) = vr[1]; } while (0)
    GLD(0); LST(0);
    __syncthreads();
#pragma nounroll
    for (int it = 0; it < 4; ++it) {
        const int kp0 = kvb * MB + 64 * it; const int b = it & 1;
        if (it + 1 < 4) GLD(it + 1);
        if (wave_valid && (!own || kp0 <= qfirst + 31)) {
            const LAS unsigned char* Kb = kld + b * AT_BUF; const LAS unsigned char* vb = vld + b * AT_BUF;
            f32x4 st[2][4];
#pragma unroll
            for (int mt = 0; mt < 4; ++mt) { st[0][mt] = (f32x4){0.f, 0.f, 0.f, 0.f}; st[1][mt] = st[0][mt];
#pragma unroll
                for (int ks = 0; ks < 4; ++ks) { const bf16x8 kf = *(const LAS bf16x8*)(Kb + (16 * mt * KST + 32 * ks) * 2);
                    st[0][mt] = __builtin_amdgcn_mfma_f32_16x16x32_bf16(kf, qf[0][ks], st[0][mt], 0, 0, 0);
                    st[1][mt] = __builtin_amdgcn_mfma_f32_16x16x32_bf16(kf, qf[1][ks], st[1][mt], 0, 0, 0); } }
            bf16x8 pf[2][2];
#pragma unroll
            for (int g = 0; g < 2; ++g) {
                if (own && kp0 + 63 > qfirst + 16 * g) {
#pragma unroll
                    for (int mt = 0; mt < 4; ++mt)
#pragma unroll
                        for (int rg = 0; rg < 4; ++rg) { const int kpos = kp0 + 16 * mt + 4 * g4 + rg; st[g][mt][rg] = (kpos <= myq[g]) ? st[g][mt][rg] : -1e30f; }
                }
                float mloc = fmaxf(fmaxf(fmaxf(st[g][0][0], st[g][0][1]), fmaxf(st[g][0][2], st[g][0][3])), fmaxf(fmaxf(st[g][1][0], st[g][1][1]), fmaxf(st[g][1][2], st[g][1][3])));
                mloc = fmaxf(mloc, fmaxf(fmaxf(fmaxf(st[g][2][0], st[g][2][1]), fmaxf(st[g][2][2], st[g][2][3])), fmaxf(fmaxf(st[g][3][0], st[g][3][1]), fmaxf(st[g][3][2], st[g][3][3]))));
                mloc = fmaxf(mloc, __shfl_xor(mloc, 16)); mloc = fmaxf(mloc, __shfl_xor(mloc, 32));
                const float mnew = fmaxf(mrun[g], mloc * sc2); const float alpha = __builtin_amdgcn_exp2f(mrun[g] - mnew); mrun[g] = mnew;
                float psum = 0.f;
#pragma unroll
                for (int mt = 0; mt < 4; ++mt)
#pragma unroll
                    for (int rg = 0; rg < 4; ++rg) { const float p = __builtin_amdgcn_exp2f(fmaf(st[g][mt][rg], sc2, -mnew)); st[g][mt][rg] = p; psum += p; }
                lrun[g] = lrun[g] * alpha + psum;
#pragma unroll
                for (int dt = 0; dt < 8; ++dt) oacc[g][dt] = oacc[g][dt] * alpha;
#pragma unroll
                for (int s = 0; s < 2; ++s) { u32x4 w; w.x = pk2(st[g][2 * s][0], st[g][2 * s][1]); w.y = pk2(st[g][2 * s][2], st[g][2 * s][3]); w.z = pk2(st[g][2 * s + 1][0], st[g][2 * s + 1][1]); w.w = pk2(st[g][2 * s + 1][2], st[g][2 * s + 1][3]);
                    pf[g][s] = __builtin_bit_cast(bf16x8, w); }
            }
#pragma unroll
            for (int dt = 0; dt < 8; ++dt)
#pragma unroll
                for (int s = 0; s < 2; ++s) {
                    const s16x4 lo = __builtin_amdgcn_ds_read_tr16_b64_v4i16((LAS s16x4*)(vb + (32 * s * VST + 16 * dt) * 2));
                    const s16x4 hi = __builtin_amdgcn_ds_read_tr16_b64_v4i16((LAS s16x4*)(vb + ((32 * s + 16) * VST + 16 * dt) * 2));
                    bf16x8 vf; vf[0] = lo[0]; vf[1] = lo[1]; vf[2] = lo[2]; vf[3] = lo[3]; vf[4] = hi[0]; vf[5] = hi[1]; vf[6] = hi[2]; vf[7] = hi[3];
                    oacc[0][dt] = __builtin_amdgcn_mfma_f32_16x16x32_bf16(vf, pf[0][s], oacc[0][dt], 0, 0, 0);
                    oacc[1][dt] = __builtin_amdgcn_mfma_f32_16x16x32_bf16(vf, pf[1][s], oacc[1][dt], 0, 0, 0); }
        }
        if (it + 1 < 4) LST(b ^ 1);
        __syncthreads();
    }
#undef GLD
#undef LST
#pragma unroll
    for (int g = 0; g < 2; ++g) {
        float l = lrun[g]; l += __shfl_xor(l, 16); l += __shfl_xor(l, 32);
        if (valid[g] && wave_valid) {
            int slot = 0; if (!own) { const unsigned mk = A.mask[head * S + myq[g]]; slot = 1 + __builtin_popcount(mk & ((1u << kvb) - 1u)); }
            const size_t pidx = ((size_t)(head * S + myq[g])) * 4 + slot;
            const float inv = 1.0f / l;
            bf16* orow = A.part + pidx * AD + 4 * g4;
#pragma unroll
            for (int dt = 0; dt < 8; ++dt) { u32x2 w; w.x = pk2(oacc[g][dt][0] * inv, oacc[g][dt][1] * inv); w.y = pk2(oacc[g][dt][2] * inv, oacc[g][dt][3] * inv); *(u32x2*)(orow + 16 * dt) = w; }
            if (g4 == 0) { A.ml[pidx * 2] = mrun[g]; A.ml[pidx * 2 + 1] = l; }
        }
    }
}
__device__ __forceinline__ void moba_items(LAS unsigned char* lds, const AttnBufs& A, int* qhead, LAS int* pre, LAS int* tick, int tid, int lane, int wave) {
    const int nitems = AH * NB + pre[256];
    if (tid == 0) tick[0] = atomicAdd(qhead, 1);
    __syncthreads();
    int item = tick[0];
    while (item < nitems) {
        __syncthreads();
        if (tid == 0) tick[0] = atomicAdd(qhead, 1);
        if (item < AH * NB) moba_item2(lds, A, item >> 5, item & 31, true, 0, 0, tid, lane, wave);
        else { const int s = item - AH * NB; int lo_ = 0, hi_ = 256;
            while (hi_ - lo_ > 1) { const int mid = (lo_ + hi_) >> 1; if (pre[mid] <= s) lo_ = mid; else hi_ = mid; }
            moba_item2(lds, A, lo_ >> 5, lo_ & 31, false, s - pre[lo_], A.cnt[lo_ * ACNT_STR], tid, lane, wave); }
        __syncthreads();
        item = tick[0];
    }
}

constexpr int RST = 72, SLOTB = 64 * RST * 2;
constexpr int NCH = S / 64;
__device__ __forceinline__ bf16x8 frag_rows(const LAS bf16* M, int r0, int k0, int c16, int g4) { return *(const LAS bf16x8*)(M + (r0 + c16) * RST + k0 + 8 * g4); }
__device__ __forceinline__ bf16x8 frag_cols(const LAS bf16* M, int c0, int k0, int c16, int g4) {
    const unsigned base = (unsigned)(size_t)M; const int tq = c16 >> 2, tp = c16 & 3;
    const s16x4 lo = tr_read4(base + ((k0 + 8 * g4 + tq) * RST + c0 + 4 * tp) * 2);
    const s16x4 hi = tr_read4(base + ((k0 + 8 * g4 + 4 + tq) * RST + c0 + 4 * tp) * 2);
    bf16x8 r; r[0] = lo[0]; r[1] = lo[1]; r[2] = lo[2]; r[3] = lo[3]; r[4] = hi[0]; r[5] = hi[1]; r[6] = hi[2]; r[7] = hi[3]; return r;
}
__device__ __forceinline__ void st_tile(LAS bf16* M, const f32x4 v, int r0, int c0, int c16, int g4) {
#pragma unroll
    for (int rg = 0; rg < 4; rg += 2) { const unsigned p = pk2(v[rg], v[rg + 1]); M[(r0 + 4 * g4 + rg) * RST + c0 + c16] = (bf16)(p & 0xffffu); M[(r0 + 4 * g4 + rg + 1) * RST + c0 + c16] = (bf16)(p >> 16); }
}
#define MFMA16(a, b, c) __builtin_amdgcn_mfma_f32_16x16x32_bf16(a, b, c, 0, 0, 0)

struct RwkvBufs { const float* rkv; const float* lw; const float* av; bf16* P; float* QmT; bf16* Rt; float* Yi; float* bonus; };

#define R1_BAR() do { asm volatile("s_waitcnt lgkmcnt(0)" ::: "memory"); __builtin_amdgcn_s_barrier(); asm volatile("" ::: "memory"); } while (0)
struct R1In { float lwv[8], av[8], rr[9], kr[9], vr[9]; };
__device__ __forceinline__ void rwkv_r1_load(R1In& I, const RwkvBufs& B, int head, int chunk, int lane, int wave) {
    const int ch = head * RN + lane; const int t0 = chunk * 64 + wave * 8;
#pragma unroll
    for (int i = 0; i < 8; ++i) { I.lwv[i] = B.lw[(size_t)(t0 + i) * RW + ch]; I.av[i] = B.av[(size_t)(t0 + i) * RW + ch]; }
#pragma unroll
    for (int i = 0; i < 9; ++i) { const int t = t0 - 1 + i; if (t >= 0) { const float* cr = B.rkv + (size_t)t * (3 * RW) + ch; I.rr[i] = cr[0]; I.kr[i] = cr[RW]; I.vr[i] = cr[2 * RW]; } else { I.rr[i] = 0.f; I.kr[i] = 0.f; I.vr[i] = 0.f; } }
}
__device__ __forceinline__ void rwkv_r1_unit(LAS unsigned char* lds, const RwkvBufs& B, const float* const* in, R1In& I, int head, int chunk, int nhead, int nchunk, int tid, int lane, int wave) {
    LAS bf16* sA = (LAS bf16*)(lds + 0 * SLOTB); LAS bf16* sB = (LAS bf16*)(lds + 1 * SLOTB); LAS bf16* sK = (LAS bf16*)(lds + 2 * SLOTB); LAS bf16* sR = (LAS bf16*)(lds + 3 * SLOTB); LAS bf16* sV = (LAS bf16*)(lds + 4 * SLOTB);
    LAS bf16* sM0 = (LAS bf16*)(lds + 5 * SLOTB); LAS bf16* sM1 = (LAS bf16*)(lds + 6 * SLOTB); LAS bf16* sT0 = (LAS bf16*)(lds + 7 * SLOTB); LAS bf16* sT1 = (LAS bf16*)(lds + 8 * SLOTB);
    LAS bf16* sLak = (LAS bf16*)(lds + 9 * SLOTB); LAS bf16* sMrb = (LAS bf16*)(lds + 10 * SLOTB); LAS bf16* sMrk = (LAS bf16*)(lds + 11 * SLOTB); LAS bf16* sX = (LAS bf16*)(lds + 12 * SLOTB);
    LAS bf16* sW = (LAS bf16*)(lds + 13 * SLOTB); LAS bf16* sU = (LAS bf16*)(lds + 14 * SLOTB);
    LAS float* cs = (LAS float*)(lds + 15 * SLOTB); LAS float* gC = cs + 512;
    const int c16 = lane & 15, g4 = lane >> 4;
    {
        const int ch = head * RN + lane; const int t0 = chunk * 64 + wave * 8;
        const float mur = in[9][ch], muk = in[10][ch], muv = in[11][ch], kkc = in[23][ch], kac = in[24][ch], rkc = in[25][ch];
        float run = 0.f;
#pragma unroll
        for (int i = 0; i < 8; ++i) run += I.lwv[i];
        cs[wave * 64 + lane] = run;
        R1_BAR();
        float off = 0.f;
        for (int w = 0; w < wave; ++w) off += cs[w * 64 + lane];
        float gcur = off;
#pragma unroll
        for (int i = 0; i < 8; ++i) {
            const int t = t0 + i;
            const float r0 = I.rr[i + 1], k0 = I.kr[i + 1], v0 = I.vr[i + 1], rp = I.rr[i], kp = I.kr[i], vp = I.vr[i];
            const float r = r0 + (rp - r0) * mur, kx = k0 + (kp - k0) * muk, vx = v0 + (vp - v0) * muv;
            const float a = I.av[i];
            float kk = kx * kkc; const float ss = wave_sum(kk * kk); kk = kk * __builtin_amdgcn_rcpf(fmaxf(sqrtf(ss), 1e-12f));
            const float kt = kx * (1.0f + (a - 1.0f) * kac);
            const float bn = wave_sum(r * kt * rkc);
            if (lane == 0) B.bonus[(size_t)t * RH + head] = bn;
            const float gprev = gcur; gcur += I.lwv[i];
            const float eg = __expf(gcur), egp = __expf(gprev), eng = __expf(-gcur);
            const int tl = wave * 8 + i;
            { const unsigned pab = pk2(-kk * egp, kk * a * eng), pkr = pk2(kt * eng, r * eg), pv_ = pk2(vx, vx);
              sA[tl * RST + lane] = (bf16)(pab & 0xffffu); sB[tl * RST + lane] = (bf16)(pab >> 16); sK[tl * RST + lane] = (bf16)(pkr & 0xffffu); sR[tl * RST + lane] = (bf16)(pkr >> 16); sV[tl * RST + lane] = (bf16)(pv_ & 0xffffu); }
        }
        if (wave == 7) gC[lane] = __expf(gcur);
    }
    if (nhead >= 0) rwkv_r1_load(I, B, nhead, nchunk, lane, wave);
    R1_BAR();
    const int mt = wave >> 1, ntb = 2 * (wave & 1);
    f32x4 Treg[2];
    for (int r14 = 0; r14 < 1 + REP_R1A; ++r14) {
        f32x4 ab[2], ak[2], rb[2], rk[2];
#pragma unroll
        for (int n = 0; n < 2; ++n) { ab[n] = (f32x4){0.f, 0.f, 0.f, 0.f}; ak[n] = ab[n]; rb[n] = ab[n]; rk[n] = ab[n]; }
#pragma unroll
        for (int s = 0; s < 2; ++s) { const bf16x8 aA = frag_rows(sA, 16 * mt, 32 * s, c16, g4), aR = frag_rows(sR, 16 * mt, 32 * s, c16, g4);
#pragma unroll
            for (int n = 0; n < 2; ++n) { const bf16x8 bB = frag_rows(sB, 16 * (ntb + n), 32 * s, c16, g4), bK = frag_rows(sK, 16 * (ntb + n), 32 * s, c16, g4);
                ab[n] = MFMA16(aA, bB, ab[n]); ak[n] = MFMA16(aA, bK, ak[n]); rb[n] = MFMA16(aR, bB, rb[n]); rk[n] = MFMA16(aR, bK, rk[n]); } }
#pragma unroll
        for (int n = 0; n < 2; ++n) { const int i = 16 * (ntb + n) + c16;
#pragma unroll
            for (int rg = 0; rg < 4; ++rg) { const int t = 16 * mt + 4 * g4 + rg; const bool lo = i < t, le = i <= t;
                ab[n][rg] = lo ? ab[n][rg] : 0.f; ak[n][rg] = lo ? ak[n][rg] : 0.f; rb[n][rg] = le ? rb[n][rg] : 0.f; rk[n][rg] = le ? rk[n][rg] : 0.f;
                Treg[n][rg] = ab[n][rg] + (i == t ? 1.0f : 0.f); }
            st_tile(sM0, ab[n], 16 * mt, 16 * (ntb + n), c16, g4); st_tile(sT0, Treg[n], 16 * mt, 16 * (ntb + n), c16, g4);
            st_tile(sLak, ak[n], 16 * mt, 16 * (ntb + n), c16, g4); st_tile(sMrb, rb[n], 16 * mt, 16 * (ntb + n), c16, g4); st_tile(sMrk, rk[n], 16 * mt, 16 * (ntb + n), c16, g4); }
    }
    R1_BAR();
    LAS bf16* Tc = sT0; LAS bf16* Tn = sT1; LAS bf16* Mc = sM0; LAS bf16* Mn = sM1;
    {
        f32x4 am[2] = {(f32x4){0.f, 0.f, 0.f, 0.f}, (f32x4){0.f, 0.f, 0.f, 0.f}}, ax[2] = {(f32x4){0.f, 0.f, 0.f, 0.f}, (f32x4){0.f, 0.f, 0.f, 0.f}};
#pragma unroll
        for (int s = 0; s < 2; ++s) { const bf16x8 aM = frag_rows(Mc, 16 * mt, 32 * s, c16, g4), aL = frag_rows(sLak, 16 * mt, 32 * s, c16, g4);
#pragma unroll
            for (int n = 0; n < 2; ++n) { am[n] = MFMA16(aM, frag_cols(Mc, 16 * (ntb + n), 32 * s, c16, g4), am[n]); ax[n] = MFMA16(aL, frag_cols(sV, 16 * (ntb + n), 32 * s, c16, g4), ax[n]); } }
#pragma unroll
        for (int n = 0; n < 2; ++n) { st_tile(Mn, am[n], 16 * mt, 16 * (ntb + n), c16, g4); st_tile(sX, ax[n], 16 * mt, 16 * (ntb + n), c16, g4); }
        R1_BAR();
        LAS bf16* t2 = Mc; Mc = Mn; Mn = t2;
    }
    for (int kround = 1; kround <= 5 + REP_R1NR; ++kround) {
        f32x4 am[2] = {(f32x4){0.f, 0.f, 0.f, 0.f}, (f32x4){0.f, 0.f, 0.f, 0.f}};
#pragma unroll
        for (int s = 0; s < 2; ++s) { const bf16x8 aT = frag_rows(Tc, 16 * mt, 32 * s, c16, g4), aM = frag_rows(Mc, 16 * mt, 32 * s, c16, g4);
#pragma unroll
            for (int n = 0; n < 2; ++n) { const bf16x8 bM = frag_cols(Mc, 16 * (ntb + n), 32 * s, c16, g4); Treg[n] = MFMA16(aT, bM, Treg[n]); am[n] = MFMA16(aM, bM, am[n]); } }
#pragma unroll
        for (int n = 0; n < 2; ++n) { st_tile(Tn, Treg[n], 16 * mt, 16 * (ntb + n), c16, g4); st_tile(Mn, am[n], 16 * mt, 16 * (ntb + n), c16, g4); }
        R1_BAR();
        LAS bf16* t1 = Tc; Tc = Tn; Tn = t1; LAS bf16* t2 = Mc; Mc = Mn; Mn = t2;
    }
    for (int rwu = 0; rwu < 1 + REP_R1B; ++rwu) {
        f32x4 aw[2] = {(f32x4){0.f, 0.f, 0.f, 0.f}, (f32x4){0.f, 0.f, 0.f, 0.f}}, au[2] = {(f32x4){0.f, 0.f, 0.f, 0.f}, (f32x4){0.f, 0.f, 0.f, 0.f}};
#pragma unroll
        for (int s = 0; s < 2; ++s) { const bf16x8 aT = frag_rows(Tc, 16 * mt, 32 * s, c16, g4);
#pragma unroll
            for (int n = 0; n < 2; ++n) { aw[n] = MFMA16(aT, frag_cols(sA, 16 * (ntb + n), 32 * s, c16, g4), aw[n]); au[n] = MFMA16(aT, frag_cols(sX, 16 * (ntb + n), 32 * s, c16, g4), au[n]); } }
#pragma unroll
        for (int n = 0; n < 2; ++n) { st_tile(sW, aw[n], 16 * mt, 16 * (ntb + n), c16, g4); st_tile(sU, au[n], 16 * mt, 16 * (ntb + n), c16, g4); }
    }
    R1_BAR();
    for (int rs8 = 0; rs8 < 1 + REP_R1C; ++rs8) {
        const size_t ub = (size_t)(head * NCH + chunk) * 4096;
        f32x4 pp[2], qq[2], rr[2], yy[2];
#pragma unroll
        for (int n = 0; n < 2; ++n) { pp[n] = (f32x4){0.f, 0.f, 0.f, 0.f}; qq[n] = pp[n]; rr[n] = pp[n]; yy[n] = pp[n]; }
#pragma unroll
        for (int s = 0; s < 2; ++s) {
            const bf16x8 cW = frag_cols(sW, 16 * mt, 32 * s, c16, g4), cB = frag_cols(sB, 16 * mt, 32 * s, c16, g4), cK = frag_cols(sK, 16 * mt, 32 * s, c16, g4), cU = frag_cols(sU, 16 * mt, 32 * s, c16, g4), cV = frag_cols(sV, 16 * mt, 32 * s, c16, g4);
#pragma unroll
            for (int n = 0; n < 2; ++n) { const int c0 = 16 * (ntb + n);
                const bf16x8 bB = frag_cols(sB, c0, 32 * s, c16, g4), bU = frag_cols(sU, c0, 32 * s, c16, g4), bV = frag_cols(sV, c0, 32 * s, c16, g4);
                const bf16x8 rMrb = frag_rows(sMrb, c0, 32 * s, c16, g4), rMrk = frag_rows(sMrk, c0, 32 * s, c16, g4);
                pp[n] = MFMA16(cW, bB, pp[n]);
                qq[n] = MFMA16(cB, bU, qq[n]); qq[n] = MFMA16(cK, bV, qq[n]);
                rr[n] = MFMA16(cW, rMrb, rr[n]);
                yy[n] = MFMA16(cU, rMrb, yy[n]); yy[n] = MFMA16(cV, rMrk, yy[n]); } }
#pragma unroll
        for (int n = 0; n < 2; ++n) { const int j = 16 * (ntb + n) + c16; const int i0 = 16 * mt + 4 * g4;
            {
                const float gc = gC[j]; float o[4];
#pragma unroll
                for (int rg = 0; rg < 4; ++rg) o[rg] = gc * (pp[n][rg] + ((i0 + rg) == j ? 1.0f : 0.f));
                u32x2 w; w.x = pk2(o[0], o[1]); w.y = pk2(o[2], o[3]); *(u32x2*)(B.P + ub + (size_t)j * 64 + i0) = w; }
            {
                f32x4 o;
#pragma unroll
                for (int rg = 0; rg < 4; ++rg) o[rg] = gC[i0 + rg] * qq[n][rg];
                *(f32x4*)(B.QmT + ub + (size_t)j * 64 + i0) = o; }
            {
                const u32x2 rb2 = *(const LAS u32x2*)(sR + j * RST + i0); float o[4];
                o[0] = rr[n][0] + __uint_as_float(rb2.x << 16); o[1] = rr[n][1] + __uint_as_float(rb2.x & 0xffff0000u); o[2] = rr[n][2] + __uint_as_float(rb2.y << 16); o[3] = rr[n][3] + __uint_as_float(rb2.y & 0xffff0000u);
                u32x2 w; w.x = pk2(o[0], o[1]); w.y = pk2(o[2], o[3]); *(u32x2*)(B.Rt + ub + (size_t)j * 64 + i0) = w; }
            *(f32x4*)(B.Yi + ub + (size_t)j * 64 + i0) = yy[n];
        }
    }
    R1_BAR();
}

constexpr int R2_PST = 136, R2_QST = 272, R2_QOFF = 64 * R2_PST, R2_SLOT = R2_QOFF + 16 * R2_QST;
__device__ __forceinline__ void rwkv_r2_wg(LAS unsigned char* lds, const bf16* __restrict__ P, const float* __restrict__ QmT, bf16* __restrict__ H0T, int head, int cg, int wave, int lane) {
    const int c16 = lane & 15, g4 = lane >> 4;
    const int lt = ((wave & 3) << 6) | lane;
#define R2_BAR() do { asm volatile("s_waitcnt lgkmcnt(0)" ::: "memory"); __builtin_amdgcn_s_barrier(); asm volatile("" ::: "memory"); } while (0)
    if (wave >= 4) {
        constexpr int NST = 8;
        u32x4 st[NST][3];
        auto gl = [&](int c, u32x4 (&r)[3]) { const size_t ub = (size_t)(head * NCH + c) * 4096;
            const u32x4* p = (const u32x4*)(P + ub); const u32x4* q = (const u32x4*)(QmT + ub + (size_t)(16 * cg) * 64);
            r[0] = p[lt]; r[1] = p[lt + 256]; r[2] = q[lt]; };
        auto lw = [&](int slot, const u32x4 (&r)[3]) { LAS unsigned char* s = lds + slot * R2_SLOT;
#pragma unroll
            for (int i = 0; i < 2; ++i) { const int idx = lt + 256 * i; LAS u32x2* d = (LAS u32x2*)(s + (idx >> 3) * R2_PST + (idx & 7) * 16); u32x2 a; a.x = r[i].x; a.y = r[i].y; u32x2 b; b.x = r[i].z; b.y = r[i].w; d[0] = a; d[1] = b; }
            *(LAS u32x4*)(s + R2_QOFF + (lt >> 4) * R2_QST + (lt & 15) * 16) = r[2]; };
#pragma unroll
        for (int j = 0; j < NST; ++j) gl(j, st[j]);
        lw(0, st[0]); gl(NST, st[0]);
        R2_BAR();
        for (int c4 = 0; c4 < NCH / NST; ++c4) {
#pragma unroll
            for (int j = 0; j < NST; ++j) { const int c = NST * c4 + j;
                if (c + 1 < NCH) lw((c + 1) & 1, st[(j + 1) % NST]);
                if (c + 1 + NST < NCH) gl(c + 1 + NST, st[(j + 1) % NST]);
                R2_BAR(); }
        }
    } else if (wave == 0) {
        f32x4 hacc[4];
#pragma unroll
        for (int m = 0; m < 4; ++m) hacc[m] = (f32x4){0.f, 0.f, 0.f, 0.f};
        R2_BAR();
        for (int c = 0; c < NCH; ++c) {
            const LAS unsigned char* s = lds + (c & 1) * R2_SLOT; const size_t ub = (size_t)(head * NCH + c) * 4096;
            bf16x8 af[4][2]; f32x4 qv[4];
#pragma unroll
            for (int m = 0; m < 4; ++m) { qv[m] = *(const LAS f32x4*)(s + R2_QOFF + c16 * R2_QST + (16 * m + 4 * g4) * 4);
#pragma unroll
                for (int sx = 0; sx < 2; ++sx) { const LAS unsigned char* pr = s + (16 * m + c16) * R2_PST + (32 * sx + 4 * g4) * 2; const u32x2 a = *(const LAS u32x2*)pr, b = *(const LAS u32x2*)(pr + 32);
                    u32x4 w; w.x = a.x; w.y = a.y; w.z = b.x; w.w = b.y; af[m][sx] = __builtin_bit_cast(bf16x8, w); } }
            bf16x8 bfr[2];
#pragma unroll
            for (int sx = 0; sx < 2; ++sx) { u32x4 w; w.x = pk2(hacc[2 * sx][0], hacc[2 * sx][1]); w.y = pk2(hacc[2 * sx][2], hacc[2 * sx][3]); w.z = pk2(hacc[2 * sx + 1][0], hacc[2 * sx + 1][1]); w.w = pk2(hacc[2 * sx + 1][2], hacc[2 * sx + 1][3]);
                bfr[sx] = __builtin_bit_cast(bf16x8, w);
                u32x2 h0; h0.x = w.x; h0.y = w.y; *(u32x2*)(H0T + ub + (size_t)(16 * cg + c16) * 64 + 16 * (2 * sx) + 4 * g4) = h0;
                u32x2 h1; h1.x = w.z; h1.y = w.w; *(u32x2*)(H0T + ub + (size_t)(16 * cg + c16) * 64 + 16 * (2 * sx + 1) + 4 * g4) = h1; }
#pragma unroll
            for (int m = 0; m < 4; ++m) { hacc[m] = MFMA16(af[m][0], bfr[0], qv[m]); hacc[m] = MFMA16(af[m][1], bfr[1], hacc[m]); }
            R2_BAR();
        }
    } else {
        for (int c = 0; c <= NCH; ++c) R2_BAR();
    }
#undef R2_BAR
}

__device__ __forceinline__ void rwkv_r3_wave(const RwkvBufs& B, const bf16* __restrict__ H0T, const float* const* in, const float* __restrict__ gv, bf16* __restrict__ ocat, int head, int chunk, int nt, int lane) {
    const int c16 = lane & 15, g4 = lane >> 4; const size_t ub = (size_t)(head * NCH + chunk) * 4096;
    const int t = chunk * 64 + 16 * nt + c16;
    bf16x8 rf[2], hf[4][2]; f32x4 y[4], gw[4], gb[4], muv[4], gg[4], v0[4], vp[4];
#pragma unroll
    for (int s = 0; s < 2; ++s) rf[s] = *(const bf16x8*)(B.Rt + ub + (size_t)(16 * nt + c16) * 64 + 32 * s + 8 * g4);
#pragma unroll
    for (int m = 0; m < 4; ++m) { y[m] = *(const f32x4*)(B.Yi + ub + (size_t)(16 * nt + c16) * 64 + 16 * m + 4 * g4);
#pragma unroll
        for (int s = 0; s < 2; ++s) hf[m][s] = *(const bf16x8*)(H0T + ub + (size_t)(16 * m + c16) * 64 + 32 * s + 8 * g4); }
    const float bn = B.bonus[(size_t)t * RH + head];
#pragma unroll
    for (int m = 0; m < 4; ++m) { const int ch = head * RN + 16 * m + 4 * g4;
        gw[m] = *(const f32x4*)(in[26] + ch); gb[m] = *(const f32x4*)(in[27] + ch); muv[m] = *(const f32x4*)(in[11] + ch); gg[m] = *(const f32x4*)(gv + (size_t)t * RW + ch);
        v0[m] = *(const f32x4*)(B.rkv + (size_t)t * (3 * RW) + 2 * RW + ch); vp[m] = (f32x4){0.f, 0.f, 0.f, 0.f}; if (t > 0) vp[m] = *(const f32x4*)(B.rkv + (size_t)(t - 1) * (3 * RW) + 2 * RW + ch); }
    float s1 = 0.f;
#pragma unroll
    for (int m = 0; m < 4; ++m) {
#pragma unroll
        for (int s = 0; s < 2; ++s) y[m] = MFMA16(hf[m][s], rf[s], y[m]);
        s1 += (y[m][0] + y[m][1]) + (y[m][2] + y[m][3]); }
    s1 += __shfl_xor(s1, 16); s1 += __shfl_xor(s1, 32);
    const float mean = s1 * (1.0f / 64.0f); float s2 = 0.f;
#pragma unroll
    for (int m = 0; m < 4; ++m) { y[m] = y[m] - mean; s2 += (y[m][0] * y[m][0] + y[m][1] * y[m][1]) + (y[m][2] * y[m][2] + y[m][3] * y[m][3]); }
    s2 += __shfl_xor(s2, 16); s2 += __shfl_xor(s2, 32);
    const float rstd = rsqrtf(s2 * (1.0f / 64.0f) + 64e-5f);
#pragma unroll
    for (int m = 0; m < 4; ++m) { const int ch = head * RN + 16 * m + 4 * g4;
        const f32x4 vx = v0[m] + (vp[m] - v0[m]) * muv[m];
        const f32x4 o = (y[m] * rstd * gw[m] + gb[m] + vx * bn) * gg[m];
        u32x2 w; w.x = pk2(o[0], o[1]); w.y = pk2(o[2], o[3]); *(u32x2*)(ocat + (size_t)t * (2 * RW) + RW + ch) = w; }
}
template <int WHICH> struct Lora2Order { static constexpr bool GATHER = false; const int* tok; int G, c;
    __device__ bool next(int i, pg8::Unit& u) const { const int L = i * G + c; if (L >= (S / 128) * 4) return false; u.pm = L >> 2; u.pn = WHICH * 4 + (L & 3); u.koff = WHICH * 512; u.koffB = 0; return true; }
    __device__ __forceinline__ void a_ready(const pg8::Unit&) const {}
    __device__ __forceinline__ void done(const pg8::Unit&) const {} };
template <int WHICH> struct EpiLora2 {
    static constexpr bool PERM = true, AFTER_DRAIN = false, MIDK = false;
    float* dst; const float* bias;
    __device__ __forceinline__ void operator()(const pg8::f32x4 (&acc)[2][2][4][2], const pg8::Unit& u, int wr, int wc, int fr, int fq) const {
        const int row0 = u.pm * 128 + wr * 64 + fr; const int col0 = (u.pn & 3) * 256 + wc * 32 + 8 * fq;
#pragma unroll
        for (int ai = 0; ai < 1; ++ai)
#pragma unroll
            for (int m = 0; m < 4; ++m) { float* p = dst + (size_t)(row0 + ai * 128 + m * 16) * RW + col0;
#pragma unroll
                for (int bj = 0; bj < 2; ++bj) { f32x4 v0 = acc[ai][bj][m][0], v1 = acc[ai][bj][m][1];
                    if (WHICH < 2) { const f32x4 b0 = *(const f32x4*)(bias + col0 + bj * 128), b1 = *(const f32x4*)(bias + col0 + bj * 128 + 4);
#pragma unroll
                        for (int j = 0; j < 4; ++j) { v0[j] = sigmoidf_(v0[j] + b0[j]); v1[j] = sigmoidf_(v1[j] + b1[j]); }
                        if (WHICH == 0) { v0 = v0 * -0.60653065971263342f; v1 = v1 * -0.60653065971263342f; } }
                    *(f32x4*)(p + bj * 128) = v0; *(f32x4*)(p + bj * 128 + 4) = v1; } }
    }
};

__global__ void __launch_bounds__(NTHR, 2) fwd(Args args) {
    extern __shared__ __attribute__((aligned(16))) unsigned char lds_raw[];
    LAS unsigned char* lds = (LAS unsigned char*)lds_raw;
    const int wave = __builtin_amdgcn_readfirstlane(threadIdx.x >> 6);
    const int G = gridDim.x, wg = blockIdx.x;
    unsigned char* ws = args.ws;
    unsigned* ctl = (unsigned*)(ws + WS_CTL);
    if (threadIdx.x < 4) ((LAS unsigned*)(lds + LDSCTL_OFF))[threadIdx.x] = 0u;
    __syncthreads();
    XcdBarrier bar = xcd_barrier_post(ctl + CW_BAR, (volatile LAS unsigned*)(lds + LDSCTL_OFF));
    const int lo = args.ph_lo, hi = args.ph_hi;
#define IN(k) (lo <= (k) && (k) < hi)
#define PH(k) for (int rep_ = 0; rep_ < ((k) == REP_PHASE ? 1 + REP_N : 1); ++rep_) if (IN(k))
#define SEAM(k) do { if (IN(k) && IN((k) + 1)) xcd_barrier(bar); } while (0)
#define ROUTE_TABLE() do { LAS int* tb_ = (LAS int*)(lds + RT_OFF); \
        if (tid < 64) { const int c_ = ((const int*)ctl)[CW_CNT + tid * CNT_STR]; const int nt_ = (c_ + 127) >> 7; int o_ = nt_; \
            _Pragma("unroll") for (int d_ = 1; d_ < 64; d_ <<= 1) { const int t_ = __shfl_up(o_, d_); if (tid >= d_) o_ += t_; } \
            const int first_ = o_ - nt_; tb_[tid] = c_; tb_[64 + tid] = first_ * 128; \
            for (int t_ = 0; t_ < nt_; ++t_) { tb_[128 + first_ + t_] = tid; tb_[320 + first_ + t_] = t_ * 128; } \
            if (tid == 63) tb_[512] = o_; } \
        __syncthreads(); } while (0)
    const int gw = wg * NWAVES + wave, NGW = G * NWAVES;

    const float* x = args.in[0];
    float* ada = (float*)(ws + WS_ADA); float* rope = (float*)(ws + WS_ROPE);
    bf16* h = (bf16*)(ws + WS_H); bf16* W1t = (bf16*)(ws + WS_W1T); bf16* Wupt = (bf16*)(ws + WS_WUPT); bf16* Wot = (bf16*)(ws + WS_WOT);
    unsigned char* Wgut = ws + WS_WGUT; unsigned char* Wdt = ws + WS_WDT;

    PH(0) { const int lane = lane_fresh(); const int tid = (wave << 6) | lane; (void)tid; (void)lane;
        {
            const float* c = args.in[1]; const float* w_ada = args.in[2]; const float* b_ada = args.in[3];
            LAS float* red = (LAS float*)lds;
            for (int u = wg; u < 6 * D / 64; u += G) {
                const int n = u * 64 + lane; float s = 0.f;
#pragma unroll 8
                for (int kq = wave; kq < D; kq += NWAVES) s += c[kq] * w_ada[(size_t)kq * (6 * D) + n];
                red[wave * 64 + lane] = s;
                __syncthreads();
                if (wave == 0) { float t = b_ada[n]; for (int w = 0; w < NWAVES; ++w) t += red[w * 64 + lane];
                    __hip_atomic_store(ada + n, t, __ATOMIC_RELAXED, __HIP_MEMORY_SCOPE_AGENT);
                    asm volatile("s_waitcnt vmcnt(0)" ::: "memory");
                    if (lane == 0) (void)xb_add(ctl + CW_ADA, 1u); }
                __syncthreads();
            }
        }
        for (int i = wg * NTHR + tid; i < S * 16; i += G * NTHR) {
            const int pos = i >> 4, j = i & 15; const float inv = powf(500000.0f, -(float)j / 16.0f); const float ang = (float)pos * inv;
            rope[2 * i] = cosf(ang); rope[2 * i + 1] = sinf(ang);
        }
        for (int i = wg * NTHR + tid; i < 128 * D / 8; i += G * NTHR) ((u32x4*)(W1t + (size_t)(N1 - 128) * D))[i] = (u32x4){0u, 0u, 0u, 0u};
        {
            bf16* wrh = (bf16*)(ws + WS_WR); bf16* wrl = wrh + 80 * D; const float* w_rg = args.in[31]; const float* w_re = args.in[33];
            for (int i = wg * NTHR + tid; i < 80 * D; i += G * NTHR) { const int n = i / D, kq = i % D; const float v = n < NG ? w_rg[kq * NG + n] : (n < NG + NE ? w_re[kq * NE + n - NG] : 0.f);
                const bf16 hi = f2bf(v); wrh[i] = hi; wrl[i] = f2bf(v - bf2f(hi)); }
        }
        {
            bf16* wl2 = (bf16*)(ws + WS_WL2); const float* w_w2 = args.in[17]; const float* w_a2 = args.in[20]; const float* w_g2 = args.in[22];
            for (int i = wg * NTHR + tid; i < 3 * RW * 256; i += G * NTHR) { const int n = i >> 8, kq = i & 255, which = n / RW, cc = n % RW; float v = 0.f;
                if (which == 0) { if (kq < LW) v = w_w2[kq * RW + cc]; } else if (which == 1) { if (kq < LA) v = w_a2[kq * RW + cc]; } else v = w_g2[kq * RW + cc];
                wl2[i] = f2bf(v); }
        }
        LAS float* scr = (LAS float*)(lds + wave * 16384);
        constexpr int I_W = (D / 64) * (LW / 32), I_A = (D / 64) * (LA / 32), I_G = (D / 64) * (LG / 32);
        constexpr int NIT = 2 * (I_W + I_A + I_G);
        for (int it = gw; it < NIT; it += NGW) {
            int r = it, k0, n0;
            if (r < 2 * I_W) { const int md = 1 + r / I_W; item_kn(r % I_W, LW, k0, n0); tr_item(args.in[16], LW, k0, n0, W1t + (size_t)(INW + (md - 1) * LO + n0) * D + k0, D, args.in[12], md, scr, lane); continue; } r -= 2 * I_W;
            if (r < 2 * I_A) { const int md = 1 + r / I_A; item_kn(r % I_A, LA, k0, n0); tr_item(args.in[19], LA, k0, n0, W1t + (size_t)(INW + (md - 1) * LO + LW + n0) * D + k0, D, args.in[13], md, scr, lane); continue; } r -= 2 * I_A;
            const int md = 1 + r / I_G; item_kn(r % I_G, LG, k0, n0); tr_item(args.in[21], LG, k0, n0, W1t + (size_t)(INW + (md - 1) * LO + LW + LA + n0) * D + k0, D, args.in[14], md, scr, lane);
        }
        __syncthreads();
        {
            const int lr = tid >> 5, c4 = tid & 31, nl = lane & 15, kq = lane >> 4, ncol = 16 * wave + nl;
            f32x4 v[8]; int T = wg;
            if (T < CT_ALL) { const ConvTile t = conv_decode(T, args.in, ws);
#pragma unroll
                for (int i = 0; i < 8; ++i) v[i] = *(const f32x4*)(t.src + (size_t)(lr + 16 * i) * t.ldw + 4 * c4); }
            for (int itc = 0; T < CT_ALL; T += G, ++itc) {
                LAS float* buf = (LAS float*)(lds + (itc & 1) * 69632);
#pragma unroll
                for (int i = 0; i < 8; ++i) *(LAS f32x4*)(buf + conv_off(lr + 16 * i, 4 * c4)) = v[i];
                const ConvTile t = conv_decode(T, args.in, ws);
                if (T + G < CT_ALL) { const ConvTile tn = conv_decode(T + G, args.in, ws);
#pragma unroll
                    for (int i = 0; i < 8; ++i) v[i] = *(const f32x4*)(tn.src + (size_t)(lr + 16 * i) * tn.ldw + 4 * c4); }
                R1_BAR();
                float xv[32];
#pragma unroll
                for (int j = 0; j < 32; ++j) xv[j] = buf[conv_off(32 * kq + j, ncol)];
                if (t.kind) { unsigned char* d = t.dst + (size_t)ncol * t.rs + 32 * kq;
                    u32x4 o0, o1; o0.x = pk_fp8x4(xv[0], xv[1], xv[2], xv[3], t.sc); o0.y = pk_fp8x4(xv[4], xv[5], xv[6], xv[7], t.sc); o0.z = pk_fp8x4(xv[8], xv[9], xv[10], xv[11], t.sc); o0.w = pk_fp8x4(xv[12], xv[13], xv[14], xv[15], t.sc);
                    o1.x = pk_fp8x4(xv[16], xv[17], xv[18], xv[19], t.sc); o1.y = pk_fp8x4(xv[20], xv[21], xv[22], xv[23], t.sc); o1.z = pk_fp8x4(xv[24], xv[25], xv[26], xv[27], t.sc); o1.w = pk_fp8x4(xv[28], xv[29], xv[30], xv[31], t.sc);
                    *(u32x4*)d = o0; *(u32x4*)(d + 16) = o1; }
                else { unsigned char* d = t.dst + (size_t)ncol * t.rs + 64 * kq;
#pragma unroll
                    for (int q = 0; q < 4; ++q) { u32x4 o; o.x = pk2(xv[8 * q], xv[8 * q + 1]); o.y = pk2(xv[8 * q + 2], xv[8 * q + 3]); o.z = pk2(xv[8 * q + 4], xv[8 * q + 5]); o.w = pk2(xv[8 * q + 6], xv[8 * q + 7]); *(u32x4*)(d + 16 * q) = o; } }
            }
            __syncthreads();
        }
        {
            if (tid == 0) { XB_SPIN(xb_ld(ctl + CW_ADA) < (unsigned)(6 * D / 64), bar.bar); __builtin_amdgcn_fence(__ATOMIC_ACQUIRE, "agent"); asm volatile("s_waitcnt vmcnt(0)" ::: "memory"); }
            __syncthreads();
        const float* g = args.in[4]; const float* sh1 = ada; const float* sc1 = ada + D;
        f32x4 gs[8], sh[8];
#pragma unroll
        for (int j = 0; j < 8; ++j) { const int c = 4 * lane + 256 * j; const f32x4 gg = *(const f32x4*)(g + c), ss = *(const f32x4*)(sc1 + c); gs[j] = gg * (ss + 1.0f); sh[j] = *(const f32x4*)(sh1 + c); }
        for (int rb = gw; rb < S; rb += 2 * NGW) {
            f32x4 v[2][8]; float s[2] = {0.f, 0.f};
#pragma unroll
            for (int q = 0; q < 2; ++q) { const f32x4* xr = (const f32x4*)(x + (size_t)(rb + q * NGW) * D) + lane;
#pragma unroll
                for (int j = 0; j < 8; ++j) v[q][j] = xr[64 * j]; }
#pragma unroll
            for (int q = 0; q < 2; ++q)
#pragma unroll
                for (int j = 0; j < 8; ++j) s[q] += (v[q][j].x * v[q][j].x + v[q][j].y * v[q][j].y) + (v[q][j].z * v[q][j].z + v[q][j].w * v[q][j].w);
            float r[2]; r[0] = rsqrtf(wave_sum(s[0]) * (1.0f / D) + 1e-6f); r[1] = rsqrtf(wave_sum(s[1]) * (1.0f / D) + 1e-6f);
#pragma unroll
            for (int q = 0; q < 2; ++q) { u32x2* o = (u32x2*)(h + (size_t)(rb + q * NGW) * D) + lane;
#pragma unroll
                for (int j = 0; j < 8; ++j) { const f32x4 t = v[q][j] * r[q] * gs[j] + sh[j]; u32x2 w; w.x = pk2(t.x, t.y); w.y = pk2(t.z, t.w); o[64 * j] = w; } }
        }

        }
    }
    SEAM(0);
    PH(2) { const int lane = lane_fresh(); const int tid = (wave << 6) | lane; (void)tid; (void)lane;
        EpiProj E{(bf16*)(ws + WS_Q), (bf16*)(ws + WS_K), (bf16*)(ws + WS_V), (float*)(ws + WS_RKV), (bf16*)(ws + WS_GATE), (float*)(ws + WS_LORA), (float*)(ws + WS_LORAB), rope};
        { pg8::Gemm g{h, W1t, S, INW, D, D, D}; pg8::StaticOrder So; So.init(S, INW, G, wg);
          pg8::gemm_phase<EpiProj, pg8::StaticOrder, true, true>(lds, g, So, E); }
        { int ld_ = D; asm volatile("" : "+s"(ld_)); pg8::Gemm g{h, W1t, S, N1, AW, ld_, ld_}; LoraOrder So{nullptr, G, wg};
          pg8::gemm_phase<EpiProj, LoraOrder, true, true>(lds, g, So, E); }
    }
    SEAM(2);

    bf16* qb = (bf16*)(ws + WS_Q); bf16* kb = (bf16*)(ws + WS_K); bf16* vb = (bf16*)(ws + WS_V);
    bf16* kmh = (bf16*)(ws + WS_KMEAN); bf16* kml = kmh + AH * NB * AD;
    AttnBufs AB{qb, kb, vb, kmh, kml, (unsigned*)(ws + WS_AMASK), (int*)(ws + WS_ALIST), (int*)ctl + CW_ACNT, (bf16*)(ws + WS_APART), (float*)(ws + WS_AML)};
    PH(3) { const int lane = lane_fresh(); const int tid = (wave << 6) | lane; (void)tid; (void)lane;
        for (int hb = wg; hb < AH * NB; hb += G) { const int hd = hb / NB, bk = hb % NB; LAS float* red = (LAS float*)lds;
            float s0 = 0.f, s1 = 0.f; const unsigned* src = (const unsigned*)(kb + (size_t)(bk * MB + wave * 32) * AW + hd * AD) + lane;
#pragma unroll 8
            for (int r = 0; r < 32; ++r) { const unsigned w2 = src[(size_t)r * (AW / 2)]; s0 += __uint_as_float(w2 << 16); s1 += __uint_as_float(w2 & 0xffff0000u); }
            red[wave * 128 + 2 * lane] = s0; red[wave * 128 + 2 * lane + 1] = s1;
            __syncthreads();
            if (tid < AD) { float s = 0.f;
#pragma unroll
                for (int w = 0; w < 8; ++w) s += red[w * 128 + tid];
                s *= (1.0f / MB); const bf16 hi = f2bf(s); kmh[hb * AD + tid] = hi; kml[hb * AD + tid] = f2bf(s - bf2f(hi)); }
            __syncthreads();
        }
        {
            const float* lora = (const float*)(ws + WS_LORA); bf16* al2 = (bf16*)(ws + WS_AL2);
#pragma unroll 4
            for (int i = wg * NTHR + tid; i < S * 768; i += G * NTHR) { const int t = i / 768, j = i % 768, which = j >> 8, jj = j & 255; float v = 0.f;
                const int src = which == 0 ? jj : (which == 1 ? LW + jj : LW + LA + jj); const bool real = which == 2 || jj < LW;
                if (real) { const float* lb = (const float*)(ws + WS_LORAB); v = lora[(size_t)t * 1024 + src] + lb[(size_t)t * 1024 + src] + (t > 0 ? lora[(size_t)(t - 1) * 1024 + LO + src] + lb[(size_t)(t - 1) * 1024 + LO + src] : 0.f); if (which == 0) v = 1.0f - 2.0f / (1.0f + __expf(2.0f * v)); else if (which == 2) v = sigmoidf_(v); }
                al2[i] = f2bf(v); }
        }
    }
    SEAM(3);
    PH(4) { const int lane = lane_fresh(); const int tid = (wave << 6) | lane; (void)tid; (void)lane;
#define L2CALL(W, DST, BIAS, CID) { int lda_ = 768; asm volatile("" : "+s"(lda_)); pg8::Gemm g{(const bf16*)(ws + WS_AL2), (const bf16*)(ws + WS_WL2), S, 3 * RW, 256, lda_, 256}; \
            Lora2Order<W> So{nullptr, G, CID}; EpiLora2<W> E{DST, BIAS}; pg8::gemm_phase<EpiLora2<W>, Lora2Order<W>, true, true, 0, true>(lds, g, So, E); }
        L2CALL(0, (float*)(ws + WS_LW), args.in[15], wg)
        L2CALL(1, (float*)(ws + WS_A), args.in[18], wg)
        L2CALL(2, (float*)(ws + WS_G), nullptr, wg)
#undef L2CALL
        for (int u = wg; u < AH * 64; u += G) moba_select_unit(lds, AB, u >> 6, u & 63, tid, lane, wave);
    }
    SEAM(4);
    RwkvBufs RB{(const float*)(ws + WS_RKV), (const float*)(ws + WS_LW), (const float*)(ws + WS_A), (bf16*)(ws + WS_RWP), (float*)(ws + WS_RWQ), (bf16*)(ws + WS_RWR), (float*)(ws + WS_RWY), (float*)(ws + WS_RWB)};
    bf16* H0T = (bf16*)(ws + WS_RWH);
    PH(5) { const int lane = lane_fresh(); const int tid = (wave << 6) | lane; (void)tid; (void)lane; R1In I; if (wg < RH * NCH) rwkv_r1_load(I, RB, wg / NCH, wg % NCH, lane, wave);
        for (int u = wg; u < RH * NCH; u += G) { const int un = u + G; rwkv_r1_unit(lds, RB, args.in, I, u / NCH, u % NCH, un < RH * NCH ? un / NCH : -1, un % NCH, tid, lane, wave); } }
    SEAM(5);
    PH(7) { const int lane = lane_fresh(); const int tid = (wave << 6) | lane; (void)tid; (void)lane;
        if (wg < RH * 4) { for (int rsc = 0; rsc < 1 + REP_SCAN; ++rsc) { rwkv_r2_wg(lds, RB.P, RB.QmT, H0T, wg >> 2, wg & 3, wave, lane); __syncthreads(); } }
        LAS int* pre = (LAS int*)(lds + AT_ITEMS); LAS int* tick = pre + 260;
        if (tid < 256) pre[1 + tid] = (AB.cnt[tid * ACNT_STR] + 255) >> 8;
        __syncthreads();
        if (wave == 0) {
            int v0 = pre[1 + 4 * lane], v1 = pre[2 + 4 * lane], v2 = pre[3 + 4 * lane], v3 = pre[4 + 4 * lane]; v1 += v0; v2 += v1; v3 += v2; int tot = v3;
#pragma unroll
            for (int o = 1; o < 64; o <<= 1) { const int t = __shfl_up(tot, o); if (lane >= o) tot += t; }
            const int ex = tot - v3; pre[1 + 4 * lane] = ex + v0; pre[2 + 4 * lane] = ex + v1; pre[3 + 4 * lane] = ex + v2; pre[4 + 4 * lane] = ex + v3;
            if (lane == 0) pre[0] = 0; }
        __syncthreads();
        moba_items(lds, AB, (int*)ctl + CW_AQ + rep_, pre, tick, tid, lane, wave);
    }
    SEAM(7);
    PH(8) { const int lane = lane_fresh(); const int tid = (wave << 6) | lane; (void)tid; (void)lane; for (int u = wg * 2 + (wave >> 2); u < RH * NCH; u += 2 * G) rwkv_r3_wave(RB, H0T, args.in, (const float*)(ws + WS_G), (bf16*)(ws + WS_OCAT), u / NCH, u % NCH, wave & 3, lane);
#pragma unroll 2
        for (int i = wg * NTHR + tid; i < AH * S * 16; i += G * NTHR) { const int c8 = i & 15, hq = i >> 4, hh = hq / S, qq = hq % S;
            const unsigned mk = AB.mask[hq]; const f32x4 ml0 = *(const f32x4*)(AB.ml + (size_t)hq * 8), ml1 = *(const f32x4*)(AB.ml + (size_t)hq * 8 + 4);
            u32x4 pr[4];
#pragma unroll
            for (int s = 0; s < 4; ++s) pr[s] = *(const u32x4*)(AB.part + ((size_t)hq * 4 + s) * AD + 8 * c8);
            const int ns = 1 + __builtin_popcount(mk);
            const float m_[4] = {ml0[0], ml0[2], ml1[0], ml1[2]}, l_[4] = {ml0[1], ml0[3], ml1[1], ml1[3]};
            float mx = m_[0];
#pragma unroll
            for (int s = 1; s < 4; ++s) mx = (s < ns) ? fmaxf(mx, m_[s]) : mx;
            float wv[4]; float wsum = 0.f;
#pragma unroll
            for (int s = 0; s < 4; ++s) { wv[s] = s < ns ? l_[s] * __builtin_amdgcn_exp2f(m_[s] - mx) : 0.f; wsum += wv[s]; }
            const float inv = 1.0f / wsum; float o[8] = {0.f, 0.f, 0.f, 0.f, 0.f, 0.f, 0.f, 0.f};
#pragma unroll
            for (int s = 0; s < 4; ++s) { float pv[8]; unpack8(pr[s], pv); const float ws_ = wv[s] * inv;
#pragma unroll
                for (int j = 0; j < 8; ++j) o[j] += (s < ns) ? ws_ * pv[j] : 0.f; }
            u32x4 w; w.x = pk2(o[0], o[1]); w.y = pk2(o[2], o[3]); w.z = pk2(o[4], o[5]); w.w = pk2(o[6], o[7]);
            *(u32x4*)((bf16*)(ws + WS_OCAT) + (size_t)qq * (2 * AW) + hh * AD + 8 * c8) = w; }
    }
    SEAM(8);

    bf16* ocat = (bf16*)(ws + WS_OCAT); bf16* gate = (bf16*)(ws + WS_GATE); bf16* mix = (bf16*)(ws + WS_MIX); bf16* y = (bf16*)(ws + WS_Y); bf16* x1 = (bf16*)(ws + WS_X1);     unsigned char* h2 = ws + WS_H2;
    float* ew = (float*)(ws + WS_ROUTE + 65536); int* slot = (int*)(ws + WS_ROUTE + 131072);
    int* elist = (int*)(ws + WS_ELIST);
    unsigned char* xbuf = ws + WS_XBUF; unsigned char* hid = ws + WS_HID; bf16* ybuf = (bf16*)(ws + WS_YBUF);
    PH(9) { const int lane = lane_fresh(); const int tid = (wave << 6) | lane; (void)tid; (void)lane;
        pg8::Gemm g{ocat, Wupt, S, D, AW, D, D}; MixOrder So{nullptr, G, wg};
        EpiMix E{gate, mix};
        pg8::gemm_phase<EpiMix, MixOrder, true, true>(lds, g, So, E);
    }
    SEAM(9);
    PH(10) { const int lane = lane_fresh(); const int tid = (wave << 6) | lane; (void)tid; (void)lane;
        pg8::Gemm g{mix, Wot, S, D, D, D, D}; pg8::StaticOrder So; So.init(S, D, G, wg);
        EpiBf16P E{y, D};
        pg8::gemm_phase<EpiBf16P, pg8::StaticOrder, true, true>(lds, g, So, E);
    }
    SEAM(10);
    PH(11) { const int lane = lane_fresh(); const int tid = (wave << 6) | lane; (void)tid; (void)lane;
        const float* gpost = args.in[5]; const float* gpre2 = args.in[6]; const float* gt1 = ada + 2 * D; const float* sh2 = ada + 3 * D; const float* sc2 = ada + 4 * D;
        const bf16* wrh = (const bf16*)(ws + WS_WR); const bf16* wrl = wrh + 80 * D; const float* b_rg = args.in[32]; const float* b_re = args.in[34];
        LAS bf16* Ah = (LAS bf16*)lds; LAS bf16* Al = Ah + 16 * RS8; LAS float* Pp = (LAS float*)lds;
        LAS float* Lg = (LAS float*)(lds + 8 * 16 * 80 * 4);
        for (int unit = wg; unit < S / 16; unit += G) {
            {
                const int rl0 = wave * 2, row0 = unit * 16 + rl0;
                f32x4 v[2][8], xv[2][8]; float s[2] = {0.f, 0.f};
#pragma unroll
                for (int rr = 0; rr < 2; ++rr) { const u32x2* yr = (const u32x2*)(y + (size_t)(row0 + rr) * D) + lane; const f32x4* xr = (const f32x4*)(x + (size_t)(row0 + rr) * D) + lane;
#pragma unroll
                    for (int j = 0; j < 8; ++j) { const u32x2 yb = yr[64 * j]; v[rr][j] = (f32x4){__uint_as_float(yb.x << 16), __uint_as_float(yb.x & 0xffff0000u), __uint_as_float(yb.y << 16), __uint_as_float(yb.y & 0xffff0000u)}; xv[rr][j] = xr[64 * j]; } }
#pragma unroll
                for (int rr = 0; rr < 2; ++rr)
#pragma unroll
                    for (int j = 0; j < 8; ++j) s[rr] += (v[rr][j].x * v[rr][j].x + v[rr][j].y * v[rr][j].y) + (v[rr][j].z * v[rr][j].z + v[rr][j].w * v[rr][j].w);
                float r1[2]; r1[0] = rsqrtf(wave_sum(s[0]) * (1.0f / D) + 1e-6f); r1[1] = rsqrtf(wave_sum(s[1]) * (1.0f / D) + 1e-6f); s[0] = 0.f; s[1] = 0.f;
#pragma unroll
                for (int rr = 0; rr < 2; ++rr)
#pragma unroll
                    for (int j = 0; j < 8; ++j) { const int c = 4 * lane + 256 * j; const f32x4 t = xv[rr][j] + *(const f32x4*)(gt1 + c) * *(const f32x4*)(gpost + c) * (v[rr][j] * r1[rr]); v[rr][j] = t;
                        { u32x2 xb; xb.x = pk2(t.x, t.y); xb.y = pk2(t.z, t.w); ((u32x2*)(x1 + (size_t)(row0 + rr) * D))[lane + 64 * j] = xb; } s[rr] += (t.x * t.x + t.y * t.y) + (t.z * t.z + t.w * t.w); }
                float r2[2]; r2[0] = rsqrtf(wave_sum(s[0]) * (1.0f / D) + 1e-6f); r2[1] = rsqrtf(wave_sum(s[1]) * (1.0f / D) + 1e-6f);
#pragma unroll
                for (int rr = 0; rr < 2; ++rr)
#pragma unroll
                    for (int j = 0; j < 8; ++j) { const int c = 4 * lane + 256 * j; const f32x4 t = v[rr][j] * r2[rr] * (*(const f32x4*)(gpre2 + c) * (*(const f32x4*)(sc2 + c) + 1.0f)) + *(const f32x4*)(sh2 + c);
                        u32x2 wh; wh.x = pk2(t.x, t.y); wh.y = pk2(t.z, t.w);
                        u32x2 wl; wl.x = pk2(t.x - __uint_as_float(wh.x << 16), t.y - __uint_as_float(wh.x & 0xffff0000u)); wl.y = pk2(t.z - __uint_as_float(wh.y << 16), t.w - __uint_as_float(wh.y & 0xffff0000u));
                        ((unsigned*)(h2 + (size_t)(row0 + rr) * D))[lane + 64 * j] = pk_fp8x4(t.x, t.y, t.z, t.w, 8.0f);
                        *(LAS u32x2*)(Ah + (rl0 + rr) * RS8 + c) = wh; *(LAS u32x2*)(Al + (rl0 + rr) * RS8 + c) = wl; }
            }
            R1_BAR();
            f32x4 acc[5];
#pragma unroll
            for (int nt = 0; nt < 5; ++nt) acc[nt] = (f32x4){0.f, 0.f, 0.f, 0.f};
            for (int rmf = 0; rmf < 1 + REP_P11B; ++rmf) {
#pragma unroll
            for (int nt = 0; nt < 5; ++nt) acc[nt] = (f32x4){0.f, 0.f, 0.f, 0.f};
#pragma unroll 2
            for (int ks = 0; ks < 8; ++ks) {
                const int k0 = 256 * wave + 32 * ks + 8 * (lane >> 4);
                const bf16x8 ah = *(const LAS bf16x8*)(Ah + (lane & 15) * RS8 + k0), al = *(const LAS bf16x8*)(Al + (lane & 15) * RS8 + k0);
#pragma unroll
                for (int nt = 0; nt < 5; ++nt) { const bf16x8 bh = *(const bf16x8*)(wrh + (size_t)(16 * nt + (lane & 15)) * D + k0), bl = *(const bf16x8*)(wrl + (size_t)(16 * nt + (lane & 15)) * D + k0);
                    acc[nt] = __builtin_amdgcn_mfma_f32_16x16x32_bf16(ah, bh, acc[nt], 0, 0, 0);
                    acc[nt] = __builtin_amdgcn_mfma_f32_16x16x32_bf16(al, bh, acc[nt], 0, 0, 0);
                    acc[nt] = __builtin_amdgcn_mfma_f32_16x16x32_bf16(ah, bl, acc[nt], 0, 0, 0); }
            }
            }
            R1_BAR();
#pragma unroll
            for (int nt = 0; nt < 5; ++nt)
#pragma unroll
                for (int rg = 0; rg < 4; ++rg) Pp[(wave * 16 + 4 * (lane >> 4) + rg) * 80 + 16 * nt + (lane & 15)] = acc[nt][rg];
            R1_BAR();
            for (int i = tid; i < 16 * 72; i += NTHR) { const int r = i / 72, c = i % 72; float t = c < NG ? b_rg[c] : b_re[c - NG];
#pragma unroll
                for (int w = 0; w < 8; ++w) t += Pp[(w * 16 + r) * 80 + c];
                Lg[r * 72 + c] = t; }
            R1_BAR();
            if (tid < 16) {
                const LAS float* lg = Lg + tid * 72; const int row = unit * 16 + tid;
                float mx = lg[0]; int gi = 0; for (int j = 1; j < 8; ++j) if (lg[j] > mx) { mx = lg[j]; gi = j; }
                float sg = 0.f; for (int j = 0; j < 8; ++j) sg += __expf(lg[j] - mx);
                const float pg = 1.0f / sg;
                const LAS float* le = lg + 8 + gi * EPG;
                float m1 = le[0]; int i1 = 0; for (int j = 1; j < 8; ++j) if (le[j] > m1) { m1 = le[j]; i1 = j; }
                float m2 = -3e38f; int i2 = 0; for (int j = 0; j < 8; ++j) if (j != i1 && le[j] > m2) { m2 = le[j]; i2 = j; }
                const float e2 = __expf(m2 - m1); const float p1 = 1.0f / (1.0f + e2), p2 = e2 / (1.0f + e2);
                const int e1g = gi * EPG + i1, e2g = gi * EPG + i2;
                ew[row * 2] = pg * p1; ew[row * 2 + 1] = pg * p2;
                if (rep_ == 0) {
                    const int q1 = atomicAdd((int*)ctl + CW_CNT + e1g * CNT_STR, 1), q2 = atomicAdd((int*)ctl + CW_CNT + e2g * CNT_STR, 1);
                    elist[e1g * S + q1] = row; elist[e2g * S + q2] = row; slot[row * 2] = (e1g << 16) | q1; slot[row * 2 + 1] = (e2g << 16) | q2; }
            }
            R1_BAR();
        }
    }
    SEAM(11);
    PH(13) { const int lane = lane_fresh(); const int tid = (wave << 6) | lane; (void)tid; (void)lane;
        ROUTE_TABLE();
        pg8::Gemm g{(const bf16*)h2, (const bf16*)Wgut, MAXROWS, NE * 1024, D / 2, D / 2, D / 2}; ExpertOrderT<true> So{elist, (LAS const int*)(lds + RT_OFF), 4, G, wg};
        EpiHid E{hid};
        pg8::gemm_phase<EpiHid, ExpertOrderT<true>, true, true, (124 << 8) | 119, true>(lds, g, So, E);
    }
    SEAM(13);
    PH(14) { const int lane = lane_fresh(); const int tid = (wave << 6) | lane; (void)tid; (void)lane;
        if (args.ph_lo == 14) ROUTE_TABLE();
        pg8::Gemm g{(const bf16*)hid, (const bf16*)Wdt, MAXROWS, NE * D, FF / 2, FF / 2, FF / 2}; ExpertOrderT<false> So{nullptr, (LAS const int*)(lds + RT_OFF), 8, G, wg};
        EpiYbuf E{ybuf};
        pg8::gemm_phase<EpiYbuf, ExpertOrderT<false>, true, true, (124 << 8) | 120, true>(lds, g, So, E);
    }
    SEAM(14);
    PH(15) { const int lane = lane_fresh(); const int tid = (wave << 6) | lane; (void)tid; (void)lane;
        const float* gpost2 = args.in[7]; const float* gt2 = ada + 5 * D; float* out = args.out;
        if (args.ph_lo == 15) ROUTE_TABLE();
        LAS const int* tb = (LAS const int*)(lds + RT_OFF);
        for (int rb = gw; rb < S; rb += 2 * NGW) {
            int s0[2], s1[2]; float w0[2], w1[2]; const int rows[2] = {rb, rb + NGW};
#pragma unroll
            for (int q = 0; q < 2; ++q) { const int row = rows[q] < S ? rows[q] : rb; const int v0 = slot[row * 2], v1 = slot[row * 2 + 1]; s0[q] = tb[64 + (v0 >> 16)] + (v0 & 0xffff); s1[q] = tb[64 + (v1 >> 16)] + (v1 & 0xffff); w0[q] = ew[row * 2]; w1[q] = ew[row * 2 + 1]; }
            u32x2 xb[2][8];
#pragma unroll
            for (int q = 0; q < 2; ++q) { const int row = rows[q] < S ? rows[q] : rb;
#pragma unroll
                for (int j = 0; j < 8; ++j) xb[q][j] = ((const u32x2*)(x1 + (size_t)row * D))[lane + 64 * j]; }
            f32x4 v[2][8]; float s[2] = {0.f, 0.f};
#pragma unroll
            for (int q = 0; q < 2; ++q) { const u32x2* y0 = (const u32x2*)(ybuf + (size_t)s0[q] * D) + lane; const u32x2* y1 = (const u32x2*)(ybuf + (size_t)s1[q] * D) + lane;
#pragma unroll
                for (int j = 0; j < 8; ++j) { const u32x2 a = y0[64 * j], b = y1[64 * j];
                    v[q][j].x = w0[q] * __uint_as_float(a.x << 16) + w1[q] * __uint_as_float(b.x << 16); v[q][j].y = w0[q] * __uint_as_float(a.x & 0xffff0000u) + w1[q] * __uint_as_float(b.x & 0xffff0000u);
                    v[q][j].z = w0[q] * __uint_as_float(a.y << 16) + w1[q] * __uint_as_float(b.y << 16); v[q][j].w = w0[q] * __uint_as_float(a.y & 0xffff0000u) + w1[q] * __uint_as_float(b.y & 0xffff0000u);
                    s[q] += (v[q][j].x * v[q][j].x + v[q][j].y * v[q][j].y) + (v[q][j].z * v[q][j].z + v[q][j].w * v[q][j].w); } }
            float r[2]; r[0] = rsqrtf(wave_sum(s[0]) * (1.0f / D) + 1e-6f); r[1] = rsqrtf(wave_sum(s[1]) * (1.0f / D) + 1e-6f);
#pragma unroll
            for (int q = 0; q < 2; ++q) if (rows[q] < S) {
#pragma unroll
                for (int j = 0; j < 8; ++j) { const int c = 4 * lane + 256 * j; const u32x2 xx = xb[q][j];
                    const f32x4 xf = (f32x4){__uint_as_float(xx.x << 16), __uint_as_float(xx.x & 0xffff0000u), __uint_as_float(xx.y << 16), __uint_as_float(xx.y & 0xffff0000u)};
                    ((f32x4*)(out + (size_t)rows[q] * D))[lane + 64 * j] = xf + *(const f32x4*)(gt2 + c) * (v[q][j] * r[q] * *(const f32x4*)(gpost2 + c)); } }
        }
    }
#undef IN
#undef SEAM
}
extern "C" void kernel_launch(void* const* d_in, const int* in_sizes, int n_in, void* d_out, int out_size, void* d_ws, size_t ws_size, hipStream_t stream) {
    static int grid = 0;
    if (grid == 0) {
        if (ws_size < WS_END || n_in != 38) { fprintf(stderr, "kernel_launch: unexpected workspace/inputs: %zu < %zu or n_in %d\n", ws_size, (size_t)WS_END, n_in); grid = -1; return; }
        int dev = 0, cus = 0;
        if (hipGetDevice(&dev) != hipSuccess || hipDeviceGetAttribute(&cus, hipDeviceAttributeMultiprocessorCount, dev) != hipSuccess) { fprintf(stderr, "device query failed\n"); grid = -1; return; }
        if (hipFuncSetAttribute((const void*)fwd, hipFuncAttributeMaxDynamicSharedMemorySize, LDS_BYTES) != hipSuccess) { fprintf(stderr, "hipFuncSetAttribute failed\n"); grid = -1; return; }
        grid = cus;
    }
    if (grid < 0) return;
    (void)hipMemsetAsync((char*)d_ws + WS_CTL, 0, 1 * MiB, stream);
    Args a{};
    for (int i = 0; i < 38; ++i) a.in[i] = (const float*)d_in[i];
    a.out = (float*)d_out; a.ws = (unsigned char*)d_ws;
#if N_LAUNCH_PER_PHASE
    for (int ph = 0; ph < 16; ++ph) { a.ph_lo = ph; a.ph_hi = ph + 1; hipLaunchKernelGGL(fwd, dim3(grid), dim3(NTHR), LDS_BYTES, stream, a); }
#else
    a.ph_lo = 0; a.ph_hi = 16; hipLaunchKernelGGL(fwd, dim3(grid), dim3(NTHR), LDS_BYTES, stream, a);
#endif
}
```

```cpp
#include <hip/hip_runtime.h>
#include <cstdio>
#include <cstdint>

typedef unsigned short bf16;
__device__ __forceinline__ float bf2f(bf16 b) { return __uint_as_float(((unsigned)b) << 16); }
__device__ __forceinline__ bf16 f2bf(float f) { unsigned u = __float_as_uint(f); u += 0x7fffu + ((u >> 16) & 1u); return (bf16)(u >> 16); }
__device__ __forceinline__ float sigmoidf_(float x) { return __builtin_amdgcn_rcpf(1.0f + __expf(-x)); }

#ifndef N_LAUNCH_PER_PHASE
#define N_LAUNCH_PER_PHASE 0
#endif
#ifndef REP_PHASE
#define REP_PHASE -1
#define REP_N 0
#endif
#ifndef REP_SCAN
#define REP_SCAN 0
#endif
#ifndef REP_P11A
#define REP_P11A 0
#endif
#ifndef REP_P11B
#define REP_P11B 0
#endif
#ifndef REP_R1A
#define REP_R1A 0
#define REP_R1B 0
#define REP_R1C 0
#endif
#ifndef REP_R1NR
#define REP_R1NR 0
#endif
#ifndef REP_R1S0
#define REP_R1S0 0
#endif
constexpr int S = 8192, D = 2048;
constexpr int AH = 8, AD = 128, AW = 1024, MB = 256, NB = S / MB;
constexpr int RH = 16, RN = 64, RW = 1024;
constexpr int LW = 96, LA = 96, LG = 256, LO = LW + LA + LG;
constexpr int INW = 3 * AW + 3 * RW + 2 * D;
constexpr int NE = 64, NG = 8, EPG = 8, FF = 512;
constexpr int MAXROWS = 32768;
constexpr int MAXTILES = MAXROWS / 256;

constexpr size_t MiB = 1u << 20;
constexpr size_t WS_CTL   = 0;
constexpr size_t WS_ADA   = 1 * MiB;
constexpr size_t WS_ROPE  = 2 * MiB;
constexpr size_t WS_KMEAN = 3 * MiB;
constexpr size_t WS_WL2   = 3 * MiB + 256 * 1024;
constexpr size_t WS_ROUTE = 5 * MiB;
constexpr size_t WS_TOK   = 6 * MiB;
constexpr size_t WS_WR    = 7 * MiB;
constexpr size_t WS_H     = 8 * MiB;
constexpr size_t WS_Q     = 40 * MiB;
constexpr size_t WS_K     = 56 * MiB;
constexpr size_t WS_V     = 72 * MiB;
constexpr size_t WS_RKV   = 88 * MiB;
constexpr size_t WS_GATE  = 184 * MiB;
constexpr size_t WS_LORA  = 248 * MiB;
constexpr size_t WS_LORAB = 424 * MiB;
constexpr size_t WS_AL2   = 280 * MiB;
constexpr size_t WS_LW    = 296 * MiB;
constexpr size_t WS_A     = 328 * MiB;
constexpr size_t WS_G     = 360 * MiB;
constexpr size_t WS_OCAT  = 392 * MiB;
constexpr size_t WS_MIX   = 424 * MiB;
constexpr size_t WS_Y     = 456 * MiB;
constexpr size_t WS_X1    = 520 * MiB;
constexpr size_t WS_H2    = 584 * MiB;
constexpr size_t WS_WUPT  = 616 * MiB;
constexpr size_t WS_WOT   = 624 * MiB;
constexpr size_t WS_WGUT  = 632 * MiB;
constexpr size_t WS_WDT   = 888 * MiB;
constexpr size_t WS_END   = 1016 * MiB;
constexpr size_t WS_W1T   = WS_Y;
constexpr size_t WS_ELIST = 16 * MiB;
constexpr size_t WS_XBUF  = WS_H;
constexpr size_t WS_HID   = 136 * MiB;
constexpr size_t WS_YBUF  = 168 * MiB;
constexpr size_t WS_ALIST = 8 * MiB, WS_AMASK = 12 * MiB, WS_AML = 13 * MiB, WS_APART = 248 * MiB;
constexpr size_t WS_RWP = 456 * MiB, WS_RWQ = 472 * MiB, WS_RWR = 504 * MiB, WS_RWY = 520 * MiB, WS_RWH = 552 * MiB, WS_RWB = 568 * MiB;
constexpr size_t WS_NR = WS_MIX, WS_NW = WS_NR + 32 * MiB, WS_NKT = WS_NR + 64 * MiB, WS_NV = WS_NR + 96 * MiB, WS_NKK = WS_NR + 128 * MiB, WS_NY = WS_NR + 160 * MiB;
constexpr size_t WS_MIXTMP = WS_Y;
constexpr size_t WS_GTMP = WS_Y;

constexpr int CW_CNT = 16384, CNT_STR = 1088;
constexpr int CW_FILL = 1152;
constexpr int CW_OFF = 1280;
constexpr int CW_ADA = 1408;
constexpr int CW_ACNT = 90112, ACNT_STR = 576;
constexpr int CW_AQ = 1920;

namespace pg8 {
#define PG8_LAS __attribute__((address_space(3)))
typedef unsigned short bf16_t;
typedef short bf16x8 __attribute__((ext_vector_type(8)));
typedef float f32x4 __attribute__((ext_vector_type(4)));
typedef unsigned u32x4 __attribute__((ext_vector_type(4)));
typedef int i32x8_t __attribute__((ext_vector_type(8)));
template <bool IS8> struct FragSel { typedef bf16x8 T; static constexpr int NK = 2; };
template <> struct FragSel<true> { typedef i32x8_t T; static constexpr int NK = 1; };
template <int F8> struct FragT : FragSel<(F8 != 0)> {};
constexpr int BM = 256, BK = 64, HALF = 128, HTB = HALF * BK * 2  , STAGE_BYTES = 8 * HTB, NXCD = 8, WGM = 8;

__host__ __device__ __forceinline__ int lds_byte(int r, int c) { const int st = (r >> 4) * 2 + (c >> 5), rr = r & 15, cc = c & 31, ob = rr * 64 + cc * 2; return st * 1024 + (ob ^ (((ob >> 9) & 1) << 5)); }
__host__ __device__ __forceinline__ void stage_rc(int b, int& R, int& C) { const int st = b / 1024, sb = b % 1024, swz = sb ^ (((sb >> 9) & 1) << 5); R = (st >> 1) * 16 + swz / 64; C = (st & 1) * 32 + (swz % 64) / 2; }
__host__ __device__ __forceinline__ int perm32(int rho) { const int n = rho >> 4, i = rho & 15; return 8 * (i >> 2) + 4 * n + (i & 3); }

struct Unit { int pm, pn, koff, koffB; };
struct Gemm { const bf16_t* A; const bf16_t* Bt; int M, N, K, lda, ldb; };

struct StaticOrder {
    static constexpr bool GATHER = false; const int* tok = nullptr;
    int nM, nN, nwg, G, c;
    __host__ __device__ void init(int M, int N, int G_, int c_) { nM = M / BM; nN = N / BM; nwg = nM * nN; G = G_; c = c_; }
    __host__ __device__ bool next(int i, Unit& u) const {
        const long L = (long)i * G + c; if (L >= nwg) return false;
        int wgid = (int)L; { const int q = nwg / NXCD, r = nwg % NXCD, xcd = wgid % NXCD, off = wgid / NXCD; wgid = (xcd < r ? xcd * (q + 1) : r * (q + 1) + (xcd - r) * q) + off; }
        const int nig = WGM * nN, gid = wgid / nig, fm = gid * WGM, gsz = (nM - fm) < WGM ? (nM - fm) : WGM;
        u.pm = fm + ((wgid % nig) % gsz); u.pn = (wgid % nig) / gsz; u.koff = 0; u.koffB = 0; return true;
    }
    __device__ __forceinline__ void a_ready(const Unit&) const {}
    __device__ __forceinline__ void done(const Unit&) const {}
};

__device__ __forceinline__ unsigned cvt_pk_bf16(float lo, float hi) { unsigned r; asm volatile("v_cvt_pk_bf16_f32 %0, %1, %2" : "=v"(r) : "v"(lo), "v"(hi)); return r; }
template <class Epi, class Sched, bool ALIGN_EPI = false, bool SP2 = false, int F8 = 0, bool HM = false>
__device__ __forceinline__ void gemm_phase(PG8_LAS unsigned char* lds, const Gemm g, const Sched& S, const Epi& E) {
    int tid_ = threadIdx.x; asm volatile("" : "+v"(tid_));
    const int tid = tid_, wid = __builtin_amdgcn_readfirstlane(tid >> 6), lane = tid & 63, wr = wid >> 2, wc = wid & 3, fr = lane & 15, fq = lane >> 4;
    const int K = g.K, nt = K / BK;
    unsigned voffA[2], voffB[2], voffN[2] = {0u, 0u};
#pragma unroll
    for (int i = 0; i < 2; ++i) { int R, C; stage_rc(tid * 16 + i * 8192, R, C); const int Rb = Epi::PERM ? ((R & ~31) + perm32(R & 31)) : R;
        voffA[i] = (unsigned)(R * g.lda + C) * 2u; voffB[i] = (unsigned)(Rb * g.ldb + C) * 2u; }
    const size_t kstep = (size_t)(BK * 2);
    const size_t hstepA = HM ? (size_t)0 : (size_t)HALF * g.lda * 2, hstepB = (size_t)HALF * g.ldb * 2;
    const size_t tstepA = Sched::GATHER ? (size_t)0 : (HM ? 1 : 2) * (size_t)HALF * g.lda * 2, tstepB = 2 * hstepB;
    const unsigned ldsw = (unsigned)wid * 1024u;
    const int aoff = lds_byte(wr * 64 + fr, fq * 8), boff = lds_byte(wc * 32 + fr, fq * 8);
#define PG8_SA(b, h) (((b) * 2 + (h)) * HTB)
#define PG8_SB(b, h) ((4 + (b) * 2 + (h)) * HTB)
#define PG8_STAGE(bufoff, gbase, voff) do { _Pragma("unroll") for (int _i = 0; _i < 2; ++_i) \
        __builtin_amdgcn_global_load_lds((const unsigned*)((const char*)(gbase) + (voff)[_i]), (PG8_LAS unsigned*)(lds + (bufoff) + ldsw + _i * 8192), 16, 0, 0); } while (0)
#define PG8_CAT(lo, hi) __builtin_bit_cast(i32x8_t, __builtin_shufflevector(lo, hi, 0, 1, 2, 3, 4, 5, 6, 7, 8, 9, 10, 11, 12, 13, 14, 15))
#define PG8_RD(off) (*(const PG8_LAS bf16x8*)(lds + (off)))
#define PG8_LDA(dst, b, h) do { if constexpr (!(HM && (h) == 1)) _Pragma("unroll") for (int m = 0; m < 4; ++m) { if constexpr (F8 == 0) { _Pragma("unroll") for (int k = 0; k < 2; ++k) dst[m][k] = PG8_RD(PG8_SA(b, h) + aoff + m * 2048 + k * 1024); } \
        else dst[m][0] = PG8_CAT(PG8_RD(PG8_SA(b, h) + aoff + m * 2048), PG8_RD(PG8_SA(b, h) + aoff + m * 2048 + 1024)); } } while (0)
#define PG8_LDB(dst, b, h) do { _Pragma("unroll") for (int n = 0; n < 2; ++n) { if constexpr (F8 == 0) { _Pragma("unroll") for (int k = 0; k < 2; ++k) dst[n][k] = PG8_RD(PG8_SB(b, h) + boff + n * 2048 + k * 1024); } \
        else dst[n][0] = PG8_CAT(PG8_RD(PG8_SB(b, h) + boff + n * 2048), PG8_RD(PG8_SB(b, h) + boff + n * 2048 + 1024)); } } while (0)
#define PG8_MMA(ai, bj, At, Bt) do { __builtin_amdgcn_s_setprio(1); if constexpr (!(HM && (ai) == 1)) _Pragma("unroll") for (int m = 0; m < 4; ++m) _Pragma("unroll") for (int n = 0; n < 2; ++n) { \
        if constexpr (F8 == 0) { _Pragma("unroll") for (int k = 0; k < 2; ++k) acc[ai][bj][m][n] = __builtin_amdgcn_mfma_f32_16x16x32_bf16(Bt[n][k], At[m][k], acc[ai][bj][m][n], 0, 0, 0); } \
        else acc[ai][bj][m][n] = __builtin_amdgcn_mfma_scale_f32_16x16x128_f8f6f4(Bt[n][0], At[m][0], acc[ai][bj][m][n], 0, 0, 0, (F8 & 255) * 0x01010101, 0, ((F8 >> 8) & 255) * 0x01010101); } \
        __builtin_amdgcn_s_setprio(0); } while (0)
#define PG8_WAIT_V(n) asm volatile("s_waitcnt vmcnt(" #n ")" ::: "memory")
#define PG8_WAIT_L(n) asm volatile("s_waitcnt lgkmcnt(" #n ")" ::: "memory")
#define PG8_BAR __builtin_amdgcn_s_barrier()
#define PG8_SCHED __builtin_amdgcn_sched_barrier(0)
    Unit cur, nxt; int ui = 0;
    if (!S.next(0, cur)) return;
    f32x4 acc[2][2][4][2];
#pragma unroll
    for (int a = 0; a < 2; ++a)
#pragma unroll
        for (int b = 0; b < 2; ++b)
#pragma unroll
            for (int m = 0; m < 4; ++m)
#pragma unroll
                for (int n = 0; n < 2; ++n) acc[a][b][m][n] = (f32x4){0.f, 0.f, 0.f, 0.f};
    typename FragT<F8>::T At[4][FragT<F8>::NK], B0[2][FragT<F8>::NK], B1[2][FragT<F8>::NK];
    const char* cA = (const char*)g.A + (size_t)cur.pm * tstepA + cur.koff; const char* cB = (const char*)g.Bt + (size_t)cur.pn * tstepB + cur.koffB;
#define PG8_GVOFF(u, out) do { _Pragma("unroll") for (int i_ = 0; i_ < 2; ++i_) { int R_, C_; stage_rc(tid * 16 + i_ * 8192, R_, C_); out[i_] = ((unsigned)S.row_tok((u).pm, R_) * (unsigned)g.lda + (unsigned)C_) * 2u; } } while (0)
    if constexpr (Sched::GATHER) PG8_GVOFF(cur, voffA);
    S.a_ready(cur);
    if constexpr (SP2) {
        PG8_STAGE(PG8_SB(0, 0), cB, voffB); PG8_STAGE(PG8_SB(0, 1), cB + hstepB, voffB); PG8_STAGE(PG8_SA(0, 0), cA, voffA); PG8_STAGE(PG8_SA(0, 1), cA + hstepA, voffA);
        if (wr == 1) PG8_BAR;
        PG8_WAIT_V(2); PG8_BAR;
        PG8_STAGE(PG8_SB(1, 0), cB + kstep, voffB); PG8_STAGE(PG8_SA(1, 0), cA + kstep, voffA); PG8_STAGE(PG8_SB(1, 1), cB + hstepB + kstep, voffB);
        PG8_WAIT_V(6); PG8_BAR;
    } else {
        PG8_STAGE(PG8_SB(0, 0), cB, voffB); PG8_STAGE(PG8_SA(0, 0), cA, voffA); PG8_STAGE(PG8_SB(0, 1), cB + hstepB, voffB); PG8_STAGE(PG8_SA(0, 1), cA + hstepA, voffA);
        if (wr == 1) PG8_BAR;
        PG8_WAIT_V(4); PG8_BAR;
        PG8_STAGE(PG8_SB(1, 0), cB + kstep, voffB); PG8_STAGE(PG8_SA(1, 0), cA + kstep, voffA); PG8_STAGE(PG8_SB(1, 1), cB + hstepB + kstep, voffB);
        PG8_WAIT_V(6); PG8_BAR;
    }
    for (;;) {
        const bool has_next = S.next(ui + 1, nxt);
        if constexpr (Sched::GATHER) { if (has_next) PG8_GVOFF(nxt, voffN); }
        const char* nA = has_next ? (const char*)g.A + (size_t)nxt.pm * tstepA + nxt.koff : cA; const char* nB = has_next ? (const char*)g.Bt + (size_t)nxt.pn * tstepB + nxt.koffB : cB;
#pragma nounroll
        for (int t = 0; t < nt; t += 2) {
            const bool last = (t == nt - 2);
            const char* a1 = cA + (size_t)(t + 1) * kstep;
            const char* a2 = last ? nA : cA + (size_t)(t + 2) * kstep; const char* b2 = last ? nB : cB + (size_t)(t + 2) * kstep;
            const char* a3 = a2 + kstep; const char* b3 = b2 + kstep;
            unsigned vA2[2] = {voffA[0], voffA[1]}; if constexpr (Sched::GATHER) { if (last) { vA2[0] = voffN[0]; vA2[1] = voffN[1]; } }
            if (last && has_next) S.a_ready(nxt);
            if constexpr (SP2) {
            PG8_LDB(B0, 0, 0); PG8_LDB(B1, 0, 1); PG8_SCHED; PG8_LDA(At, 0, 0); PG8_STAGE(PG8_SA(1, 1), a1 + hstepA, voffA);
            PG8_WAIT_V(8); PG8_WAIT_L(0); PG8_BAR; PG8_MMA(0, 0, At, B0); PG8_MMA(0, 1, At, B1); PG8_BAR; PG8_SCHED;
            PG8_LDA(At, 0, 1); PG8_STAGE(PG8_SB(0, 0), b2, voffB); PG8_STAGE(PG8_SB(0, 1), b2 + hstepB, voffB); PG8_STAGE(PG8_SA(0, 0), a2, vA2);
            PG8_WAIT_V(8); PG8_WAIT_L(0); PG8_BAR; PG8_MMA(1, 0, At, B0); PG8_MMA(1, 1, At, B1); PG8_BAR; PG8_SCHED;
            PG8_LDB(B0, 1, 0); PG8_LDB(B1, 1, 1); PG8_SCHED; PG8_LDA(At, 1, 0); PG8_STAGE(PG8_SA(0, 1), a2 + hstepA, vA2);
            PG8_WAIT_V(8); PG8_WAIT_L(0); PG8_BAR; PG8_MMA(0, 0, At, B0); PG8_MMA(0, 1, At, B1); PG8_BAR; PG8_SCHED;
            PG8_LDA(At, 1, 1); PG8_STAGE(PG8_SB(1, 0), b3, voffB); PG8_STAGE(PG8_SB(1, 1), b3 + hstepB, voffB); PG8_STAGE(PG8_SA(1, 0), a3, vA2);
            PG8_WAIT_V(8); PG8_WAIT_L(0); PG8_BAR; PG8_MMA(1, 0, At, B0); PG8_MMA(1, 1, At, B1); PG8_BAR; PG8_SCHED;
            } else {
            PG8_LDB(B0, 0, 0); PG8_SCHED; PG8_LDA(At, 0, 0); PG8_STAGE(PG8_SA(1, 1), a1 + hstepA, voffA);
            PG8_WAIT_L(8); PG8_BAR; PG8_WAIT_L(0); PG8_MMA(0, 0, At, B0); PG8_BAR; PG8_SCHED;
            PG8_LDB(B1, 0, 1); PG8_STAGE(PG8_SB(0, 0), b2, voffB);
            PG8_BAR; PG8_WAIT_L(0); PG8_MMA(0, 1, At, B1); PG8_BAR;
            PG8_LDA(At, 0, 1); PG8_STAGE(PG8_SA(0, 0), a2, vA2);
            PG8_BAR; PG8_WAIT_L(0); PG8_MMA(1, 0, At, B0); PG8_BAR; PG8_SCHED;
            PG8_STAGE(PG8_SB(0, 1), b2 + hstepB, voffB);
            PG8_WAIT_V(6); PG8_BAR; PG8_MMA(1, 1, At, B1); PG8_BAR;
            PG8_LDB(B0, 1, 0); PG8_SCHED; PG8_LDA(At, 1, 0); PG8_STAGE(PG8_SA(0, 1), a2 + hstepA, vA2);
            PG8_WAIT_L(8); PG8_BAR; PG8_WAIT_L(0); PG8_MMA(0, 0, At, B0); PG8_BAR; PG8_SCHED;
            PG8_LDB(B1, 1, 1); PG8_STAGE(PG8_SB(1, 0), b3, voffB);
            PG8_BAR; PG8_WAIT_L(0); PG8_MMA(0, 1, At, B1); PG8_BAR;
            PG8_LDA(At, 1, 1); PG8_STAGE(PG8_SA(1, 0), a3, vA2);
            PG8_BAR; PG8_WAIT_L(0); PG8_MMA(1, 0, At, B0); PG8_BAR; PG8_SCHED;
            PG8_STAGE(PG8_SB(1, 1), b3 + hstepB, voffB);
            PG8_WAIT_V(6); PG8_BAR; PG8_MMA(1, 1, At, B1); PG8_BAR;
            }
        }
        if constexpr (ALIGN_EPI) { if (wr == 0) PG8_BAR; }
        if constexpr (!Epi::AFTER_DRAIN) { E(acc, cur, wr, wc, fr, fq); S.done(cur); }
        if (!has_next) break;
        {
#pragma unroll
        for (int a = 0; a < 2; ++a)
#pragma unroll
            for (int b = 0; b < 2; ++b)
#pragma unroll
                for (int m = 0; m < 4; ++m)
#pragma unroll
                    for (int n = 0; n < 2; ++n) acc[a][b][m][n] = (f32x4){0.f, 0.f, 0.f, 0.f};
        }
        cur = nxt; cA = nA; cB = nB; ++ui;
        if constexpr (Sched::GATHER) { voffA[0] = voffN[0]; voffA[1] = voffN[1]; }
        if constexpr (ALIGN_EPI) { if (wr == 1) PG8_BAR; }
    }
    PG8_WAIT_V(0);
    if constexpr (!ALIGN_EPI) { if (wr == 0) PG8_BAR; }
    PG8_BAR;
    if constexpr (Epi::AFTER_DRAIN) { E.fused(acc, cur, wr, wc, fr, fq, lds, wid, lane); S.done(cur); }
#undef PG8_SA
#undef PG8_SB
#undef PG8_STAGE
#undef PG8_LDA
#undef PG8_LDB
#undef PG8_MMA
#undef PG8_CAT
#undef PG8_GVOFF
#undef PG8_RD
#undef PG8_WAIT_V
#undef PG8_WAIT_L
#undef PG8_BAR
#undef PG8_SCHED
}
}

#define XB_TMO      128
#define XB_XCNT(j)  (256  + 64 * (j))
#define XB_XSUB(j)  (1280 + 64 * (j))
#define XB_XGEN(j)  (2304 + 64 * (j))
#define XB_TOP      3328
#define XB_TOPGEN   3392
#define XCD_BAR_WORDS 3456
#define XB_SPIN_CAP (1u << 18)
#define LAS __attribute__((address_space(3)))

__device__ __forceinline__ unsigned xb_ld(unsigned* p)              { return __hip_atomic_load(p, __ATOMIC_RELAXED, __HIP_MEMORY_SCOPE_AGENT); }
__device__ __forceinline__ unsigned xb_add(unsigned* p, unsigned v) { return __hip_atomic_fetch_add(p, v, __ATOMIC_RELAXED, __HIP_MEMORY_SCOPE_AGENT); }
__device__ __forceinline__ unsigned xb_xcc_id() { return (unsigned)__builtin_amdgcn_s_getreg((3 << 11) | 20) & 0xFu; }
#define XB_SPIN(cond, bar) do { unsigned _sp = 0; while (cond) { __builtin_amdgcn_s_sleep(1); \
    if ((++_sp & 255u) == 0u) { if (xb_ld(&(bar)[XB_TMO])) break; if (_sp > XB_SPIN_CAP) { atomicAdd(&(bar)[XB_TMO], 1u); break; } } } } while (0)

struct XcdBarrier {
    unsigned* bar; unsigned x;
    volatile LAS unsigned* st;
};

__device__ __forceinline__ XcdBarrier xcd_barrier_post(unsigned* bar, volatile LAS unsigned* st) {
    XcdBarrier b; b.bar = bar; b.x = xb_xcc_id(); b.st = st;
    if (threadIdx.x == 0) (void)xb_add(&bar[XB_XCNT(b.x)], 1u);
    return b;
}
__device__ __forceinline__ void xcd_barrier_complete(unsigned* bar, unsigned x, unsigned& nloc, unsigned& nx) {
    const unsigned G = gridDim.x * gridDim.y * gridDim.z;
    unsigned sum, cnt, mine, sp = 0u;
    for (;;) {
        sum = 0u; cnt = 0u; mine = 0u;
#pragma unroll
        for (unsigned j = 0; j < 16; ++j) { const unsigned c = xb_ld(&bar[XB_XCNT(j)]); sum += c; cnt += (c > 0u) ? 1u : 0u; mine = (j == x) ? c : mine; }
        if (sum == G) break;
        __builtin_amdgcn_s_sleep(1);
        if ((++sp & 255u) == 0u) { if (xb_ld(&bar[XB_TMO])) break; if (sp > XB_SPIN_CAP) { atomicAdd(&bar[XB_TMO], 1u); break; } }
    }
    nloc = mine > 0u ? mine : 1u; nx = cnt > 0u ? cnt : 1u;
}

__device__ __forceinline__ void xcd_barrier(const XcdBarrier& b) {
    asm volatile("s_waitcnt vmcnt(0)" ::: "memory");
    __syncthreads();
    if (threadIdx.x == 0) {
        unsigned* bar = b.bar;
        __builtin_amdgcn_s_waitcnt(0);
        unsigned nloc = b.st[0], nx = b.st[1];
        if (nloc == 0u) { xcd_barrier_complete(bar, b.x, nloc, nx); b.st[0] = nloc; b.st[1] = nx; }
        const unsigned old = xb_add(&bar[XB_XSUB(b.x)], 1u);
        const unsigned gen = old / nloc;
        if (old + 1u == (gen + 1u) * nloc) {
            __builtin_amdgcn_fence(__ATOMIC_RELEASE, "agent");
            asm volatile("s_waitcnt vmcnt(0)" ::: "memory");
            const unsigned og = xb_add(&bar[XB_TOP], 1u);
            const unsigned tg = og / nx;
            if (og + 1u == (tg + 1u) * nx) xb_add(&bar[XB_TOPGEN], 1u);
            else XB_SPIN(xb_ld(&bar[XB_TOPGEN]) == tg, bar);
            __builtin_amdgcn_fence(__ATOMIC_ACQUIRE, "agent");
            xb_add(&bar[XB_XGEN(b.x)], 1u);
            asm volatile("s_waitcnt vmcnt(0)" ::: "memory");
        } else {
            XB_SPIN(xb_ld(&bar[XB_XGEN(b.x)]) == gen, bar);
            __builtin_amdgcn_fence(__ATOMIC_ACQUIRE, "agent");
            asm volatile("s_waitcnt vmcnt(0)" ::: "memory");
        }
    }
    __syncthreads();
}

constexpr int NWAVES = 8, NTHR = 512;
constexpr int RING_BYTES = 131072;
constexpr int LDS_BYTES = 147456;
constexpr int RT_OFF = 131072;
constexpr int LDSCTL_OFF = LDS_BYTES - 16;
constexpr int CW_BAR = 4096;
typedef float f32x4 __attribute__((ext_vector_type(4)));
typedef unsigned u32x4 __attribute__((ext_vector_type(4)));
typedef unsigned u32x2 __attribute__((ext_vector_type(2)));
typedef short bf16x8 __attribute__((ext_vector_type(8)));
#define LDS_WAIT() asm volatile("s_waitcnt lgkmcnt(0)" ::: "memory")
typedef __bf16 bf16x2_t __attribute__((ext_vector_type(2)));
typedef float f32x2_t __attribute__((ext_vector_type(2)));
__device__ __forceinline__ unsigned pk2(float lo, float hi) { const f32x2_t v = {lo, hi}; return __builtin_bit_cast(unsigned, __builtin_convertvector(v, bf16x2_t)); }
__device__ __forceinline__ int lane_fresh() { int l; asm volatile("v_mbcnt_lo_u32_b32 %0, -1, 0\n\tv_mbcnt_hi_u32_b32 %0, -1, %0" : "=v"(l)); return l; }
#define DPP_ADD(v, ctrl) ((v) + __builtin_bit_cast(float, __builtin_amdgcn_update_dpp(0, __builtin_bit_cast(int, (v)), (ctrl), 0xf, 0xf, true)))
__device__ __forceinline__ float wave_sum(float v) {
    v = DPP_ADD(v, 0xB1);
    v = DPP_ADD(v, 0x4E);
    v = DPP_ADD(v, 0x141);
    v = DPP_ADD(v, 0x140);
    const int iv = __builtin_bit_cast(int, v);
    return (__builtin_bit_cast(float, __builtin_amdgcn_readlane(iv, 0)) + __builtin_bit_cast(float, __builtin_amdgcn_readlane(iv, 16)))
         + (__builtin_bit_cast(float, __builtin_amdgcn_readlane(iv, 32)) + __builtin_bit_cast(float, __builtin_amdgcn_readlane(iv, 48)));
}

constexpr int N1 = 11264;
struct Args { const float* in[38]; float* out; unsigned char* ws; int ph_lo, ph_hi; };

__device__ __forceinline__ void tr_item(const float* W, int ldw, int k0, int n0, bf16* dst, int ldd, const float* mu, int mode, LAS float* scr, int lane) {
    f32x4 v[8];
#pragma unroll
    for (int i = 0; i < 8; ++i) v[i] = *(const f32x4*)(W + (size_t)(k0 + 8 * i + (lane >> 3)) * ldw + n0 + 4 * (lane & 7));
#pragma unroll
    for (int i = 0; i < 8; ++i) { const int kk = 8 * i + (lane >> 3); f32x4 t = v[i];
        if (mode == 1) t = t * (1.0f - mu[k0 + kk]); else if (mode == 2) t = t * mu[k0 + kk];
        LAS float* s = scr + kk * 33 + 4 * (lane & 7); s[0] = t.x; s[1] = t.y; s[2] = t.z; s[3] = t.w; }
    LDS_WAIT(); asm volatile("" ::: "memory");
    const int c = lane & 7;
#pragma unroll
    for (int j = 0; j < 4; ++j) { const int n = (lane >> 3) + 8 * j; const LAS float* s = scr + (8 * c) * 33 + n;
        u32x4 o; o.x = pk2(s[0 * 33], s[1 * 33]); o.y = pk2(s[2 * 33], s[3 * 33]); o.z = pk2(s[4 * 33], s[5 * 33]); o.w = pk2(s[6 * 33], s[7 * 33]);
        *(u32x4*)(dst + (size_t)n * ldd + 8 * c) = o; }
    LDS_WAIT(); asm volatile("" ::: "memory");
}
__device__ __forceinline__ unsigned pk_fp8x4(float a, float b, float c, float d, float sc) {
    a = fminf(fmaxf(a * sc, -448.f), 448.f); b = fminf(fmaxf(b * sc, -448.f), 448.f); c = fminf(fmaxf(c * sc, -448.f), 448.f); d = fminf(fmaxf(d * sc, -448.f), 448.f);
    int p = __builtin_amdgcn_cvt_pk_fp8_f32(a, b, 0, false); p = __builtin_amdgcn_cvt_pk_fp8_f32(c, d, p, true); return (unsigned)p; }
__device__ __forceinline__ void tr_item8(const float* W, int ldw, int k0, int n0, unsigned char* dst, int ldd, float sc, LAS float* scr, int lane) {
    f32x4 v[8];
#pragma unroll
    for (int i = 0; i < 8; ++i) v[i] = *(const f32x4*)(W + (size_t)(k0 + 8 * i + (lane >> 3)) * ldw + n0 + 4 * (lane & 7));
#pragma unroll
    for (int i = 0; i < 8; ++i) { const int kk = 8 * i + (lane >> 3); LAS float* s = scr + kk * 33 + 4 * (lane & 7); s[0] = v[i].x; s[1] = v[i].y; s[2] = v[i].z; s[3] = v[i].w; }
    LDS_WAIT(); asm volatile("" ::: "memory");
    const int c = lane & 7;
#pragma unroll
    for (int j = 0; j < 4; ++j) { const int n = (lane >> 3) + 8 * j; const LAS float* s = scr + (8 * c) * 33 + n;
        u32x2 o; o.x = pk_fp8x4(s[0 * 33], s[1 * 33], s[2 * 33], s[3 * 33], sc); o.y = pk_fp8x4(s[4 * 33], s[5 * 33], s[6 * 33], s[7 * 33], sc);
        *(u32x2*)(dst + (size_t)n * ldd + 8 * c) = o; }
    LDS_WAIT(); asm volatile("" ::: "memory");
}

struct ConvTile { const float* src; int ldw; unsigned char* dst; int rs; int kind; float sc; };
constexpr int CT_IN = (D / 128) * (INW / 128), CT_UP = (AW / 128) * (D / 128), CT_O = (D / 128) * (D / 128), CT_EG = (D / 128) * (FF / 128), CT_ED = (FF / 128) * (D / 128);
constexpr int CT_ALL = CT_IN + 2 * CT_UP + CT_O + NE * (2 * CT_EG + CT_ED);
__device__ __forceinline__ ConvTile conv_decode(int T, const float* const* in, unsigned char* ws) {
    ConvTile t; int r = T;
    if (r < CT_IN) { const int kt = r / (INW / 128), nt = r % (INW / 128), k0 = 128 * kt, n0 = 128 * nt; int dr = n0;
        if (n0 >= 3 * AW + 3 * RW + D) { const int cc = n0 - (3 * AW + 3 * RW + D); dr = 3 * AW + 3 * RW + 256 * (cc / 128) + 128; }
        else if (n0 >= 3 * AW + 3 * RW) { const int cc = n0 - (3 * AW + 3 * RW); dr = 3 * AW + 3 * RW + 256 * (cc / 128); }
        t.src = in[8] + (size_t)k0 * INW + n0; t.ldw = INW; t.dst = ws + WS_W1T + ((size_t)dr * D + k0) * 2; t.rs = D * 2; t.kind = 0; t.sc = 1.f; return t; } r -= CT_IN;
    if (r < 2 * CT_UP) { const int which = r / CT_UP, q = r % CT_UP, kt = q / (D / 128), nt = q % (D / 128), k0 = 128 * kt, n0 = 128 * nt;
        t.src = in[28 + which] + (size_t)k0 * D + n0; t.ldw = D; t.dst = ws + WS_WUPT + ((size_t)n0 * D + which * AW + k0) * 2; t.rs = D * 2; t.kind = 0; t.sc = 1.f; return t; } r -= 2 * CT_UP;
    if (r < CT_O) { const int kt = r / (D / 128), nt = r % (D / 128), k0 = 128 * kt, n0 = 128 * nt;
        t.src = in[30] + (size_t)k0 * D + n0; t.ldw = D; t.dst = ws + WS_WOT + ((size_t)n0 * D + k0) * 2; t.rs = D * 2; t.kind = 0; t.sc = 1.f; return t; } r -= CT_O;
    const int e = r / (2 * CT_EG + CT_ED); r -= e * (2 * CT_EG + CT_ED);
    if (r < 2 * CT_EG) { const int up = r / CT_EG, q = r % CT_EG, kt = q / (FF / 128), nt = q % (FF / 128), k0 = 128 * kt;
        t.src = in[35 + up] + (size_t)e * D * FF + (size_t)k0 * FF + 128 * nt; t.ldw = FF; t.dst = ws + WS_WGUT + ((size_t)e * 1024 + 256 * nt + 128 * up) * D + k0; t.rs = D; t.kind = 1; t.sc = 256.f; return t; } r -= 2 * CT_EG;
    { const int kt = r / (D / 128), nt = r % (D / 128), k0 = 128 * kt, n0 = 128 * nt;
        t.src = in[37] + (size_t)e * FF * D + (size_t)k0 * D + n0; t.ldw = D; t.dst = ws + WS_WDT + ((size_t)e * D + n0) * FF + k0; t.rs = FF; t.kind = 1; t.sc = 128.f; return t; }
}
__device__ __forceinline__ int conv_off(int k, int n) { return k * 132 + 16 * (k >> 5) + n; }
__device__ __forceinline__ void item_kn(int it, int N, int& k0, int& n0) { const int nblk = N / 32; k0 = 64 * (it / nblk); n0 = 32 * (it % nblk); }

struct EpiProj {
    static constexpr bool PERM = true, AFTER_DRAIN = false, MIDK = false;
    bf16* q; bf16* k; bf16* v; bf16* rkv; bf16* gate; float* lora; float* lorab; const float* rope;
    __device__ __forceinline__ void operator()(const pg8::f32x4 (&acc)[2][2][4][2], const pg8::Unit& u, int wr, int wc, int fr, int fq) const {
        const int row0 = u.pm * 256 + wr * 64 + fr; const int pn = u.pn; const int colw = wc * 32 + 8 * fq;
        if (pn < 8) {
            bf16* base = (pn < 4 ? q : k) + (pn & 3) * 256 + colw;
            const float sgn = fq < 2 ? -1.0f : 1.0f;
#pragma unroll
            for (int ai = 0; ai < 2; ++ai)
#pragma unroll
                for (int m = 0; m < 4; ++m) { const int row = row0 + ai * 128 + m * 16;
                    f32x4 c0, c1, c2, c3;
                    if (wc == 0) { const float* rp = rope + ((size_t)row * 16 + 8 * (fq & 1)) * 2; c0 = *(const f32x4*)rp; c1 = *(const f32x4*)(rp + 4); c2 = *(const f32x4*)(rp + 8); c3 = *(const f32x4*)(rp + 12); }
#pragma unroll
                    for (int bj = 0; bj < 2; ++bj) { f32x4 v0 = acc[ai][bj][m][0], v1 = acc[ai][bj][m][1];
                        if (wc == 0) {
                            f32x4 p0, p1;
#pragma unroll
                            for (int j = 0; j < 4; ++j) { p0[j] = __shfl_xor(v0[j], 32) * sgn; p1[j] = __shfl_xor(v1[j], 32) * sgn; }
                            v0[0] = v0[0] * c0[0] + p0[0] * c0[1]; v0[1] = v0[1] * c0[2] + p0[1] * c0[3]; v0[2] = v0[2] * c1[0] + p0[2] * c1[1]; v0[3] = v0[3] * c1[2] + p0[3] * c1[3];
                            v1[0] = v1[0] * c2[0] + p1[0] * c2[1]; v1[1] = v1[1] * c2[2] + p1[1] * c2[3]; v1[2] = v1[2] * c3[0] + p1[2] * c3[1]; v1[3] = v1[3] * c3[2] + p1[3] * c3[3];
                        }
                        u32x4 w; w.x = pk2(v0[0], v0[1]); w.y = pk2(v0[2], v0[3]); w.z = pk2(v1[0], v1[1]); w.w = pk2(v1[2], v1[3]);
                        *(u32x4*)(base + (size_t)row * AW + bj * 128) = w; } }
        } else if (pn < 12) {
            bf16* base = v + (pn - 8) * 256 + colw;
#pragma unroll
            for (int ai = 0; ai < 2; ++ai)
#pragma unroll
                for (int m = 0; m < 4; ++m) { const int row = row0 + ai * 128 + m * 16;
#pragma unroll
                    for (int bj = 0; bj < 2; ++bj) { const f32x4 v0 = acc[ai][bj][m][0], v1 = acc[ai][bj][m][1];
                        u32x4 w; w.x = pk2(v0[0], v0[1]); w.y = pk2(v0[2], v0[3]); w.z = pk2(v1[0], v1[1]); w.w = pk2(v1[2], v1[3]);
                        *(u32x4*)(base + (size_t)row * AW + bj * 128) = w; } }
        } else if (pn < 24) {
            bf16* base = rkv + (pn - 12) * 256 + colw;
#pragma unroll
            for (int ai = 0; ai < 2; ++ai)
#pragma unroll
                for (int m = 0; m < 4; ++m) { const int row = row0 + ai * 128 + m * 16;
#pragma unroll
                    for (int bj = 0; bj < 2; ++bj) { const f32x4 v0 = acc[ai][bj][m][0], v1 = acc[ai][bj][m][1];
                        u32x4 w; w.x = pk2(v0[0], v0[1]); w.y = pk2(v0[2], v0[3]); w.z = pk2(v1[0], v1[1]); w.w = pk2(v1[2], v1[3]);
                        *(u32x4*)(base + (size_t)row * (3 * RW) + bj * 128) = w; } }
        } else if (pn < 40) {
            bf16* base = gate + (pn - 24) * 128 + colw;
#pragma unroll
            for (int ai = 0; ai < 2; ++ai)
#pragma unroll
                for (int m = 0; m < 4; ++m) { const int row = row0 + ai * 128 + m * 16;
                    const f32x4 a0 = acc[ai][0][m][0], a1 = acc[ai][0][m][1], r0 = acc[ai][1][m][0], r1 = acc[ai][1][m][1]; float ra[8], sr[8];
#pragma unroll
                    for (int j = 0; j < 4; ++j) { const float ea = __expf(-a0[j]), er = __expf(-r0[j]), ea1 = __expf(-a1[j]), er1 = __expf(-r1[j]);
                        sr[j] = __builtin_amdgcn_rcpf(1.0f + er); ra[j] = (1.0f + er) * __builtin_amdgcn_rcpf(1.0f + ea); sr[4 + j] = __builtin_amdgcn_rcpf(1.0f + er1); ra[4 + j] = (1.0f + er1) * __builtin_amdgcn_rcpf(1.0f + ea1); }
                    u32x4 w; w.x = pk2(ra[0], ra[1]); w.y = pk2(ra[2], ra[3]); w.z = pk2(ra[4], ra[5]); w.w = pk2(ra[6], ra[7]);
                    *(u32x4*)(base + (size_t)row * (2 * D)) = w;
                    w.x = pk2(sr[0], sr[1]); w.y = pk2(sr[2], sr[3]); w.z = pk2(sr[4], sr[5]); w.w = pk2(sr[6], sr[7]);
                    *(u32x4*)(base + (size_t)row * (2 * D) + D) = w; }
        } else {
            float* base = (u.koff ? lorab : lora) + (pn - 40) * 256 + colw;
#pragma unroll
            for (int ai = 0; ai < 2; ++ai)
#pragma unroll
                for (int m = 0; m < 4; ++m) { const int row = row0 + ai * 128 + m * 16;
#pragma unroll
                    for (int bj = 0; bj < 2; ++bj) { float* p = base + (size_t)row * 1024 + bj * 128; *(f32x4*)p = acc[ai][bj][m][0]; *(f32x4*)(p + 4) = acc[ai][bj][m][1]; } }
        }
    }
};


struct LoraOrder { static constexpr bool GATHER = false; const int* tok; int G, c;
    __device__ bool next(int i, pg8::Unit& u) const { const int L = i * G + c; if (L >= (S / 256) * 8) return false; u.pm = L >> 3; u.pn = 40 + ((L >> 1) & 3); u.koff = (L & 1) * AW * 2; u.koffB = u.koff; return true; }
    __device__ __forceinline__ void a_ready(const pg8::Unit&) const {}
    __device__ __forceinline__ void done(const pg8::Unit&) const {} };
__device__ __forceinline__ void unpack8(const u32x4 w, float (&f)[8]) {
    f[0] = __uint_as_float(w.x << 16); f[1] = __uint_as_float(w.x & 0xffff0000u); f[2] = __uint_as_float(w.y << 16); f[3] = __uint_as_float(w.y & 0xffff0000u);
    f[4] = __uint_as_float(w.z << 16); f[5] = __uint_as_float(w.z & 0xffff0000u); f[6] = __uint_as_float(w.w << 16); f[7] = __uint_as_float(w.w & 0xffff0000u);
}
struct EpiMix {
    static constexpr bool PERM = true, AFTER_DRAIN = false, MIDK = false;
    const bf16* gate; bf16* mix;
    __device__ __forceinline__ void operator()(const pg8::f32x4 (&acc)[2][2][4][2], const pg8::Unit& u, int wr, int wc, int fr, int fq) const {
        const int row0 = u.pm * 256 + wr * 64 + fr; const int col0 = u.pn * 256 + wc * 32 + 8 * fq;
        if (u.koff == 0) {
#pragma unroll
            for (int ai = 0; ai < 2; ++ai)
#pragma unroll
                for (int m = 0; m < 4; ++m) { const size_t row = row0 + ai * 128 + m * 16; const bf16* gp = gate + row * (2 * D) + col0;
#pragma unroll
                    for (int bj = 0; bj < 2; ++bj) { float ga[8]; unpack8(*(const u32x4*)(gp + bj * 128), ga); const pg8::f32x4 v0 = acc[ai][bj][m][0], v1 = acc[ai][bj][m][1];
                        u32x4 w; w.x = pk2(v0[0] * ga[0], v0[1] * ga[1]); w.y = pk2(v0[2] * ga[2], v0[3] * ga[3]); w.z = pk2(v1[0] * ga[4], v1[1] * ga[5]); w.w = pk2(v1[2] * ga[6], v1[3] * ga[7]);
                        *(u32x4*)(mix + row * D + col0 + bj * 128) = w; } }
        } else {
#pragma unroll
            for (int ai = 0; ai < 2; ++ai)
#pragma unroll
                for (int m = 0; m < 4; ++m) { const size_t row = row0 + ai * 128 + m * 16; const bf16* gp = gate + row * (2 * D) + D + col0;
#pragma unroll
                    for (int bj = 0; bj < 2; ++bj) { float gr[8], tp[8]; unpack8(*(const u32x4*)(gp + bj * 128), gr); unpack8(*(const u32x4*)(mix + row * D + col0 + bj * 128), tp); const pg8::f32x4 v0 = acc[ai][bj][m][0], v1 = acc[ai][bj][m][1];
                        u32x4 w; w.x = pk2((v0[0] + tp[0]) * gr[0], (v0[1] + tp[1]) * gr[1]); w.y = pk2((v0[2] + tp[2]) * gr[2], (v0[3] + tp[3]) * gr[3]);
                        w.z = pk2((v1[0] + tp[4]) * gr[4], (v1[1] + tp[5]) * gr[5]); w.w = pk2((v1[2] + tp[6]) * gr[6], (v1[3] + tp[7]) * gr[7]);
                        *(u32x4*)(mix + row * D + col0 + bj * 128) = w; } }
        }
    }
};
struct MixOrder {
    static constexpr bool GATHER = false; const int* tok; int G, c;
    __device__ bool next(int i, pg8::Unit& u) const { const int L = (i >> 1) * G + c; if (L >= (S / 256) * (D / 256)) return false; u.pm = L / (D / 256); u.pn = L % (D / 256); u.koff = (i & 1) * AW * 2; u.koffB = u.koff; return true; }
    __device__ __forceinline__ void a_ready(const pg8::Unit&) const {}
    __device__ __forceinline__ void done(const pg8::Unit&) const {}
};
struct EpiBf16P {
    static constexpr bool PERM = true, AFTER_DRAIN = false, MIDK = false;
    bf16* C; long ldc;
    __device__ __forceinline__ void operator()(const pg8::f32x4 (&acc)[2][2][4][2], const pg8::Unit& u, int wr, int wc, int fr, int fq) const {
        const int row0 = u.pm * 256 + wr * 64 + fr; const int col0 = u.pn * 256 + wc * 32 + 8 * fq;
#pragma unroll
        for (int ai = 0; ai < 2; ++ai)
#pragma unroll
            for (int m = 0; m < 4; ++m) { bf16* p = C + (size_t)(row0 + ai * 128 + m * 16) * ldc + col0;
#pragma unroll
                for (int bj = 0; bj < 2; ++bj) { const pg8::f32x4 v0 = acc[ai][bj][m][0], v1 = acc[ai][bj][m][1];
                    u32x4 w; w.x = pk2(v0[0], v0[1]); w.y = pk2(v0[2], v0[3]); w.z = pk2(v1[0], v1[1]); w.w = pk2(v1[2], v1[3]);
                    *(u32x4*)(p + bj * 128) = w; } }
    }
};
struct EpiF32P {
    static constexpr bool PERM = true, AFTER_DRAIN = false, MIDK = false;
    float* C; long ldc;
    __device__ __forceinline__ void operator()(const pg8::f32x4 (&acc)[2][2][4][2], const pg8::Unit& u, int wr, int wc, int fr, int fq) const {
        const int row0 = u.pm * 256 + wr * 64 + fr; const int col0 = u.pn * 256 + wc * 32 + 8 * fq;
#pragma unroll
        for (int ai = 0; ai < 2; ++ai)
#pragma unroll
            for (int m = 0; m < 4; ++m) { float* p = C + (size_t)(row0 + ai * 128 + m * 16) * ldc + col0;
#pragma unroll
                for (int bj = 0; bj < 2; ++bj) { *(f32x4*)(p + bj * 128) = acc[ai][bj][m][0]; *(f32x4*)(p + bj * 128 + 4) = acc[ai][bj][m][1]; } }
    }
};
template <bool GA> struct ExpertOrderT {
    static constexpr bool GATHER = GA; const int* elist;
    LAS const int* tb; int nj, G, c;
    __device__ bool next(int i, pg8::Unit& u) const { const int L = i * G + c; const int pm = L / nj; if (pm >= tb[512]) return false; u.pm = pm; u.pn = tb[128 + pm] * nj + (L % nj); u.koff = 0; u.koffB = 0; return true; }
    __device__ __forceinline__ int row_tok(int pm, int r) const { const int e = tb[128 + pm]; const int q = tb[320 + pm] + r; return q < tb[e] ? elist[e * S + q] : 0; }
    __device__ __forceinline__ void a_ready(const pg8::Unit&) const {}
    __device__ __forceinline__ void done(const pg8::Unit&) const {}
};
struct EpiHid {
    static constexpr bool PERM = true, AFTER_DRAIN = false, MIDK = false;
    unsigned char* hid;
    __device__ __forceinline__ void operator()(const pg8::f32x4 (&acc)[2][2][4][2], const pg8::Unit& u, int wr, int wc, int fr, int fq) const {
        const int row0 = u.pm * 128 + wr * 64 + fr; const int col0 = (u.pn & 3) * 128 + wc * 32 + 8 * fq;
#pragma unroll
        for (int ai = 0; ai < 1; ++ai)
#pragma unroll
            for (int m = 0; m < 4; ++m) { const pg8::f32x4 g0 = acc[ai][0][m][0], g1 = acc[ai][0][m][1], u0 = acc[ai][1][m][0], u1 = acc[ai][1][m][1]; float o[8];
#pragma unroll
                for (int j = 0; j < 4; ++j) { o[j] = g0[j] * sigmoidf_(g0[j]) * u0[j]; o[4 + j] = g1[j] * sigmoidf_(g1[j]) * u1[j]; }
                u32x2 w; w.x = pk_fp8x4(o[0], o[1], o[2], o[3], 8.0f); w.y = pk_fp8x4(o[4], o[5], o[6], o[7], 8.0f);
                *(u32x2*)(hid + (size_t)(row0 + ai * 128 + m * 16) * FF + col0) = w; }
    }
};
struct EpiYbuf {
    static constexpr bool PERM = true, AFTER_DRAIN = false, MIDK = false;
    bf16* ybuf;
    __device__ __forceinline__ void operator()(const pg8::f32x4 (&acc)[2][2][4][2], const pg8::Unit& u, int wr, int wc, int fr, int fq) const {
        const int row0 = u.pm * 128 + wr * 64 + fr; const int col0 = (u.pn & 7) * 256 + wc * 32 + 8 * fq;
#pragma unroll
        for (int ai = 0; ai < 1; ++ai)
#pragma unroll
            for (int m = 0; m < 4; ++m) { bf16* p = ybuf + (size_t)(row0 + ai * 128 + m * 16) * D + col0;
#pragma unroll
                for (int bj = 0; bj < 2; ++bj) { const pg8::f32x4 v0 = acc[ai][bj][m][0], v1 = acc[ai][bj][m][1];
                    u32x4 w; w.x = pk2(v0[0], v0[1]); w.y = pk2(v0[2], v0[3]); w.z = pk2(v1[0], v1[1]); w.w = pk2(v1[2], v1[3]);
                    *(u32x4*)(p + bj * 128) = w; } }
    }
};
constexpr int RS8 = D + 8;

typedef short s16x4 __attribute__((ext_vector_type(4)));
constexpr int KST = 136, VST = 144;
constexpr int KT_BYTES = 64 * KST * 2, VT_BYTES = 64 * VST * 2;
constexpr int AT_BUF = KT_BYTES + VT_BYTES;
constexpr int AT_G = 2 * AT_BUF;
constexpr int AT_HIST = AT_G + 8 * 2112;
constexpr int AT_ITEMS = AT_HIST + 256;
constexpr int LIST_PER_HEAD = 256 * 496;
__device__ __forceinline__ int list_off(int j) { return 256 * (31 * j - (j * (j - 1)) / 2); }
__device__ __forceinline__ s16x4 tr_read4(unsigned addr) { return __builtin_amdgcn_ds_read_tr16_b64_v4i16((LAS s16x4*)(size_t)addr); }

struct AttnBufs { const bf16* q; const bf16* k; const bf16* v; const bf16* kmh; const bf16* kml; unsigned* mask; int* list; int* cnt; bf16* part; float* ml; };

__device__ __forceinline__ void moba_select_unit(LAS unsigned char* lds, const AttnBufs& A, int head, int qt, int tid, int lane, int wave) {
    const int q0 = qt * 128, qblk = qt >> 1, g4 = lane >> 4, c16 = lane & 15; const int myq = q0 + wave * 16 + c16;
    LAS int* hist = (LAS int*)(lds + AT_HIST); LAS int* base = hist + 32;
    if (tid < 32) hist[tid] = 0;
    __syncthreads();
    unsigned msk = 0u; int lp0 = 0, lp1 = 0, lp2 = 0, b0 = 0, b1 = 0, b2 = 0, nsel = 0;
    if (qblk > 0) {
        bf16x8 qf[4];
#pragma unroll
        for (int ks = 0; ks < 4; ++ks) qf[ks] = *(const bf16x8*)(A.q + (size_t)myq * AW + head * AD + 32 * ks + 8 * g4);
        f32x4 gs[2] = {(f32x4){0.f, 0.f, 0.f, 0.f}, (f32x4){0.f, 0.f, 0.f, 0.f}};
#pragma unroll
        for (int mt = 0; mt < 2; ++mt)
#pragma unroll
            for (int ks = 0; ks < 4; ++ks) { const size_t o = (size_t)(head * NB + 16 * mt + c16) * AD + 32 * ks + 8 * g4;
                gs[mt] = __builtin_amdgcn_mfma_f32_16x16x32_bf16(*(const bf16x8*)(A.kmh + o), qf[ks], gs[mt], 0, 0, 0);
                gs[mt] = __builtin_amdgcn_mfma_f32_16x16x32_bf16(*(const bf16x8*)(A.kml + o), qf[ks], gs[mt], 0, 0, 0); }
        LAS float* G = (LAS float*)(lds + AT_G + wave * 2112);
#pragma unroll
        for (int mt = 0; mt < 2; ++mt)
#pragma unroll
            for (int rg = 0; rg < 4; ++rg) G[c16 * 33 + 16 * mt + 4 * g4 + rg] = gs[mt][rg];
        LDS_WAIT(); asm volatile("" ::: "memory");
        if (lane < 16) {
            nsel = qblk < 3 ? qblk : 3;
            float gvv[32];
#pragma unroll
            for (int n = 0; n < 32; ++n) gvv[n] = G[lane * 33 + n];
#pragma unroll
            for (int n = 0; n < 32; ++n) gvv[n] = n < qblk ? gvv[n] : -3e38f;
#pragma unroll
            for (int t = 0; t < 3; ++t) if (t < nsel) { float best = -3e38f; int bi = 0;
#pragma unroll
                for (int n = 0; n < 32; ++n) { const bool take = gvv[n] > best; best = take ? gvv[n] : best; bi = take ? n : bi; }
#pragma unroll
                for (int n = 0; n < 32; ++n) gvv[n] = (n == bi) ? -3e38f : gvv[n];
                msk |= 1u << bi;
                const int lp = atomicAdd((int*)&hist[bi], 1); if (t == 0) { lp0 = lp; b0 = bi; } else if (t == 1) { lp1 = lp; b1 = bi; } else { lp2 = lp; b2 = bi; } }
        }
    }
    if (lane < 16) A.mask[head * S + myq] = msk;
    __syncthreads();
    if (tid < 32) { const int hcount = hist[tid]; base[tid] = hcount > 0 ? atomicAdd(A.cnt + (head * NB + tid) * ACNT_STR, hcount) : 0; }
    __syncthreads();
    if (lane < 16) { int* lh = A.list + head * LIST_PER_HEAD;
        if (nsel > 0) lh[list_off(b0) + base[b0] + lp0] = myq;
        if (nsel > 1) lh[list_off(b1) + base[b1] + lp1] = myq;
        if (nsel > 2) lh[list_off(b2) + base[b2] + lp2] = myq; }
    __syncthreads();
}

__device__ __forceinline__ void moba_item2(LAS unsigned char* lds, const AttnBufs& A, int head, int kvb, bool own, int r, int cntj, int tid, int lane, int wave) {
    const int g4 = lane >> 4, c16 = lane & 15;
    int myq[2]; bool valid[2];
    if (own) { myq[0] = kvb * MB + wave * 32 + c16; myq[1] = myq[0] + 16; valid[0] = true; valid[1] = true; }
    else { const int* lp = A.list + head * LIST_PER_HEAD + list_off(kvb);
#pragma unroll
        for (int g = 0; g < 2; ++g) { const int e = r * 256 + wave * 32 + 16 * g + c16; valid[g] = e < cntj; myq[g] = lp[valid[g] ? e : 0]; } }
    const bool wave_valid = own || (r * 256 + wave * 32 < cntj);
    const int qfirst = kvb * MB + wave * 32;
    bf16x8 qf[2][4];
#pragma unroll
    for (int g = 0; g < 2; ++g)
#pragma unroll
        for (int ks = 0; ks < 4; ++ks) qf[g][ks] = *(const bf16x8*)(A.q + (size_t)myq[g] * AW + head * AD + 32 * ks + 8 * g4);
    f32x4 oacc[2][8];
#pragma unroll
    for (int g = 0; g < 2; ++g)
#pragma unroll
        for (int dt = 0; dt < 8; ++dt) oacc[g][dt] = (f32x4){0.f, 0.f, 0.f, 0.f};
    float mrun[2] = {-1e30f, -1e30f}, lrun[2] = {0.f, 0.f};
    const float sc2 = 0.08838834764831845f * 1.4426950408889634f;
    const int r0 = tid >> 4, ch = tid & 15;
    u32x4 kr[2], vr[2];
    const bf16* kg = A.k + (size_t)(kvb * MB + r0) * AW + head * AD + 8 * ch; const bf16* vg = A.v + (size_t)(kvb * MB + r0) * AW + head * AD + 8 * ch;
    LAS unsigned char* kst = lds + (r0 * KST + 8 * ch) * 2; LAS unsigned char* vst = lds + KT_BYTES + (r0 * VST + 8 * ch) * 2;
    const LAS unsigned char* kld = lds + (c16 * KST + 8 * g4) * 2; const LAS unsigned char* vld = lds + KT_BYTES + ((4 * g4 + (c16 >> 2)) * VST + 4 * (c16 & 3)) * 2;
#define GLD(it) do { kr[0] = *(const u32x4*)(kg + (size_t)(64 * (it)) * AW); kr[1] = *(const u32x4*)(kg + (size_t)(64 * (it) + 32) * AW); vr[0] = *(const u32x4*)(vg + (size_t)(64 * (it)) * AW); vr[1] = *(const u32x4*)(vg + (size_t)(64 * (it) + 32) * AW); } while (0)
#define LST(b) do { *(LAS u32x4*)(kst + (b) * AT_BUF) = kr[0]; *(LAS u32x4*)(kst + (b) * AT_BUF + 32 * KST * 2) = kr[1]; *(LAS u32x4*)(vst + (b) * AT_BUF) = vr[0]; *(LAS u32x4*)(vst + (b) * AT_BUF + 32 * VST * 2) = vr[1]; } while (0)
    GLD(0); LST(0);
    __syncthreads();
#pragma nounroll
    for (int it = 0; it < 4; ++it) {
        const int kp0 = kvb * MB + 64 * it; const int b = it & 1;
        if (it + 1 < 4) GLD(it + 1);
        if (wave_valid && (!own || kp0 <= qfirst + 31)) {
            const LAS unsigned char* Kb = kld + b * AT_BUF; const LAS unsigned char* vb = vld + b * AT_BUF;
            f32x4 st[2][4];
#pragma unroll
            for (int mt = 0; mt < 4; ++mt) { st[0][mt] = (f32x4){0.f, 0.f, 0.f, 0.f}; st[1][mt] = st[0][mt];
#pragma unroll
                for (int ks = 0; ks < 4; ++ks) { const bf16x8 kf = *(const LAS bf16x8*)(Kb + (16 * mt * KST + 32 * ks) * 2);
                    st[0][mt] = __builtin_amdgcn_mfma_f32_16x16x32_bf16(kf, qf[0][ks], st[0][mt], 0, 0, 0);
                    st[1][mt] = __builtin_amdgcn_mfma_f32_16x16x32_bf16(kf, qf[1][ks], st[1][mt], 0, 0, 0); } }
            bf16x8 pf[2][2];
#pragma unroll
            for (int g = 0; g < 2; ++g) {
                if (own && kp0 + 63 > qfirst + 16 * g) {
#pragma unroll
                    for (int mt = 0; mt < 4; ++mt)
#pragma unroll
                        for (int rg = 0; rg < 4; ++rg) { const int kpos = kp0 + 16 * mt + 4 * g4 + rg; st[g][mt][rg] = (kpos <= myq[g]) ? st[g][mt][rg] : -1e30f; }
                }
                float mloc = fmaxf(fmaxf(fmaxf(st[g][0][0], st[g][0][1]), fmaxf(st[g][0][2], st[g][0][3])), fmaxf(fmaxf(st[g][1][0], st[g][1][1]), fmaxf(st[g][1][2], st[g][1][3])));
                mloc = fmaxf(mloc, fmaxf(fmaxf(fmaxf(st[g][2][0], st[g][2][1]), fmaxf(st[g][2][2], st[g][2][3])), fmaxf(fmaxf(st[g][3][0], st[g][3][1]), fmaxf(st[g][3][2], st[g][3][3]))));
                mloc = fmaxf(mloc, __shfl_xor(mloc, 16)); mloc = fmaxf(mloc, __shfl_xor(mloc, 32));
                const float mnew = fmaxf(mrun[g], mloc * sc2); const float alpha = __builtin_amdgcn_exp2f(mrun[g] - mnew); mrun[g] = mnew;
                float psum = 0.f;
#pragma unroll
                for (int mt = 0; mt < 4; ++mt)
#pragma unroll
                    for (int rg = 0; rg < 4; ++rg) { const float p = __builtin_amdgcn_exp2f(fmaf(st[g][mt][rg], sc2, -mnew)); st[g][mt][rg] = p; psum += p; }
                lrun[g] = lrun[g] * alpha + psum;
#pragma unroll
                for (int dt = 0; dt < 8; ++dt) oacc[g][dt] = oacc[g][dt] * alpha;
#pragma unroll
                for (int s = 0; s < 2; ++s) { u32x4 w; w.x = pk2(st[g][2 * s][0], st[g][2 * s][1]); w.y = pk2(st[g][2 * s][2], st[g][2 * s][3]); w.z = pk2(st[g][2 * s + 1][0], st[g][2 * s + 1][1]); w.w = pk2(st[g][2 * s + 1][2], st[g][2 * s + 1][3]);
                    pf[g][s] = __builtin_bit_cast(bf16x8, w); }
            }
#pragma unroll
            for (int dt = 0; dt < 8; ++dt)
#pragma unroll
                for (int s = 0; s < 2; ++s) {
                    const s16x4 lo = __builtin_amdgcn_ds_read_tr16_b64_v4i16((LAS s16x4*)(vb + (32 * s * VST + 16 * dt) * 2));
                    const s16x4 hi = __builtin_amdgcn_ds_read_tr16_b64_v4i16((LAS s16x4*)(vb + ((32 * s + 16) * VST + 16 * dt) * 2));
                    bf16x8 vf; vf[0] = lo[0]; vf[1] = lo[1]; vf[2] = lo[2]; vf[3] = lo[3]; vf[4] = hi[0]; vf[5] = hi[1]; vf[6] = hi[2]; vf[7] = hi[3];
                    oacc[0][dt] = __builtin_amdgcn_mfma_f32_16x16x32_bf16(vf, pf[0][s], oacc[0][dt], 0, 0, 0);
                    oacc[1][dt] = __builtin_amdgcn_mfma_f32_16x16x32_bf16(vf, pf[1][s], oacc[1][dt], 0, 0, 0); }
        }
        if (it + 1 < 4) LST(b ^ 1);
        __syncthreads();
    }
#undef GLD
#undef LST
#pragma unroll
    for (int g = 0; g < 2; ++g) {
        float l = lrun[g]; l += __shfl_xor(l, 16); l += __shfl_xor(l, 32);
        if (valid[g] && wave_valid) {
            int slot = 0; if (!own) { const unsigned mk = A.mask[head * S + myq[g]]; slot = 1 + __builtin_popcount(mk & ((1u << kvb) - 1u)); }
            const size_t pidx = ((size_t)(head * S + myq[g])) * 4 + slot;
            const float inv = 1.0f / l;
            bf16* orow = A.part + pidx * AD + 4 * g4;
#pragma unroll
            for (int dt = 0; dt < 8; ++dt) { u32x2 w; w.x = pk2(oacc[g][dt][0] * inv, oacc[g][dt][1] * inv); w.y = pk2(oacc[g][dt][2] * inv, oacc[g][dt][3] * inv); *(u32x2*)(orow + 16 * dt) = w; }
            if (g4 == 0) { A.ml[pidx * 2] = mrun[g]; A.ml[pidx * 2 + 1] = l; }
        }
    }
}
__device__ __forceinline__ void moba_items(LAS unsigned char* lds, const AttnBufs& A, int* qhead, LAS int* pre, LAS int* tick, int tid, int lane, int wave) {
    const int nitems = AH * NB + pre[256];
    if (tid == 0) tick[0] = atomicAdd(qhead, 1);
    __syncthreads();
    int item = tick[0];
    while (item < nitems) {
        __syncthreads();
        if (tid == 0) tick[0] = atomicAdd(qhead, 1);
        if (item < AH * NB) moba_item2(lds, A, item >> 5, item & 31, true, 0, 0, tid, lane, wave);
        else { const int s = item - AH * NB; int lo_ = 0, hi_ = 256;
            while (hi_ - lo_ > 1) { const int mid = (lo_ + hi_) >> 1; if (pre[mid] <= s) lo_ = mid; else hi_ = mid; }
            moba_item2(lds, A, lo_ >> 5, lo_ & 31, false, s - pre[lo_], A.cnt[lo_ * ACNT_STR], tid, lane, wave); }
        __syncthreads();
        item = tick[0];
    }
}

constexpr int RST = 72, SLOTB = 64 * RST * 2;
constexpr int NCH = S / 64;
__device__ __forceinline__ bf16x8 frag_rows(const LAS bf16* M, int r0, int k0, int c16, int g4) { return *(const LAS bf16x8*)(M + (r0 + c16) * RST + k0 + 8 * g4); }
__device__ __forceinline__ bf16x8 frag_cols(const LAS bf16* M, int c0, int k0, int c16, int g4) {
    const unsigned base = (unsigned)(size_t)M; const int tq = c16 >> 2, tp = c16 & 3;
    const s16x4 lo = tr_read4(base + ((k0 + 8 * g4 + tq) * RST + c0 + 4 * tp) * 2);
    const s16x4 hi = tr_read4(base + ((k0 + 8 * g4 + 4 + tq) * RST + c0 + 4 * tp) * 2);
    bf16x8 r; r[0] = lo[0]; r[1] = lo[1]; r[2] = lo[2]; r[3] = lo[3]; r[4] = hi[0]; r[5] = hi[1]; r[6] = hi[2]; r[7] = hi[3]; return r;
}
__device__ __forceinline__ void st_tile(LAS bf16* M, const f32x4 v, int r0, int c0, int c16, int g4) {
#pragma unroll
    for (int rg = 0; rg < 4; rg += 2) { const unsigned p = pk2(v[rg], v[rg + 1]); M[(r0 + 4 * g4 + rg) * RST + c0 + c16] = (bf16)(p & 0xffffu); M[(r0 + 4 * g4 + rg + 1) * RST + c0 + c16] = (bf16)(p >> 16); }
}
#define MFMA16(a, b, c) __builtin_amdgcn_mfma_f32_16x16x32_bf16(a, b, c, 0, 0, 0)

struct RwkvBufs { const bf16* rkv; const float* lw; const bf16* av; bf16* P; float* QmT; bf16* Rt; bf16* Yi; float* bonus; };

#define R1_BAR() do { asm volatile("s_waitcnt lgkmcnt(0)" ::: "memory"); __builtin_amdgcn_s_barrier(); asm volatile("" ::: "memory"); } while (0)
struct R1In { float lwv[8], av[8], rr[9], kr[9], vr[9]; };
__device__ __forceinline__ void rwkv_r1_load(R1In& I, const RwkvBufs& B, int head, int chunk, int lane, int wave) {
    const int ch = head * RN + lane; const int t0 = chunk * 64 + wave * 8;
#pragma unroll
    for (int i = 0; i < 8; ++i) { I.lwv[i] = B.lw[(size_t)(t0 + i) * RW + ch]; I.av[i] = bf2f(B.av[(size_t)(t0 + i) * RW + ch]); }
#pragma unroll
    for (int i = 0; i < 9; ++i) { const int t = t0 - 1 + i; if (t >= 0) { const bf16* cr = B.rkv + (size_t)t * (3 * RW) + ch; I.rr[i] = bf2f(cr[0]); I.kr[i] = bf2f(cr[RW]); I.vr[i] = bf2f(cr[2 * RW]); } else { I.rr[i] = 0.f; I.kr[i] = 0.f; I.vr[i] = 0.f; } }
}
__device__ __forceinline__ void rwkv_r1_unit(LAS unsigned char* lds, const RwkvBufs& B, const float* const* in, R1In& I, int head, int chunk, int nhead, int nchunk, int tid, int lane, int wave) {
    LAS bf16* sA = (LAS bf16*)(lds + 0 * SLOTB); LAS bf16* sB = (LAS bf16*)(lds + 1 * SLOTB); LAS bf16* sK = (LAS bf16*)(lds + 2 * SLOTB); LAS bf16* sR = (LAS bf16*)(lds + 3 * SLOTB); LAS bf16* sV = (LAS bf16*)(lds + 4 * SLOTB);
    LAS bf16* sM0 = (LAS bf16*)(lds + 5 * SLOTB); LAS bf16* sM1 = (LAS bf16*)(lds + 6 * SLOTB); LAS bf16* sT0 = (LAS bf16*)(lds + 7 * SLOTB); LAS bf16* sT1 = (LAS bf16*)(lds + 8 * SLOTB);
    LAS bf16* sLak = (LAS bf16*)(lds + 9 * SLOTB); LAS bf16* sMrb = (LAS bf16*)(lds + 10 * SLOTB); LAS bf16* sMrk = (LAS bf16*)(lds + 11 * SLOTB); LAS bf16* sX = (LAS bf16*)(lds + 12 * SLOTB);
    LAS bf16* sW = (LAS bf16*)(lds + 13 * SLOTB); LAS bf16* sU = (LAS bf16*)(lds + 14 * SLOTB);
    LAS float* cs = (LAS float*)(lds + 15 * SLOTB); LAS float* gC = cs + 512;
    const int c16 = lane & 15, g4 = lane >> 4;
    {
        const int ch = head * RN + lane; const int t0 = chunk * 64 + wave * 8;
        const float mur = in[9][ch], muk = in[10][ch], muv = in[11][ch], kkc = in[23][ch], kac = in[24][ch], rkc = in[25][ch];
        float run = 0.f;
#pragma unroll
        for (int i = 0; i < 8; ++i) run += I.lwv[i];
        cs[wave * 64 + lane] = run;
        R1_BAR();
        float off = 0.f;
        for (int w = 0; w < wave; ++w) off += cs[w * 64 + lane];
        float gcur = off;
#pragma unroll
        for (int i = 0; i < 8; ++i) {
            const int t = t0 + i;
            const float r0 = I.rr[i + 1], k0 = I.kr[i + 1], v0 = I.vr[i + 1], rp = I.rr[i], kp = I.kr[i], vp = I.vr[i];
            const float r = r0 + (rp - r0) * mur, kx = k0 + (kp - k0) * muk, vx = v0 + (vp - v0) * muv;
            const float a = I.av[i];
            float kk = kx * kkc; const float ss = wave_sum(kk * kk); kk = kk * __builtin_amdgcn_rcpf(fmaxf(sqrtf(ss), 1e-12f));
            const float kt = kx * (1.0f + (a - 1.0f) * kac);
            const float bn = wave_sum(r * kt * rkc);
            if (lane == 0) B.bonus[(size_t)t * RH + head] = bn;
            const float gprev = gcur; gcur += I.lwv[i];
            const float eg = __expf(gcur), egp = __expf(gprev), eng = __expf(-gcur);
            const int tl = wave * 8 + i;
            { const unsigned pab = pk2(-kk * egp, kk * a * eng), pkr = pk2(kt * eng, r * eg), pv_ = pk2(vx, vx);
              sA[tl * RST + lane] = (bf16)(pab & 0xffffu); sB[tl * RST + lane] = (bf16)(pab >> 16); sK[tl * RST + lane] = (bf16)(pkr & 0xffffu); sR[tl * RST + lane] = (bf16)(pkr >> 16); sV[tl * RST + lane] = (bf16)(pv_ & 0xffffu); }
        }
        if (wave == 7) gC[lane] = __expf(gcur);
    }
    if (nhead >= 0) rwkv_r1_load(I, B, nhead, nchunk, lane, wave);
    R1_BAR();
    const int mt = wave >> 1, ntb = 2 * (wave & 1);
    f32x4 Treg[2];
    for (int r14 = 0; r14 < 1 + REP_R1A; ++r14) {
        f32x4 ab[2], ak[2], rb[2], rk[2];
#pragma unroll
        for (int n = 0; n < 2; ++n) { ab[n] = (f32x4){0.f, 0.f, 0.f, 0.f}; ak[n] = ab[n]; rb[n] = ab[n]; rk[n] = ab[n]; }
#pragma unroll
        for (int s = 0; s < 2; ++s) { const bf16x8 aA = frag_rows(sA, 16 * mt, 32 * s, c16, g4), aR = frag_rows(sR, 16 * mt, 32 * s, c16, g4);
#pragma unroll
            for (int n = 0; n < 2; ++n) { const bf16x8 bB = frag_rows(sB, 16 * (ntb + n), 32 * s, c16, g4), bK = frag_rows(sK, 16 * (ntb + n), 32 * s, c16, g4);
                ab[n] = MFMA16(aA, bB, ab[n]); ak[n] = MFMA16(aA, bK, ak[n]); rb[n] = MFMA16(aR, bB, rb[n]); rk[n] = MFMA16(aR, bK, rk[n]); } }
#pragma unroll
        for (int n = 0; n < 2; ++n) { const int i = 16 * (ntb + n) + c16;
#pragma unroll
            for (int rg = 0; rg < 4; ++rg) { const int t = 16 * mt + 4 * g4 + rg; const bool lo = i < t, le = i <= t;
                ab[n][rg] = lo ? ab[n][rg] : 0.f; ak[n][rg] = lo ? ak[n][rg] : 0.f; rb[n][rg] = le ? rb[n][rg] : 0.f; rk[n][rg] = le ? rk[n][rg] : 0.f;
                Treg[n][rg] = ab[n][rg] + (i == t ? 1.0f : 0.f); }
            st_tile(sM0, ab[n], 16 * mt, 16 * (ntb + n), c16, g4); st_tile(sT0, Treg[n], 16 * mt, 16 * (ntb + n), c16, g4);
            st_tile(sLak, ak[n], 16 * mt, 16 * (ntb + n), c16, g4); st_tile(sMrb, rb[n], 16 * mt, 16 * (ntb + n), c16, g4); st_tile(sMrk, rk[n], 16 * mt, 16 * (ntb + n), c16, g4); }
    }
    R1_BAR();
    LAS bf16* Tc = sT0; LAS bf16* Tn = sT1; LAS bf16* Mc = sM0; LAS bf16* Mn = sM1;
    {
        f32x4 am[2] = {(f32x4){0.f, 0.f, 0.f, 0.f}, (f32x4){0.f, 0.f, 0.f, 0.f}}, ax[2] = {(f32x4){0.f, 0.f, 0.f, 0.f}, (f32x4){0.f, 0.f, 0.f, 0.f}};
#pragma unroll
        for (int s = 0; s < 2; ++s) { const bf16x8 aM = frag_rows(Mc, 16 * mt, 32 * s, c16, g4), aL = frag_rows(sLak, 16 * mt, 32 * s, c16, g4);
#pragma unroll
            for (int n = 0; n < 2; ++n) { am[n] = MFMA16(aM, frag_cols(Mc, 16 * (ntb + n), 32 * s, c16, g4), am[n]); ax[n] = MFMA16(aL, frag_cols(sV, 16 * (ntb + n), 32 * s, c16, g4), ax[n]); } }
#pragma unroll
        for (int n = 0; n < 2; ++n) { st_tile(Mn, am[n], 16 * mt, 16 * (ntb + n), c16, g4); st_tile(sX, ax[n], 16 * mt, 16 * (ntb + n), c16, g4); }
        R1_BAR();
        LAS bf16* t2 = Mc; Mc = Mn; Mn = t2;
    }
    for (int kround = 1; kround <= 5 + REP_R1NR; ++kround) {
        f32x4 am[2] = {(f32x4){0.f, 0.f, 0.f, 0.f}, (f32x4){0.f, 0.f, 0.f, 0.f}};
#pragma unroll
        for (int s = 0; s < 2; ++s) { const bf16x8 aT = frag_rows(Tc, 16 * mt, 32 * s, c16, g4), aM = frag_rows(Mc, 16 * mt, 32 * s, c16, g4);
#pragma unroll
            for (int n = 0; n < 2; ++n) { const bf16x8 bM = frag_cols(Mc, 16 * (ntb + n), 32 * s, c16, g4); Treg[n] = MFMA16(aT, bM, Treg[n]); am[n] = MFMA16(aM, bM, am[n]); } }
#pragma unroll
        for (int n = 0; n < 2; ++n) { st_tile(Tn, Treg[n], 16 * mt, 16 * (ntb + n), c16, g4); st_tile(Mn, am[n], 16 * mt, 16 * (ntb + n), c16, g4); }
        R1_BAR();
        LAS bf16* t1 = Tc; Tc = Tn; Tn = t1; LAS bf16* t2 = Mc; Mc = Mn; Mn = t2;
    }
    for (int rwu = 0; rwu < 1 + REP_R1B; ++rwu) {
        f32x4 aw[2] = {(f32x4){0.f, 0.f, 0.f, 0.f}, (f32x4){0.f, 0.f, 0.f, 0.f}}, au[2] = {(f32x4){0.f, 0.f, 0.f, 0.f}, (f32x4){0.f, 0.f, 0.f, 0.f}};
#pragma unroll
        for (int s = 0; s < 2; ++s) { const bf16x8 aT = frag_rows(Tc, 16 * mt, 32 * s, c16, g4);
#pragma unroll
            for (int n = 0; n < 2; ++n) { aw[n] = MFMA16(aT, frag_cols(sA, 16 * (ntb + n), 32 * s, c16, g4), aw[n]); au[n] = MFMA16(aT, frag_cols(sX, 16 * (ntb + n), 32 * s, c16, g4), au[n]); } }
#pragma unroll
        for (int n = 0; n < 2; ++n) { st_tile(sW, aw[n], 16 * mt, 16 * (ntb + n), c16, g4); st_tile(sU, au[n], 16 * mt, 16 * (ntb + n), c16, g4); }
    }
    R1_BAR();
    for (int rs8 = 0; rs8 < 1 + REP_R1C; ++rs8) {
        const size_t ub = (size_t)(head * NCH + chunk) * 4096;
        f32x4 pp[2], qq[2], rr[2], yy[2];
#pragma unroll
        for (int n = 0; n < 2; ++n) { pp[n] = (f32x4){0.f, 0.f, 0.f, 0.f}; qq[n] = pp[n]; rr[n] = pp[n]; yy[n] = pp[n]; }
#pragma unroll
        for (int s = 0; s < 2; ++s) {
            const bf16x8 cW = frag_cols(sW, 16 * mt, 32 * s, c16, g4), cB = frag_cols(sB, 16 * mt, 32 * s, c16, g4), cK = frag_cols(sK, 16 * mt, 32 * s, c16, g4), cU = frag_cols(sU, 16 * mt, 32 * s, c16, g4), cV = frag_cols(sV, 16 * mt, 32 * s, c16, g4);
#pragma unroll
            for (int n = 0; n < 2; ++n) { const int c0 = 16 * (ntb + n);
                const bf16x8 bB = frag_cols(sB, c0, 32 * s, c16, g4), bU = frag_cols(sU, c0, 32 * s, c16, g4), bV = frag_cols(sV, c0, 32 * s, c16, g4);
                const bf16x8 rMrb = frag_rows(sMrb, c0, 32 * s, c16, g4), rMrk = frag_rows(sMrk, c0, 32 * s, c16, g4);
                pp[n] = MFMA16(cW, bB, pp[n]);
                qq[n] = MFMA16(cB, bU, qq[n]); qq[n] = MFMA16(cK, bV, qq[n]);
                rr[n] = MFMA16(cW, rMrb, rr[n]);
                yy[n] = MFMA16(cU, rMrb, yy[n]); yy[n] = MFMA16(cV, rMrk, yy[n]); } }
#pragma unroll
        for (int n = 0; n < 2; ++n) { const int j = 16 * (ntb + n) + c16; const int i0 = 16 * mt + 4 * g4;
            {
                const float gc = gC[j]; float o[4];
#pragma unroll
                for (int rg = 0; rg < 4; ++rg) o[rg] = gc * (pp[n][rg] + ((i0 + rg) == j ? 1.0f : 0.f));
                u32x2 w; w.x = pk2(o[0], o[1]); w.y = pk2(o[2], o[3]); *(u32x2*)(B.P + ub + (size_t)j * 64 + i0) = w; }
            {
                f32x4 o;
#pragma unroll
                for (int rg = 0; rg < 4; ++rg) o[rg] = gC[i0 + rg] * qq[n][rg];
                *(f32x4*)(B.QmT + ub + (size_t)j * 64 + i0) = o; }
            {
                const u32x2 rb2 = *(const LAS u32x2*)(sR + j * RST + i0); float o[4];
                o[0] = rr[n][0] + __uint_as_float(rb2.x << 16); o[1] = rr[n][1] + __uint_as_float(rb2.x & 0xffff0000u); o[2] = rr[n][2] + __uint_as_float(rb2.y << 16); o[3] = rr[n][3] + __uint_as_float(rb2.y & 0xffff0000u);
                u32x2 w; w.x = pk2(o[0], o[1]); w.y = pk2(o[2], o[3]); *(u32x2*)(B.Rt + ub + (size_t)j * 64 + i0) = w; }
            { u32x2 w; w.x = pk2(yy[n][0], yy[n][1]); w.y = pk2(yy[n][2], yy[n][3]); *(u32x2*)(B.Yi + ub + (size_t)j * 64 + i0) = w; }
        }
    }
    R1_BAR();
}

constexpr int R2_PST = 136, R2_QST = 272, R2_QOFF = 64 * R2_PST, R2_SLOT = R2_QOFF + 16 * R2_QST;
__device__ __forceinline__ void rwkv_r2_wg(LAS unsigned char* lds, const bf16* __restrict__ P, const float* __restrict__ QmT, bf16* __restrict__ H0T, int head, int cg, int wave, int lane) {
    const int c16 = lane & 15, g4 = lane >> 4;
    const int lt = ((wave & 3) << 6) | lane;
#define R2_BAR() do { asm volatile("s_waitcnt lgkmcnt(0)" ::: "memory"); __builtin_amdgcn_s_barrier(); asm volatile("" ::: "memory"); } while (0)
    if (wave >= 4) {
        constexpr int NST = 8;
        u32x4 st[NST][3];
        auto gl = [&](int c, u32x4 (&r)[3]) { const size_t ub = (size_t)(head * NCH + c) * 4096;
            const u32x4* p = (const u32x4*)(P + ub); const u32x4* q = (const u32x4*)(QmT + ub + (size_t)(16 * cg) * 64);
            r[0] = p[lt]; r[1] = p[lt + 256]; r[2] = q[lt]; };
        auto lw = [&](int slot, const u32x4 (&r)[3]) { LAS unsigned char* s = lds + slot * R2_SLOT;
#pragma unroll
            for (int i = 0; i < 2; ++i) { const int idx = lt + 256 * i; LAS u32x2* d = (LAS u32x2*)(s + (idx >> 3) * R2_PST + (idx & 7) * 16); u32x2 a; a.x = r[i].x; a.y = r[i].y; u32x2 b; b.x = r[i].z; b.y = r[i].w; d[0] = a; d[1] = b; }
            *(LAS u32x4*)(s + R2_QOFF + (lt >> 4) * R2_QST + (lt & 15) * 16) = r[2]; };
#pragma unroll
        for (int j = 0; j < NST; ++j) gl(j, st[j]);
        lw(0, st[0]); gl(NST, st[0]);
        R2_BAR();
        for (int c4 = 0; c4 < NCH / NST; ++c4) {
#pragma unroll
            for (int j = 0; j < NST; ++j) { const int c = NST * c4 + j;
                if (c + 1 < NCH) lw((c + 1) & 1, st[(j + 1) % NST]);
                if (c + 1 + NST < NCH) gl(c + 1 + NST, st[(j + 1) % NST]);
                R2_BAR(); }
        }
    } else if (wave == 0) {
        f32x4 hacc[4];
#pragma unroll
        for (int m = 0; m < 4; ++m) hacc[m] = (f32x4){0.f, 0.f, 0.f, 0.f};
        R2_BAR();
        for (int c = 0; c < NCH; ++c) {
            const LAS unsigned char* s = lds + (c & 1) * R2_SLOT; const size_t ub = (size_t)(head * NCH + c) * 4096;
            bf16x8 af[4][2]; f32x4 qv[4];
#pragma unroll
            for (int m = 0; m < 4; ++m) { qv[m] = *(const LAS f32x4*)(s + R2_QOFF + c16 * R2_QST + (16 * m + 4 * g4) * 4);
#pragma unroll
                for (int sx = 0; sx < 2; ++sx) { const LAS unsigned char* pr = s + (16 * m + c16) * R2_PST + (32 * sx + 4 * g4) * 2; const u32x2 a = *(const LAS u32x2*)pr, b = *(const LAS u32x2*)(pr + 32);
                    u32x4 w; w.x = a.x; w.y = a.y; w.z = b.x; w.w = b.y; af[m][sx] = __builtin_bit_cast(bf16x8, w); } }
            bf16x8 bfr[2];
#pragma unroll
            for (int sx = 0; sx < 2; ++sx) { u32x4 w; w.x = pk2(hacc[2 * sx][0], hacc[2 * sx][1]); w.y = pk2(hacc[2 * sx][2], hacc[2 * sx][3]); w.z = pk2(hacc[2 * sx + 1][0], hacc[2 * sx + 1][1]); w.w = pk2(hacc[2 * sx + 1][2], hacc[2 * sx + 1][3]);
                bfr[sx] = __builtin_bit_cast(bf16x8, w);
                u32x2 h0; h0.x = w.x; h0.y = w.y; *(u32x2*)(H0T + ub + (size_t)(16 * cg + c16) * 64 + 16 * (2 * sx) + 4 * g4) = h0;
                u32x2 h1; h1.x = w.z; h1.y = w.w; *(u32x2*)(H0T + ub + (size_t)(16 * cg + c16) * 64 + 16 * (2 * sx + 1) + 4 * g4) = h1; }
#pragma unroll
            for (int m = 0; m < 4; ++m) { hacc[m] = MFMA16(af[m][0], bfr[0], qv[m]); hacc[m] = MFMA16(af[m][1], bfr[1], hacc[m]); }
            R2_BAR();
        }
    } else {
        for (int c = 0; c <= NCH; ++c) R2_BAR();
    }
#undef R2_BAR
}

__device__ __forceinline__ f32x4 ld_bf4(const bf16* p) { const u32x2 w = *(const u32x2*)p; return (f32x4){__uint_as_float(w.x << 16), __uint_as_float(w.x & 0xffff0000u), __uint_as_float(w.y << 16), __uint_as_float(w.y & 0xffff0000u)}; }
__device__ __forceinline__ void rwkv_r3_wave(const RwkvBufs& B, const bf16* __restrict__ H0T, const float* const* in, const bf16* __restrict__ gv, bf16* __restrict__ ocat, int head, int chunk, int nt, int lane) {
    const int c16 = lane & 15, g4 = lane >> 4; const size_t ub = (size_t)(head * NCH + chunk) * 4096;
    const int t = chunk * 64 + 16 * nt + c16;
    bf16x8 rf[2], hf[4][2]; f32x4 y[4], gw[4], gb[4], muv[4], gg[4], v0[4], vp[4];
#pragma unroll
    for (int s = 0; s < 2; ++s) rf[s] = *(const bf16x8*)(B.Rt + ub + (size_t)(16 * nt + c16) * 64 + 32 * s + 8 * g4);
#pragma unroll
    for (int m = 0; m < 4; ++m) { y[m] = ld_bf4(B.Yi + ub + (size_t)(16 * nt + c16) * 64 + 16 * m + 4 * g4);
#pragma unroll
        for (int s = 0; s < 2; ++s) hf[m][s] = *(const bf16x8*)(H0T + ub + (size_t)(16 * m + c16) * 64 + 32 * s + 8 * g4); }
    const float bn = B.bonus[(size_t)t * RH + head];
#pragma unroll
    for (int m = 0; m < 4; ++m) { const int ch = head * RN + 16 * m + 4 * g4;
        gw[m] = *(const f32x4*)(in[26] + ch); gb[m] = *(const f32x4*)(in[27] + ch); muv[m] = *(const f32x4*)(in[11] + ch); gg[m] = ld_bf4(gv + (size_t)t * RW + ch);
        v0[m] = ld_bf4(B.rkv + (size_t)t * (3 * RW) + 2 * RW + ch); vp[m] = (f32x4){0.f, 0.f, 0.f, 0.f}; if (t > 0) vp[m] = ld_bf4(B.rkv + (size_t)(t - 1) * (3 * RW) + 2 * RW + ch); }
    float s1 = 0.f;
#pragma unroll
    for (int m = 0; m < 4; ++m) {
#pragma unroll
        for (int s = 0; s < 2; ++s) y[m] = MFMA16(hf[m][s], rf[s], y[m]);
        s1 += (y[m][0] + y[m][1]) + (y[m][2] + y[m][3]); }
    s1 += __shfl_xor(s1, 16); s1 += __shfl_xor(s1, 32);
    const float mean = s1 * (1.0f / 64.0f); float s2 = 0.f;
#pragma unroll
    for (int m = 0; m < 4; ++m) { y[m] = y[m] - mean; s2 += (y[m][0] * y[m][0] + y[m][1] * y[m][1]) + (y[m][2] * y[m][2] + y[m][3] * y[m][3]); }
    s2 += __shfl_xor(s2, 16); s2 += __shfl_xor(s2, 32);
    const float rstd = rsqrtf(s2 * (1.0f / 64.0f) + 64e-5f);
#pragma unroll
    for (int m = 0; m < 4; ++m) { const int ch = head * RN + 16 * m + 4 * g4;
        const f32x4 vx = v0[m] + (vp[m] - v0[m]) * muv[m];
        const f32x4 o = (y[m] * rstd * gw[m] + gb[m] + vx * bn) * gg[m];
        u32x2 w; w.x = pk2(o[0], o[1]); w.y = pk2(o[2], o[3]); *(u32x2*)(ocat + (size_t)t * (2 * RW) + RW + ch) = w; }
}
template <int WHICH> struct Lora2Order { static constexpr bool GATHER = false; const int* tok; int G, c;
    __device__ bool next(int i, pg8::Unit& u) const { const int L = i * G + c; if (L >= (S / 128) * 4) return false; u.pm = L >> 2; u.pn = WHICH * 4 + (L & 3); u.koff = WHICH * 512; u.koffB = 0; return true; }
    __device__ __forceinline__ void a_ready(const pg8::Unit&) const {}
    __device__ __forceinline__ void done(const pg8::Unit&) const {} };
template <int WHICH> struct EpiLora2 {
    static constexpr bool PERM = true, AFTER_DRAIN = false, MIDK = false;
    void* dst; const float* bias;
    __device__ __forceinline__ void operator()(const pg8::f32x4 (&acc)[2][2][4][2], const pg8::Unit& u, int wr, int wc, int fr, int fq) const {
        const int row0 = u.pm * 128 + wr * 64 + fr; const int col0 = (u.pn & 3) * 256 + wc * 32 + 8 * fq;
#pragma unroll
        for (int ai = 0; ai < 1; ++ai)
#pragma unroll
            for (int m = 0; m < 4; ++m) { const size_t off = (size_t)(row0 + ai * 128 + m * 16) * RW + col0;
#pragma unroll
                for (int bj = 0; bj < 2; ++bj) { f32x4 v0 = acc[ai][bj][m][0], v1 = acc[ai][bj][m][1];
                    if (WHICH < 2) { const f32x4 b0 = *(const f32x4*)(bias + col0 + bj * 128), b1 = *(const f32x4*)(bias + col0 + bj * 128 + 4);
#pragma unroll
                        for (int j = 0; j < 4; ++j) { v0[j] = sigmoidf_(v0[j] + b0[j]); v1[j] = sigmoidf_(v1[j] + b1[j]); }
                        if (WHICH == 0) { v0 = v0 * -0.60653065971263342f; v1 = v1 * -0.60653065971263342f; } }
                    if (WHICH == 0) { float* p = (float*)dst + off + bj * 128; *(f32x4*)p = v0; *(f32x4*)(p + 4) = v1; }
                    else { u32x4 w; w.x = pk2(v0[0], v0[1]); w.y = pk2(v0[2], v0[3]); w.z = pk2(v1[0], v1[1]); w.w = pk2(v1[2], v1[3]); *(u32x4*)((bf16*)dst + off + bj * 128) = w; } } }
    }
};

__global__ void __launch_bounds__(NTHR, 2) fwd(Args args) {
    extern __shared__ __attribute__((aligned(16))) unsigned char lds_raw[];
    LAS unsigned char* lds = (LAS unsigned char*)lds_raw;
    const int wave = __builtin_amdgcn_readfirstlane(threadIdx.x >> 6);
    const int G = gridDim.x, wg = blockIdx.x;
    unsigned char* ws = args.ws;
    unsigned* ctl = (unsigned*)(ws + WS_CTL);
    if (threadIdx.x < 4) ((LAS unsigned*)(lds + LDSCTL_OFF))[threadIdx.x] = 0u;
    __syncthreads();
    XcdBarrier bar = xcd_barrier_post(ctl + CW_BAR, (volatile LAS unsigned*)(lds + LDSCTL_OFF));
    const int lo = args.ph_lo, hi = args.ph_hi;
#define IN(k) (lo <= (k) && (k) < hi)
#define PH(k) for (int rep_ = 0; rep_ < ((k) == REP_PHASE ? 1 + REP_N : 1); ++rep_) if (IN(k))
#define SEAM(k) do { if (IN(k) && IN((k) + 1)) xcd_barrier(bar); } while (0)
#define ROUTE_TABLE() do { LAS int* tb_ = (LAS int*)(lds + RT_OFF); \
        if (tid < 64) { const int c_ = ((const int*)ctl)[CW_CNT + tid * CNT_STR]; const int nt_ = (c_ + 127) >> 7; int o_ = nt_; \
            _Pragma("unroll") for (int d_ = 1; d_ < 64; d_ <<= 1) { const int t_ = __shfl_up(o_, d_); if (tid >= d_) o_ += t_; } \
            const int first_ = o_ - nt_; tb_[tid] = c_; tb_[64 + tid] = first_ * 128; \
            for (int t_ = 0; t_ < nt_; ++t_) { tb_[128 + first_ + t_] = tid; tb_[320 + first_ + t_] = t_ * 128; } \
            if (tid == 63) tb_[512] = o_; } \
        __syncthreads(); } while (0)
    const int gw = wg * NWAVES + wave, NGW = G * NWAVES;

    const float* x = args.in[0];
    float* ada = (float*)(ws + WS_ADA); float* rope = (float*)(ws + WS_ROPE);
    bf16* h = (bf16*)(ws + WS_H); bf16* W1t = (bf16*)(ws + WS_W1T); bf16* Wupt = (bf16*)(ws + WS_WUPT); bf16* Wot = (bf16*)(ws + WS_WOT);
    unsigned char* Wgut = ws + WS_WGUT; unsigned char* Wdt = ws + WS_WDT;

    PH(0) { const int lane = lane_fresh(); const int tid = (wave << 6) | lane; (void)tid; (void)lane;
        {
            const float* c = args.in[1]; const float* w_ada = args.in[2]; const float* b_ada = args.in[3];
            LAS float* red = (LAS float*)lds;
            for (int u = wg; u < 6 * D / 64; u += G) {
                const int n = u * 64 + lane; float s = 0.f;
#pragma unroll 8
                for (int kq = wave; kq < D; kq += NWAVES) s += c[kq] * w_ada[(size_t)kq * (6 * D) + n];
                red[wave * 64 + lane] = s;
                __syncthreads();
                if (wave == 0) { float t = b_ada[n]; for (int w = 0; w < NWAVES; ++w) t += red[w * 64 + lane];
                    __hip_atomic_store(ada + n, t, __ATOMIC_RELAXED, __HIP_MEMORY_SCOPE_AGENT);
                    asm volatile("s_waitcnt vmcnt(0)" ::: "memory");
                    if (lane == 0) (void)xb_add(ctl + CW_ADA, 1u); }
                __syncthreads();
            }
        }
        for (int i = wg * NTHR + tid; i < S * 16; i += G * NTHR) {
            const int pos = i >> 4, j = i & 15; const float inv = powf(500000.0f, -(float)j / 16.0f); const float ang = (float)pos * inv;
            rope[2 * i] = cosf(ang); rope[2 * i + 1] = sinf(ang);
        }
        for (int i = wg * NTHR + tid; i < 128 * D / 8; i += G * NTHR) ((u32x4*)(W1t + (size_t)(N1 - 128) * D))[i] = (u32x4){0u, 0u, 0u, 0u};
        {
            bf16* wrh = (bf16*)(ws + WS_WR); bf16* wrl = wrh + 80 * D; const float* w_rg = args.in[31]; const float* w_re = args.in[33];
            for (int i = wg * NTHR + tid; i < 80 * D; i += G * NTHR) { const int n = i / D, kq = i % D; const float v = n < NG ? w_rg[kq * NG + n] : (n < NG + NE ? w_re[kq * NE + n - NG] : 0.f);
                const bf16 hi = f2bf(v); wrh[i] = hi; wrl[i] = f2bf(v - bf2f(hi)); }
        }
        {
            bf16* wl2 = (bf16*)(ws + WS_WL2); const float* w_w2 = args.in[17]; const float* w_a2 = args.in[20]; const float* w_g2 = args.in[22];
            for (int i = wg * NTHR + tid; i < 3 * RW * 256; i += G * NTHR) { const int n = i >> 8, kq = i & 255, which = n / RW, cc = n % RW; float v = 0.f;
                if (which == 0) { if (kq < LW) v = w_w2[kq * RW + cc]; } else if (which == 1) { if (kq < LA) v = w_a2[kq * RW + cc]; } else v = w_g2[kq * RW + cc];
                wl2[i] = f2bf(v); }
        }
        LAS float* scr = (LAS float*)(lds + wave * 16384);
        constexpr int I_W = (D / 64) * (LW / 32), I_A = (D / 64) * (LA / 32), I_G = (D / 64) * (LG / 32);
        constexpr int NIT = 2 * (I_W + I_A + I_G);
        for (int it = gw; it < NIT; it += NGW) {
            int r = it, k0, n0;
            if (r < 2 * I_W) { const int md = 1 + r / I_W; item_kn(r % I_W, LW, k0, n0); tr_item(args.in[16], LW, k0, n0, W1t + (size_t)(INW + (md - 1) * LO + n0) * D + k0, D, args.in[12], md, scr, lane); continue; } r -= 2 * I_W;
            if (r < 2 * I_A) { const int md = 1 + r / I_A; item_kn(r % I_A, LA, k0, n0); tr_item(args.in[19], LA, k0, n0, W1t + (size_t)(INW + (md - 1) * LO + LW + n0) * D + k0, D, args.in[13], md, scr, lane); continue; } r -= 2 * I_A;
            const int md = 1 + r / I_G; item_kn(r % I_G, LG, k0, n0); tr_item(args.in[21], LG, k0, n0, W1t + (size_t)(INW + (md - 1) * LO + LW + LA + n0) * D + k0, D, args.in[14], md, scr, lane);
        }
        __syncthreads();
        {
            const int lr = tid >> 5, c4 = tid & 31, nl = lane & 15, kq = lane >> 4, ncol = 16 * wave + nl;
            f32x4 v[8]; int T = wg;
            if (T < CT_ALL) { const ConvTile t = conv_decode(T, args.in, ws);
#pragma unroll
                for (int i = 0; i < 8; ++i) v[i] = *(const f32x4*)(t.src + (size_t)(lr + 16 * i) * t.ldw + 4 * c4); }
            for (int itc = 0; T < CT_ALL; T += G, ++itc) {
                LAS float* buf = (LAS float*)(lds + (itc & 1) * 69632);
#pragma unroll
                for (int i = 0; i < 8; ++i) *(LAS f32x4*)(buf + conv_off(lr + 16 * i, 4 * c4)) = v[i];
                const ConvTile t = conv_decode(T, args.in, ws);
                if (T + G < CT_ALL) { const ConvTile tn = conv_decode(T + G, args.in, ws);
#pragma unroll
                    for (int i = 0; i < 8; ++i) v[i] = *(const f32x4*)(tn.src + (size_t)(lr + 16 * i) * tn.ldw + 4 * c4); }
                R1_BAR();
                float xv[32];
#pragma unroll
                for (int j = 0; j < 32; ++j) xv[j] = buf[conv_off(32 * kq + j, ncol)];
                if (t.kind) { unsigned char* d = t.dst + (size_t)ncol * t.rs + 32 * kq;
                    u32x4 o0, o1; o0.x = pk_fp8x4(xv[0], xv[1], xv[2], xv[3], t.sc); o0.y = pk_fp8x4(xv[4], xv[5], xv[6], xv[7], t.sc); o0.z = pk_fp8x4(xv[8], xv[9], xv[10], xv[11], t.sc); o0.w = pk_fp8x4(xv[12], xv[13], xv[14], xv[15], t.sc);
                    o1.x = pk_fp8x4(xv[16], xv[17], xv[18], xv[19], t.sc); o1.y = pk_fp8x4(xv[20], xv[21], xv[22], xv[23], t.sc); o1.z = pk_fp8x4(xv[24], xv[25], xv[26], xv[27], t.sc); o1.w = pk_fp8x4(xv[28], xv[29], xv[30], xv[31], t.sc);
                    *(u32x4*)d = o0; *(u32x4*)(d + 16) = o1; }
                else { unsigned char* d = t.dst + (size_t)ncol * t.rs + 64 * kq;
#pragma unroll
                    for (int q = 0; q < 4; ++q) { u32x4 o; o.x = pk2(xv[8 * q], xv[8 * q + 1]); o.y = pk2(xv[8 * q + 2], xv[8 * q + 3]); o.z = pk2(xv[8 * q + 4], xv[8 * q + 5]); o.w = pk2(xv[8 * q + 6], xv[8 * q + 7]); *(u32x4*)(d + 16 * q) = o; } }
            }
            __syncthreads();
        }
        {
            if (tid == 0) { XB_SPIN(xb_ld(ctl + CW_ADA) < (unsigned)(6 * D / 64), bar.bar); __builtin_amdgcn_fence(__ATOMIC_ACQUIRE, "agent"); asm volatile("s_waitcnt vmcnt(0)" ::: "memory"); }
            __syncthreads();
        const float* g = args.in[4]; const float* sh1 = ada; const float* sc1 = ada + D;
        f32x4 gs[8], sh[8];
#pragma unroll
        for (int j = 0; j < 8; ++j) { const int c = 4 * lane + 256 * j; const f32x4 gg = *(const f32x4*)(g + c), ss = *(const f32x4*)(sc1 + c); gs[j] = gg * (ss + 1.0f); sh[j] = *(const f32x4*)(sh1 + c); }
        for (int rb = gw; rb < S; rb += 2 * NGW) {
            f32x4 v[2][8]; float s[2] = {0.f, 0.f};
#pragma unroll
            for (int q = 0; q < 2; ++q) { const f32x4* xr = (const f32x4*)(x + (size_t)(rb + q * NGW) * D) + lane;
#pragma unroll
                for (int j = 0; j < 8; ++j) v[q][j] = xr[64 * j]; }
#pragma unroll
            for (int q = 0; q < 2; ++q)
#pragma unroll
                for (int j = 0; j < 8; ++j) s[q] += (v[q][j].x * v[q][j].x + v[q][j].y * v[q][j].y) + (v[q][j].z * v[q][j].z + v[q][j].w * v[q][j].w);
            float r[2]; r[0] = rsqrtf(wave_sum(s[0]) * (1.0f / D) + 1e-6f); r[1] = rsqrtf(wave_sum(s[1]) * (1.0f / D) + 1e-6f);
#pragma unroll
            for (int q = 0; q < 2; ++q) { u32x2* o = (u32x2*)(h + (size_t)(rb + q * NGW) * D) + lane;
#pragma unroll
                for (int j = 0; j < 8; ++j) { const f32x4 t = v[q][j] * r[q] * gs[j] + sh[j]; u32x2 w; w.x = pk2(t.x, t.y); w.y = pk2(t.z, t.w); o[64 * j] = w; } }
        }

        }
    }
    SEAM(0);
    PH(2) { const int lane = lane_fresh(); const int tid = (wave << 6) | lane; (void)tid; (void)lane;
        EpiProj E{(bf16*)(ws + WS_Q), (bf16*)(ws + WS_K), (bf16*)(ws + WS_V), (bf16*)(ws + WS_RKV), (bf16*)(ws + WS_GATE), (float*)(ws + WS_LORA), (float*)(ws + WS_LORAB), rope};
        { pg8::Gemm g{h, W1t, S, INW, D, D, D}; pg8::StaticOrder So; So.init(S, INW, G, wg);
          pg8::gemm_phase<EpiProj, pg8::StaticOrder, true, true>(lds, g, So, E); }
        { int ld_ = D; asm volatile("" : "+s"(ld_)); pg8::Gemm g{h, W1t, S, N1, AW, ld_, ld_}; LoraOrder So{nullptr, G, wg};
          pg8::gemm_phase<EpiProj, LoraOrder, true, true>(lds, g, So, E); }
    }
    SEAM(2);

    bf16* qb = (bf16*)(ws + WS_Q); bf16* kb = (bf16*)(ws + WS_K); bf16* vb = (bf16*)(ws + WS_V);
    bf16* kmh = (bf16*)(ws + WS_KMEAN); bf16* kml = kmh + AH * NB * AD;
    AttnBufs AB{qb, kb, vb, kmh, kml, (unsigned*)(ws + WS_AMASK), (int*)(ws + WS_ALIST), (int*)ctl + CW_ACNT, (bf16*)(ws + WS_APART), (float*)(ws + WS_AML)};
    PH(3) { const int lane = lane_fresh(); const int tid = (wave << 6) | lane; (void)tid; (void)lane;
        for (int hb = wg; hb < AH * NB; hb += G) { const int hd = hb / NB, bk = hb % NB; LAS float* red = (LAS float*)lds;
            float s0 = 0.f, s1 = 0.f; const unsigned* src = (const unsigned*)(kb + (size_t)(bk * MB + wave * 32) * AW + hd * AD) + lane;
#pragma unroll 8
            for (int r = 0; r < 32; ++r) { const unsigned w2 = src[(size_t)r * (AW / 2)]; s0 += __uint_as_float(w2 << 16); s1 += __uint_as_float(w2 & 0xffff0000u); }
            red[wave * 128 + 2 * lane] = s0; red[wave * 128 + 2 * lane + 1] = s1;
            __syncthreads();
            if (tid < AD) { float s = 0.f;
#pragma unroll
                for (int w = 0; w < 8; ++w) s += red[w * 128 + tid];
                s *= (1.0f / MB); const bf16 hi = f2bf(s); kmh[hb * AD + tid] = hi; kml[hb * AD + tid] = f2bf(s - bf2f(hi)); }
            __syncthreads();
        }
        {
            const float* lora = (const float*)(ws + WS_LORA); bf16* al2 = (bf16*)(ws + WS_AL2);
#pragma unroll 4
            for (int i = wg * NTHR + tid; i < S * 768; i += G * NTHR) { const int t = i / 768, j = i % 768, which = j >> 8, jj = j & 255; float v = 0.f;
                const int src = which == 0 ? jj : (which == 1 ? LW + jj : LW + LA + jj); const bool real = which == 2 || jj < LW;
                if (real) { const float* lb = (const float*)(ws + WS_LORAB); v = lora[(size_t)t * 1024 + src] + lb[(size_t)t * 1024 + src] + (t > 0 ? lora[(size_t)(t - 1) * 1024 + LO + src] + lb[(size_t)(t - 1) * 1024 + LO + src] : 0.f); if (which == 0) v = 1.0f - 2.0f / (1.0f + __expf(2.0f * v)); else if (which == 2) v = sigmoidf_(v); }
                al2[i] = f2bf(v); }
        }
    }
    SEAM(3);
    PH(4) { const int lane = lane_fresh(); const int tid = (wave << 6) | lane; (void)tid; (void)lane;
#define L2CALL(W, DST, BIAS, CID) { int lda_ = 768; asm volatile("" : "+s"(lda_)); pg8::Gemm g{(const bf16*)(ws + WS_AL2), (const bf16*)(ws + WS_WL2), S, 3 * RW, 256, lda_, 256}; \
            Lora2Order<W> So{nullptr, G, CID}; EpiLora2<W> E{DST, BIAS}; pg8::gemm_phase<EpiLora2<W>, Lora2Order<W>, true, true, 0, true>(lds, g, So, E); }
        L2CALL(0, (void*)(ws + WS_LW), args.in[15], wg)
        L2CALL(1, (void*)(ws + WS_A), args.in[18], wg)
        L2CALL(2, (void*)(ws + WS_G), nullptr, wg)
#undef L2CALL
        for (int u = wg; u < AH * 64; u += G) moba_select_unit(lds, AB, u >> 6, u & 63, tid, lane, wave);
    }
    SEAM(4);
    RwkvBufs RB{(const bf16*)(ws + WS_RKV), (const float*)(ws + WS_LW), (const bf16*)(ws + WS_A), (bf16*)(ws + WS_RWP), (float*)(ws + WS_RWQ), (bf16*)(ws + WS_RWR), (bf16*)(ws + WS_RWY), (float*)(ws + WS_RWB)};
    bf16* H0T = (bf16*)(ws + WS_RWH);
    PH(5) { const int lane = lane_fresh(); const int tid = (wave << 6) | lane; (void)tid; (void)lane; R1In I; if (wg < RH * NCH) rwkv_r1_load(I, RB, wg / NCH, wg % NCH, lane, wave);
        for (int u = wg; u < RH * NCH; u += G) { const int un = u + G; rwkv_r1_unit(lds, RB, args.in, I, u / NCH, u % NCH, un < RH * NCH ? un / NCH : -1, un % NCH, tid, lane, wave); } }
    SEAM(5);
    PH(7) { const int lane = lane_fresh(); const int tid = (wave << 6) | lane; (void)tid; (void)lane;
        if (wg < RH * 4) { for (int rsc = 0; rsc < 1 + REP_SCAN; ++rsc) { rwkv_r2_wg(lds, RB.P, RB.QmT, H0T, wg >> 2, wg & 3, wave, lane); __syncthreads(); } }
        LAS int* pre = (LAS int*)(lds + AT_ITEMS); LAS int* tick = pre + 260;
        if (tid < 256) pre[1 + tid] = (AB.cnt[tid * ACNT_STR] + 255) >> 8;
        __syncthreads();
        if (wave == 0) {
            int v0 = pre[1 + 4 * lane], v1 = pre[2 + 4 * lane], v2 = pre[3 + 4 * lane], v3 = pre[4 + 4 * lane]; v1 += v0; v2 += v1; v3 += v2; int tot = v3;
#pragma unroll
            for (int o = 1; o < 64; o <<= 1) { const int t = __shfl_up(tot, o); if (lane >= o) tot += t; }
            const int ex = tot - v3; pre[1 + 4 * lane] = ex + v0; pre[2 + 4 * lane] = ex + v1; pre[3 + 4 * lane] = ex + v2; pre[4 + 4 * lane] = ex + v3;
            if (lane == 0) pre[0] = 0; }
        __syncthreads();
        moba_items(lds, AB, (int*)ctl + CW_AQ + rep_, pre, tick, tid, lane, wave);
    }
    SEAM(7);
    PH(8) { const int lane = lane_fresh(); const int tid = (wave << 6) | lane; (void)tid; (void)lane; for (int u = wg * 2 + (wave >> 2); u < RH * NCH; u += 2 * G) rwkv_r3_wave(RB, H0T, args.in, (const bf16*)(ws + WS_G), (bf16*)(ws + WS_OCAT), u / NCH, u % NCH, wave & 3, lane);
#pragma unroll 2
        for (int i = wg * NTHR + tid; i < AH * S * 16; i += G * NTHR) { const int c8 = i & 15, hq = i >> 4, hh = hq / S, qq = hq % S;
            const unsigned mk = AB.mask[hq]; const f32x4 ml0 = *(const f32x4*)(AB.ml + (size_t)hq * 8), ml1 = *(const f32x4*)(AB.ml + (size_t)hq * 8 + 4);
            u32x4 pr[4];
#pragma unroll
            for (int s = 0; s < 4; ++s) pr[s] = *(const u32x4*)(AB.part + ((size_t)hq * 4 + s) * AD + 8 * c8);
            const int ns = 1 + __builtin_popcount(mk);
            const float m_[4] = {ml0[0], ml0[2], ml1[0], ml1[2]}, l_[4] = {ml0[1], ml0[3], ml1[1], ml1[3]};
            float mx = m_[0];
#pragma unroll
            for (int s = 1; s < 4; ++s) mx = (s < ns) ? fmaxf(mx, m_[s]) : mx;
            float wv[4]; float wsum = 0.f;
#pragma unroll
            for (int s = 0; s < 4; ++s) { wv[s] = s < ns ? l_[s] * __builtin_amdgcn_exp2f(m_[s] - mx) : 0.f; wsum += wv[s]; }
            const float inv = 1.0f / wsum; float o[8] = {0.f, 0.f, 0.f, 0.f, 0.f, 0.f, 0.f, 0.f};
#pragma unroll
            for (int s = 0; s < 4; ++s) { float pv[8]; unpack8(pr[s], pv); const float ws_ = wv[s] * inv;
#pragma unroll
                for (int j = 0; j < 8; ++j) o[j] += (s < ns) ? ws_ * pv[j] : 0.f; }
            u32x4 w; w.x = pk2(o[0], o[1]); w.y = pk2(o[2], o[3]); w.z = pk2(o[4], o[5]); w.w = pk2(o[6], o[7]);
            *(u32x4*)((bf16*)(ws + WS_OCAT) + (size_t)qq * (2 * AW) + hh * AD + 8 * c8) = w; }
    }
    SEAM(8);

    bf16* ocat = (bf16*)(ws + WS_OCAT); bf16* gate = (bf16*)(ws + WS_GATE); bf16* mix = (bf16*)(ws + WS_MIX); bf16* y = (bf16*)(ws + WS_Y); bf16* x1 = (bf16*)(ws + WS_X1);     unsigned char* h2 = ws + WS_H2;
    float* ew = (float*)(ws + WS_ROUTE + 65536); int* slot = (int*)(ws + WS_ROUTE + 131072);
    int* elist = (int*)(ws + WS_ELIST);
    unsigned char* xbuf = ws + WS_XBUF; unsigned char* hid = ws + WS_HID; bf16* ybuf = (bf16*)(ws + WS_YBUF);
    PH(9) { const int lane = lane_fresh(); const int tid = (wave << 6) | lane; (void)tid; (void)lane;
        pg8::Gemm g{ocat, Wupt, S, D, AW, D, D}; MixOrder So{nullptr, G, wg};
        EpiMix E{gate, mix};
        pg8::gemm_phase<EpiMix, MixOrder, true, true>(lds, g, So, E);
    }
    SEAM(9);
    PH(10) { const int lane = lane_fresh(); const int tid = (wave << 6) | lane; (void)tid; (void)lane;
        pg8::Gemm g{mix, Wot, S, D, D, D, D}; pg8::StaticOrder So; So.init(S, D, G, wg);
        EpiBf16P E{y, D};
        pg8::gemm_phase<EpiBf16P, pg8::StaticOrder, true, true>(lds, g, So, E);
    }
    SEAM(10);
    PH(11) { const int lane = lane_fresh(); const int tid = (wave << 6) | lane; (void)tid; (void)lane;
        const float* gpost = args.in[5]; const float* gpre2 = args.in[6]; const float* gt1 = ada + 2 * D; const float* sh2 = ada + 3 * D; const float* sc2 = ada + 4 * D;
        const bf16* wrh = (const bf16*)(ws + WS_WR); const bf16* wrl = wrh + 80 * D; const float* b_rg = args.in[32]; const float* b_re = args.in[34];
        LAS bf16* Ah = (LAS bf16*)lds; LAS bf16* Al = Ah + 16 * RS8; LAS float* Pp = (LAS float*)lds;
        LAS float* Lg = (LAS float*)(lds + 8 * 16 * 80 * 4);
        for (int unit = wg; unit < S / 16; unit += G) {
            {
                const int rl0 = wave * 2, row0 = unit * 16 + rl0;
                f32x4 v[2][8], xv[2][8]; float s[2] = {0.f, 0.f};
#pragma unroll
                for (int rr = 0; rr < 2; ++rr) { const u32x2* yr = (const u32x2*)(y + (size_t)(row0 + rr) * D) + lane; const f32x4* xr = (const f32x4*)(x + (size_t)(row0 + rr) * D) + lane;
#pragma unroll
                    for (int j = 0; j < 8; ++j) { const u32x2 yb = yr[64 * j]; v[rr][j] = (f32x4){__uint_as_float(yb.x << 16), __uint_as_float(yb.x & 0xffff0000u), __uint_as_float(yb.y << 16), __uint_as_float(yb.y & 0xffff0000u)}; xv[rr][j] = xr[64 * j]; } }
#pragma unroll
                for (int rr = 0; rr < 2; ++rr)
#pragma unroll
                    for (int j = 0; j < 8; ++j) s[rr] += (v[rr][j].x * v[rr][j].x + v[rr][j].y * v[rr][j].y) + (v[rr][j].z * v[rr][j].z + v[rr][j].w * v[rr][j].w);
                float r1[2]; r1[0] = rsqrtf(wave_sum(s[0]) * (1.0f / D) + 1e-6f); r1[1] = rsqrtf(wave_sum(s[1]) * (1.0f / D) + 1e-6f); s[0] = 0.f; s[1] = 0.f;
#pragma unroll
                for (int rr = 0; rr < 2; ++rr)
#pragma unroll
                    for (int j = 0; j < 8; ++j) { const int c = 4 * lane + 256 * j; const f32x4 t = xv[rr][j] + *(const f32x4*)(gt1 + c) * *(const f32x4*)(gpost + c) * (v[rr][j] * r1[rr]); v[rr][j] = t;
                        { u32x2 xb; xb.x = pk2(t.x, t.y); xb.y = pk2(t.z, t.w); ((u32x2*)(x1 + (size_t)(row0 + rr) * D))[lane + 64 * j] = xb; } s[rr] += (t.x * t.x + t.y * t.y) + (t.z * t.z + t.w * t.w); }
                float r2[2]; r2[0] = rsqrtf(wave_sum(s[0]) * (1.0f / D) + 1e-6f); r2[1] = rsqrtf(wave_sum(s[1]) * (1.0f / D) + 1e-6f);
#pragma unroll
                for (int rr = 0; rr < 2; ++rr)
#pragma unroll
                    for (int j = 0; j < 8; ++j) { const int c = 4 * lane + 256 * j; const f32x4 t = v[rr][j] * r2[rr] * (*(const f32x4*)(gpre2 + c) * (*(const f32x4*)(sc2 + c) + 1.0f)) + *(const f32x4*)(sh2 + c);
                        u32x2 wh; wh.x = pk2(t.x, t.y); wh.y = pk2(t.z, t.w);
                        u32x2 wl; wl.x = pk2(t.x - __uint_as_float(wh.x << 16), t.y - __uint_as_float(wh.x & 0xffff0000u)); wl.y = pk2(t.z - __uint_as_float(wh.y << 16), t.w - __uint_as_float(wh.y & 0xffff0000u));
                        ((unsigned*)(h2 + (size_t)(row0 + rr) * D))[lane + 64 * j] = pk_fp8x4(t.x, t.y, t.z, t.w, 8.0f);
                        *(LAS u32x2*)(Ah + (rl0 + rr) * RS8 + c) = wh; *(LAS u32x2*)(Al + (rl0 + rr) * RS8 + c) = wl; }
            }
            R1_BAR();
            f32x4 acc[5];
#pragma unroll
            for (int nt = 0; nt < 5; ++nt) acc[nt] = (f32x4){0.f, 0.f, 0.f, 0.f};
            for (int rmf = 0; rmf < 1 + REP_P11B; ++rmf) {
#pragma unroll
            for (int nt = 0; nt < 5; ++nt) acc[nt] = (f32x4){0.f, 0.f, 0.f, 0.f};
#pragma unroll 2
            for (int ks = 0; ks < 8; ++ks) {
                const int k0 = 256 * wave + 32 * ks + 8 * (lane >> 4);
                const bf16x8 ah = *(const LAS bf16x8*)(Ah + (lane & 15) * RS8 + k0), al = *(const LAS bf16x8*)(Al + (lane & 15) * RS8 + k0);
#pragma unroll
                for (int nt = 0; nt < 5; ++nt) { const bf16x8 bh = *(const bf16x8*)(wrh + (size_t)(16 * nt + (lane & 15)) * D + k0), bl = *(const bf16x8*)(wrl + (size_t)(16 * nt + (lane & 15)) * D + k0);
                    acc[nt] = __builtin_amdgcn_mfma_f32_16x16x32_bf16(ah, bh, acc[nt], 0, 0, 0);
                    acc[nt] = __builtin_amdgcn_mfma_f32_16x16x32_bf16(al, bh, acc[nt], 0, 0, 0);
                    acc[nt] = __builtin_amdgcn_mfma_f32_16x16x32_bf16(ah, bl, acc[nt], 0, 0, 0); }
            }
            }
            R1_BAR();
#pragma unroll
            for (int nt = 0; nt < 5; ++nt)
#pragma unroll
                for (int rg = 0; rg < 4; ++rg) Pp[(wave * 16 + 4 * (lane >> 4) + rg) * 80 + 16 * nt + (lane & 15)] = acc[nt][rg];
            R1_BAR();
            for (int i = tid; i < 16 * 72; i += NTHR) { const int r = i / 72, c = i % 72; float t = c < NG ? b_rg[c] : b_re[c - NG];
#pragma unroll
                for (int w = 0; w < 8; ++w) t += Pp[(w * 16 + r) * 80 + c];
                Lg[r * 72 + c] = t; }
            R1_BAR();
            if (tid < 16) {
                const LAS float* lg = Lg + tid * 72; const int row = unit * 16 + tid;
                float mx = lg[0]; int gi = 0; for (int j = 1; j < 8; ++j) if (lg[j] > mx) { mx = lg[j]; gi = j; }
                float sg = 0.f; for (int j = 0; j < 8; ++j) sg += __expf(lg[j] - mx);
                const float pg = 1.0f / sg;
                const LAS float* le = lg + 8 + gi * EPG;
                float m1 = le[0]; int i1 = 0; for (int j = 1; j < 8; ++j) if (le[j] > m1) { m1 = le[j]; i1 = j; }
                float m2 = -3e38f; int i2 = 0; for (int j = 0; j < 8; ++j) if (j != i1 && le[j] > m2) { m2 = le[j]; i2 = j; }
                const float e2 = __expf(m2 - m1); const float p1 = 1.0f / (1.0f + e2), p2 = e2 / (1.0f + e2);
                const int e1g = gi * EPG + i1, e2g = gi * EPG + i2;
                ew[row * 2] = pg * p1; ew[row * 2 + 1] = pg * p2;
                if (rep_ == 0) {
                    const int q1 = atomicAdd((int*)ctl + CW_CNT + e1g * CNT_STR, 1), q2 = atomicAdd((int*)ctl + CW_CNT + e2g * CNT_STR, 1);
                    elist[e1g * S + q1] = row; elist[e2g * S + q2] = row; slot[row * 2] = (e1g << 16) | q1; slot[row * 2 + 1] = (e2g << 16) | q2; }
            }
            R1_BAR();
        }
    }
    SEAM(11);
    PH(13) { const int lane = lane_fresh(); const int tid = (wave << 6) | lane; (void)tid; (void)lane;
        ROUTE_TABLE();
        pg8::Gemm g{(const bf16*)h2, (const bf16*)Wgut, MAXROWS, NE * 1024, D / 2, D / 2, D / 2}; ExpertOrderT<true> So{elist, (LAS const int*)(lds + RT_OFF), 4, G, wg};
        EpiHid E{hid};
        pg8::gemm_phase<EpiHid, ExpertOrderT<true>, true, true, (124 << 8) | 119, true>(lds, g, So, E);
    }
    SEAM(13);
    PH(14) { const int lane = lane_fresh(); const int tid = (wave << 6) | lane; (void)tid; (void)lane;
        if (args.ph_lo == 14) ROUTE_TABLE();
        pg8::Gemm g{(const bf16*)hid, (const bf16*)Wdt, MAXROWS, NE * D, FF / 2, FF / 2, FF / 2}; ExpertOrderT<false> So{nullptr, (LAS const int*)(lds + RT_OFF), 8, G, wg};
        EpiYbuf E{ybuf};
        pg8::gemm_phase<EpiYbuf, ExpertOrderT<false>, true, true, (124 << 8) | 120, true>(lds, g, So, E);
    }
    SEAM(14);
    PH(15) { const int lane = lane_fresh(); const int tid = (wave << 6) | lane; (void)tid; (void)lane;
        const float* gpost2 = args.in[7]; const float* gt2 = ada + 5 * D; float* out = args.out;
        if (args.ph_lo == 15) ROUTE_TABLE();
        LAS const int* tb = (LAS const int*)(lds + RT_OFF);
        for (int rb = gw; rb < S; rb += 2 * NGW) {
            int s0[2], s1[2]; float w0[2], w1[2]; const int rows[2] = {rb, rb + NGW};
#pragma unroll
            for (int q = 0; q < 2; ++q) { const int row = rows[q] < S ? rows[q] : rb; const int v0 = slot[row * 2], v1 = slot[row * 2 + 1]; s0[q] = tb[64 + (v0 >> 16)] + (v0 & 0xffff); s1[q] = tb[64 + (v1 >> 16)] + (v1 & 0xffff); w0[q] = ew[row * 2]; w1[q] = ew[row * 2 + 1]; }
            u32x2 xb[2][8];
#pragma unroll
            for (int q = 0; q < 2; ++q) { const int row = rows[q] < S ? rows[q] : rb;
#pragma unroll
                for (int j = 0; j < 8; ++j) xb[q][j] = ((const u32x2*)(x1 + (size_t)row * D))[lane + 64 * j]; }
            f32x4 v[2][8]; float s[2] = {0.f, 0.f};
#pragma unroll
            for (int q = 0; q < 2; ++q) { const u32x2* y0 = (const u32x2*)(ybuf + (size_t)s0[q] * D) + lane; const u32x2* y1 = (const u32x2*)(ybuf + (size_t)s1[q] * D) + lane;
#pragma unroll
                for (int j = 0; j < 8; ++j) { const u32x2 a = y0[64 * j], b = y1[64 * j];
                    v[q][j].x = w0[q] * __uint_as_float(a.x << 16) + w1[q] * __uint_as_float(b.x << 16); v[q][j].y = w0[q] * __uint_as_float(a.x & 0xffff0000u) + w1[q] * __uint_as_float(b.x & 0xffff0000u);
                    v[q][j].z = w0[q] * __uint_as_float(a.y << 16) + w1[q] * __uint_as_float(b.y << 16); v[q][j].w = w0[q] * __uint_as_float(a.y & 0xffff0000u) + w1[q] * __uint_as_float(b.y & 0xffff0000u);
                    s[q] += (v[q][j].x * v[q][j].x + v[q][j].y * v[q][j].y) + (v[q][j].z * v[q][j].z + v[q][j].w * v[q][j].w); } }
            float r[2]; r[0] = rsqrtf(wave_sum(s[0]) * (1.0f / D) + 1e-6f); r[1] = rsqrtf(wave_sum(s[1]) * (1.0f / D) + 1e-6f);
#pragma unroll
            for (int q = 0; q < 2; ++q) if (rows[q] < S) {
#pragma unroll
                for (int j = 0; j < 8; ++j) { const int c = 4 * lane + 256 * j; const u32x2 xx = xb[q][j];
                    const f32x4 xf = (f32x4){__uint_as_float(xx.x << 16), __uint_as_float(xx.x & 0xffff0000u), __uint_as_float(xx.y << 16), __uint_as_float(xx.y & 0xffff0000u)};
                    ((f32x4*)(out + (size_t)rows[q] * D))[lane + 64 * j] = xf + *(const f32x4*)(gt2 + c) * (v[q][j] * r[q] * *(const f32x4*)(gpost2 + c)); } }
        }
    }
#undef IN
#undef SEAM
}
extern "C" void kernel_launch(void* const* d_in, const int* in_sizes, int n_in, void* d_out, int out_size, void* d_ws, size_t ws_size, hipStream_t stream) {
    static int grid = 0;
    if (grid == 0) {
        if (ws_size < WS_END || n_in != 38) { fprintf(stderr, "kernel_launch: unexpected workspace/inputs: %zu < %zu or n_in %d\n", ws_size, (size_t)WS_END, n_in); grid = -1; return; }
        int dev = 0, cus = 0;
        if (hipGetDevice(&dev) != hipSuccess || hipDeviceGetAttribute(&cus, hipDeviceAttributeMultiprocessorCount, dev) != hipSuccess) { fprintf(stderr, "device query failed\n"); grid = -1; return; }
        if (hipFuncSetAttribute((const void*)fwd, hipFuncAttributeMaxDynamicSharedMemorySize, LDS_BYTES) != hipSuccess) { fprintf(stderr, "hipFuncSetAttribute failed\n"); grid = -1; return; }
        grid = cus;
    }
    if (grid < 0) return;
    (void)hipMemsetAsync((char*)d_ws + WS_CTL, 0, 1 * MiB, stream);
    Args a{};
    for (int i = 0; i < 38; ++i) a.in[i] = (const float*)d_in[i];
    a.out = (float*)d_out; a.ws = (unsigned char*)d_ws;
#if N_LAUNCH_PER_PHASE
    for (int ph = 0; ph < 16; ++ph) { a.ph_lo = ph; a.ph_hi = ph + 1; hipLaunchKernelGGL(fwd, dim3(grid), dim3(NTHR), LDS_BYTES, stream, a); }
#else
    a.ph_lo = 0; a.ph_hi = 16; hipLaunchKernelGGL(fwd, dim3(grid), dim3(NTHR), LDS_BYTES, stream, a);
#endif
}
```

```cpp
#include <hip/hip_runtime.h>
#include <cstdio>
#include <cstdint>

typedef unsigned short bf16;
__device__ __forceinline__ float bf2f(bf16 b) { return __uint_as_float(((unsigned)b) << 16); }
__device__ __forceinline__ bf16 f2bf(float f) { unsigned u = __float_as_uint(f); u += 0x7fffu + ((u >> 16) & 1u); return (bf16)(u >> 16); }
__device__ __forceinline__ float sigmoidf_(float x) { return __builtin_amdgcn_rcpf(1.0f + __expf(-x)); }

#ifndef N_LAUNCH_PER_PHASE
#define N_LAUNCH_PER_PHASE 0
#endif
#ifndef REP_PHASE
#define REP_PHASE -1
#define REP_N 0
#endif
#ifndef REP_SCAN
#define REP_SCAN 0
#endif
#ifndef REP_P11A
#define REP_P11A 0
#endif
#ifndef REP_P11B
#define REP_P11B 0
#endif
#ifndef REP_R1A
#define REP_R1A 0
#define REP_R1B 0
#define REP_R1C 0
#endif
#ifndef REP_R1NR
#define REP_R1NR 0
#endif
#ifndef REP_R1S0
#define REP_R1S0 0
#endif
constexpr int S = 8192, D = 2048;
constexpr int AH = 8, AD = 128, AW = 1024, MB = 256, NB = S / MB;
constexpr int RH = 16, RN = 64, RW = 1024;
constexpr int LW = 96, LA = 96, LG = 256, LO = LW + LA + LG;
constexpr int INW = 3 * AW + 3 * RW + 2 * D;
constexpr int NE = 64, NG = 8, EPG = 8, FF = 512;
constexpr int MAXROWS = 32768;
constexpr int MAXTILES = MAXROWS / 256;

constexpr size_t MiB = 1u << 20;
constexpr size_t WS_CTL   = 0;
constexpr size_t WS_ADA   = 1 * MiB;
constexpr size_t WS_ROPE  = 2 * MiB;
constexpr size_t WS_KMEAN = 3 * MiB;
constexpr size_t WS_WL2   = 3 * MiB + 256 * 1024;
constexpr size_t WS_ROUTE = 5 * MiB;
constexpr size_t WS_TOK   = 6 * MiB;
constexpr size_t WS_WR    = 7 * MiB;
constexpr size_t WS_H     = 8 * MiB;
constexpr size_t WS_Q     = 40 * MiB;
constexpr size_t WS_K     = 56 * MiB;
constexpr size_t WS_V     = 72 * MiB;
constexpr size_t WS_RKV   = 88 * MiB;
constexpr size_t WS_GATE  = 184 * MiB;
constexpr size_t WS_LORA  = 248 * MiB;
constexpr size_t WS_LORAB = 424 * MiB;
constexpr size_t WS_AL2   = 280 * MiB;
constexpr size_t WS_LW    = 296 * MiB;
constexpr size_t WS_A     = 328 * MiB;
constexpr size_t WS_G     = 360 * MiB;
constexpr size_t WS_OCAT  = 392 * MiB;
constexpr size_t WS_MIX   = 424 * MiB;
constexpr size_t WS_Y     = 456 * MiB;
constexpr size_t WS_X1    = 520 * MiB;
constexpr size_t WS_H2    = 584 * MiB;
constexpr size_t WS_WUPT  = 616 * MiB;
constexpr size_t WS_WOT   = 624 * MiB;
constexpr size_t WS_WGUT  = 632 * MiB;
constexpr size_t WS_WDT   = 888 * MiB;
constexpr size_t WS_END   = 1016 * MiB;
constexpr size_t WS_W1T   = WS_Y;
constexpr size_t WS_ELIST = 16 * MiB;
constexpr size_t WS_XBUF  = WS_H;
constexpr size_t WS_HID   = 136 * MiB;
constexpr size_t WS_YBUF  = 168 * MiB;
constexpr size_t WS_ALIST = 8 * MiB, WS_AMASK = 12 * MiB, WS_AML = 13 * MiB, WS_APART = 248 * MiB;
constexpr size_t WS_RWP = 456 * MiB, WS_RWQ = 472 * MiB, WS_RWR = 504 * MiB, WS_RWY = 520 * MiB, WS_RWH = 552 * MiB, WS_RWB = 568 * MiB;
constexpr size_t WS_NR = WS_MIX, WS_NW = WS_NR + 32 * MiB, WS_NKT = WS_NR + 64 * MiB, WS_NV = WS_NR + 96 * MiB, WS_NKK = WS_NR + 128 * MiB, WS_NY = WS_NR + 160 * MiB;
constexpr size_t WS_MIXTMP = WS_Y;
constexpr size_t WS_GTMP = WS_Y;

constexpr int CW_CNT = 16384, CNT_STR = 1088;
constexpr int CW_FILL = 1152;
constexpr int CW_OFF = 1280;
constexpr int CW_ADA = 1408;
constexpr int CW_ACNT = 90112, ACNT_STR = 576;
constexpr int CW_AQ = 1920;

namespace pg8 {
#define PG8_LAS __attribute__((address_space(3)))
typedef unsigned short bf16_t;
typedef short bf16x8 __attribute__((ext_vector_type(8)));
typedef float f32x4 __attribute__((ext_vector_type(4)));
typedef unsigned u32x4 __attribute__((ext_vector_type(4)));
typedef int i32x8_t __attribute__((ext_vector_type(8)));
template <bool IS8> struct FragSel { typedef bf16x8 T; static constexpr int NK = 2; };
template <> struct FragSel<true> { typedef i32x8_t T; static constexpr int NK = 1; };
template <int F8> struct FragT : FragSel<(F8 != 0)> {};
constexpr int BM = 256, BK = 64, HALF = 128, HTB = HALF * BK * 2  , STAGE_BYTES = 8 * HTB, NXCD = 8, WGM = 8;

__host__ __device__ __forceinline__ int lds_byte(int r, int c) { const int st = (r >> 4) * 2 + (c >> 5), rr = r & 15, cc = c & 31, ob = rr * 64 + cc * 2; return st * 1024 + (ob ^ (((ob >> 9) & 1) << 5)); }
__host__ __device__ __forceinline__ void stage_rc(int b, int& R, int& C) { const int st = b / 1024, sb = b % 1024, swz = sb ^ (((sb >> 9) & 1) << 5); R = (st >> 1) * 16 + swz / 64; C = (st & 1) * 32 + (swz % 64) / 2; }
__host__ __device__ __forceinline__ int perm32(int rho) { const int n = rho >> 4, i = rho & 15; return 8 * (i >> 2) + 4 * n + (i & 3); }

struct Unit { int pm, pn, koff, koffB; };
struct Gemm { const bf16_t* A; const bf16_t* Bt; int M, N, K, lda, ldb; };

struct StaticOrder {
    static constexpr bool GATHER = false; const int* tok = nullptr;
    int nM, nN, nwg, G, c;
    __host__ __device__ void init(int M, int N, int G_, int c_) { nM = M / BM; nN = N / BM; nwg = nM * nN; G = G_; c = c_; }
    __host__ __device__ bool next(int i, Unit& u) const {
        const long L = (long)i * G + c; if (L >= nwg) return false;
        int wgid = (int)L; { const int q = nwg / NXCD, r = nwg % NXCD, xcd = wgid % NXCD, off = wgid / NXCD; wgid = (xcd < r ? xcd * (q + 1) : r * (q + 1) + (xcd - r) * q) + off; }
        const int nig = WGM * nN, gid = wgid / nig, fm = gid * WGM, gsz = (nM - fm) < WGM ? (nM - fm) : WGM;
        u.pm = fm + ((wgid % nig) % gsz); u.pn = (wgid % nig) / gsz; u.koff = 0; u.koffB = 0; return true;
    }
    __device__ __forceinline__ void a_ready(const Unit&) const {}
    __device__ __forceinline__ void done(const Unit&) const {}
};

__device__ __forceinline__ unsigned cvt_pk_bf16(float lo, float hi) { unsigned r; asm volatile("v_cvt_pk_bf16_f32 %0, %1, %2" : "=v"(r) : "v"(lo), "v"(hi)); return r; }
template <class Epi, class Sched, bool ALIGN_EPI = false, bool SP2 = false, int F8 = 0, bool HM = false>
__device__ __forceinline__ void gemm_phase(PG8_LAS unsigned char* lds, const Gemm g, const Sched& S, const Epi& E) {
    int tid_ = threadIdx.x; asm volatile("" : "+v"(tid_));
    const int tid = tid_, wid = __builtin_amdgcn_readfirstlane(tid >> 6), lane = tid & 63, wr = wid >> 2, wc = wid & 3, fr = lane & 15, fq = lane >> 4;
    const int K = g.K, nt = K / BK;
    unsigned voffA[2], voffB[2], voffN[2] = {0u, 0u};
#pragma unroll
    for (int i = 0; i < 2; ++i) { int R, C; stage_rc(tid * 16 + i * 8192, R, C); const int Rb = Epi::PERM ? ((R & ~31) + perm32(R & 31)) : R;
        voffA[i] = (unsigned)(R * g.lda + C) * 2u; voffB[i] = (unsigned)(Rb * g.ldb + C) * 2u; }
    const size_t kstep = (size_t)(BK * 2);
    const size_t hstepA = HM ? (size_t)0 : (size_t)HALF * g.lda * 2, hstepB = (size_t)HALF * g.ldb * 2;
    const size_t tstepA = Sched::GATHER ? (size_t)0 : (HM ? 1 : 2) * (size_t)HALF * g.lda * 2, tstepB = 2 * hstepB;
    const unsigned ldsw = (unsigned)wid * 1024u;
    const int aoff = lds_byte(wr * 64 + fr, fq * 8), boff = lds_byte(wc * 32 + fr, fq * 8);
#define PG8_SA(b, h) (((b) * 2 + (h)) * HTB)
#define PG8_SB(b, h) ((4 + (b) * 2 + (h)) * HTB)
#define PG8_STAGE(bufoff, gbase, voff) do { _Pragma("unroll") for (int _i = 0; _i < 2; ++_i) \
        __builtin_amdgcn_global_load_lds((const unsigned*)((const char*)(gbase) + (voff)[_i]), (PG8_LAS unsigned*)(lds + (bufoff) + ldsw + _i * 8192), 16, 0, 0); } while (0)
#define PG8_CAT(lo, hi) __builtin_bit_cast(i32x8_t, __builtin_shufflevector(lo, hi, 0, 1, 2, 3, 4, 5, 6, 7, 8, 9, 10, 11, 12, 13, 14, 15))
#define PG8_RD(off) (*(const PG8_LAS bf16x8*)(lds + (off)))
#define PG8_LDA(dst, b, h) do { if constexpr (!(HM && (h) == 1)) _Pragma("unroll") for (int m = 0; m < 4; ++m) { if constexpr (F8 == 0) { _Pragma("unroll") for (int k = 0; k < 2; ++k) dst[m][k] = PG8_RD(PG8_SA(b, h) + aoff + m * 2048 + k * 1024); } \
        else dst[m][0] = PG8_CAT(PG8_RD(PG8_SA(b, h) + aoff + m * 2048), PG8_RD(PG8_SA(b, h) + aoff + m * 2048 + 1024)); } } while (0)
#define PG8_LDB(dst, b, h) do { _Pragma("unroll") for (int n = 0; n < 2; ++n) { if constexpr (F8 == 0) { _Pragma("unroll") for (int k = 0; k < 2; ++k) dst[n][k] = PG8_RD(PG8_SB(b, h) + boff + n * 2048 + k * 1024); } \
        else dst[n][0] = PG8_CAT(PG8_RD(PG8_SB(b, h) + boff + n * 2048), PG8_RD(PG8_SB(b, h) + boff + n * 2048 + 1024)); } } while (0)
#define PG8_MMA(ai, bj, At, Bt) do { __builtin_amdgcn_s_setprio(1); if constexpr (!(HM && (ai) == 1)) _Pragma("unroll") for (int m = 0; m < 4; ++m) _Pragma("unroll") for (int n = 0; n < 2; ++n) { \
        if constexpr (F8 == 0) { _Pragma("unroll") for (int k = 0; k < 2; ++k) acc[ai][bj][m][n] = __builtin_amdgcn_mfma_f32_16x16x32_bf16(Bt[n][k], At[m][k], acc[ai][bj][m][n], 0, 0, 0); } \
        else acc[ai][bj][m][n] = __builtin_amdgcn_mfma_scale_f32_16x16x128_f8f6f4(Bt[n][0], At[m][0], acc[ai][bj][m][n], 0, 0, 0, (F8 & 255) * 0x01010101, 0, ((F8 >> 8) & 255) * 0x01010101); } \
        __builtin_amdgcn_s_setprio(0); } while (0)
#define PG8_WAIT_V(n) asm volatile("s_waitcnt vmcnt(" #n ")" ::: "memory")
#define PG8_WAIT_L(n) asm volatile("s_waitcnt lgkmcnt(" #n ")" ::: "memory")
#define PG8_BAR __builtin_amdgcn_s_barrier()
#define PG8_SCHED __builtin_amdgcn_sched_barrier(0)
    Unit cur, nxt; int ui = 0;
    if (!S.next(0, cur)) return;
    f32x4 acc[2][2][4][2];
#pragma unroll
    for (int a = 0; a < 2; ++a)
#pragma unroll
        for (int b = 0; b < 2; ++b)
#pragma unroll
            for (int m = 0; m < 4; ++m)
#pragma unroll
                for (int n = 0; n < 2; ++n) acc[a][b][m][n] = (f32x4){0.f, 0.f, 0.f, 0.f};
    typename FragT<F8>::T At[4][FragT<F8>::NK], B0[2][FragT<F8>::NK], B1[2][FragT<F8>::NK];
    const char* cA = (const char*)g.A + (size_t)cur.pm * tstepA + cur.koff; const char* cB = (const char*)g.Bt + (size_t)cur.pn * tstepB + cur.koffB;
#define PG8_GVOFF(u, out) do { _Pragma("unroll") for (int i_ = 0; i_ < 2; ++i_) { int R_, C_; stage_rc(tid * 16 + i_ * 8192, R_, C_); out[i_] = ((unsigned)S.row_tok((u).pm, R_) * (unsigned)g.lda + (unsigned)C_) * 2u; } } while (0)
    if constexpr (Sched::GATHER) PG8_GVOFF(cur, voffA);
    S.a_ready(cur);
    if constexpr (SP2) {
        PG8_STAGE(PG8_SB(0, 0), cB, voffB); PG8_STAGE(PG8_SB(0, 1), cB + hstepB, voffB); PG8_STAGE(PG8_SA(0, 0), cA, voffA); PG8_STAGE(PG8_SA(0, 1), cA + hstepA, voffA);
        if (wr == 1) PG8_BAR;
        PG8_WAIT_V(2); PG8_BAR;
        PG8_STAGE(PG8_SB(1, 0), cB + kstep, voffB); PG8_STAGE(PG8_SA(1, 0), cA + kstep, voffA); PG8_STAGE(PG8_SB(1, 1), cB + hstepB + kstep, voffB);
        PG8_WAIT_V(6); PG8_BAR;
    } else {
        PG8_STAGE(PG8_SB(0, 0), cB, voffB); PG8_STAGE(PG8_SA(0, 0), cA, voffA); PG8_STAGE(PG8_SB(0, 1), cB + hstepB, voffB); PG8_STAGE(PG8_SA(0, 1), cA + hstepA, voffA);
        if (wr == 1) PG8_BAR;
        PG8_WAIT_V(4); PG8_BAR;
        PG8_STAGE(PG8_SB(1, 0), cB + kstep, voffB); PG8_STAGE(PG8_SA(1, 0), cA + kstep, voffA); PG8_STAGE(PG8_SB(1, 1), cB + hstepB + kstep, voffB);
        PG8_WAIT_V(6); PG8_BAR;
    }
    for (;;) {
        const bool has_next = S.next(ui + 1, nxt);
        if constexpr (Sched::GATHER) { if (has_next) PG8_GVOFF(nxt, voffN); }
        const char* nA = has_next ? (const char*)g.A + (size_t)nxt.pm * tstepA + nxt.koff : cA; const char* nB = has_next ? (const char*)g.Bt + (size_t)nxt.pn * tstepB + nxt.koffB : cB;
#pragma nounroll
        for (int t = 0; t < nt; t += 2) {
            const bool last = (t == nt - 2);
            const char* a1 = cA + (size_t)(t + 1) * kstep;
            const char* a2 = last ? nA : cA + (size_t)(t + 2) * kstep; const char* b2 = last ? nB : cB + (size_t)(t + 2) * kstep;
            const char* a3 = a2 + kstep; const char* b3 = b2 + kstep;
            unsigned vA2[2] = {voffA[0], voffA[1]}; if constexpr (Sched::GATHER) { if (last) { vA2[0] = voffN[0]; vA2[1] = voffN[1]; } }
            if (last && has_next) S.a_ready(nxt);
            if constexpr (SP2) {
            PG8_LDB(B0, 0, 0); PG8_LDB(B1, 0, 1); PG8_SCHED; PG8_LDA(At, 0, 0); PG8_STAGE(PG8_SA(1, 1), a1 + hstepA, voffA);
            PG8_WAIT_V(8); PG8_WAIT_L(0); PG8_BAR; PG8_MMA(0, 0, At, B0); PG8_MMA(0, 1, At, B1); PG8_BAR; PG8_SCHED;
            PG8_LDA(At, 0, 1); PG8_STAGE(PG8_SB(0, 0), b2, voffB); PG8_STAGE(PG8_SB(0, 1), b2 + hstepB, voffB); PG8_STAGE(PG8_SA(0, 0), a2, vA2);
            PG8_WAIT_V(8); PG8_WAIT_L(0); PG8_BAR; PG8_MMA(1, 0, At, B0); PG8_MMA(1, 1, At, B1); PG8_BAR; PG8_SCHED;
            PG8_LDB(B0, 1, 0); PG8_LDB(B1, 1, 1); PG8_SCHED; PG8_LDA(At, 1, 0); PG8_STAGE(PG8_SA(0, 1), a2 + hstepA, vA2);
            PG8_WAIT_V(8); PG8_WAIT_L(0); PG8_BAR; PG8_MMA(0, 0, At, B0); PG8_MMA(0, 1, At, B1); PG8_BAR; PG8_SCHED;
            PG8_LDA(At, 1, 1); PG8_STAGE(PG8_SB(1, 0), b3, voffB); PG8_STAGE(PG8_SB(1, 1), b3 + hstepB, voffB); PG8_STAGE(PG8_SA(1, 0), a3, vA2);
            PG8_WAIT_V(8); PG8_WAIT_L(0); PG8_BAR; PG8_MMA(1, 0, At, B0); PG8_MMA(1, 1, At, B1); PG8_BAR; PG8_SCHED;
            } else {
            PG8_LDB(B0, 0, 0); PG8_SCHED; PG8_LDA(At, 0, 0); PG8_STAGE(PG8_SA(1, 1), a1 + hstepA, voffA);
            PG8_WAIT_L(8); PG8_BAR; PG8_WAIT_L(0); PG8_MMA(0, 0, At, B0); PG8_BAR; PG8_SCHED;
            PG8_LDB(B1, 0, 1); PG8_STAGE(PG8_SB(0, 0), b2, voffB);
            PG8_BAR; PG8_WAIT_L(0); PG8_MMA(0, 1, At, B1); PG8_BAR;
            PG8_LDA(At, 0, 1); PG8_STAGE(PG8_SA(0, 0), a2, vA2);
            PG8_BAR; PG8_WAIT_L(0); PG8_MMA(1, 0, At, B0); PG8_BAR; PG8_SCHED;
            PG8_STAGE(PG8_SB(0, 1), b2 + hstepB, voffB);
            PG8_WAIT_V(6); PG8_BAR; PG8_MMA(1, 1, At, B1); PG8_BAR;
            PG8_LDB(B0, 1, 0); PG8_SCHED; PG8_LDA(At, 1, 0); PG8_STAGE(PG8_SA(0, 1), a2 + hstepA, vA2);
            PG8_WAIT_L(8); PG8_BAR; PG8_WAIT_L(0); PG8_MMA(0, 0, At, B0); PG8_BAR; PG8_SCHED;
            PG8_LDB(B1, 1, 1); PG8_STAGE(PG8_SB(1, 0), b3, voffB);
            PG8_BAR; PG8_WAIT_L(0); PG8_MMA(0, 1, At, B1); PG8_BAR;
            PG8_LDA(At, 1, 1); PG8_STAGE(PG8_SA(1, 0), a3, vA2);
            PG8_BAR; PG8_WAIT_L(0); PG8_MMA(1, 0, At, B0); PG8_BAR; PG8_SCHED;
            PG8_STAGE(PG8_SB(1, 1), b3 + hstepB, voffB);
            PG8_WAIT_V(6); PG8_BAR; PG8_MMA(1, 1, At, B1); PG8_BAR;
            }
        }
        if constexpr (ALIGN_EPI) { if (wr == 0) PG8_BAR; }
        if constexpr (!Epi::AFTER_DRAIN) { E(acc, cur, wr, wc, fr, fq); S.done(cur); }
        if (!has_next) break;
        {
#pragma unroll
        for (int a = 0; a < 2; ++a)
#pragma unroll
            for (int b = 0; b < 2; ++b)
#pragma unroll
                for (int m = 0; m < 4; ++m)
#pragma unroll
                    for (int n = 0; n < 2; ++n) acc[a][b][m][n] = (f32x4){0.f, 0.f, 0.f, 0.f};
        }
        cur = nxt; cA = nA; cB = nB; ++ui;
        if constexpr (Sched::GATHER) { voffA[0] = voffN[0]; voffA[1] = voffN[1]; }
        if constexpr (ALIGN_EPI) { if (wr == 1) PG8_BAR; }
    }
    PG8_WAIT_V(0);
    if constexpr (!ALIGN_EPI) { if (wr == 0) PG8_BAR; }
    PG8_BAR;
    if constexpr (Epi::AFTER_DRAIN) { E.fused(acc, cur, wr, wc, fr, fq, lds, wid, lane); S.done(cur); }
#undef PG8_SA
#undef PG8_SB
#undef PG8_STAGE
#undef PG8_LDA
#undef PG8_LDB
#undef PG8_MMA
#undef PG8_CAT
#undef PG8_GVOFF
#undef PG8_RD
#undef PG8_WAIT_V
#undef PG8_WAIT_L
#undef PG8_BAR
#undef PG8_SCHED
}
}

#define XB_TMO      128
#define XB_XCNT(j)  (256  + 64 * (j))
#define XB_XSUB(j)  (1280 + 64 * (j))
#define XB_XGEN(j)  (2304 + 64 * (j))
#define XB_TOP      3328
#define XB_TOPGEN   3392
#define XCD_BAR_WORDS 3456
#define XB_SPIN_CAP (1u << 18)
#define LAS __attribute__((address_space(3)))

__device__ __forceinline__ unsigned xb_ld(unsigned* p)              { return __hip_atomic_load(p, __ATOMIC_RELAXED, __HIP_MEMORY_SCOPE_AGENT); }
__device__ __forceinline__ unsigned xb_add(unsigned* p, unsigned v) { return __hip_atomic_fetch_add(p, v, __ATOMIC_RELAXED, __HIP_MEMORY_SCOPE_AGENT); }
__device__ __forceinline__ unsigned xb_xcc_id() { return (unsigned)__builtin_amdgcn_s_getreg((3 << 11) | 20) & 0xFu; }
#define XB_SPIN(cond, bar) do { unsigned _sp = 0; while (cond) { __builtin_amdgcn_s_sleep(1); \
    if ((++_sp & 255u) == 0u) { if (xb_ld(&(bar)[XB_TMO])) break; if (_sp > XB_SPIN_CAP) { atomicAdd(&(bar)[XB_TMO], 1u); break; } } } } while (0)

struct XcdBarrier {
    unsigned* bar; unsigned x;
    volatile LAS unsigned* st;
};

__device__ __forceinline__ XcdBarrier xcd_barrier_post(unsigned* bar, volatile LAS unsigned* st) {
    XcdBarrier b; b.bar = bar; b.x = xb_xcc_id(); b.st = st;
    if (threadIdx.x == 0) (void)xb_add(&bar[XB_XCNT(b.x)], 1u);
    return b;
}
__device__ __forceinline__ void xcd_barrier_complete(unsigned* bar, unsigned x, unsigned& nloc, unsigned& nx) {
    const unsigned G = gridDim.x * gridDim.y * gridDim.z;
    unsigned sum, cnt, mine, sp = 0u;
    for (;;) {
        sum = 0u; cnt = 0u; mine = 0u;
#pragma unroll
        for (unsigned j = 0; j < 16; ++j) { const unsigned c = xb_ld(&bar[XB_XCNT(j)]); sum += c; cnt += (c > 0u) ? 1u : 0u; mine = (j == x) ? c : mine; }
        if (sum == G) break;
        __builtin_amdgcn_s_sleep(1);
        if ((++sp & 255u) == 0u) { if (xb_ld(&bar[XB_TMO])) break; if (sp > XB_SPIN_CAP) { atomicAdd(&bar[XB_TMO], 1u); break; } }
    }
    nloc = mine > 0u ? mine : 1u; nx = cnt > 0u ? cnt : 1u;
}

__device__ __forceinline__ void xcd_barrier(const XcdBarrier& b) {
    asm volatile("s_waitcnt vmcnt(0)" ::: "memory");
    __syncthreads();
    if (threadIdx.x == 0) {
        unsigned* bar = b.bar;
        __builtin_amdgcn_s_waitcnt(0);
        unsigned nloc = b.st[0], nx = b.st[1];
        if (nloc == 0u) { xcd_barrier_complete(bar, b.x, nloc, nx); b.st[0] = nloc; b.st[1] = nx; }
        const unsigned old = xb_add(&bar[XB_XSUB(b.x)], 1u);
        const unsigned gen = old / nloc;
        if (old + 1u == (gen + 1u) * nloc) {
            __builtin_amdgcn_fence(__ATOMIC_RELEASE, "agent");
            asm volatile("s_waitcnt vmcnt(0)" ::: "memory");
            const unsigned og = xb_add(&bar[XB_TOP], 1u);
            const unsigned tg = og / nx;
            if (og + 1u == (tg + 1u) * nx) xb_add(&bar[XB_TOPGEN], 1u);
            else XB_SPIN(xb_ld(&bar[XB_TOPGEN]) == tg, bar);
            __builtin_amdgcn_fence(__ATOMIC_ACQUIRE, "agent");
            xb_add(&bar[XB_XGEN(b.x)], 1u);
            asm volatile("s_waitcnt vmcnt(0)" ::: "memory");
        } else {
            XB_SPIN(xb_ld(&bar[XB_XGEN(b.x)]) == gen, bar);
            __builtin_amdgcn_fence(__ATOMIC_ACQUIRE, "agent");
            asm volatile("s_waitcnt vmcnt(0)" ::: "memory");
        }
    }
    __syncthreads();
}

constexpr int NWAVES = 8, NTHR = 512;
constexpr int RING_BYTES = 131072;
constexpr int LDS_BYTES = 147456;
constexpr int RT_OFF = 131072;
constexpr int LDSCTL_OFF = LDS_BYTES - 16;
constexpr int CW_BAR = 4096;
typedef float f32x4 __attribute__((ext_vector_type(4)));
typedef unsigned u32x4 __attribute__((ext_vector_type(4)));
typedef unsigned u32x2 __attribute__((ext_vector_type(2)));
typedef short bf16x8 __attribute__((ext_vector_type(8)));
#define LDS_WAIT() asm volatile("s_waitcnt lgkmcnt(0)" ::: "memory")
typedef __bf16 bf16x2_t __attribute__((ext_vector_type(2)));
typedef float f32x2_t __attribute__((ext_vector_type(2)));
__device__ __forceinline__ unsigned pk2(float lo, float hi) { const f32x2_t v = {lo, hi}; return __builtin_bit_cast(unsigned, __builtin_convertvector(v, bf16x2_t)); }
__device__ __forceinline__ int lane_fresh() { int l; asm volatile("v_mbcnt_lo_u32_b32 %0, -1, 0\n\tv_mbcnt_hi_u32_b32 %0, -1, %0" : "=v"(l)); return l; }
#define DPP_ADD(v, ctrl) ((v) + __builtin_bit_cast(float, __builtin_amdgcn_update_dpp(0, __builtin_bit_cast(int, (v)), (ctrl), 0xf, 0xf, true)))
__device__ __forceinline__ float wave_sum(float v) {
    v = DPP_ADD(v, 0xB1);
    v = DPP_ADD(v, 0x4E);
    v = DPP_ADD(v, 0x141);
    v = DPP_ADD(v, 0x140);
    const int iv = __builtin_bit_cast(int, v);
    return (__builtin_bit_cast(float, __builtin_amdgcn_readlane(iv, 0)) + __builtin_bit_cast(float, __builtin_amdgcn_readlane(iv, 16)))
         + (__builtin_bit_cast(float, __builtin_amdgcn_readlane(iv, 32)) + __builtin_bit_cast(float, __builtin_amdgcn_readlane(iv, 48)));
}

constexpr int N1 = 11264;
struct Args { const float* in[38]; float* out; unsigned char* ws; int ph_lo, ph_hi; };

__device__ __forceinline__ void tr_item(const float* W, int ldw, int k0, int n0, bf16* dst, int ldd, const float* mu, int mode, LAS float* scr, int lane) {
    f32x4 v[8];
#pragma unroll
    for (int i = 0; i < 8; ++i) v[i] = *(const f32x4*)(W + (size_t)(k0 + 8 * i + (lane >> 3)) * ldw + n0 + 4 * (lane & 7));
#pragma unroll
    for (int i = 0; i < 8; ++i) { const int kk = 8 * i + (lane >> 3); f32x4 t = v[i];
        if (mode == 1) t = t * (1.0f - mu[k0 + kk]); else if (mode == 2) t = t * mu[k0 + kk];
        LAS float* s = scr + kk * 33 + 4 * (lane & 7); s[0] = t.x; s[1] = t.y; s[2] = t.z; s[3] = t.w; }
    LDS_WAIT(); asm volatile("" ::: "memory");
    const int c = lane & 7;
#pragma unroll
    for (int j = 0; j < 4; ++j) { const int n = (lane >> 3) + 8 * j; const LAS float* s = scr + (8 * c) * 33 + n;
        u32x4 o; o.x = pk2(s[0 * 33], s[1 * 33]); o.y = pk2(s[2 * 33], s[3 * 33]); o.z = pk2(s[4 * 33], s[5 * 33]); o.w = pk2(s[6 * 33], s[7 * 33]);
        *(u32x4*)(dst + (size_t)n * ldd + 8 * c) = o; }
    LDS_WAIT(); asm volatile("" ::: "memory");
}
__device__ __forceinline__ unsigned pk_fp8x4(float a, float b, float c, float d, float sc) {
    a = fminf(fmaxf(a * sc, -448.f), 448.f); b = fminf(fmaxf(b * sc, -448.f), 448.f); c = fminf(fmaxf(c * sc, -448.f), 448.f); d = fminf(fmaxf(d * sc, -448.f), 448.f);
    int p = __builtin_amdgcn_cvt_pk_fp8_f32(a, b, 0, false); p = __builtin_amdgcn_cvt_pk_fp8_f32(c, d, p, true); return (unsigned)p; }
__device__ __forceinline__ void tr_item8(const float* W, int ldw, int k0, int n0, unsigned char* dst, int ldd, float sc, LAS float* scr, int lane) {
    f32x4 v[8];
#pragma unroll
    for (int i = 0; i < 8; ++i) v[i] = *(const f32x4*)(W + (size_t)(k0 + 8 * i + (lane >> 3)) * ldw + n0 + 4 * (lane & 7));
#pragma unroll
    for (int i = 0; i < 8; ++i) { const int kk = 8 * i + (lane >> 3); LAS float* s = scr + kk * 33 + 4 * (lane & 7); s[0] = v[i].x; s[1] = v[i].y; s[2] = v[i].z; s[3] = v[i].w; }
    LDS_WAIT(); asm volatile("" ::: "memory");
    const int c = lane & 7;
#pragma unroll
    for (int j = 0; j < 4; ++j) { const int n = (lane >> 3) + 8 * j; const LAS float* s = scr + (8 * c) * 33 + n;
        u32x2 o; o.x = pk_fp8x4(s[0 * 33], s[1 * 33], s[2 * 33], s[3 * 33], sc); o.y = pk_fp8x4(s[4 * 33], s[5 * 33], s[6 * 33], s[7 * 33], sc);
        *(u32x2*)(dst + (size_t)n * ldd + 8 * c) = o; }
    LDS_WAIT(); asm volatile("" ::: "memory");
}

struct ConvTile { const float* src; int ldw; unsigned char* dst; int rs; int kind; float sc; };
constexpr int CT_IN = (D / 128) * (INW / 128), CT_UP = (AW / 128) * (D / 128), CT_O = (D / 128) * (D / 128), CT_EG = (D / 128) * (FF / 128), CT_ED = (FF / 128) * (D / 128);
constexpr int CT_ALL = CT_IN + 2 * CT_UP + CT_O + NE * (2 * CT_EG + CT_ED);
__device__ __forceinline__ ConvTile conv_decode(int T, const float* const* in, unsigned char* ws) {
    ConvTile t; int r = T;
    if (r < CT_IN) { const int kt = r / (INW / 128), nt = r % (INW / 128), k0 = 128 * kt, n0 = 128 * nt; int dr = n0;
        if (n0 >= 3 * AW + 3 * RW + D) { const int cc = n0 - (3 * AW + 3 * RW + D); dr = 3 * AW + 3 * RW + 256 * (cc / 128) + 128; }
        else if (n0 >= 3 * AW + 3 * RW) { const int cc = n0 - (3 * AW + 3 * RW); dr = 3 * AW + 3 * RW + 256 * (cc / 128); }
        t.src = in[8] + (size_t)k0 * INW + n0; t.ldw = INW; t.dst = ws + WS_W1T + ((size_t)dr * D + k0) * 2; t.rs = D * 2; t.kind = 0; t.sc = 1.f; return t; } r -= CT_IN;
    if (r < 2 * CT_UP) { const int which = r / CT_UP, q = r % CT_UP, kt = q / (D / 128), nt = q % (D / 128), k0 = 128 * kt, n0 = 128 * nt;
        t.src = in[28 + which] + (size_t)k0 * D + n0; t.ldw = D; t.dst = ws + WS_WUPT + ((size_t)n0 * D + which * AW + k0) * 2; t.rs = D * 2; t.kind = 0; t.sc = 1.f; return t; } r -= 2 * CT_UP;
    if (r < CT_O) { const int kt = r / (D / 128), nt = r % (D / 128), k0 = 128 * kt, n0 = 128 * nt;
        t.src = in[30] + (size_t)k0 * D + n0; t.ldw = D; t.dst = ws + WS_WOT + ((size_t)n0 * D + k0) * 2; t.rs = D * 2; t.kind = 0; t.sc = 1.f; return t; } r -= CT_O;
    const int e = r / (2 * CT_EG + CT_ED); r -= e * (2 * CT_EG + CT_ED);
    if (r < 2 * CT_EG) { const int up = r / CT_EG, q = r % CT_EG, kt = q / (FF / 128), nt = q % (FF / 128), k0 = 128 * kt;
        t.src = in[35 + up] + (size_t)e * D * FF + (size_t)k0 * FF + 128 * nt; t.ldw = FF; t.dst = ws + WS_WGUT + ((size_t)e * 1024 + 256 * nt + 128 * up) * D + k0; t.rs = D; t.kind = 1; t.sc = 256.f; return t; } r -= 2 * CT_EG;
    { const int kt = r / (D / 128), nt = r % (D / 128), k0 = 128 * kt, n0 = 128 * nt;
        t.src = in[37] + (size_t)e * FF * D + (size_t)k0 * D + n0; t.ldw = D; t.dst = ws + WS_WDT + ((size_t)e * D + n0) * FF + k0; t.rs = FF; t.kind = 1; t.sc = 128.f; return t; }
}
__device__ __forceinline__ int conv_off(int k, int n) { return k * 132 + 16 * (k >> 5) + n; }
__device__ __forceinline__ void item_kn(int it, int N, int& k0, int& n0) { const int nblk = N / 32; k0 = 64 * (it / nblk); n0 = 32 * (it % nblk); }

struct EpiProj {
    static constexpr bool PERM = true, AFTER_DRAIN = false, MIDK = false;
    bf16* q; bf16* k; bf16* v; bf16* rkv; bf16* gate; bf16* lora; bf16* lorab; const float* rope;
    __device__ __forceinline__ void operator()(const pg8::f32x4 (&acc)[2][2][4][2], const pg8::Unit& u, int wr, int wc, int fr, int fq) const {
        const int row0 = u.pm * 256 + wr * 64 + fr; const int pn = u.pn; const int colw = wc * 32 + 8 * fq;
        if (pn < 8) {
            bf16* base = (pn < 4 ? q : k) + (pn & 3) * 256 + colw;
            const float sgn = fq < 2 ? -1.0f : 1.0f;
#pragma unroll
            for (int ai = 0; ai < 2; ++ai)
#pragma unroll
                for (int m = 0; m < 4; ++m) { const int row = row0 + ai * 128 + m * 16;
                    f32x4 c0, c1, c2, c3;
                    if (wc == 0) { const float* rp = rope + ((size_t)row * 16 + 8 * (fq & 1)) * 2; c0 = *(const f32x4*)rp; c1 = *(const f32x4*)(rp + 4); c2 = *(const f32x4*)(rp + 8); c3 = *(const f32x4*)(rp + 12); }
#pragma unroll
                    for (int bj = 0; bj < 2; ++bj) { f32x4 v0 = acc[ai][bj][m][0], v1 = acc[ai][bj][m][1];
                        if (wc == 0) {
                            f32x4 p0, p1;
#pragma unroll
                            for (int j = 0; j < 4; ++j) { p0[j] = __shfl_xor(v0[j], 32) * sgn; p1[j] = __shfl_xor(v1[j], 32) * sgn; }
                            v0[0] = v0[0] * c0[0] + p0[0] * c0[1]; v0[1] = v0[1] * c0[2] + p0[1] * c0[3]; v0[2] = v0[2] * c1[0] + p0[2] * c1[1]; v0[3] = v0[3] * c1[2] + p0[3] * c1[3];
                            v1[0] = v1[0] * c2[0] + p1[0] * c2[1]; v1[1] = v1[1] * c2[2] + p1[1] * c2[3]; v1[2] = v1[2] * c3[0] + p1[2] * c3[1]; v1[3] = v1[3] * c3[2] + p1[3] * c3[3];
                        }
                        u32x4 w; w.x = pk2(v0[0], v0[1]); w.y = pk2(v0[2], v0[3]); w.z = pk2(v1[0], v1[1]); w.w = pk2(v1[2], v1[3]);
                        *(u32x4*)(base + (size_t)row * AW + bj * 128) = w; } }
        } else if (pn < 12) {
            bf16* base = v + (pn - 8) * 256 + colw;
#pragma unroll
            for (int ai = 0; ai < 2; ++ai)
#pragma unroll
                for (int m = 0; m < 4; ++m) { const int row = row0 + ai * 128 + m * 16;
#pragma unroll
                    for (int bj = 0; bj < 2; ++bj) { const f32x4 v0 = acc[ai][bj][m][0], v1 = acc[ai][bj][m][1];
                        u32x4 w; w.x = pk2(v0[0], v0[1]); w.y = pk2(v0[2], v0[3]); w.z = pk2(v1[0], v1[1]); w.w = pk2(v1[2], v1[3]);
                        *(u32x4*)(base + (size_t)row * AW + bj * 128) = w; } }
        } else if (pn < 24) {
            bf16* base = rkv + (pn - 12) * 256 + colw;
#pragma unroll
            for (int ai = 0; ai < 2; ++ai)
#pragma unroll
                for (int m = 0; m < 4; ++m) { const int row = row0 + ai * 128 + m * 16;
#pragma unroll
                    for (int bj = 0; bj < 2; ++bj) { const f32x4 v0 = acc[ai][bj][m][0], v1 = acc[ai][bj][m][1];
                        u32x4 w; w.x = pk2(v0[0], v0[1]); w.y = pk2(v0[2], v0[3]); w.z = pk2(v1[0], v1[1]); w.w = pk2(v1[2], v1[3]);
                        *(u32x4*)(base + (size_t)row * (3 * RW) + bj * 128) = w; } }
        } else if (pn < 40) {
            bf16* base = gate + (pn - 24) * 128 + colw;
#pragma unroll
            for (int ai = 0; ai < 2; ++ai)
#pragma unroll
                for (int m = 0; m < 4; ++m) { const int row = row0 + ai * 128 + m * 16;
                    const f32x4 a0 = acc[ai][0][m][0], a1 = acc[ai][0][m][1], r0 = acc[ai][1][m][0], r1 = acc[ai][1][m][1]; float ra[8], sr[8];
#pragma unroll
                    for (int j = 0; j < 4; ++j) { const float ea = __expf(-a0[j]), er = __expf(-r0[j]), ea1 = __expf(-a1[j]), er1 = __expf(-r1[j]);
                        sr[j] = __builtin_amdgcn_rcpf(1.0f + er); ra[j] = (1.0f + er) * __builtin_amdgcn_rcpf(1.0f + ea); sr[4 + j] = __builtin_amdgcn_rcpf(1.0f + er1); ra[4 + j] = (1.0f + er1) * __builtin_amdgcn_rcpf(1.0f + ea1); }
                    u32x4 w; w.x = pk2(ra[0], ra[1]); w.y = pk2(ra[2], ra[3]); w.z = pk2(ra[4], ra[5]); w.w = pk2(ra[6], ra[7]);
                    *(u32x4*)(base + (size_t)row * (2 * D)) = w;
                    w.x = pk2(sr[0], sr[1]); w.y = pk2(sr[2], sr[3]); w.z = pk2(sr[4], sr[5]); w.w = pk2(sr[6], sr[7]);
                    *(u32x4*)(base + (size_t)row * (2 * D) + D) = w; }
        } else {
            bf16* base = (u.koff ? lorab : lora) + (pn - 40) * 256 + colw;
#pragma unroll
            for (int ai = 0; ai < 2; ++ai)
#pragma unroll
                for (int m = 0; m < 4; ++m) { const int row = row0 + ai * 128 + m * 16;
#pragma unroll
                    for (int bj = 0; bj < 2; ++bj) { const f32x4 v0 = acc[ai][bj][m][0], v1 = acc[ai][bj][m][1];
                        u32x4 w; w.x = pk2(v0[0], v0[1]); w.y = pk2(v0[2], v0[3]); w.z = pk2(v1[0], v1[1]); w.w = pk2(v1[2], v1[3]);
                        *(u32x4*)(base + (size_t)row * 1024 + bj * 128) = w; } }
        }
    }
};


struct LoraOrder { static constexpr bool GATHER = false; const int* tok; int G, c;
    __device__ bool next(int i, pg8::Unit& u) const { const int L = i * G + c; if (L >= (S / 256) * 8) return false; u.pm = L >> 3; u.pn = 40 + ((L >> 1) & 3); u.koff = (L & 1) * AW * 2; u.koffB = u.koff; return true; }
    __device__ __forceinline__ void a_ready(const pg8::Unit&) const {}
    __device__ __forceinline__ void done(const pg8::Unit&) const {} };
__device__ __forceinline__ void unpack8(const u32x4 w, float (&f)[8]) {
    f[0] = __uint_as_float(w.x << 16); f[1] = __uint_as_float(w.x & 0xffff0000u); f[2] = __uint_as_float(w.y << 16); f[3] = __uint_as_float(w.y & 0xffff0000u);
    f[4] = __uint_as_float(w.z << 16); f[5] = __uint_as_float(w.z & 0xffff0000u); f[6] = __uint_as_float(w.w << 16); f[7] = __uint_as_float(w.w & 0xffff0000u);
}
struct EpiMix {
    static constexpr bool PERM = true, AFTER_DRAIN = false, MIDK = false;
    const bf16* gate; bf16* mix;
    __device__ __forceinline__ void operator()(const pg8::f32x4 (&acc)[2][2][4][2], const pg8::Unit& u, int wr, int wc, int fr, int fq) const {
        const int row0 = u.pm * 256 + wr * 64 + fr; const int col0 = u.pn * 256 + wc * 32 + 8 * fq;
        if (u.koff == 0) {
#pragma unroll
            for (int ai = 0; ai < 2; ++ai)
#pragma unroll
                for (int m = 0; m < 4; ++m) { const size_t row = row0 + ai * 128 + m * 16; const bf16* gp = gate + row * (2 * D) + col0;
#pragma unroll
                    for (int bj = 0; bj < 2; ++bj) { float ga[8]; unpack8(*(const u32x4*)(gp + bj * 128), ga); const pg8::f32x4 v0 = acc[ai][bj][m][0], v1 = acc[ai][bj][m][1];
                        u32x4 w; w.x = pk2(v0[0] * ga[0], v0[1] * ga[1]); w.y = pk2(v0[2] * ga[2], v0[3] * ga[3]); w.z = pk2(v1[0] * ga[4], v1[1] * ga[5]); w.w = pk2(v1[2] * ga[6], v1[3] * ga[7]);
                        *(u32x4*)(mix + row * D + col0 + bj * 128) = w; } }
        } else {
#pragma unroll
            for (int ai = 0; ai < 2; ++ai)
#pragma unroll
                for (int m = 0; m < 4; ++m) { const size_t row = row0 + ai * 128 + m * 16; const bf16* gp = gate + row * (2 * D) + D + col0;
#pragma unroll
                    for (int bj = 0; bj < 2; ++bj) { float gr[8], tp[8]; unpack8(*(const u32x4*)(gp + bj * 128), gr); unpack8(*(const u32x4*)(mix + row * D + col0 + bj * 128), tp); const pg8::f32x4 v0 = acc[ai][bj][m][0], v1 = acc[ai][bj][m][1];
                        u32x4 w; w.x = pk2((v0[0] + tp[0]) * gr[0], (v0[1] + tp[1]) * gr[1]); w.y = pk2((v0[2] + tp[2]) * gr[2], (v0[3] + tp[3]) * gr[3]);
                        w.z = pk2((v1[0] + tp[4]) * gr[4], (v1[1] + tp[5]) * gr[5]); w.w = pk2((v1[2] + tp[6]) * gr[6], (v1[3] + tp[7]) * gr[7]);
                        *(u32x4*)(mix + row * D + col0 + bj * 128) = w; } }
        }
    }
};
struct MixOrder {
    static constexpr bool GATHER = false; const int* tok; int G, c;
    __device__ bool next(int i, pg8::Unit& u) const { const int L = (i >> 1) * G + c; if (L >= (S / 256) * (D / 256)) return false; u.pm = L / (D / 256); u.pn = L % (D / 256); u.koff = (i & 1) * AW * 2; u.koffB = u.koff; return true; }
    __device__ __forceinline__ void a_ready(const pg8::Unit&) const {}
    __device__ __forceinline__ void done(const pg8::Unit&) const {}
};
struct EpiBf16P {
    static constexpr bool PERM = true, AFTER_DRAIN = false, MIDK = false;
    bf16* C; long ldc;
    __device__ __forceinline__ void operator()(const pg8::f32x4 (&acc)[2][2][4][2], const pg8::Unit& u, int wr, int wc, int fr, int fq) const {
        const int row0 = u.pm * 256 + wr * 64 + fr; const int col0 = u.pn * 256 + wc * 32 + 8 * fq;
#pragma unroll
        for (int ai = 0; ai < 2; ++ai)
#pragma unroll
            for (int m = 0; m < 4; ++m) { bf16* p = C + (size_t)(row0 + ai * 128 + m * 16) * ldc + col0;
#pragma unroll
                for (int bj = 0; bj < 2; ++bj) { const pg8::f32x4 v0 = acc[ai][bj][m][0], v1 = acc[ai][bj][m][1];
                    u32x4 w; w.x = pk2(v0[0], v0[1]); w.y = pk2(v0[2], v0[3]); w.z = pk2(v1[0], v1[1]); w.w = pk2(v1[2], v1[3]);
                    *(u32x4*)(p + bj * 128) = w; } }
    }
};
struct EpiF32P {
    static constexpr bool PERM = true, AFTER_DRAIN = false, MIDK = false;
    float* C; long ldc;
    __device__ __forceinline__ void operator()(const pg8::f32x4 (&acc)[2][2][4][2], const pg8::Unit& u, int wr, int wc, int fr, int fq) const {
        const int row0 = u.pm * 256 + wr * 64 + fr; const int col0 = u.pn * 256 + wc * 32 + 8 * fq;
#pragma unroll
        for (int ai = 0; ai < 2; ++ai)
#pragma unroll
            for (int m = 0; m < 4; ++m) { float* p = C + (size_t)(row0 + ai * 128 + m * 16) * ldc + col0;
#pragma unroll
                for (int bj = 0; bj < 2; ++bj) { *(f32x4*)(p + bj * 128) = acc[ai][bj][m][0]; *(f32x4*)(p + bj * 128 + 4) = acc[ai][bj][m][1]; } }
    }
};
template <bool GA> struct ExpertOrderT {
    static constexpr bool GATHER = GA; const int* elist;
    LAS const int* tb; int nj, G, c;
    __device__ bool next(int i, pg8::Unit& u) const { const int L = i * G + c; const int pm = L / nj; if (pm >= tb[512]) return false; u.pm = pm; u.pn = tb[128 + pm] * nj + (L % nj); u.koff = 0; u.koffB = 0; return true; }
    __device__ __forceinline__ int row_tok(int pm, int r) const { const int e = tb[128 + pm]; const int q = tb[320 + pm] + r; return q < tb[e] ? elist[e * S + q] : 0; }
    __device__ __forceinline__ void a_ready(const pg8::Unit&) const {}
    __device__ __forceinline__ void done(const pg8::Unit&) const {}
};
struct EpiHid {
    static constexpr bool PERM = true, AFTER_DRAIN = false, MIDK = false;
    unsigned char* hid;
    __device__ __forceinline__ void operator()(const pg8::f32x4 (&acc)[2][2][4][2], const pg8::Unit& u, int wr, int wc, int fr, int fq) const {
        const int row0 = u.pm * 128 + wr * 64 + fr; const int col0 = (u.pn & 3) * 128 + wc * 32 + 8 * fq;
#pragma unroll
        for (int ai = 0; ai < 1; ++ai)
#pragma unroll
            for (int m = 0; m < 4; ++m) { const pg8::f32x4 g0 = acc[ai][0][m][0], g1 = acc[ai][0][m][1], u0 = acc[ai][1][m][0], u1 = acc[ai][1][m][1]; float o[8];
#pragma unroll
                for (int j = 0; j < 4; ++j) { o[j] = g0[j] * sigmoidf_(g0[j]) * u0[j]; o[4 + j] = g1[j] * sigmoidf_(g1[j]) * u1[j]; }
                u32x2 w; w.x = pk_fp8x4(o[0], o[1], o[2], o[3], 8.0f); w.y = pk_fp8x4(o[4], o[5], o[6], o[7], 8.0f);
                *(u32x2*)(hid + (size_t)(row0 + ai * 128 + m * 16) * FF + col0) = w; }
    }
};
struct EpiYbuf {
    static constexpr bool PERM = true, AFTER_DRAIN = false, MIDK = false;
    bf16* ybuf;
    __device__ __forceinline__ void operator()(const pg8::f32x4 (&acc)[2][2][4][2], const pg8::Unit& u, int wr, int wc, int fr, int fq) const {
        const int row0 = u.pm * 128 + wr * 64 + fr; const int col0 = (u.pn & 7) * 256 + wc * 32 + 8 * fq;
#pragma unroll
        for (int ai = 0; ai < 1; ++ai)
#pragma unroll
            for (int m = 0; m < 4; ++m) { bf16* p = ybuf + (size_t)(row0 + ai * 128 + m * 16) * D + col0;
#pragma unroll
                for (int bj = 0; bj < 2; ++bj) { const pg8::f32x4 v0 = acc[ai][bj][m][0], v1 = acc[ai][bj][m][1];
                    u32x4 w; w.x = pk2(v0[0], v0[1]); w.y = pk2(v0[2], v0[3]); w.z = pk2(v1[0], v1[1]); w.w = pk2(v1[2], v1[3]);
                    *(u32x4*)(p + bj * 128) = w; } }
    }
};
constexpr int RS8 = D + 8;

typedef short s16x4 __attribute__((ext_vector_type(4)));
constexpr int KST = 136, VST = 144;
constexpr int KT_BYTES = 64 * KST * 2, VT_BYTES = 64 * VST * 2;
constexpr int AT_BUF = KT_BYTES + VT_BYTES;
constexpr int AT_G = 2 * AT_BUF;
constexpr int AT_HIST = AT_G + 8 * 2112;
constexpr int AT_ITEMS = AT_HIST + 256;
constexpr int LIST_PER_HEAD = 256 * 496;
__device__ __forceinline__ int list_off(int j) { return 256 * (31 * j - (j * (j - 1)) / 2); }
__device__ __forceinline__ s16x4 tr_read4(unsigned addr) { return __builtin_amdgcn_ds_read_tr16_b64_v4i16((LAS s16x4*)(size_t)addr); }

struct AttnBufs { const bf16* q; const bf16* k; const bf16* v; const bf16* kmh; const bf16* kml; unsigned* mask; int* list; int* cnt; bf16* part; float* ml; };

__device__ __forceinline__ void moba_select_unit(LAS unsigned char* lds, const AttnBufs& A, int head, int qt, int tid, int lane, int wave) {
    const int q0 = qt * 128, qblk = qt >> 1, g4 = lane >> 4, c16 = lane & 15; const int myq = q0 + wave * 16 + c16;
    LAS int* hist = (LAS int*)(lds + AT_HIST); LAS int* base = hist + 32;
    if (tid < 32) hist[tid] = 0;
    __syncthreads();
    unsigned msk = 0u; int lp0 = 0, lp1 = 0, lp2 = 0, b0 = 0, b1 = 0, b2 = 0, nsel = 0;
    if (qblk > 0) {
        bf16x8 qf[4];
#pragma unroll
        for (int ks = 0; ks < 4; ++ks) qf[ks] = *(const bf16x8*)(A.q + (size_t)myq * AW + head * AD + 32 * ks + 8 * g4);
        f32x4 gs[2] = {(f32x4){0.f, 0.f, 0.f, 0.f}, (f32x4){0.f, 0.f, 0.f, 0.f}};
#pragma unroll
        for (int mt = 0; mt < 2; ++mt)
#pragma unroll
            for (int ks = 0; ks < 4; ++ks) { const size_t o = (size_t)(head * NB + 16 * mt + c16) * AD + 32 * ks + 8 * g4;
                gs[mt] = __builtin_amdgcn_mfma_f32_16x16x32_bf16(*(const bf16x8*)(A.kmh + o), qf[ks], gs[mt], 0, 0, 0);
                gs[mt] = __builtin_amdgcn_mfma_f32_16x16x32_bf16(*(const bf16x8*)(A.kml + o), qf[ks], gs[mt], 0, 0, 0); }
        LAS float* G = (LAS float*)(lds + AT_G + wave * 2112);
#pragma unroll
        for (int mt = 0; mt < 2; ++mt)
#pragma unroll
            for (int rg = 0; rg < 4; ++rg) G[c16 * 33 + 16 * mt + 4 * g4 + rg] = gs[mt][rg];
        LDS_WAIT(); asm volatile("" ::: "memory");
        if (lane < 16) {
            nsel = qblk < 3 ? qblk : 3;
            float gvv[32];
#pragma unroll
            for (int n = 0; n < 32; ++n) gvv[n] = G[lane * 33 + n];
#pragma unroll
            for (int n = 0; n < 32; ++n) gvv[n] = n < qblk ? gvv[n] : -3e38f;
#pragma unroll
            for (int t = 0; t < 3; ++t) if (t < nsel) { float best = -3e38f; int bi = 0;
#pragma unroll
                for (int n = 0; n < 32; ++n) { const bool take = gvv[n] > best; best = take ? gvv[n] : best; bi = take ? n : bi; }
#pragma unroll
                for (int n = 0; n < 32; ++n) gvv[n] = (n == bi) ? -3e38f : gvv[n];
                msk |= 1u << bi;
                const int lp = atomicAdd((int*)&hist[bi], 1); if (t == 0) { lp0 = lp; b0 = bi; } else if (t == 1) { lp1 = lp; b1 = bi; } else { lp2 = lp; b2 = bi; } }
        }
    }
    if (lane < 16) A.mask[head * S + myq] = msk;
    __syncthreads();
    if (tid < 32) { const int hcount = hist[tid]; base[tid] = hcount > 0 ? atomicAdd(A.cnt + (head * NB + tid) * ACNT_STR, hcount) : 0; }
    __syncthreads();
    if (lane < 16) { int* lh = A.list + head * LIST_PER_HEAD;
        if (nsel > 0) lh[list_off(b0) + base[b0] + lp0] = myq;
        if (nsel > 1) lh[list_off(b1) + base[b1] + lp1] = myq;
        if (nsel > 2) lh[list_off(b2) + base[b2] + lp2] = myq; }
    __syncthreads();
}

__device__ __forceinline__ void moba_item2(LAS unsigned char* lds, const AttnBufs& A, int head, int kvb, bool own, int r, int cntj, int tid, int lane, int wave) {
    const int g4 = lane >> 4, c16 = lane & 15;
    int myq[2]; bool valid[2];
    if (own) { myq[0] = kvb * MB + wave * 32 + c16; myq[1] = myq[0] + 16; valid[0] = true; valid[1] = true; }
    else { const int* lp = A.list + head * LIST_PER_HEAD + list_off(kvb);
#pragma unroll
        for (int g = 0; g < 2; ++g) { const int e = r * 256 + wave * 32 + 16 * g + c16; valid[g] = e < cntj; myq[g] = lp[valid[g] ? e : 0]; } }
    const bool wave_valid = own || (r * 256 + wave * 32 < cntj);
    const int qfirst = kvb * MB + wave * 32;
    bf16x8 qf[2][4];
#pragma unroll
    for (int g = 0; g < 2; ++g)
#pragma unroll
        for (int ks = 0; ks < 4; ++ks) qf[g][ks] = *(const bf16x8*)(A.q + (size_t)myq[g] * AW + head * AD + 32 * ks + 8 * g4);
    f32x4 oacc[2][8];
#pragma unroll
    for (int g = 0; g < 2; ++g)
#pragma unroll
        for (int dt = 0; dt < 8; ++dt) oacc[g][dt] = (f32x4){0.f, 0.f, 0.f, 0.f};
    float mrun[2] = {-1e30f, -1e30f}, lrun[2] = {0.f, 0.f};
    const float sc2 = 0.08838834764831845f * 1.4426950408889634f;
    const int r0 = tid >> 4, ch = tid & 15;
    u32x4 kr[2], vr[2];
    const bf16* kg = A.k + (size_t)(kvb * MB + r0) * AW + head * AD + 8 * ch; const bf16* vg = A.v + (size_t)(kvb * MB + r0) * AW + head * AD + 8 * ch;
    LAS unsigned char* kst = lds + (r0 * KST + 8 * ch) * 2; LAS unsigned char* vst = lds + KT_BYTES + (r0 * VST + 8 * ch) * 2;
    const LAS unsigned char* kld = lds + (c16 * KST + 8 * g4) * 2; const LAS unsigned char* vld = lds + KT_BYTES + ((4 * g4 + (c16 >> 2)) * VST + 4 * (c16 & 3)) * 2;
#define GLD(it) do { kr[0] = *(const u32x4*)(kg + (size_t)(64 * (it)) * AW); kr[1] = *(const u32x4*)(kg + (size_t)(64 * (it) + 32) * AW); vr[0] = *(const u32x4*)(vg + (size_t)(64 * (it)) * AW); vr[1] = *(const u32x4*)(vg + (size_t)(64 * (it) + 32) * AW); } while (0)
#define LST(b) do { *(LAS u32x4*)(kst + (b) * AT_BUF) = kr[0]; *(LAS u32x4*)(kst + (b) * AT_BUF + 32 * KST * 2) = kr[1]; *(LAS u32x4*)(vst + (b) * AT_BUF) = vr[0]; *(LAS u32x4*)(vst + (b) * AT_BUF + 32 * VST * 2) = vr[1]; } while (0)
    GLD(0); LST(0);
    __syncthreads();
#pragma nounroll
    for (int it = 0; it < 4; ++it) {
        const int kp0 = kvb * MB + 64 * it; const int b = it & 1;
        if (it + 1 < 4) GLD(it + 1);
        if (wave_valid && (!own || kp0 <= qfirst + 31)) {
            const LAS unsigned char* Kb = kld + b * AT_BUF; const LAS unsigned char* vb = vld + b * AT_BUF;
            f32x4 st[2][4];
#pragma unroll
            for (int mt = 0; mt < 4; ++mt) { st[0][mt] = (f32x4){0.f, 0.f, 0.f, 0.f}; st[1][mt] = st[0][mt];
#pragma unroll
                for (int ks = 0; ks < 4; ++ks) { const bf16x8 kf = *(const LAS bf16x8*)(Kb + (16 * mt * KST + 32 * ks) * 2);
                    st[0][mt] = __builtin_amdgcn_mfma_f32_16x16x32_bf16(kf, qf[0][ks], st[0][mt], 0, 0, 0);
                    st[1][mt] = __builtin_amdgcn_mfma_f32_16x16x32_bf16(kf, qf[1][ks], st[1][mt], 0, 0, 0); } }
            bf16x8 pf[2][2];
#pragma unroll
            for (int g = 0; g < 2; ++g) {
                if (own && kp0 + 63 > qfirst + 16 * g) {
#pragma unroll
                    for (int mt = 0; mt < 4; ++mt)
#pragma unroll
                        for (int rg = 0; rg < 4; ++rg) { const int kpos = kp0 + 16 * mt + 4 * g4 + rg; st[g][mt][rg] = (kpos <= myq[g]) ? st[g][mt][rg] : -1e30f; }
                }
                float mloc = fmaxf(fmaxf(fmaxf(st[g][0][0], st[g][0][1]), fmaxf(st[g][0][2], st[g][0][3])), fmaxf(fmaxf(st[g][1][0], st[g][1][1]), fmaxf(st[g][1][2], st[g][1][3])));
                mloc = fmaxf(mloc, fmaxf(fmaxf(fmaxf(st[g][2][0], st[g][2][1]), fmaxf(st[g][2][2], st[g][2][3])), fmaxf(fmaxf(st[g][3][0], st[g][3][1]), fmaxf(st[g][3][2], st[g][3][3]))));
                mloc = fmaxf(mloc, __shfl_xor(mloc, 16)); mloc = fmaxf(mloc, __shfl_xor(mloc, 32));
                const float mnew = fmaxf(mrun[g], mloc * sc2); const float alpha = __builtin_amdgcn_exp2f(mrun[g] - mnew); mrun[g] = mnew;
                float psum = 0.f;
#pragma unroll
                for (int mt = 0; mt < 4; ++mt)
#pragma unroll
                    for (int rg = 0; rg < 4; ++rg) { const float p = __builtin_amdgcn_exp2f(fmaf(st[g][mt][rg], sc2, -mnew)); st[g][mt][rg] = p; psum += p; }
                lrun[g] = lrun[g] * alpha + psum;
#pragma unroll
                for (int dt = 0; dt < 8; ++dt) oacc[g][dt] = oacc[g][dt] * alpha;
#pragma unroll
                for (int s = 0; s < 2; ++s) { u32x4 w; w.x = pk2(st[g][2 * s][0], st[g][2 * s][1]); w.y = pk2(st[g][2 * s][2], st[g][2 * s][3]); w.z = pk2(st[g][2 * s + 1][0], st[g][2 * s + 1][1]); w.w = pk2(st[g][2 * s + 1][2], st[g][2 * s + 1][3]);
                    pf[g][s] = __builtin_bit_cast(bf16x8, w); }
            }
#pragma unroll
            for (int dt = 0; dt < 8; ++dt)
#pragma unroll
                for (int s = 0; s < 2; ++s) {
                    const s16x4 lo = __builtin_amdgcn_ds_read_tr16_b64_v4i16((LAS s16x4*)(vb + (32 * s * VST + 16 * dt) * 2));
                    const s16x4 hi = __builtin_amdgcn_ds_read_tr16_b64_v4i16((LAS s16x4*)(vb + ((32 * s + 16) * VST + 16 * dt) * 2));
                    bf16x8 vf; vf[0] = lo[0]; vf[1] = lo[1]; vf[2] = lo[2]; vf[3] = lo[3]; vf[4] = hi[0]; vf[5] = hi[1]; vf[6] = hi[2]; vf[7] = hi[3];
                    oacc[0][dt] = __builtin_amdgcn_mfma_f32_16x16x32_bf16(vf, pf[0][s], oacc[0][dt], 0, 0, 0);
                    oacc[1][dt] = __builtin_amdgcn_mfma_f32_16x16x32_bf16(vf, pf[1][s], oacc[1][dt], 0, 0, 0); }
        }
        if (it + 1 < 4) LST(b ^ 1);
        __syncthreads();
    }
#undef GLD
#undef LST
#pragma unroll
    for (int g = 0; g < 2; ++g) {
        float l = lrun[g]; l += __shfl_xor(l, 16); l += __shfl_xor(l, 32);
        if (valid[g] && wave_valid) {
            int slot = 0; if (!own) { const unsigned mk = A.mask[head * S + myq[g]]; slot = 1 + __builtin_popcount(mk & ((1u << kvb) - 1u)); }
            const size_t pidx = ((size_t)(head * S + myq[g])) * 4 + slot;
            const float inv = 1.0f / l;
            bf16* orow = A.part + pidx * AD + 4 * g4;
#pragma unroll
            for (int dt = 0; dt < 8; ++dt) { u32x2 w; w.x = pk2(oacc[g][dt][0] * inv, oacc[g][dt][1] * inv); w.y = pk2(oacc[g][dt][2] * inv, oacc[g][dt][3] * inv); *(u32x2*)(orow + 16 * dt) = w; }
            if (g4 == 0) { A.ml[pidx * 2] = mrun[g]; A.ml[pidx * 2 + 1] = l; }
        }
    }
}
__device__ __forceinline__ void moba_items(LAS unsigned char* lds, const AttnBufs& A, int* qhead, LAS int* pre, LAS int* tick, int tid, int lane, int wave) {
    const int nitems = AH * NB + pre[256];
    if (tid == 0) tick[0] = atomicAdd(qhead, 1);
    __syncthreads();
    int item = tick[0];
    while (item < nitems) {
        __syncthreads();
        if (tid == 0) tick[0] = atomicAdd(qhead, 1);
        if (item < AH * NB) moba_item2(lds, A, item >> 5, item & 31, true, 0, 0, tid, lane, wave);
        else { const int s = item - AH * NB; int lo_ = 0, hi_ = 256;
            while (hi_ - lo_ > 1) { const int mid = (lo_ + hi_) >> 1; if (pre[mid] <= s) lo_ = mid; else hi_ = mid; }
            moba_item2(lds, A, lo_ >> 5, lo_ & 31, false, s - pre[lo_], A.cnt[lo_ * ACNT_STR], tid, lane, wave); }
        __syncthreads();
        item = tick[0];
    }
}

constexpr int RST = 72, SLOTB = 64 * RST * 2;
constexpr int NCH = S / 64;
__device__ __forceinline__ bf16x8 frag_rows(const LAS bf16* M, int r0, int k0, int c16, int g4) { return *(const LAS bf16x8*)(M + (r0 + c16) * RST + k0 + 8 * g4); }
__device__ __forceinline__ bf16x8 frag_cols(const LAS bf16* M, int c0, int k0, int c16, int g4) {
    const unsigned base = (unsigned)(size_t)M; const int tq = c16 >> 2, tp = c16 & 3;
    const s16x4 lo = tr_read4(base + ((k0 + 8 * g4 + tq) * RST + c0 + 4 * tp) * 2);
    const s16x4 hi = tr_read4(base + ((k0 + 8 * g4 + 4 + tq) * RST + c0 + 4 * tp) * 2);
    bf16x8 r; r[0] = lo[0]; r[1] = lo[1]; r[2] = lo[2]; r[3] = lo[3]; r[4] = hi[0]; r[5] = hi[1]; r[6] = hi[2]; r[7] = hi[3]; return r;
}
__device__ __forceinline__ void st_tile(LAS bf16* M, const f32x4 v, int r0, int c0, int c16, int g4) {
#pragma unroll
    for (int rg = 0; rg < 4; rg += 2) { const unsigned p = pk2(v[rg], v[rg + 1]); M[(r0 + 4 * g4 + rg) * RST + c0 + c16] = (bf16)(p & 0xffffu); M[(r0 + 4 * g4 + rg + 1) * RST + c0 + c16] = (bf16)(p >> 16); }
}
#define MFMA16(a, b, c) __builtin_amdgcn_mfma_f32_16x16x32_bf16(a, b, c, 0, 0, 0)

struct RwkvBufs { const bf16* rkv; const float* lw; const bf16* av; bf16* P; float* QmT; bf16* Rt; bf16* Yi; float* bonus; };

#define R1_BAR() do { asm volatile("s_waitcnt lgkmcnt(0)" ::: "memory"); __builtin_amdgcn_s_barrier(); asm volatile("" ::: "memory"); } while (0)
struct R1In { float lwv[8], av[8], rr[9], kr[9], vr[9]; };
__device__ __forceinline__ void rwkv_r1_load(R1In& I, const RwkvBufs& B, int head, int chunk, int lane, int wave) {
    const int ch = head * RN + lane; const int t0 = chunk * 64 + wave * 8;
#pragma unroll
    for (int i = 0; i < 8; ++i) { I.lwv[i] = B.lw[(size_t)(t0 + i) * RW + ch]; I.av[i] = bf2f(B.av[(size_t)(t0 + i) * RW + ch]); }
#pragma unroll
    for (int i = 0; i < 9; ++i) { const int t = t0 - 1 + i; if (t >= 0) { const bf16* cr = B.rkv + (size_t)t * (3 * RW) + ch; I.rr[i] = bf2f(cr[0]); I.kr[i] = bf2f(cr[RW]); I.vr[i] = bf2f(cr[2 * RW]); } else { I.rr[i] = 0.f; I.kr[i] = 0.f; I.vr[i] = 0.f; } }
}
__device__ __forceinline__ void rwkv_r1_unit(LAS unsigned char* lds, const RwkvBufs& B, const float* const* in, R1In& I, int head, int chunk, int nhead, int nchunk, int tid, int lane, int wave) {
    LAS bf16* sA = (LAS bf16*)(lds + 0 * SLOTB); LAS bf16* sB = (LAS bf16*)(lds + 1 * SLOTB); LAS bf16* sK = (LAS bf16*)(lds + 2 * SLOTB); LAS bf16* sR = (LAS bf16*)(lds + 3 * SLOTB); LAS bf16* sV = (LAS bf16*)(lds + 4 * SLOTB);
    LAS bf16* sM0 = (LAS bf16*)(lds + 5 * SLOTB); LAS bf16* sM1 = (LAS bf16*)(lds + 6 * SLOTB); LAS bf16* sT0 = (LAS bf16*)(lds + 7 * SLOTB); LAS bf16* sT1 = (LAS bf16*)(lds + 8 * SLOTB);
    LAS bf16* sLak = (LAS bf16*)(lds + 9 * SLOTB); LAS bf16* sMrb = (LAS bf16*)(lds + 10 * SLOTB); LAS bf16* sMrk = (LAS bf16*)(lds + 11 * SLOTB); LAS bf16* sX = (LAS bf16*)(lds + 12 * SLOTB);
    LAS bf16* sW = (LAS bf16*)(lds + 13 * SLOTB); LAS bf16* sU = (LAS bf16*)(lds + 14 * SLOTB);
    LAS float* cs = (LAS float*)(lds + 15 * SLOTB); LAS float* gC = cs + 512;
    const int c16 = lane & 15, g4 = lane >> 4;
    {
        const int ch = head * RN + lane; const int t0 = chunk * 64 + wave * 8;
        const float mur = in[9][ch], muk = in[10][ch], muv = in[11][ch], kkc = in[23][ch], kac = in[24][ch], rkc = in[25][ch];
        float run = 0.f;
#pragma unroll
        for (int i = 0; i < 8; ++i) run += I.lwv[i];
        cs[wave * 64 + lane] = run;
        R1_BAR();
        float off = 0.f;
        for (int w = 0; w < wave; ++w) off += cs[w * 64 + lane];
        float gcur = off;
#pragma unroll
        for (int i = 0; i < 8; ++i) {
            const int t = t0 + i;
            const float r0 = I.rr[i + 1], k0 = I.kr[i + 1], v0 = I.vr[i + 1], rp = I.rr[i], kp = I.kr[i], vp = I.vr[i];
            const float r = r0 + (rp - r0) * mur, kx = k0 + (kp - k0) * muk, vx = v0 + (vp - v0) * muv;
            const float a = I.av[i];
            float kk = kx * kkc; const float ss = wave_sum(kk * kk); kk = kk * __builtin_amdgcn_rcpf(fmaxf(sqrtf(ss), 1e-12f));
            const float kt = kx * (1.0f + (a - 1.0f) * kac);
            const float bn = wave_sum(r * kt * rkc);
            if (lane == 0) B.bonus[(size_t)t * RH + head] = bn;
            const float gprev = gcur; gcur += I.lwv[i];
            const float eg = __expf(gcur), egp = __expf(gprev), eng = __expf(-gcur);
            const int tl = wave * 8 + i;
            { const unsigned pab = pk2(-kk * egp, kk * a * eng), pkr = pk2(kt * eng, r * eg), pv_ = pk2(vx, vx);
              sA[tl * RST + lane] = (bf16)(pab & 0xffffu); sB[tl * RST + lane] = (bf16)(pab >> 16); sK[tl * RST + lane] = (bf16)(pkr & 0xffffu); sR[tl * RST + lane] = (bf16)(pkr >> 16); sV[tl * RST + lane] = (bf16)(pv_ & 0xffffu); }
        }
        if (wave == 7) gC[lane] = __expf(gcur);
    }
    if (nhead >= 0) rwkv_r1_load(I, B, nhead, nchunk, lane, wave);
    R1_BAR();
    const int mt = wave >> 1, ntb = 2 * (wave & 1);
    f32x4 Treg[2];
    for (int r14 = 0; r14 < 1 + REP_R1A; ++r14) {
        f32x4 ab[2], ak[2], rb[2], rk[2];
#pragma unroll
        for (int n = 0; n < 2; ++n) { ab[n] = (f32x4){0.f, 0.f, 0.f, 0.f}; ak[n] = ab[n]; rb[n] = ab[n]; rk[n] = ab[n]; }
#pragma unroll
        for (int s = 0; s < 2; ++s) { const bf16x8 aA = frag_rows(sA, 16 * mt, 32 * s, c16, g4), aR = frag_rows(sR, 16 * mt, 32 * s, c16, g4);
#pragma unroll
            for (int n = 0; n < 2; ++n) { const bf16x8 bB = frag_rows(sB, 16 * (ntb + n), 32 * s, c16, g4), bK = frag_rows(sK, 16 * (ntb + n), 32 * s, c16, g4);
                ab[n] = MFMA16(aA, bB, ab[n]); ak[n] = MFMA16(aA, bK, ak[n]); rb[n] = MFMA16(aR, bB, rb[n]); rk[n] = MFMA16(aR, bK, rk[n]); } }
#pragma unroll
        for (int n = 0; n < 2; ++n) { const int i = 16 * (ntb + n) + c16;
#pragma unroll
            for (int rg = 0; rg < 4; ++rg) { const int t = 16 * mt + 4 * g4 + rg; const bool lo = i < t, le = i <= t;
                ab[n][rg] = lo ? ab[n][rg] : 0.f; ak[n][rg] = lo ? ak[n][rg] : 0.f; rb[n][rg] = le ? rb[n][rg] : 0.f; rk[n][rg] = le ? rk[n][rg] : 0.f;
                Treg[n][rg] = ab[n][rg] + (i == t ? 1.0f : 0.f); }
            st_tile(sM0, ab[n], 16 * mt, 16 * (ntb + n), c16, g4); st_tile(sT0, Treg[n], 16 * mt, 16 * (ntb + n), c16, g4);
            st_tile(sLak, ak[n], 16 * mt, 16 * (ntb + n), c16, g4); st_tile(sMrb, rb[n], 16 * mt, 16 * (ntb + n), c16, g4); st_tile(sMrk, rk[n], 16 * mt, 16 * (ntb + n), c16, g4); }
    }
    R1_BAR();
    LAS bf16* Tc = sT0; LAS bf16* Tn = sT1; LAS bf16* Mc = sM0; LAS bf16* Mn = sM1;
    {
        f32x4 am[2] = {(f32x4){0.f, 0.f, 0.f, 0.f}, (f32x4){0.f, 0.f, 0.f, 0.f}}, ax[2] = {(f32x4){0.f, 0.f, 0.f, 0.f}, (f32x4){0.f, 0.f, 0.f, 0.f}};
#pragma unroll
        for (int s = 0; s < 2; ++s) { const bf16x8 aM = frag_rows(Mc, 16 * mt, 32 * s, c16, g4), aL = frag_rows(sLak, 16 * mt, 32 * s, c16, g4);
#pragma unroll
            for (int n = 0; n < 2; ++n) { am[n] = MFMA16(aM, frag_cols(Mc, 16 * (ntb + n), 32 * s, c16, g4), am[n]); ax[n] = MFMA16(aL, frag_cols(sV, 16 * (ntb + n), 32 * s, c16, g4), ax[n]); } }
#pragma unroll
        for (int n = 0; n < 2; ++n) { st_tile(Mn, am[n], 16 * mt, 16 * (ntb + n), c16, g4); st_tile(sX, ax[n], 16 * mt, 16 * (ntb + n), c16, g4); }
        R1_BAR();
        LAS bf16* t2 = Mc; Mc = Mn; Mn = t2;
    }
    for (int kround = 1; kround <= 5 + REP_R1NR; ++kround) {
        f32x4 am[2] = {(f32x4){0.f, 0.f, 0.f, 0.f}, (f32x4){0.f, 0.f, 0.f, 0.f}};
#pragma unroll
        for (int s = 0; s < 2; ++s) { const bf16x8 aT = frag_rows(Tc, 16 * mt, 32 * s, c16, g4), aM = frag_rows(Mc, 16 * mt, 32 * s, c16, g4);
#pragma unroll
            for (int n = 0; n < 2; ++n) { const bf16x8 bM = frag_cols(Mc, 16 * (ntb + n), 32 * s, c16, g4); Treg[n] = MFMA16(aT, bM, Treg[n]); am[n] = MFMA16(aM, bM, am[n]); } }
#pragma unroll
        for (int n = 0; n < 2; ++n) { st_tile(Tn, Treg[n], 16 * mt, 16 * (ntb + n), c16, g4); st_tile(Mn, am[n], 16 * mt, 16 * (ntb + n), c16, g4); }
        R1_BAR();
        LAS bf16* t1 = Tc; Tc = Tn; Tn = t1; LAS bf16* t2 = Mc; Mc = Mn; Mn = t2;
    }
    for (int rwu = 0; rwu < 1 + REP_R1B; ++rwu) {
        f32x4 aw[2] = {(f32x4){0.f, 0.f, 0.f, 0.f}, (f32x4){0.f, 0.f, 0.f, 0.f}}, au[2] = {(f32x4){0.f, 0.f, 0.f, 0.f}, (f32x4){0.f, 0.f, 0.f, 0.f}};
#pragma unroll
        for (int s = 0; s < 2; ++s) { const bf16x8 aT = frag_rows(Tc, 16 * mt, 32 * s, c16, g4);
#pragma unroll
            for (int n = 0; n < 2; ++n) { aw[n] = MFMA16(aT, frag_cols(sA, 16 * (ntb + n), 32 * s, c16, g4), aw[n]); au[n] = MFMA16(aT, frag_cols(sX, 16 * (ntb + n), 32 * s, c16, g4), au[n]); } }
#pragma unroll
        for (int n = 0; n < 2; ++n) { st_tile(sW, aw[n], 16 * mt, 16 * (ntb + n), c16, g4); st_tile(sU, au[n], 16 * mt, 16 * (ntb + n), c16, g4); }
    }
    R1_BAR();
    for (int rs8 = 0; rs8 < 1 + REP_R1C; ++rs8) {
        const size_t ub = (size_t)(head * NCH + chunk) * 4096;
        f32x4 pp[2], qq[2], rr[2], yy[2];
#pragma unroll
        for (int n = 0; n < 2; ++n) { pp[n] = (f32x4){0.f, 0.f, 0.f, 0.f}; qq[n] = pp[n]; rr[n] = pp[n]; yy[n] = pp[n]; }
#pragma unroll
        for (int s = 0; s < 2; ++s) {
            const bf16x8 cW = frag_cols(sW, 16 * mt, 32 * s, c16, g4), cB = frag_cols(sB, 16 * mt, 32 * s, c16, g4), cK = frag_cols(sK, 16 * mt, 32 * s, c16, g4), cU = frag_cols(sU, 16 * mt, 32 * s, c16, g4), cV = frag_cols(sV, 16 * mt, 32 * s, c16, g4);
#pragma unroll
            for (int n = 0; n < 2; ++n) { const int c0 = 16 * (ntb + n);
                const bf16x8 bB = frag_cols(sB, c0, 32 * s, c16, g4), bU = frag_cols(sU, c0, 32 * s, c16, g4), bV = frag_cols(sV, c0, 32 * s, c16, g4);
                const bf16x8 rMrb = frag_rows(sMrb, c0, 32 * s, c16, g4), rMrk = frag_rows(sMrk, c0, 32 * s, c16, g4);
                pp[n] = MFMA16(cW, bB, pp[n]);
                qq[n] = MFMA16(cB, bU, qq[n]); qq[n] = MFMA16(cK, bV, qq[n]);
                rr[n] = MFMA16(cW, rMrb, rr[n]);
                yy[n] = MFMA16(cU, rMrb, yy[n]); yy[n] = MFMA16(cV, rMrk, yy[n]); } }
#pragma unroll
        for (int n = 0; n < 2; ++n) { const int j = 16 * (ntb + n) + c16; const int i0 = 16 * mt + 4 * g4;
            {
                const float gc = gC[j]; float o[4];
#pragma unroll
                for (int rg = 0; rg < 4; ++rg) o[rg] = gc * (pp[n][rg] + ((i0 + rg) == j ? 1.0f : 0.f));
                u32x2 w; w.x = pk2(o[0], o[1]); w.y = pk2(o[2], o[3]); *(u32x2*)(B.P + ub + (size_t)j * 64 + i0) = w; }
            {
                f32x4 o;
#pragma unroll
                for (int rg = 0; rg < 4; ++rg) o[rg] = gC[i0 + rg] * qq[n][rg];
                *(f32x4*)(B.QmT + ub + (size_t)j * 64 + i0) = o; }
            {
                const u32x2 rb2 = *(const LAS u32x2*)(sR + j * RST + i0); float o[4];
                o[0] = rr[n][0] + __uint_as_float(rb2.x << 16); o[1] = rr[n][1] + __uint_as_float(rb2.x & 0xffff0000u); o[2] = rr[n][2] + __uint_as_float(rb2.y << 16); o[3] = rr[n][3] + __uint_as_float(rb2.y & 0xffff0000u);
                u32x2 w; w.x = pk2(o[0], o[1]); w.y = pk2(o[2], o[3]); *(u32x2*)(B.Rt + ub + (size_t)j * 64 + i0) = w; }
            { u32x2 w; w.x = pk2(yy[n][0], yy[n][1]); w.y = pk2(yy[n][2], yy[n][3]); *(u32x2*)(B.Yi + ub + (size_t)j * 64 + i0) = w; }
        }
    }
    R1_BAR();
}

constexpr int R2_PST = 136, R2_QST = 272, R2_QOFF = 64 * R2_PST, R2_SLOT = R2_QOFF + 16 * R2_QST;
__device__ __forceinline__ void rwkv_r2_wg(LAS unsigned char* lds, const bf16* __restrict__ P, const float* __restrict__ QmT, bf16* __restrict__ H0T, int head, int cg, int wave, int lane) {
    const int c16 = lane & 15, g4 = lane >> 4;
    const int lt = ((wave & 3) << 6) | lane;
#define R2_BAR() do { asm volatile("s_waitcnt lgkmcnt(0)" ::: "memory"); __builtin_amdgcn_s_barrier(); asm volatile("" ::: "memory"); } while (0)
    if (wave >= 4) {
        constexpr int NST = 8;
        u32x4 st[NST][3];
        auto gl = [&](int c, u32x4 (&r)[3]) { const size_t ub = (size_t)(head * NCH + c) * 4096;
            const u32x4* p = (const u32x4*)(P + ub); const u32x4* q = (const u32x4*)(QmT + ub + (size_t)(16 * cg) * 64);
            r[0] = p[lt]; r[1] = p[lt + 256]; r[2] = q[lt]; };
        auto lw = [&](int slot, const u32x4 (&r)[3]) { LAS unsigned char* s = lds + slot * R2_SLOT;
#pragma unroll
            for (int i = 0; i < 2; ++i) { const int idx = lt + 256 * i; LAS u32x2* d = (LAS u32x2*)(s + (idx >> 3) * R2_PST + (idx & 7) * 16); u32x2 a; a.x = r[i].x; a.y = r[i].y; u32x2 b; b.x = r[i].z; b.y = r[i].w; d[0] = a; d[1] = b; }
            *(LAS u32x4*)(s + R2_QOFF + (lt >> 4) * R2_QST + (lt & 15) * 16) = r[2]; };
#pragma unroll
        for (int j = 0; j < NST; ++j) gl(j, st[j]);
        lw(0, st[0]); gl(NST, st[0]);
        R2_BAR();
        for (int c4 = 0; c4 < NCH / NST; ++c4) {
#pragma unroll
            for (int j = 0; j < NST; ++j) { const int c = NST * c4 + j;
                if (c + 1 < NCH) lw((c + 1) & 1, st[(j + 1) % NST]);
                if (c + 1 + NST < NCH) gl(c + 1 + NST, st[(j + 1) % NST]);
                R2_BAR(); }
        }
    } else if (wave == 0) {
        f32x4 hacc[4];
#pragma unroll
        for (int m = 0; m < 4; ++m) hacc[m] = (f32x4){0.f, 0.f, 0.f, 0.f};
        R2_BAR();
        for (int c = 0; c < NCH; ++c) {
            const LAS unsigned char* s = lds + (c & 1) * R2_SLOT; const size_t ub = (size_t)(head * NCH + c) * 4096;
            bf16x8 af[4][2]; f32x4 qv[4];
#pragma unroll
            for (int m = 0; m < 4; ++m) { qv[m] = *(const LAS f32x4*)(s + R2_QOFF + c16 * R2_QST + (16 * m + 4 * g4) * 4);
#pragma unroll
                for (int sx = 0; sx < 2; ++sx) { const LAS unsigned char* pr = s + (16 * m + c16) * R2_PST + (32 * sx + 4 * g4) * 2; const u32x2 a = *(const LAS u32x2*)pr, b = *(const LAS u32x2*)(pr + 32);
                    u32x4 w; w.x = a.x; w.y = a.y; w.z = b.x; w.w = b.y; af[m][sx] = __builtin_bit_cast(bf16x8, w); } }
            bf16x8 bfr[2];
#pragma unroll
            for (int sx = 0; sx < 2; ++sx) { u32x4 w; w.x = pk2(hacc[2 * sx][0], hacc[2 * sx][1]); w.y = pk2(hacc[2 * sx][2], hacc[2 * sx][3]); w.z = pk2(hacc[2 * sx + 1][0], hacc[2 * sx + 1][1]); w.w = pk2(hacc[2 * sx + 1][2], hacc[2 * sx + 1][3]);
                bfr[sx] = __builtin_bit_cast(bf16x8, w);
                u32x2 h0; h0.x = w.x; h0.y = w.y; *(u32x2*)(H0T + ub + (size_t)(16 * cg + c16) * 64 + 16 * (2 * sx) + 4 * g4) = h0;
                u32x2 h1; h1.x = w.z; h1.y = w.w; *(u32x2*)(H0T + ub + (size_t)(16 * cg + c16) * 64 + 16 * (2 * sx + 1) + 4 * g4) = h1; }
#pragma unroll
            for (int m = 0; m < 4; ++m) { hacc[m] = MFMA16(af[m][0], bfr[0], qv[m]); hacc[m] = MFMA16(af[m][1], bfr[1], hacc[m]); }
            R2_BAR();
        }
    } else {
        for (int c = 0; c <= NCH; ++c) R2_BAR();
    }
#undef R2_BAR
}

__device__ __forceinline__ f32x4 ld_bf4(const bf16* p) { const u32x2 w = *(const u32x2*)p; return (f32x4){__uint_as_float(w.x << 16), __uint_as_float(w.x & 0xffff0000u), __uint_as_float(w.y << 16), __uint_as_float(w.y & 0xffff0000u)}; }
__device__ __forceinline__ void rwkv_r3_wave(const RwkvBufs& B, const bf16* __restrict__ H0T, const float* const* in, const bf16* __restrict__ gv, bf16* __restrict__ ocat, int head, int chunk, int nt, int lane) {
    const int c16 = lane & 15, g4 = lane >> 4; const size_t ub = (size_t)(head * NCH + chunk) * 4096;
    const int t = chunk * 64 + 16 * nt + c16;
    bf16x8 rf[2], hf[4][2]; f32x4 y[4], gw[4], gb[4], muv[4], gg[4], v0[4], vp[4];
#pragma unroll
    for (int s = 0; s < 2; ++s) rf[s] = *(const bf16x8*)(B.Rt + ub + (size_t)(16 * nt + c16) * 64 + 32 * s + 8 * g4);
#pragma unroll
    for (int m = 0; m < 4; ++m) { y[m] = ld_bf4(B.Yi + ub + (size_t)(16 * nt + c16) * 64 + 16 * m + 4 * g4);
#pragma unroll
        for (int s = 0; s < 2; ++s) hf[m][s] = *(const bf16x8*)(H0T + ub + (size_t)(16 * m + c16) * 64 + 32 * s + 8 * g4); }
    const float bn = B.bonus[(size_t)t * RH + head];
#pragma unroll
    for (int m = 0; m < 4; ++m) { const int ch = head * RN + 16 * m + 4 * g4;
        gw[m] = *(const f32x4*)(in[26] + ch); gb[m] = *(const f32x4*)(in[27] + ch); muv[m] = *(const f32x4*)(in[11] + ch); gg[m] = ld_bf4(gv + (size_t)t * RW + ch);
        v0[m] = ld_bf4(B.rkv + (size_t)t * (3 * RW) + 2 * RW + ch); vp[m] = (f32x4){0.f, 0.f, 0.f, 0.f}; if (t > 0) vp[m] = ld_bf4(B.rkv + (size_t)(t - 1) * (3 * RW) + 2 * RW + ch); }
    float s1 = 0.f;
#pragma unroll
    for (int m = 0; m < 4; ++m) {
#pragma unroll
        for (int s = 0; s < 2; ++s) y[m] = MFMA16(hf[m][s], rf[s], y[m]);
        s1 += (y[m][0] + y[m][1]) + (y[m][2] + y[m][3]); }
    s1 += __shfl_xor(s1, 16); s1 += __shfl_xor(s1, 32);
    const float mean = s1 * (1.0f / 64.0f); float s2 = 0.f;
#pragma unroll
    for (int m = 0; m < 4; ++m) { y[m] = y[m] - mean; s2 += (y[m][0] * y[m][0] + y[m][1] * y[m][1]) + (y[m][2] * y[m][2] + y[m][3] * y[m][3]); }
    s2 += __shfl_xor(s2, 16); s2 += __shfl_xor(s2, 32);
    const float rstd = rsqrtf(s2 * (1.0f / 64.0f) + 64e-5f);
#pragma unroll
    for (int m = 0; m < 4; ++m) { const int ch = head * RN + 16 * m + 4 * g4;
        const f32x4 vx = v0[m] + (vp[m] - v0[m]) * muv[m];
        const f32x4 o = (y[m] * rstd * gw[m] + gb[m] + vx * bn) * gg[m];
        u32x2 w; w.x = pk2(o[0], o[1]); w.y = pk2(o[2], o[3]); *(u32x2*)(ocat + (size_t)t * (2 * RW) + RW + ch) = w; }
}
template <int WHICH> struct Lora2Order { static constexpr bool GATHER = false; const int* tok; int G, c;
    __device__ bool next(int i, pg8::Unit& u) const { const int L = i * G + c; if (L >= (S / 128) * 4) return false; u.pm = L >> 2; u.pn = WHICH * 4 + (L & 3); u.koff = WHICH * 512; u.koffB = 0; return true; }
    __device__ __forceinline__ void a_ready(const pg8::Unit&) const {}
    __device__ __forceinline__ void done(const pg8::Unit&) const {} };
template <int WHICH> struct EpiLora2 {
    static constexpr bool PERM = true, AFTER_DRAIN = false, MIDK = false;
    void* dst; const float* bias;
    __device__ __forceinline__ void operator()(const pg8::f32x4 (&acc)[2][2][4][2], const pg8::Unit& u, int wr, int wc, int fr, int fq) const {
        const int row0 = u.pm * 128 + wr * 64 + fr; const int col0 = (u.pn & 3) * 256 + wc * 32 + 8 * fq;
#pragma unroll
        for (int ai = 0; ai < 1; ++ai)
#pragma unroll
            for (int m = 0; m < 4; ++m) { const size_t off = (size_t)(row0 + ai * 128 + m * 16) * RW + col0;
#pragma unroll
                for (int bj = 0; bj < 2; ++bj) { f32x4 v0 = acc[ai][bj][m][0], v1 = acc[ai][bj][m][1];
                    if (WHICH < 2) { const f32x4 b0 = *(const f32x4*)(bias + col0 + bj * 128), b1 = *(const f32x4*)(bias + col0 + bj * 128 + 4);
#pragma unroll
                        for (int j = 0; j < 4; ++j) { v0[j] = sigmoidf_(v0[j] + b0[j]); v1[j] = sigmoidf_(v1[j] + b1[j]); }
                        if (WHICH == 0) { v0 = v0 * -0.60653065971263342f; v1 = v1 * -0.60653065971263342f; } }
                    if (WHICH == 0) { float* p = (float*)dst + off + bj * 128; *(f32x4*)p = v0; *(f32x4*)(p + 4) = v1; }
                    else { u32x4 w; w.x = pk2(v0[0], v0[1]); w.y = pk2(v0[2], v0[3]); w.z = pk2(v1[0], v1[1]); w.w = pk2(v1[2], v1[3]); *(u32x4*)((bf16*)dst + off + bj * 128) = w; } } }
    }
};

__global__ void __launch_bounds__(NTHR, 2) fwd(Args args) {
    extern __shared__ __attribute__((aligned(16))) unsigned char lds_raw[];
    LAS unsigned char* lds = (LAS unsigned char*)lds_raw;
    const int wave = __builtin_amdgcn_readfirstlane(threadIdx.x >> 6);
    const int G = gridDim.x, wg = blockIdx.x;
    unsigned char* ws = args.ws;
    unsigned* ctl = (unsigned*)(ws + WS_CTL);
    if (threadIdx.x < 4) ((LAS unsigned*)(lds + LDSCTL_OFF))[threadIdx.x] = 0u;
    __syncthreads();
    XcdBarrier bar = xcd_barrier_post(ctl + CW_BAR, (volatile LAS unsigned*)(lds + LDSCTL_OFF));
    const int lo = args.ph_lo, hi = args.ph_hi;
#define IN(k) (lo <= (k) && (k) < hi)
#define PH(k) for (int rep_ = 0; rep_ < ((k) == REP_PHASE ? 1 + REP_N : 1); ++rep_) if (IN(k))
#define SEAM(k) do { if (IN(k) && IN((k) + 1)) xcd_barrier(bar); } while (0)
#define ROUTE_TABLE() do { LAS int* tb_ = (LAS int*)(lds + RT_OFF); \
        if (tid < 64) { const int c_ = ((const int*)ctl)[CW_CNT + tid * CNT_STR]; const int nt_ = (c_ + 127) >> 7; int o_ = nt_; \
            _Pragma("unroll") for (int d_ = 1; d_ < 64; d_ <<= 1) { const int t_ = __shfl_up(o_, d_); if (tid >= d_) o_ += t_; } \
            const int first_ = o_ - nt_; tb_[tid] = c_; tb_[64 + tid] = first_ * 128; \
            for (int t_ = 0; t_ < nt_; ++t_) { tb_[128 + first_ + t_] = tid; tb_[320 + first_ + t_] = t_ * 128; } \
            if (tid == 63) tb_[512] = o_; } \
        __syncthreads(); } while (0)
    const int gw = wg * NWAVES + wave, NGW = G * NWAVES;

    const float* x = args.in[0];
    float* ada = (float*)(ws + WS_ADA); float* rope = (float*)(ws + WS_ROPE);
    bf16* h = (bf16*)(ws + WS_H); bf16* W1t = (bf16*)(ws + WS_W1T); bf16* Wupt = (bf16*)(ws + WS_WUPT); bf16* Wot = (bf16*)(ws + WS_WOT);
    unsigned char* Wgut = ws + WS_WGUT; unsigned char* Wdt = ws + WS_WDT;

    PH(0) { const int lane = lane_fresh(); const int tid = (wave << 6) | lane; (void)tid; (void)lane;
        {
            const float* c = args.in[1]; const float* w_ada = args.in[2]; const float* b_ada = args.in[3];
            LAS float* red = (LAS float*)lds;
            for (int u = wg; u < 6 * D / 64; u += G) {
                const int n = u * 64 + lane; float s = 0.f;
#pragma unroll 8
                for (int kq = wave; kq < D; kq += NWAVES) s += c[kq] * w_ada[(size_t)kq * (6 * D) + n];
                red[wave * 64 + lane] = s;
                __syncthreads();
                if (wave == 0) { float t = b_ada[n]; for (int w = 0; w < NWAVES; ++w) t += red[w * 64 + lane];
                    __hip_atomic_store(ada + n, t, __ATOMIC_RELAXED, __HIP_MEMORY_SCOPE_AGENT);
                    asm volatile("s_waitcnt vmcnt(0)" ::: "memory");
                    if (lane == 0) (void)xb_add(ctl + CW_ADA, 1u); }
                __syncthreads();
            }
        }
        for (int i = wg * NTHR + tid; i < S * 16; i += G * NTHR) {
            const int pos = i >> 4, j = i & 15; const float inv = powf(500000.0f, -(float)j / 16.0f); const float ang = (float)pos * inv;
            rope[2 * i] = cosf(ang); rope[2 * i + 1] = sinf(ang);
        }
        for (int i = wg * NTHR + tid; i < 128 * D / 8; i += G * NTHR) ((u32x4*)(W1t + (size_t)(N1 - 128) * D))[i] = (u32x4){0u, 0u, 0u, 0u};
        {
            bf16* wrh = (bf16*)(ws + WS_WR); bf16* wrl = wrh + 80 * D; const float* w_rg = args.in[31]; const float* w_re = args.in[33];
            for (int i = wg * NTHR + tid; i < 80 * D; i += G * NTHR) { const int n = i / D, kq = i % D; const float v = n < NG ? w_rg[kq * NG + n] : (n < NG + NE ? w_re[kq * NE + n - NG] : 0.f);
                const bf16 hi = f2bf(v); wrh[i] = hi; wrl[i] = f2bf(v - bf2f(hi)); }
        }
        {
            bf16* wl2 = (bf16*)(ws + WS_WL2); const float* w_w2 = args.in[17]; const float* w_a2 = args.in[20]; const float* w_g2 = args.in[22];
            for (int i = wg * NTHR + tid; i < 3 * RW * 256; i += G * NTHR) { const int n = i >> 8, kq = i & 255, which = n / RW, cc = n % RW; float v = 0.f;
                if (which == 0) { if (kq < LW) v = w_w2[kq * RW + cc]; } else if (which == 1) { if (kq < LA) v = w_a2[kq * RW + cc]; } else v = w_g2[kq * RW + cc];
                wl2[i] = f2bf(v); }
        }
        LAS float* scr = (LAS float*)(lds + wave * 16384);
        constexpr int I_W = (D / 64) * (LW / 32), I_A = (D / 64) * (LA / 32), I_G = (D / 64) * (LG / 32);
        constexpr int NIT = 2 * (I_W + I_A + I_G);
        for (int it = gw; it < NIT; it += NGW) {
            int r = it, k0, n0;
            if (r < 2 * I_W) { const int md = 1 + r / I_W; item_kn(r % I_W, LW, k0, n0); tr_item(args.in[16], LW, k0, n0, W1t + (size_t)(INW + (md - 1) * LO + n0) * D + k0, D, args.in[12], md, scr, lane); continue; } r -= 2 * I_W;
            if (r < 2 * I_A) { const int md = 1 + r / I_A; item_kn(r % I_A, LA, k0, n0); tr_item(args.in[19], LA, k0, n0, W1t + (size_t)(INW + (md - 1) * LO + LW + n0) * D + k0, D, args.in[13], md, scr, lane); continue; } r -= 2 * I_A;
            const int md = 1 + r / I_G; item_kn(r % I_G, LG, k0, n0); tr_item(args.in[21], LG, k0, n0, W1t + (size_t)(INW + (md - 1) * LO + LW + LA + n0) * D + k0, D, args.in[14], md, scr, lane);
        }
        __syncthreads();
        {
            const int lr = tid >> 5, c4 = tid & 31, nl = lane & 15, kq = lane >> 4, ncol = 16 * wave + nl;
            f32x4 v[8]; int T = wg;
            if (T < CT_ALL) { const ConvTile t = conv_decode(T, args.in, ws);
#pragma unroll
                for (int i = 0; i < 8; ++i) v[i] = *(const f32x4*)(t.src + (size_t)(lr + 16 * i) * t.ldw + 4 * c4); }
            for (int itc = 0; T < CT_ALL; T += G, ++itc) {
                LAS float* buf = (LAS float*)(lds + (itc & 1) * 69632);
#pragma unroll
                for (int i = 0; i < 8; ++i) *(LAS f32x4*)(buf + conv_off(lr + 16 * i, 4 * c4)) = v[i];
                const ConvTile t = conv_decode(T, args.in, ws);
                if (T + G < CT_ALL) { const ConvTile tn = conv_decode(T + G, args.in, ws);
#pragma unroll
                    for (int i = 0; i < 8; ++i) v[i] = *(const f32x4*)(tn.src + (size_t)(lr + 16 * i) * tn.ldw + 4 * c4); }
                R1_BAR();
                float xv[32];
#pragma unroll
                for (int j = 0; j < 32; ++j) xv[j] = buf[conv_off(32 * kq + j, ncol)];
                if (t.kind) { unsigned char* d = t.dst + (size_t)ncol * t.rs + 32 * kq;
                    u32x4 o0, o1; o0.x = pk_fp8x4(xv[0], xv[1], xv[2], xv[3], t.sc); o0.y = pk_fp8x4(xv[4], xv[5], xv[6], xv[7], t.sc); o0.z = pk_fp8x4(xv[8], xv[9], xv[10], xv[11], t.sc); o0.w = pk_fp8x4(xv[12], xv[13], xv[14], xv[15], t.sc);
                    o1.x = pk_fp8x4(xv[16], xv[17], xv[18], xv[19], t.sc); o1.y = pk_fp8x4(xv[20], xv[21], xv[22], xv[23], t.sc); o1.z = pk_fp8x4(xv[24], xv[25], xv[26], xv[27], t.sc); o1.w = pk_fp8x4(xv[28], xv[29], xv[30], xv[31], t.sc);
                    *(u32x4*)d = o0; *(u32x4*)(d + 16) = o1; }
                else { unsigned char* d = t.dst + (size_t)ncol * t.rs + 64 * kq;
#pragma unroll
                    for (int q = 0; q < 4; ++q) { u32x4 o; o.x = pk2(xv[8 * q], xv[8 * q + 1]); o.y = pk2(xv[8 * q + 2], xv[8 * q + 3]); o.z = pk2(xv[8 * q + 4], xv[8 * q + 5]); o.w = pk2(xv[8 * q + 6], xv[8 * q + 7]); *(u32x4*)(d + 16 * q) = o; } }
            }
            __syncthreads();
        }
        {
            if (tid == 0) { XB_SPIN(xb_ld(ctl + CW_ADA) < (unsigned)(6 * D / 64), bar.bar); __builtin_amdgcn_fence(__ATOMIC_ACQUIRE, "agent"); asm volatile("s_waitcnt vmcnt(0)" ::: "memory"); }
            __syncthreads();
        const float* g = args.in[4]; const float* sh1 = ada; const float* sc1 = ada + D;
        f32x4 gs[8], sh[8];
#pragma unroll
        for (int j = 0; j < 8; ++j) { const int c = 4 * lane + 256 * j; const f32x4 gg = *(const f32x4*)(g + c), ss = *(const f32x4*)(sc1 + c); gs[j] = gg * (ss + 1.0f); sh[j] = *(const f32x4*)(sh1 + c); }
        for (int rb = gw; rb < S; rb += 2 * NGW) {
            f32x4 v[2][8]; float s[2] = {0.f, 0.f};
#pragma unroll
            for (int q = 0; q < 2; ++q) { const f32x4* xr = (const f32x4*)(x + (size_t)(rb + q * NGW) * D) + lane;
#pragma unroll
                for (int j = 0; j < 8; ++j) v[q][j] = xr[64 * j]; }
#pragma unroll
            for (int q = 0; q < 2; ++q)
#pragma unroll
                for (int j = 0; j < 8; ++j) s[q] += (v[q][j].x * v[q][j].x + v[q][j].y * v[q][j].y) + (v[q][j].z * v[q][j].z + v[q][j].w * v[q][j].w);
            float r[2]; r[0] = rsqrtf(wave_sum(s[0]) * (1.0f / D) + 1e-6f); r[1] = rsqrtf(wave_sum(s[1]) * (1.0f / D) + 1e-6f);
#pragma unroll
            for (int q = 0; q < 2; ++q) { u32x2* o = (u32x2*)(h + (size_t)(rb + q * NGW) * D) + lane;
#pragma unroll
                for (int j = 0; j < 8; ++j) { const f32x4 t = v[q][j] * r[q] * gs[j] + sh[j]; u32x2 w; w.x = pk2(t.x, t.y); w.y = pk2(t.z, t.w); o[64 * j] = w; } }
        }

        }
    }
    SEAM(0);
    PH(2) { const int lane = lane_fresh(); const int tid = (wave << 6) | lane; (void)tid; (void)lane;
        EpiProj E{(bf16*)(ws + WS_Q), (bf16*)(ws + WS_K), (bf16*)(ws + WS_V), (bf16*)(ws + WS_RKV), (bf16*)(ws + WS_GATE), (bf16*)(ws + WS_LORA), (bf16*)(ws + WS_LORAB), rope};
        { pg8::Gemm g{h, W1t, S, INW, D, D, D}; pg8::StaticOrder So; So.init(S, INW, G, wg);
          pg8::gemm_phase<EpiProj, pg8::StaticOrder, true, true>(lds, g, So, E); }
        { int ld_ = D; asm volatile("" : "+s"(ld_)); pg8::Gemm g{h, W1t, S, N1, AW, ld_, ld_}; LoraOrder So{nullptr, G, wg};
          pg8::gemm_phase<EpiProj, LoraOrder, true, true>(lds, g, So, E); }
    }
    SEAM(2);

    bf16* qb = (bf16*)(ws + WS_Q); bf16* kb = (bf16*)(ws + WS_K); bf16* vb = (bf16*)(ws + WS_V);
    bf16* kmh = (bf16*)(ws + WS_KMEAN); bf16* kml = kmh + AH * NB * AD;
    AttnBufs AB{qb, kb, vb, kmh, kml, (unsigned*)(ws + WS_AMASK), (int*)(ws + WS_ALIST), (int*)ctl + CW_ACNT, (bf16*)(ws + WS_APART), (float*)(ws + WS_AML)};
    PH(3) { const int lane = lane_fresh(); const int tid = (wave << 6) | lane; (void)tid; (void)lane;
        for (int hb = wg; hb < AH * NB; hb += G) { const int hd = hb / NB, bk = hb % NB; LAS float* red = (LAS float*)lds;
            float s0 = 0.f, s1 = 0.f; const unsigned* src = (const unsigned*)(kb + (size_t)(bk * MB + wave * 32) * AW + hd * AD) + lane;
#pragma unroll 8
            for (int r = 0; r < 32; ++r) { const unsigned w2 = src[(size_t)r * (AW / 2)]; s0 += __uint_as_float(w2 << 16); s1 += __uint_as_float(w2 & 0xffff0000u); }
            red[wave * 128 + 2 * lane] = s0; red[wave * 128 + 2 * lane + 1] = s1;
            __syncthreads();
            if (tid < AD) { float s = 0.f;
#pragma unroll
                for (int w = 0; w < 8; ++w) s += red[w * 128 + tid];
                s *= (1.0f / MB); const bf16 hi = f2bf(s); kmh[hb * AD + tid] = hi; kml[hb * AD + tid] = f2bf(s - bf2f(hi)); }
            __syncthreads();
        }
        {
            const bf16* lora = (const bf16*)(ws + WS_LORA); const bf16* lb = (const bf16*)(ws + WS_LORAB); bf16* al2 = (bf16*)(ws + WS_AL2);
#pragma unroll 4
            for (int i = wg * NTHR + tid; i < S * 384; i += G * NTHR) { const int t = i / 384, j = (i % 384) * 2, which = j >> 8, jj = j & 255; float v0 = 0.f, v1 = 0.f;
                const int src = which == 0 ? jj : (which == 1 ? LW + jj : LW + LA + jj); const bool real = which == 2 || jj < LW;
                if (real) { const unsigned a0 = *(const unsigned*)(lora + (size_t)t * 1024 + src), a1 = *(const unsigned*)(lb + (size_t)t * 1024 + src);
                    unsigned p0 = 0u, p1 = 0u; if (t > 0) { p0 = *(const unsigned*)(lora + (size_t)(t - 1) * 1024 + LO + src); p1 = *(const unsigned*)(lb + (size_t)(t - 1) * 1024 + LO + src); }
                    v0 = (__uint_as_float(a0 << 16) + __uint_as_float(a1 << 16)) + (__uint_as_float(p0 << 16) + __uint_as_float(p1 << 16));
                    v1 = (__uint_as_float(a0 & 0xffff0000u) + __uint_as_float(a1 & 0xffff0000u)) + (__uint_as_float(p0 & 0xffff0000u) + __uint_as_float(p1 & 0xffff0000u));
                    if (which == 0) { v0 = 1.0f - 2.0f / (1.0f + __expf(2.0f * v0)); v1 = 1.0f - 2.0f / (1.0f + __expf(2.0f * v1)); } else if (which == 2) { v0 = sigmoidf_(v0); v1 = sigmoidf_(v1); } }
                *(unsigned*)(al2 + (size_t)t * 768 + j) = pk2(v0, v1); }
        }
    }
    SEAM(3);
    PH(4) { const int lane = lane_fresh(); const int tid = (wave << 6) | lane; (void)tid; (void)lane;
#define L2CALL(W, DST, BIAS, CID) { int lda_ = 768; asm volatile("" : "+s"(lda_)); pg8::Gemm g{(const bf16*)(ws + WS_AL2), (const bf16*)(ws + WS_WL2), S, 3 * RW, 256, lda_, 256}; \
            Lora2Order<W> So{nullptr, G, CID}; EpiLora2<W> E{DST, BIAS}; pg8::gemm_phase<EpiLora2<W>, Lora2Order<W>, true, true, 0, true>(lds, g, So, E); }
        L2CALL(0, (void*)(ws + WS_LW), args.in[15], wg)
        L2CALL(1, (void*)(ws + WS_A), args.in[18], wg)
        L2CALL(2, (void*)(ws + WS_G), nullptr, wg)
#undef L2CALL
        for (int u = wg; u < AH * 64; u += G) moba_select_unit(lds, AB, u >> 6, u & 63, tid, lane, wave);
    }
    SEAM(4);
    RwkvBufs RB{(const bf16*)(ws + WS_RKV), (const float*)(ws + WS_LW), (const bf16*)(ws + WS_A), (bf16*)(ws + WS_RWP), (float*)(ws + WS_RWQ), (bf16*)(ws + WS_RWR), (bf16*)(ws + WS_RWY), (float*)(ws + WS_RWB)};
    bf16* H0T = (bf16*)(ws + WS_RWH);
    PH(5) { const int lane = lane_fresh(); const int tid = (wave << 6) | lane; (void)tid; (void)lane; R1In I; if (wg < RH * NCH) rwkv_r1_load(I, RB, wg / NCH, wg % NCH, lane, wave);
        for (int u = wg; u < RH * NCH; u += G) { const int un = u + G; rwkv_r1_unit(lds, RB, args.in, I, u / NCH, u % NCH, un < RH * NCH ? un / NCH : -1, un % NCH, tid, lane, wave); } }
    SEAM(5);
    PH(7) { const int lane = lane_fresh(); const int tid = (wave << 6) | lane; (void)tid; (void)lane;
        if (wg < RH * 4) { for (int rsc = 0; rsc < 1 + REP_SCAN; ++rsc) { rwkv_r2_wg(lds, RB.P, RB.QmT, H0T, wg >> 2, wg & 3, wave, lane); __syncthreads(); } }
        LAS int* pre = (LAS int*)(lds + AT_ITEMS); LAS int* tick = pre + 260;
        if (tid < 256) pre[1 + tid] = (AB.cnt[tid * ACNT_STR] + 255) >> 8;
        __syncthreads();
        if (wave == 0) {
            int v0 = pre[1 + 4 * lane], v1 = pre[2 + 4 * lane], v2 = pre[3 + 4 * lane], v3 = pre[4 + 4 * lane]; v1 += v0; v2 += v1; v3 += v2; int tot = v3;
#pragma unroll
            for (int o = 1; o < 64; o <<= 1) { const int t = __shfl_up(tot, o); if (lane >= o) tot += t; }
            const int ex = tot - v3; pre[1 + 4 * lane] = ex + v0; pre[2 + 4 * lane] = ex + v1; pre[3 + 4 * lane] = ex + v2; pre[4 + 4 * lane] = ex + v3;
            if (lane == 0) pre[0] = 0; }
        __syncthreads();
        moba_items(lds, AB, (int*)ctl + CW_AQ + rep_, pre, tick, tid, lane, wave);
    }
    SEAM(7);
    PH(8) { const int lane = lane_fresh(); const int tid = (wave << 6) | lane; (void)tid; (void)lane; for (int u = wg * 2 + (wave >> 2); u < RH * NCH; u += 2 * G) rwkv_r3_wave(RB, H0T, args.in, (const bf16*)(ws + WS_G), (bf16*)(ws + WS_OCAT), u / NCH, u % NCH, wave & 3, lane);
#pragma unroll 2
        for (int i = wg * NTHR + tid; i < AH * S * 16; i += G * NTHR) { const int c8 = i & 15, hq = i >> 4, hh = hq / S, qq = hq % S;
            const unsigned mk = AB.mask[hq]; const f32x4 ml0 = *(const f32x4*)(AB.ml + (size_t)hq * 8), ml1 = *(const f32x4*)(AB.ml + (size_t)hq * 8 + 4);
            u32x4 pr[4];
#pragma unroll
            for (int s = 0; s < 4; ++s) pr[s] = *(const u32x4*)(AB.part + ((size_t)hq * 4 + s) * AD + 8 * c8);
            const int ns = 1 + __builtin_popcount(mk);
            const float m_[4] = {ml0[0], ml0[2], ml1[0], ml1[2]}, l_[4] = {ml0[1], ml0[3], ml1[1], ml1[3]};
            float mx = m_[0];
#pragma unroll
            for (int s = 1; s < 4; ++s) mx = (s < ns) ? fmaxf(mx, m_[s]) : mx;
            float wv[4]; float wsum = 0.f;
#pragma unroll
            for (int s = 0; s < 4; ++s) { wv[s] = s < ns ? l_[s] * __builtin_amdgcn_exp2f(m_[s] - mx) : 0.f; wsum += wv[s]; }
            const float inv = 1.0f / wsum; float o[8] = {0.f, 0.f, 0.f, 0.f, 0.f, 0.f, 0.f, 0.f};
#pragma unroll
            for (int s = 0; s < 4; ++s) { float pv[8]; unpack8(pr[s], pv); const float ws_ = wv[s] * inv;
#pragma unroll
                for (int j = 0; j < 8; ++j) o[j] += (s < ns) ? ws_ * pv[j] : 0.f; }
            u32x4 w; w.x = pk2(o[0], o[1]); w.y = pk2(o[2], o[3]); w.z = pk2(o[4], o[5]); w.w = pk2(o[6], o[7]);
            *(u32x4*)((bf16*)(ws + WS_OCAT) + (size_t)qq * (2 * AW) + hh * AD + 8 * c8) = w; }
    }
    SEAM(8);

    bf16* ocat = (bf16*)(ws + WS_OCAT); bf16* gate = (bf16*)(ws + WS_GATE); bf16* mix = (bf16*)(ws + WS_MIX); bf16* y = (bf16*)(ws + WS_Y); bf16* x1 = (bf16*)(ws + WS_X1);     unsigned char* h2 = ws + WS_H2;
    float* ew = (float*)(ws + WS_ROUTE + 65536); int* slot = (int*)(ws + WS_ROUTE + 131072);
    int* elist = (int*)(ws + WS_ELIST);
    unsigned char* xbuf = ws + WS_XBUF; unsigned char* hid = ws + WS_HID; bf16* ybuf = (bf16*)(ws + WS_YBUF);
    PH(9) { const int lane = lane_fresh(); const int tid = (wave << 6) | lane; (void)tid; (void)lane;
        pg8::Gemm g{ocat, Wupt, S, D, AW, D, D}; MixOrder So{nullptr, G, wg};
        EpiMix E{gate, mix};
        pg8::gemm_phase<EpiMix, MixOrder, true, true>(lds, g, So, E);
    }
    SEAM(9);
    PH(10) { const int lane = lane_fresh(); const int tid = (wave << 6) | lane; (void)tid; (void)lane;
        pg8::Gemm g{mix, Wot, S, D, D, D, D}; pg8::StaticOrder So; So.init(S, D, G, wg);
        EpiBf16P E{y, D};
        pg8::gemm_phase<EpiBf16P, pg8::StaticOrder, true, true>(lds, g, So, E);
    }
    SEAM(10);
    PH(11) { const int lane = lane_fresh(); const int tid = (wave << 6) | lane; (void)tid; (void)lane;
        const float* gpost = args.in[5]; const float* gpre2 = args.in[6]; const float* gt1 = ada + 2 * D; const float* sh2 = ada + 3 * D; const float* sc2 = ada + 4 * D;
        const bf16* wrh = (const bf16*)(ws + WS_WR); const bf16* wrl = wrh + 80 * D; const float* b_rg = args.in[32]; const float* b_re = args.in[34];
        LAS bf16* Ah = (LAS bf16*)lds; LAS bf16* Al = Ah + 16 * RS8; LAS float* Pp = (LAS float*)lds;
        LAS float* Lg = (LAS float*)(lds + 8 * 16 * 80 * 4);
        for (int unit = wg; unit < S / 16; unit += G) {
            {
                const int rl0 = wave * 2, row0 = unit * 16 + rl0;
                f32x4 v[2][8], xv[2][8]; float s[2] = {0.f, 0.f};
#pragma unroll
                for (int rr = 0; rr < 2; ++rr) { const u32x2* yr = (const u32x2*)(y + (size_t)(row0 + rr) * D) + lane; const f32x4* xr = (const f32x4*)(x + (size_t)(row0 + rr) * D) + lane;
#pragma unroll
                    for (int j = 0; j < 8; ++j) { const u32x2 yb = yr[64 * j]; v[rr][j] = (f32x4){__uint_as_float(yb.x << 16), __uint_as_float(yb.x & 0xffff0000u), __uint_as_float(yb.y << 16), __uint_as_float(yb.y & 0xffff0000u)}; xv[rr][j] = xr[64 * j]; } }
#pragma unroll
                for (int rr = 0; rr < 2; ++rr)
#pragma unroll
                    for (int j = 0; j < 8; ++j) s[rr] += (v[rr][j].x * v[rr][j].x + v[rr][j].y * v[rr][j].y) + (v[rr][j].z * v[rr][j].z + v[rr][j].w * v[rr][j].w);
                float r1[2]; r1[0] = rsqrtf(wave_sum(s[0]) * (1.0f / D) + 1e-6f); r1[1] = rsqrtf(wave_sum(s[1]) * (1.0f / D) + 1e-6f); s[0] = 0.f; s[1] = 0.f;
#pragma unroll
                for (int rr = 0; rr < 2; ++rr)
#pragma unroll
                    for (int j = 0; j < 8; ++j) { const int c = 4 * lane + 256 * j; const f32x4 t = xv[rr][j] + *(const f32x4*)(gt1 + c) * *(const f32x4*)(gpost + c) * (v[rr][j] * r1[rr]); v[rr][j] = t;
                        { u32x2 xb; xb.x = pk2(t.x, t.y); xb.y = pk2(t.z, t.w); ((u32x2*)(x1 + (size_t)(row0 + rr) * D))[lane + 64 * j] = xb; } s[rr] += (t.x * t.x + t.y * t.y) + (t.z * t.z + t.w * t.w); }
                float r2[2]; r2[0] = rsqrtf(wave_sum(s[0]) * (1.0f / D) + 1e-6f); r2[1] = rsqrtf(wave_sum(s[1]) * (1.0f / D) + 1e-6f);
#pragma unroll
                for (int rr = 0; rr < 2; ++rr)
#pragma unroll
                    for (int j = 0; j < 8; ++j) { const int c = 4 * lane + 256 * j; const f32x4 t = v[rr][j] * r2[rr] * (*(const f32x4*)(gpre2 + c) * (*(const f32x4*)(sc2 + c) + 1.0f)) + *(const f32x4*)(sh2 + c);
                        u32x2 wh; wh.x = pk2(t.x, t.y); wh.y = pk2(t.z, t.w);
                        u32x2 wl; wl.x = pk2(t.x - __uint_as_float(wh.x << 16), t.y - __uint_as_float(wh.x & 0xffff0000u)); wl.y = pk2(t.z - __uint_as_float(wh.y << 16), t.w - __uint_as_float(wh.y & 0xffff0000u));
                        ((unsigned*)(h2 + (size_t)(row0 + rr) * D))[lane + 64 * j] = pk_fp8x4(t.x, t.y, t.z, t.w, 8.0f);
                        *(LAS u32x2*)(Ah + (rl0 + rr) * RS8 + c) = wh; *(LAS u32x2*)(Al + (rl0 + rr) * RS8 + c) = wl; }
            }
            R1_BAR();
            f32x4 acc[5];
#pragma unroll
            for (int nt = 0; nt < 5; ++nt) acc[nt] = (f32x4){0.f, 0.f, 0.f, 0.f};
            for (int rmf = 0; rmf < 1 + REP_P11B; ++rmf) {
#pragma unroll
            for (int nt = 0; nt < 5; ++nt) acc[nt] = (f32x4){0.f, 0.f, 0.f, 0.f};
#pragma unroll 2
            for (int ks = 0; ks < 8; ++ks) {
                const int k0 = 256 * wave + 32 * ks + 8 * (lane >> 4);
                const bf16x8 ah = *(const LAS bf16x8*)(Ah + (lane & 15) * RS8 + k0), al = *(const LAS bf16x8*)(Al + (lane & 15) * RS8 + k0);
#pragma unroll
                for (int nt = 0; nt < 5; ++nt) { const bf16x8 bh = *(const bf16x8*)(wrh + (size_t)(16 * nt + (lane & 15)) * D + k0), bl = *(const bf16x8*)(wrl + (size_t)(16 * nt + (lane & 15)) * D + k0);
                    acc[nt] = __builtin_amdgcn_mfma_f32_16x16x32_bf16(ah, bh, acc[nt], 0, 0, 0);
                    acc[nt] = __builtin_amdgcn_mfma_f32_16x16x32_bf16(al, bh, acc[nt], 0, 0, 0);
                    acc[nt] = __builtin_amdgcn_mfma_f32_16x16x32_bf16(ah, bl, acc[nt], 0, 0, 0); }
            }
            }
            R1_BAR();
#pragma unroll
            for (int nt = 0; nt < 5; ++nt)
#pragma unroll
                for (int rg = 0; rg < 4; ++rg) Pp[(wave * 16 + 4 * (lane >> 4) + rg) * 80 + 16 * nt + (lane & 15)] = acc[nt][rg];
            R1_BAR();
            for (int i = tid; i < 16 * 72; i += NTHR) { const int r = i / 72, c = i % 72; float t = c < NG ? b_rg[c] : b_re[c - NG];
#pragma unroll
                for (int w = 0; w < 8; ++w) t += Pp[(w * 16 + r) * 80 + c];
                Lg[r * 72 + c] = t; }
            R1_BAR();
            if (tid < 16) {
                const LAS float* lg = Lg + tid * 72; const int row = unit * 16 + tid;
                float mx = lg[0]; int gi = 0; for (int j = 1; j < 8; ++j) if (lg[j] > mx) { mx = lg[j]; gi = j; }
                float sg = 0.f; for (int j = 0; j < 8; ++j) sg += __expf(lg[j] - mx);
                const float pg = 1.0f / sg;
                const LAS float* le = lg + 8 + gi * EPG;
                float m1 = le[0]; int i1 = 0; for (int j = 1; j < 8; ++j) if (le[j] > m1) { m1 = le[j]; i1 = j; }
                float m2 = -3e38f; int i2 = 0; for (int j = 0; j < 8; ++j) if (j != i1 && le[j] > m2) { m2 = le[j]; i2 = j; }
                const float e2 = __expf(m2 - m1); const float p1 = 1.0f / (1.0f + e2), p2 = e2 / (1.0f + e2);
                const int e1g = gi * EPG + i1, e2g = gi * EPG + i2;
                ew[row * 2] = pg * p1; ew[row * 2 + 1] = pg * p2;
                if (rep_ == 0) {
                    const int q1 = atomicAdd((int*)ctl + CW_CNT + e1g * CNT_STR, 1), q2 = atomicAdd((int*)ctl + CW_CNT + e2g * CNT_STR, 1);
                    elist[e1g * S + q1] = row; elist[e2g * S + q2] = row; slot[row * 2] = (e1g << 16) | q1; slot[row * 2 + 1] = (e2g << 16) | q2; }
            }
            R1_BAR();
        }
    }
    SEAM(11);
    PH(13) { const int lane = lane_fresh(); const int tid = (wave << 6) | lane; (void)tid; (void)lane;
        ROUTE_TABLE();
        pg8::Gemm g{(const bf16*)h2, (const bf16*)Wgut, MAXROWS, NE * 1024, D / 2, D / 2, D / 2}; ExpertOrderT<true> So{elist, (LAS const int*)(lds + RT_OFF), 4, G, wg};
        EpiHid E{hid};
        pg8::gemm_phase<EpiHid, ExpertOrderT<true>, true, true, (124 << 8) | 119, true>(lds, g, So, E);
    }
    SEAM(13);
    PH(14) { const int lane = lane_fresh(); const int tid = (wave << 6) | lane; (void)tid; (void)lane;
        if (args.ph_lo == 14) ROUTE_TABLE();
        pg8::Gemm g{(const bf16*)hid, (const bf16*)Wdt, MAXROWS, NE * D, FF / 2, FF / 2, FF / 2}; ExpertOrderT<false> So{nullptr, (LAS const int*)(lds + RT_OFF), 8, G, wg};
        EpiYbuf E{ybuf};
        pg8::gemm_phase<EpiYbuf, ExpertOrderT<false>, true, true, (124 << 8) | 120, true>(lds, g, So, E);
    }
    SEAM(14);
    PH(15) { const int lane = lane_fresh(); const int tid = (wave << 6) | lane; (void)tid; (void)lane;
        const float* gpost2 = args.in[7]; const float* gt2 = ada + 5 * D; float* out = args.out;
        if (args.ph_lo == 15) ROUTE_TABLE();
        LAS const int* tb = (LAS const int*)(lds + RT_OFF);
        for (int rb = gw; rb < S; rb += 2 * NGW) {
            int s0[2], s1[2]; float w0[2], w1[2]; const int rows[2] = {rb, rb + NGW};
#pragma unroll
            for (int q = 0; q < 2; ++q) { const int row = rows[q] < S ? rows[q] : rb; const int v0 = slot[row * 2], v1 = slot[row * 2 + 1]; s0[q] = tb[64 + (v0 >> 16)] + (v0 & 0xffff); s1[q] = tb[64 + (v1 >> 16)] + (v1 & 0xffff); w0[q] = ew[row * 2]; w1[q] = ew[row * 2 + 1]; }
            u32x2 xb[2][8];
#pragma unroll
            for (int q = 0; q < 2; ++q) { const int row = rows[q] < S ? rows[q] : rb;
#pragma unroll
                for (int j = 0; j < 8; ++j) xb[q][j] = ((const u32x2*)(x1 + (size_t)row * D))[lane + 64 * j]; }
            f32x4 v[2][8]; float s[2] = {0.f, 0.f};
#pragma unroll
            for (int q = 0; q < 2; ++q) { const u32x2* y0 = (const u32x2*)(ybuf + (size_t)s0[q] * D) + lane; const u32x2* y1 = (const u32x2*)(ybuf + (size_t)s1[q] * D) + lane;
#pragma unroll
                for (int j = 0; j < 8; ++j) { const u32x2 a = y0[64 * j], b = y1[64 * j];
                    v[q][j].x = w0[q] * __uint_as_float(a.x << 16) + w1[q] * __uint_as_float(b.x << 16); v[q][j].y = w0[q] * __uint_as_float(a.x & 0xffff0000u) + w1[q] * __uint_as_float(b.x & 0xffff0000u);
                    v[q][j].z = w0[q] * __uint_as_float(a.y << 16) + w1[q] * __uint_as_float(b.y << 16); v[q][j].w = w0[q] * __uint_as_float(a.y & 0xffff0000u) + w1[q] * __uint_as_float(b.y & 0xffff0000u);
                    s[q] += (v[q][j].x * v[q][j].x + v[q][j].y * v[q][j].y) + (v[q][j].z * v[q][j].z + v[q][j].w * v[q][j].w); } }
            float r[2]; r[0] = rsqrtf(wave_sum(s[0]) * (1.0f / D) + 1e-6f); r[1] = rsqrtf(wave_sum(s[1]) * (1.0f / D) + 1e-6f);
#pragma unroll
            for (int q = 0; q < 2; ++q) if (rows[q] < S) {
#pragma unroll
                for (int j = 0; j < 8; ++j) { const int c = 4 * lane + 256 * j; const u32x2 xx = xb[q][j];
                    const f32x4 xf = (f32x4){__uint_as_float(xx.x << 16), __uint_as_float(xx.x & 0xffff0000u), __uint_as_float(xx.y << 16), __uint_as_float(xx.y & 0xffff0000u)};
                    ((f32x4*)(out + (size_t)rows[q] * D))[lane + 64 * j] = xf + *(const f32x4*)(gt2 + c) * (v[q][j] * r[q] * *(const f32x4*)(gpost2 + c)); } }
        }
    }
#undef IN
#undef SEAM
}
extern "C" void kernel_launch(void* const* d_in, const int* in_sizes, int n_in, void* d_out, int out_size, void* d_ws, size_t ws_size, hipStream_t stream) {
    static int grid = 0;
    if (grid == 0) {
        if (ws_size < WS_END || n_in != 38) { fprintf(stderr, "kernel_launch: unexpected workspace/inputs: %zu < %zu or n_in %d\n", ws_size, (size_t)WS_END, n_in); grid = -1; return; }
        int dev = 0, cus = 0;
        if (hipGetDevice(&dev) != hipSuccess || hipDeviceGetAttribute(&cus, hipDeviceAttributeMultiprocessorCount, dev) != hipSuccess) { fprintf(stderr, "device query failed\n"); grid = -1; return; }
        if (hipFuncSetAttribute((const void*)fwd, hipFuncAttributeMaxDynamicSharedMemorySize, LDS_BYTES) != hipSuccess) { fprintf(stderr, "hipFuncSetAttribute failed\n"); grid = -1; return; }
        grid = cus;
    }
    if (grid < 0) return;
    (void)hipMemsetAsync((char*)d_ws + WS_CTL, 0, 1 * MiB, stream);
    Args a{};
    for (int i = 0; i < 38; ++i) a.in[i] = (const float*)d_in[i];
    a.out = (float*)d_out; a.ws = (unsigned char*)d_ws;
#if N_LAUNCH_PER_PHASE
    for (int ph = 0; ph < 16; ++ph) { a.ph_lo = ph; a.ph_hi = ph + 1; hipLaunchKernelGGL(fwd, dim3(grid), dim3(NTHR), LDS_BYTES, stream, a); }
#else
    a.ph_lo = 0; a.ph_hi = 16; hipLaunchKernelGGL(fwd, dim3(grid), dim3(NTHR), LDS_BYTES, stream, a);
#endif
}
```

```cpp
#include <hip/hip_runtime.h>
#include <cstdio>
#include <cstdint>

typedef unsigned short bf16;
__device__ __forceinline__ float bf2f(bf16 b) { return __uint_as_float(((unsigned)b) << 16); }
__device__ __forceinline__ bf16 f2bf(float f) { unsigned u = __float_as_uint(f); u += 0x7fffu + ((u >> 16) & 1u); return (bf16)(u >> 16); }
__device__ __forceinline__ float sigmoidf_(float x) { return __builtin_amdgcn_rcpf(1.0f + __expf(-x)); }

#ifndef N_LAUNCH_PER_PHASE
#define N_LAUNCH_PER_PHASE 0
#endif
#ifndef REP_PHASE
#define REP_PHASE -1
#define REP_N 0
#endif
#ifndef REP_SCAN
#define REP_SCAN 0
#endif
#ifndef REP_P11A
#define REP_P11A 0
#endif
#ifndef REP_P11B
#define REP_P11B 0
#endif
#ifndef REP_R1A
#define REP_R1A 0
#define REP_R1B 0
#define REP_R1C 0
#endif
#ifndef REP_R1NR
#define REP_R1NR 0
#endif
#ifndef REP_R1S0
#define REP_R1S0 0
#endif
constexpr int S = 8192, D = 2048;
constexpr int AH = 8, AD = 128, AW = 1024, MB = 256, NB = S / MB;
constexpr int RH = 16, RN = 64, RW = 1024;
constexpr int LW = 96, LA = 96, LG = 256, LO = LW + LA + LG;
constexpr int INW = 3 * AW + 3 * RW + 2 * D;
constexpr int NE = 64, NG = 8, EPG = 8, FF = 512;
constexpr int MAXROWS = 32768;
constexpr int MAXTILES = MAXROWS / 256;

constexpr size_t MiB = 1u << 20;
constexpr size_t WS_CTL   = 0;
constexpr size_t WS_ADA   = 1 * MiB;
constexpr size_t WS_ROPE  = 2 * MiB;
constexpr size_t WS_KMEAN = 3 * MiB;
constexpr size_t WS_WL2   = 3 * MiB + 256 * 1024;
constexpr size_t WS_ROUTE = 5 * MiB;
constexpr size_t WS_TOK   = 6 * MiB;
constexpr size_t WS_WR    = 7 * MiB;
constexpr size_t WS_H     = 8 * MiB;
constexpr size_t WS_Q     = 40 * MiB;
constexpr size_t WS_K     = 56 * MiB;
constexpr size_t WS_V     = 72 * MiB;
constexpr size_t WS_RKV   = 88 * MiB;
constexpr size_t WS_GATE  = 184 * MiB;
constexpr size_t WS_LORA  = 248 * MiB;
constexpr size_t WS_LORAB = 424 * MiB;
constexpr size_t WS_AL2   = 280 * MiB;
constexpr size_t WS_LW    = 296 * MiB;
constexpr size_t WS_A     = 328 * MiB;
constexpr size_t WS_G     = 360 * MiB;
constexpr size_t WS_OCAT  = 392 * MiB;
constexpr size_t WS_MIX   = 424 * MiB;
constexpr size_t WS_Y     = 456 * MiB;
constexpr size_t WS_X1    = 520 * MiB;
constexpr size_t WS_H2    = 584 * MiB;
constexpr size_t WS_WUPT  = 616 * MiB;
constexpr size_t WS_WOT   = 624 * MiB;
constexpr size_t WS_WGUT  = 632 * MiB;
constexpr size_t WS_WDT   = 888 * MiB;
constexpr size_t WS_END   = 1016 * MiB;
constexpr size_t WS_W1T   = WS_Y;
constexpr size_t WS_ELIST = 16 * MiB;
constexpr size_t WS_XBUF  = WS_H;
constexpr size_t WS_HID   = 136 * MiB;
constexpr size_t WS_YBUF  = 168 * MiB;
constexpr size_t WS_ALIST = 8 * MiB, WS_AMASK = 12 * MiB, WS_AML = 13 * MiB, WS_APART = 248 * MiB;
constexpr size_t WS_RWP = 456 * MiB, WS_RWQ = 472 * MiB, WS_RWR = 504 * MiB, WS_RWY = 520 * MiB, WS_RWH = 552 * MiB, WS_RWB = 568 * MiB;
constexpr size_t WS_NR = WS_MIX, WS_NW = WS_NR + 32 * MiB, WS_NKT = WS_NR + 64 * MiB, WS_NV = WS_NR + 96 * MiB, WS_NKK = WS_NR + 128 * MiB, WS_NY = WS_NR + 160 * MiB;
constexpr size_t WS_MIXTMP = WS_Y;
constexpr size_t WS_GTMP = WS_Y;

constexpr int CW_CNT = 16384, CNT_STR = 1088;
constexpr int CW_FILL = 1152;
constexpr int CW_OFF = 1280;
constexpr int CW_ADA = 1408;
constexpr int CW_ACNT = 90112, ACNT_STR = 576;
constexpr int CW_AQ = 1920;

namespace pg8 {
#define PG8_LAS __attribute__((address_space(3)))
typedef unsigned short bf16_t;
typedef short bf16x8 __attribute__((ext_vector_type(8)));
typedef float f32x4 __attribute__((ext_vector_type(4)));
typedef unsigned u32x4 __attribute__((ext_vector_type(4)));
typedef int i32x8_t __attribute__((ext_vector_type(8)));
template <bool IS8> struct FragSel { typedef bf16x8 T; static constexpr int NK = 2; };
template <> struct FragSel<true> { typedef i32x8_t T; static constexpr int NK = 1; };
template <int F8> struct FragT : FragSel<(F8 != 0)> {};
constexpr int BM = 256, BK = 64, HALF = 128, HTB = HALF * BK * 2  , STAGE_BYTES = 8 * HTB, NXCD = 8, WGM = 8;

__host__ __device__ __forceinline__ int lds_byte(int r, int c) { const int st = (r >> 4) * 2 + (c >> 5), rr = r & 15, cc = c & 31, ob = rr * 64 + cc * 2; return st * 1024 + (ob ^ (((ob >> 9) & 1) << 5)); }
__host__ __device__ __forceinline__ void stage_rc(int b, int& R, int& C) { const int st = b / 1024, sb = b % 1024, swz = sb ^ (((sb >> 9) & 1) << 5); R = (st >> 1) * 16 + swz / 64; C = (st & 1) * 32 + (swz % 64) / 2; }
__host__ __device__ __forceinline__ int perm32(int rho) { const int n = rho >> 4, i = rho & 15; return 8 * (i >> 2) + 4 * n + (i & 3); }

struct Unit { int pm, pn, koff, koffB; };
struct Gemm { const bf16_t* A; const bf16_t* Bt; int M, N, K, lda, ldb; };

struct StaticOrder {
    static constexpr bool GATHER = false; const int* tok = nullptr;
    int nM, nN, nwg, G, c;
    __host__ __device__ void init(int M, int N, int G_, int c_) { nM = M / BM; nN = N / BM; nwg = nM * nN; G = G_; c = c_; }
    __host__ __device__ bool next(int i, Unit& u) const {
        const long L = (long)i * G + c; if (L >= nwg) return false;
        int wgid = (int)L; { const int q = nwg / NXCD, r = nwg % NXCD, xcd = wgid % NXCD, off = wgid / NXCD; wgid = (xcd < r ? xcd * (q + 1) : r * (q + 1) + (xcd - r) * q) + off; }
        const int nig = WGM * nN, gid = wgid / nig, fm = gid * WGM, gsz = (nM - fm) < WGM ? (nM - fm) : WGM;
        u.pm = fm + ((wgid % nig) % gsz); u.pn = (wgid % nig) / gsz; u.koff = 0; u.koffB = 0; return true;
    }
    __device__ __forceinline__ void a_ready(const Unit&) const {}
    __device__ __forceinline__ void done(const Unit&) const {}
};

__device__ __forceinline__ unsigned cvt_pk_bf16(float lo, float hi) { unsigned r; asm volatile("v_cvt_pk_bf16_f32 %0, %1, %2" : "=v"(r) : "v"(lo), "v"(hi)); return r; }
template <class Epi, class Sched, bool ALIGN_EPI = false, bool SP2 = false, int F8 = 0, bool HM = false>
__device__ __forceinline__ void gemm_phase(PG8_LAS unsigned char* lds, const Gemm g, const Sched& S, const Epi& E) {
    int tid_ = threadIdx.x; asm volatile("" : "+v"(tid_));
    const int tid = tid_, wid = __builtin_amdgcn_readfirstlane(tid >> 6), lane = tid & 63, wr = wid >> 2, wc = wid & 3, fr = lane & 15, fq = lane >> 4;
    const int K = g.K, nt = K / BK;
    unsigned voffA[2], voffB[2], voffN[2] = {0u, 0u};
#pragma unroll
    for (int i = 0; i < 2; ++i) { int R, C; stage_rc(tid * 16 + i * 8192, R, C); const int Rb = Epi::PERM ? ((R & ~31) + perm32(R & 31)) : R;
        voffA[i] = (unsigned)(R * g.lda + C) * 2u; voffB[i] = (unsigned)(Rb * g.ldb + C) * 2u; }
    const size_t kstep = (size_t)(BK * 2);
    const size_t hstepA = HM ? (size_t)0 : (size_t)HALF * g.lda * 2, hstepB = (size_t)HALF * g.ldb * 2;
    const size_t tstepA = Sched::GATHER ? (size_t)0 : (HM ? 1 : 2) * (size_t)HALF * g.lda * 2, tstepB = 2 * hstepB;
    const unsigned ldsw = (unsigned)wid * 1024u;
    const int aoff = lds_byte(wr * 64 + fr, fq * 8), boff = lds_byte(wc * 32 + fr, fq * 8);
#define PG8_SA(b, h) (((b) * 2 + (h)) * HTB)
#define PG8_SB(b, h) ((4 + (b) * 2 + (h)) * HTB)
#define PG8_STAGE(bufoff, gbase, voff) do { _Pragma("unroll") for (int _i = 0; _i < 2; ++_i) \
        __builtin_amdgcn_global_load_lds((const unsigned*)((const char*)(gbase) + (voff)[_i]), (PG8_LAS unsigned*)(lds + (bufoff) + ldsw + _i * 8192), 16, 0, 0); } while (0)
#define PG8_CAT(lo, hi) __builtin_bit_cast(i32x8_t, __builtin_shufflevector(lo, hi, 0, 1, 2, 3, 4, 5, 6, 7, 8, 9, 10, 11, 12, 13, 14, 15))
#define PG8_RD(off) (*(const PG8_LAS bf16x8*)(lds + (off)))
#define PG8_LDA(dst, b, h) do { if constexpr (!(HM && (h) == 1)) _Pragma("unroll") for (int m = 0; m < 4; ++m) { if constexpr (F8 == 0) { _Pragma("unroll") for (int k = 0; k < 2; ++k) dst[m][k] = PG8_RD(PG8_SA(b, h) + aoff + m * 2048 + k * 1024); } \
        else dst[m][0] = PG8_CAT(PG8_RD(PG8_SA(b, h) + aoff + m * 2048), PG8_RD(PG8_SA(b, h) + aoff + m * 2048 + 1024)); } } while (0)
#define PG8_LDB(dst, b, h) do { _Pragma("unroll") for (int n = 0; n < 2; ++n) { if constexpr (F8 == 0) { _Pragma("unroll") for (int k = 0; k < 2; ++k) dst[n][k] = PG8_RD(PG8_SB(b, h) + boff + n * 2048 + k * 1024); } \
        else dst[n][0] = PG8_CAT(PG8_RD(PG8_SB(b, h) + boff + n * 2048), PG8_RD(PG8_SB(b, h) + boff + n * 2048 + 1024)); } } while (0)
#define PG8_MMA(ai, bj, At, Bt) do { __builtin_amdgcn_s_setprio(1); if constexpr (!(HM && (ai) == 1)) _Pragma("unroll") for (int m = 0; m < 4; ++m) _Pragma("unroll") for (int n = 0; n < 2; ++n) { \
        if constexpr (F8 == 0) { _Pragma("unroll") for (int k = 0; k < 2; ++k) acc[ai][bj][m][n] = __builtin_amdgcn_mfma_f32_16x16x32_bf16(Bt[n][k], At[m][k], acc[ai][bj][m][n], 0, 0, 0); } \
        else acc[ai][bj][m][n] = __builtin_amdgcn_mfma_scale_f32_16x16x128_f8f6f4(Bt[n][0], At[m][0], acc[ai][bj][m][n], 0, 0, 0, (F8 & 255) * 0x01010101, 0, ((F8 >> 8) & 255) * 0x01010101); } \
        __builtin_amdgcn_s_setprio(0); } while (0)
#define PG8_WAIT_V(n) asm volatile("s_waitcnt vmcnt(" #n ")" ::: "memory")
#define PG8_WAIT_L(n) asm volatile("s_waitcnt lgkmcnt(" #n ")" ::: "memory")
#define PG8_BAR __builtin_amdgcn_s_barrier()
#define PG8_SCHED __builtin_amdgcn_sched_barrier(0)
    Unit cur, nxt; int ui = 0;
    if (!S.next(0, cur)) return;
    f32x4 acc[2][2][4][2];
#pragma unroll
    for (int a = 0; a < 2; ++a)
#pragma unroll
        for (int b = 0; b < 2; ++b)
#pragma unroll
            for (int m = 0; m < 4; ++m)
#pragma unroll
                for (int n = 0; n < 2; ++n) acc[a][b][m][n] = (f32x4){0.f, 0.f, 0.f, 0.f};
    typename FragT<F8>::T At[4][FragT<F8>::NK], B0[2][FragT<F8>::NK], B1[2][FragT<F8>::NK];
    const char* cA = (const char*)g.A + (size_t)cur.pm * tstepA + cur.koff; const char* cB = (const char*)g.Bt + (size_t)cur.pn * tstepB + cur.koffB;
#define PG8_GVOFF(u, out) do { _Pragma("unroll") for (int i_ = 0; i_ < 2; ++i_) { int R_, C_; stage_rc(tid * 16 + i_ * 8192, R_, C_); out[i_] = ((unsigned)S.row_tok((u).pm, R_) * (unsigned)g.lda + (unsigned)C_) * 2u; } } while (0)
    if constexpr (Sched::GATHER) PG8_GVOFF(cur, voffA);
    S.a_ready(cur);
    if constexpr (SP2) {
        PG8_STAGE(PG8_SB(0, 0), cB, voffB); PG8_STAGE(PG8_SB(0, 1), cB + hstepB, voffB); PG8_STAGE(PG8_SA(0, 0), cA, voffA); PG8_STAGE(PG8_SA(0, 1), cA + hstepA, voffA);
        if (wr == 1) PG8_BAR;
        PG8_WAIT_V(2); PG8_BAR;
        PG8_STAGE(PG8_SB(1, 0), cB + kstep, voffB); PG8_STAGE(PG8_SA(1, 0), cA + kstep, voffA); PG8_STAGE(PG8_SB(1, 1), cB + hstepB + kstep, voffB);
        PG8_WAIT_V(6); PG8_BAR;
    } else {
        PG8_STAGE(PG8_SB(0, 0), cB, voffB); PG8_STAGE(PG8_SA(0, 0), cA, voffA); PG8_STAGE(PG8_SB(0, 1), cB + hstepB, voffB); PG8_STAGE(PG8_SA(0, 1), cA + hstepA, voffA);
        if (wr == 1) PG8_BAR;
        PG8_WAIT_V(4); PG8_BAR;
        PG8_STAGE(PG8_SB(1, 0), cB + kstep, voffB); PG8_STAGE(PG8_SA(1, 0), cA + kstep, voffA); PG8_STAGE(PG8_SB(1, 1), cB + hstepB + kstep, voffB);
        PG8_WAIT_V(6); PG8_BAR;
    }
    for (;;) {
        const bool has_next = S.next(ui + 1, nxt);
        if constexpr (Sched::GATHER) { if (has_next) PG8_GVOFF(nxt, voffN); }
        const char* nA = has_next ? (const char*)g.A + (size_t)nxt.pm * tstepA + nxt.koff : cA; const char* nB = has_next ? (const char*)g.Bt + (size_t)nxt.pn * tstepB + nxt.koffB : cB;
#pragma nounroll
        for (int t = 0; t < nt; t += 2) {
            const bool last = (t == nt - 2);
            const char* a1 = cA + (size_t)(t + 1) * kstep;
            const char* a2 = last ? nA : cA + (size_t)(t + 2) * kstep; const char* b2 = last ? nB : cB + (size_t)(t + 2) * kstep;
            const char* a3 = a2 + kstep; const char* b3 = b2 + kstep;
            unsigned vA2[2] = {voffA[0], voffA[1]}; if constexpr (Sched::GATHER) { if (last) { vA2[0] = voffN[0]; vA2[1] = voffN[1]; } }
            if (last && has_next) S.a_ready(nxt);
            if constexpr (SP2) {
            PG8_LDB(B0, 0, 0); PG8_LDB(B1, 0, 1); PG8_SCHED; PG8_LDA(At, 0, 0); PG8_STAGE(PG8_SA(1, 1), a1 + hstepA, voffA);
            PG8_WAIT_V(8); PG8_WAIT_L(0); PG8_BAR; PG8_MMA(0, 0, At, B0); PG8_MMA(0, 1, At, B1); PG8_BAR; PG8_SCHED;
            PG8_LDA(At, 0, 1); PG8_STAGE(PG8_SB(0, 0), b2, voffB); PG8_STAGE(PG8_SB(0, 1), b2 + hstepB, voffB); PG8_STAGE(PG8_SA(0, 0), a2, vA2);
            PG8_WAIT_V(8); PG8_WAIT_L(0); PG8_BAR; PG8_MMA(1, 0, At, B0); PG8_MMA(1, 1, At, B1); PG8_BAR; PG8_SCHED;
            PG8_LDB(B0, 1, 0); PG8_LDB(B1, 1, 1); PG8_SCHED; PG8_LDA(At, 1, 0); PG8_STAGE(PG8_SA(0, 1), a2 + hstepA, vA2);
            PG8_WAIT_V(8); PG8_WAIT_L(0); PG8_BAR; PG8_MMA(0, 0, At, B0); PG8_MMA(0, 1, At, B1); PG8_BAR; PG8_SCHED;
            PG8_LDA(At, 1, 1); PG8_STAGE(PG8_SB(1, 0), b3, voffB); PG8_STAGE(PG8_SB(1, 1), b3 + hstepB, voffB); PG8_STAGE(PG8_SA(1, 0), a3, vA2);
            PG8_WAIT_V(8); PG8_WAIT_L(0); PG8_BAR; PG8_MMA(1, 0, At, B0); PG8_MMA(1, 1, At, B1); PG8_BAR; PG8_SCHED;
            } else {
            PG8_LDB(B0, 0, 0); PG8_SCHED; PG8_LDA(At, 0, 0); PG8_STAGE(PG8_SA(1, 1), a1 + hstepA, voffA);
            PG8_WAIT_L(8); PG8_BAR; PG8_WAIT_L(0); PG8_MMA(0, 0, At, B0); PG8_BAR; PG8_SCHED;
            PG8_LDB(B1, 0, 1); PG8_STAGE(PG8_SB(0, 0), b2, voffB);
            PG8_BAR; PG8_WAIT_L(0); PG8_MMA(0, 1, At, B1); PG8_BAR;
            PG8_LDA(At, 0, 1); PG8_STAGE(PG8_SA(0, 0), a2, vA2);
            PG8_BAR; PG8_WAIT_L(0); PG8_MMA(1, 0, At, B0); PG8_BAR; PG8_SCHED;
            PG8_STAGE(PG8_SB(0, 1), b2 + hstepB, voffB);
            PG8_WAIT_V(6); PG8_BAR; PG8_MMA(1, 1, At, B1); PG8_BAR;
            PG8_LDB(B0, 1, 0); PG8_SCHED; PG8_LDA(At, 1, 0); PG8_STAGE(PG8_SA(0, 1), a2 + hstepA, vA2);
            PG8_WAIT_L(8); PG8_BAR; PG8_WAIT_L(0); PG8_MMA(0, 0, At, B0); PG8_BAR; PG8_SCHED;
            PG8_LDB(B1, 1, 1); PG8_STAGE(PG8_SB(1, 0), b3, voffB);
            PG8_BAR; PG8_WAIT_L(0); PG8_MMA(0, 1, At, B1); PG8_BAR;
            PG8_LDA(At, 1, 1); PG8_STAGE(PG8_SA(1, 0), a3, vA2);
            PG8_BAR; PG8_WAIT_L(0); PG8_MMA(1, 0, At, B0); PG8_BAR; PG8_SCHED;
            PG8_STAGE(PG8_SB(1, 1), b3 + hstepB, voffB);
            PG8_WAIT_V(6); PG8_BAR; PG8_MMA(1, 1, At, B1); PG8_BAR;
            }
        }
        if constexpr (ALIGN_EPI) { if (wr == 0) PG8_BAR; }
        if constexpr (!Epi::AFTER_DRAIN) { E(acc, cur, wr, wc, fr, fq); S.done(cur); }
        if (!has_next) break;
        {
#pragma unroll
        for (int a = 0; a < 2; ++a)
#pragma unroll
            for (int b = 0; b < 2; ++b)
#pragma unroll
                for (int m = 0; m < 4; ++m)
#pragma unroll
                    for (int n = 0; n < 2; ++n) acc[a][b][m][n] = (f32x4){0.f, 0.f, 0.f, 0.f};
        }
        cur = nxt; cA = nA; cB = nB; ++ui;
        if constexpr (Sched::GATHER) { voffA[0] = voffN[0]; voffA[1] = voffN[1]; }
        if constexpr (ALIGN_EPI) { if (wr == 1) PG8_BAR; }
    }
    PG8_WAIT_V(0);
    if constexpr (!ALIGN_EPI) { if (wr == 0) PG8_BAR; }
    PG8_BAR;
    if constexpr (Epi::AFTER_DRAIN) { E.fused(acc, cur, wr, wc, fr, fq, lds, wid, lane); S.done(cur); }
#undef PG8_SA
#undef PG8_SB
#undef PG8_STAGE
#undef PG8_LDA
#undef PG8_LDB
#undef PG8_MMA
#undef PG8_CAT
#undef PG8_GVOFF
#undef PG8_RD
#undef PG8_WAIT_V
#undef PG8_WAIT_L
#undef PG8_BAR
#undef PG8_SCHED
}
}

#define XB_TMO      128
#define XB_XCNT(j)  (256  + 64 * (j))
#define XB_XSUB(j)  (1280 + 64 * (j))
#define XB_XGEN(j)  (2304 + 64 * (j))
#define XB_TOP      3328
#define XB_TOPGEN   3392
#define XCD_BAR_WORDS 3456
#define XB_SPIN_CAP (1u << 18)
#define LAS __attribute__((address_space(3)))

__device__ __forceinline__ unsigned xb_ld(unsigned* p)              { return __hip_atomic_load(p, __ATOMIC_RELAXED, __HIP_MEMORY_SCOPE_AGENT); }
__device__ __forceinline__ unsigned xb_add(unsigned* p, unsigned v) { return __hip_atomic_fetch_add(p, v, __ATOMIC_RELAXED, __HIP_MEMORY_SCOPE_AGENT); }
__device__ __forceinline__ unsigned xb_xcc_id() { return (unsigned)__builtin_amdgcn_s_getreg((3 << 11) | 20) & 0xFu; }
#define XB_SPIN(cond, bar) do { unsigned _sp = 0; while (cond) { __builtin_amdgcn_s_sleep(1); \
    if ((++_sp & 255u) == 0u) { if (xb_ld(&(bar)[XB_TMO])) break; if (_sp > XB_SPIN_CAP) { atomicAdd(&(bar)[XB_TMO], 1u); break; } } } } while (0)

struct XcdBarrier {
    unsigned* bar; unsigned x;
    volatile LAS unsigned* st;
};

__device__ __forceinline__ XcdBarrier xcd_barrier_post(unsigned* bar, volatile LAS unsigned* st) {
    XcdBarrier b; b.bar = bar; b.x = xb_xcc_id(); b.st = st;
    if (threadIdx.x == 0) (void)xb_add(&bar[XB_XCNT(b.x)], 1u);
    return b;
}
__device__ __forceinline__ void xcd_barrier_complete(unsigned* bar, unsigned x, unsigned& nloc, unsigned& nx) {
    const unsigned G = gridDim.x * gridDim.y * gridDim.z;
    unsigned sum, cnt, mine, sp = 0u;
    for (;;) {
        sum = 0u; cnt = 0u; mine = 0u;
#pragma unroll
        for (unsigned j = 0; j < 16; ++j) { const unsigned c = xb_ld(&bar[XB_XCNT(j)]); sum += c; cnt += (c > 0u) ? 1u : 0u; mine = (j == x) ? c : mine; }
        if (sum == G) break;
        __builtin_amdgcn_s_sleep(1);
        if ((++sp & 255u) == 0u) { if (xb_ld(&bar[XB_TMO])) break; if (sp > XB_SPIN_CAP) { atomicAdd(&bar[XB_TMO], 1u); break; } }
    }
    nloc = mine > 0u ? mine : 1u; nx = cnt > 0u ? cnt : 1u;
}

__device__ __forceinline__ void xcd_barrier(const XcdBarrier& b) {
    asm volatile("s_waitcnt vmcnt(0)" ::: "memory");
    __syncthreads();
    if (threadIdx.x == 0) {
        unsigned* bar = b.bar;
        __builtin_amdgcn_s_waitcnt(0);
        unsigned nloc = b.st[0], nx = b.st[1];
        if (nloc == 0u) { xcd_barrier_complete(bar, b.x, nloc, nx); b.st[0] = nloc; b.st[1] = nx; }
        const unsigned old = xb_add(&bar[XB_XSUB(b.x)], 1u);
        const unsigned gen = old / nloc;
        if (old + 1u == (gen + 1u) * nloc) {
            __builtin_amdgcn_fence(__ATOMIC_RELEASE, "agent");
            asm volatile("s_waitcnt vmcnt(0)" ::: "memory");
            const unsigned og = xb_add(&bar[XB_TOP], 1u);
            const unsigned tg = og / nx;
            if (og + 1u == (tg + 1u) * nx) xb_add(&bar[XB_TOPGEN], 1u);
            else XB_SPIN(xb_ld(&bar[XB_TOPGEN]) == tg, bar);
            __builtin_amdgcn_fence(__ATOMIC_ACQUIRE, "agent");
            xb_add(&bar[XB_XGEN(b.x)], 1u);
            asm volatile("s_waitcnt vmcnt(0)" ::: "memory");
        } else {
            XB_SPIN(xb_ld(&bar[XB_XGEN(b.x)]) == gen, bar);
            __builtin_amdgcn_fence(__ATOMIC_ACQUIRE, "agent");
            asm volatile("s_waitcnt vmcnt(0)" ::: "memory");
        }
    }
    __syncthreads();
}

constexpr int NWAVES = 8, NTHR = 512;
constexpr int RING_BYTES = 131072;
constexpr int LDS_BYTES = 147456;
constexpr int RT_OFF = 131072;
constexpr int LDSCTL_OFF = LDS_BYTES - 16;
constexpr int CW_BAR = 4096;
typedef float f32x4 __attribute__((ext_vector_type(4)));
typedef unsigned u32x4 __attribute__((ext_vector_type(4)));
typedef unsigned u32x2 __attribute__((ext_vector_type(2)));
typedef short bf16x8 __attribute__((ext_vector_type(8)));
#define LDS_WAIT() asm volatile("s_waitcnt lgkmcnt(0)" ::: "memory")
typedef __bf16 bf16x2_t __attribute__((ext_vector_type(2)));
typedef float f32x2_t __attribute__((ext_vector_type(2)));
__device__ __forceinline__ unsigned pk2(float lo, float hi) { const f32x2_t v = {lo, hi}; return __builtin_bit_cast(unsigned, __builtin_convertvector(v, bf16x2_t)); }
__device__ __forceinline__ int lane_fresh() { int l; asm volatile("v_mbcnt_lo_u32_b32 %0, -1, 0\n\tv_mbcnt_hi_u32_b32 %0, -1, %0" : "=v"(l)); return l; }
#define DPP_ADD(v, ctrl) ((v) + __builtin_bit_cast(float, __builtin_amdgcn_update_dpp(0, __builtin_bit_cast(int, (v)), (ctrl), 0xf, 0xf, true)))
__device__ __forceinline__ float wave_sum(float v) {
    v = DPP_ADD(v, 0xB1);
    v = DPP_ADD(v, 0x4E);
    v = DPP_ADD(v, 0x141);
    v = DPP_ADD(v, 0x140);
    const int iv = __builtin_bit_cast(int, v);
    return (__builtin_bit_cast(float, __builtin_amdgcn_readlane(iv, 0)) + __builtin_bit_cast(float, __builtin_amdgcn_readlane(iv, 16)))
         + (__builtin_bit_cast(float, __builtin_amdgcn_readlane(iv, 32)) + __builtin_bit_cast(float, __builtin_amdgcn_readlane(iv, 48)));
}

constexpr int N1 = 11264;
struct Args { const float* in[38]; float* out; unsigned char* ws; int ph_lo, ph_hi; };

__device__ __forceinline__ void tr_item(const float* W, int ldw, int k0, int n0, bf16* dst, int ldd, const float* mu, int mode, LAS float* scr, int lane) {
    f32x4 v[8];
#pragma unroll
    for (int i = 0; i < 8; ++i) v[i] = *(const f32x4*)(W + (size_t)(k0 + 8 * i + (lane >> 3)) * ldw + n0 + 4 * (lane & 7));
#pragma unroll
    for (int i = 0; i < 8; ++i) { const int kk = 8 * i + (lane >> 3); f32x4 t = v[i];
        if (mode == 1) t = t * (1.0f - mu[k0 + kk]); else if (mode == 2) t = t * mu[k0 + kk];
        LAS float* s = scr + kk * 33 + 4 * (lane & 7); s[0] = t.x; s[1] = t.y; s[2] = t.z; s[3] = t.w; }
    LDS_WAIT(); asm volatile("" ::: "memory");
    const int c = lane & 7;
#pragma unroll
    for (int j = 0; j < 4; ++j) { const int n = (lane >> 3) + 8 * j; const LAS float* s = scr + (8 * c) * 33 + n;
        u32x4 o; o.x = pk2(s[0 * 33], s[1 * 33]); o.y = pk2(s[2 * 33], s[3 * 33]); o.z = pk2(s[4 * 33], s[5 * 33]); o.w = pk2(s[6 * 33], s[7 * 33]);
        *(u32x4*)(dst + (size_t)n * ldd + 8 * c) = o; }
    LDS_WAIT(); asm volatile("" ::: "memory");
}
__device__ __forceinline__ unsigned pk_fp8x4(float a, float b, float c, float d, float sc) {
    a = fminf(fmaxf(a * sc, -448.f), 448.f); b = fminf(fmaxf(b * sc, -448.f), 448.f); c = fminf(fmaxf(c * sc, -448.f), 448.f); d = fminf(fmaxf(d * sc, -448.f), 448.f);
    int p = __builtin_amdgcn_cvt_pk_fp8_f32(a, b, 0, false); p = __builtin_amdgcn_cvt_pk_fp8_f32(c, d, p, true); return (unsigned)p; }
__device__ __forceinline__ void tr_item8(const float* W, int ldw, int k0, int n0, unsigned char* dst, int ldd, float sc, LAS float* scr, int lane) {
    f32x4 v[8];
#pragma unroll
    for (int i = 0; i < 8; ++i) v[i] = *(const f32x4*)(W + (size_t)(k0 + 8 * i + (lane >> 3)) * ldw + n0 + 4 * (lane & 7));
#pragma unroll
    for (int i = 0; i < 8; ++i) { const int kk = 8 * i + (lane >> 3); LAS float* s = scr + kk * 33 + 4 * (lane & 7); s[0] = v[i].x; s[1] = v[i].y; s[2] = v[i].z; s[3] = v[i].w; }
    LDS_WAIT(); asm volatile("" ::: "memory");
    const int c = lane & 7;
#pragma unroll
    for (int j = 0; j < 4; ++j) { const int n = (lane >> 3) + 8 * j; const LAS float* s = scr + (8 * c) * 33 + n;
        u32x2 o; o.x = pk_fp8x4(s[0 * 33], s[1 * 33], s[2 * 33], s[3 * 33], sc); o.y = pk_fp8x4(s[4 * 33], s[5 * 33], s[6 * 33], s[7 * 33], sc);
        *(u32x2*)(dst + (size_t)n * ldd + 8 * c) = o; }
    LDS_WAIT(); asm volatile("" ::: "memory");
}

struct ConvTile { const float* src; int ldw; unsigned char* dst; int rs; int kind; float sc; };
constexpr int CT_IN = (D / 128) * (INW / 128), CT_UP = (AW / 128) * (D / 128), CT_O = (D / 128) * (D / 128), CT_EG = (D / 128) * (FF / 128), CT_ED = (FF / 128) * (D / 128);
constexpr int CT_ALL = CT_IN + 2 * CT_UP + CT_O + NE * (2 * CT_EG + CT_ED);
__device__ __forceinline__ ConvTile conv_decode(int T, const float* const* in, unsigned char* ws) {
    ConvTile t; int r = T;
    if (r < CT_IN) { const int kt = r / (INW / 128), nt = r % (INW / 128), k0 = 128 * kt, n0 = 128 * nt; int dr = n0;
        if (n0 >= 3 * AW + 3 * RW + D) { const int cc = n0 - (3 * AW + 3 * RW + D); dr = 3 * AW + 3 * RW + 256 * (cc / 128) + 128; }
        else if (n0 >= 3 * AW + 3 * RW) { const int cc = n0 - (3 * AW + 3 * RW); dr = 3 * AW + 3 * RW + 256 * (cc / 128); }
        t.src = in[8] + (size_t)k0 * INW + n0; t.ldw = INW; t.dst = ws + WS_W1T + ((size_t)dr * D + k0) * 2; t.rs = D * 2; t.kind = 0; t.sc = 1.f; return t; } r -= CT_IN;
    if (r < 2 * CT_UP) { const int which = r / CT_UP, q = r % CT_UP, kt = q / (D / 128), nt = q % (D / 128), k0 = 128 * kt, n0 = 128 * nt;
        t.src = in[28 + which] + (size_t)k0 * D + n0; t.ldw = D; t.dst = ws + WS_WUPT + ((size_t)n0 * D + which * AW + k0) * 2; t.rs = D * 2; t.kind = 0; t.sc = 1.f; return t; } r -= 2 * CT_UP;
    if (r < CT_O) { const int kt = r / (D / 128), nt = r % (D / 128), k0 = 128 * kt, n0 = 128 * nt;
        t.src = in[30] + (size_t)k0 * D + n0; t.ldw = D; t.dst = ws + WS_WOT + ((size_t)n0 * D + k0) * 2; t.rs = D * 2; t.kind = 0; t.sc = 1.f; return t; } r -= CT_O;
    const int e = r / (2 * CT_EG + CT_ED); r -= e * (2 * CT_EG + CT_ED);
    if (r < 2 * CT_EG) { const int up = r / CT_EG, q = r % CT_EG, kt = q / (FF / 128), nt = q % (FF / 128), k0 = 128 * kt;
        t.src = in[35 + up] + (size_t)e * D * FF + (size_t)k0 * FF + 128 * nt; t.ldw = FF; t.dst = ws + WS_WGUT + ((size_t)e * 1024 + 256 * nt + 128 * up) * D + k0; t.rs = D; t.kind = 1; t.sc = 256.f; return t; } r -= 2 * CT_EG;
    { const int kt = r / (D / 128), nt = r % (D / 128), k0 = 128 * kt, n0 = 128 * nt;
        t.src = in[37] + (size_t)e * FF * D + (size_t)k0 * D + n0; t.ldw = D; t.dst = ws + WS_WDT + ((size_t)e * D + n0) * FF + k0; t.rs = FF; t.kind = 1; t.sc = 128.f; return t; }
}
__device__ __forceinline__ int conv_off(int k, int n) { return k * 132 + 16 * (k >> 5) + n; }
__device__ __forceinline__ void item_kn(int it, int N, int& k0, int& n0) { const int nblk = N / 32; k0 = 64 * (it / nblk); n0 = 32 * (it % nblk); }

struct EpiProj {
    static constexpr bool PERM = true, AFTER_DRAIN = false, MIDK = false;
    bf16* q; bf16* k; bf16* v; bf16* rkv; bf16* gate; bf16* lora; bf16* lorab; const float* rope;
    __device__ __forceinline__ void operator()(const pg8::f32x4 (&acc)[2][2][4][2], const pg8::Unit& u, int wr, int wc, int fr, int fq) const {
        const int row0 = u.pm * 256 + wr * 64 + fr; const int pn = u.pn; const int colw = wc * 32 + 8 * fq;
        if (pn < 8) {
            bf16* base = (pn < 4 ? q : k) + (pn & 3) * 256 + colw;
            const float sgn = fq < 2 ? -1.0f : 1.0f;
#pragma unroll
            for (int ai = 0; ai < 2; ++ai)
#pragma unroll
                for (int m = 0; m < 4; ++m) { const int row = row0 + ai * 128 + m * 16;
                    f32x4 c0, c1, c2, c3;
                    if (wc == 0) { const float* rp = rope + ((size_t)row * 16 + 8 * (fq & 1)) * 2; c0 = *(const f32x4*)rp; c1 = *(const f32x4*)(rp + 4); c2 = *(const f32x4*)(rp + 8); c3 = *(const f32x4*)(rp + 12); }
#pragma unroll
                    for (int bj = 0; bj < 2; ++bj) { f32x4 v0 = acc[ai][bj][m][0], v1 = acc[ai][bj][m][1];
                        if (wc == 0) {
                            f32x4 p0, p1;
#pragma unroll
                            for (int j = 0; j < 4; ++j) { p0[j] = __shfl_xor(v0[j], 32) * sgn; p1[j] = __shfl_xor(v1[j], 32) * sgn; }
                            v0[0] = v0[0] * c0[0] + p0[0] * c0[1]; v0[1] = v0[1] * c0[2] + p0[1] * c0[3]; v0[2] = v0[2] * c1[0] + p0[2] * c1[1]; v0[3] = v0[3] * c1[2] + p0[3] * c1[3];
                            v1[0] = v1[0] * c2[0] + p1[0] * c2[1]; v1[1] = v1[1] * c2[2] + p1[1] * c2[3]; v1[2] = v1[2] * c3[0] + p1[2] * c3[1]; v1[3] = v1[3] * c3[2] + p1[3] * c3[3];
                        }
                        u32x4 w; w.x = pk2(v0[0], v0[1]); w.y = pk2(v0[2], v0[3]); w.z = pk2(v1[0], v1[1]); w.w = pk2(v1[2], v1[3]);
                        *(u32x4*)(base + (size_t)row * AW + bj * 128) = w; } }
        } else if (pn < 12) {
            bf16* base = v + (pn - 8) * 256 + colw;
#pragma unroll
            for (int ai = 0; ai < 2; ++ai)
#pragma unroll
                for (int m = 0; m < 4; ++m) { const int row = row0 + ai * 128 + m * 16;
#pragma unroll
                    for (int bj = 0; bj < 2; ++bj) { const f32x4 v0 = acc[ai][bj][m][0], v1 = acc[ai][bj][m][1];
                        u32x4 w; w.x = pk2(v0[0], v0[1]); w.y = pk2(v0[2], v0[3]); w.z = pk2(v1[0], v1[1]); w.w = pk2(v1[2], v1[3]);
                        *(u32x4*)(base + (size_t)row * AW + bj * 128) = w; } }
        } else if (pn < 24) {
            bf16* base = rkv + (pn - 12) * 256 + colw;
#pragma unroll
            for (int ai = 0; ai < 2; ++ai)
#pragma unroll
                for (int m = 0; m < 4; ++m) { const int row = row0 + ai * 128 + m * 16;
#pragma unroll
                    for (int bj = 0; bj < 2; ++bj) { const f32x4 v0 = acc[ai][bj][m][0], v1 = acc[ai][bj][m][1];
                        u32x4 w; w.x = pk2(v0[0], v0[1]); w.y = pk2(v0[2], v0[3]); w.z = pk2(v1[0], v1[1]); w.w = pk2(v1[2], v1[3]);
                        *(u32x4*)(base + (size_t)row * (3 * RW) + bj * 128) = w; } }
        } else if (pn < 40) {
            bf16* base = gate + (pn - 24) * 128 + colw;
#pragma unroll
            for (int ai = 0; ai < 2; ++ai)
#pragma unroll
                for (int m = 0; m < 4; ++m) { const int row = row0 + ai * 128 + m * 16;
                    const f32x4 a0 = acc[ai][0][m][0], a1 = acc[ai][0][m][1], r0 = acc[ai][1][m][0], r1 = acc[ai][1][m][1]; float ra[8], sr[8];
#pragma unroll
                    for (int j = 0; j < 4; ++j) { const float ea = __expf(-a0[j]), er = __expf(-r0[j]), ea1 = __expf(-a1[j]), er1 = __expf(-r1[j]);
                        sr[j] = __builtin_amdgcn_rcpf(1.0f + er); ra[j] = (1.0f + er) * __builtin_amdgcn_rcpf(1.0f + ea); sr[4 + j] = __builtin_amdgcn_rcpf(1.0f + er1); ra[4 + j] = (1.0f + er1) * __builtin_amdgcn_rcpf(1.0f + ea1); }
                    u32x4 w; w.x = pk2(ra[0], ra[1]); w.y = pk2(ra[2], ra[3]); w.z = pk2(ra[4], ra[5]); w.w = pk2(ra[6], ra[7]);
                    *(u32x4*)(base + (size_t)row * (2 * D)) = w;
                    w.x = pk2(sr[0], sr[1]); w.y = pk2(sr[2], sr[3]); w.z = pk2(sr[4], sr[5]); w.w = pk2(sr[6], sr[7]);
                    *(u32x4*)(base + (size_t)row * (2 * D) + D) = w; }
        } else {
            bf16* base = (u.koff ? lorab : lora) + (pn - 40) * 256 + colw;
#pragma unroll
            for (int ai = 0; ai < 2; ++ai)
#pragma unroll
                for (int m = 0; m < 4; ++m) { const int row = row0 + ai * 128 + m * 16;
#pragma unroll
                    for (int bj = 0; bj < 2; ++bj) { const f32x4 v0 = acc[ai][bj][m][0], v1 = acc[ai][bj][m][1];
                        u32x4 w; w.x = pk2(v0[0], v0[1]); w.y = pk2(v0[2], v0[3]); w.z = pk2(v1[0], v1[1]); w.w = pk2(v1[2], v1[3]);
                        *(u32x4*)(base + (size_t)row * 1024 + bj * 128) = w; } }
        }
    }
};


struct LoraOrder { static constexpr bool GATHER = false; const int* tok; int G, c;
    __device__ bool next(int i, pg8::Unit& u) const { const int L = i * G + c; if (L >= (S / 256) * 8) return false; u.pm = L >> 3; u.pn = 40 + ((L >> 1) & 3); u.koff = (L & 1) * AW * 2; u.koffB = u.koff; return true; }
    __device__ __forceinline__ void a_ready(const pg8::Unit&) const {}
    __device__ __forceinline__ void done(const pg8::Unit&) const {} };
__device__ __forceinline__ void unpack8(const u32x4 w, float (&f)[8]) {
    f[0] = __uint_as_float(w.x << 16); f[1] = __uint_as_float(w.x & 0xffff0000u); f[2] = __uint_as_float(w.y << 16); f[3] = __uint_as_float(w.y & 0xffff0000u);
    f[4] = __uint_as_float(w.z << 16); f[5] = __uint_as_float(w.z & 0xffff0000u); f[6] = __uint_as_float(w.w << 16); f[7] = __uint_as_float(w.w & 0xffff0000u);
}
struct EpiMix {
    static constexpr bool PERM = true, AFTER_DRAIN = false, MIDK = false;
    const bf16* gate; bf16* mix;
    __device__ __forceinline__ void operator()(const pg8::f32x4 (&acc)[2][2][4][2], const pg8::Unit& u, int wr, int wc, int fr, int fq) const {
        const int row0 = u.pm * 256 + wr * 64 + fr; const int col0 = u.pn * 256 + wc * 32 + 8 * fq;
        if (u.koff == 0) {
#pragma unroll
            for (int ai = 0; ai < 2; ++ai)
#pragma unroll
                for (int m = 0; m < 4; ++m) { const size_t row = row0 + ai * 128 + m * 16; const bf16* gp = gate + row * (2 * D) + col0;
#pragma unroll
                    for (int bj = 0; bj < 2; ++bj) { float ga[8]; unpack8(*(const u32x4*)(gp + bj * 128), ga); const pg8::f32x4 v0 = acc[ai][bj][m][0], v1 = acc[ai][bj][m][1];
                        u32x4 w; w.x = pk2(v0[0] * ga[0], v0[1] * ga[1]); w.y = pk2(v0[2] * ga[2], v0[3] * ga[3]); w.z = pk2(v1[0] * ga[4], v1[1] * ga[5]); w.w = pk2(v1[2] * ga[6], v1[3] * ga[7]);
                        *(u32x4*)(mix + row * D + col0 + bj * 128) = w; } }
        } else {
#pragma unroll
            for (int ai = 0; ai < 2; ++ai)
#pragma unroll
                for (int m = 0; m < 4; ++m) { const size_t row = row0 + ai * 128 + m * 16; const bf16* gp = gate + row * (2 * D) + D + col0;
#pragma unroll
                    for (int bj = 0; bj < 2; ++bj) { float gr[8], tp[8]; unpack8(*(const u32x4*)(gp + bj * 128), gr); unpack8(*(const u32x4*)(mix + row * D + col0 + bj * 128), tp); const pg8::f32x4 v0 = acc[ai][bj][m][0], v1 = acc[ai][bj][m][1];
                        u32x4 w; w.x = pk2((v0[0] + tp[0]) * gr[0], (v0[1] + tp[1]) * gr[1]); w.y = pk2((v0[2] + tp[2]) * gr[2], (v0[3] + tp[3]) * gr[3]);
                        w.z = pk2((v1[0] + tp[4]) * gr[4], (v1[1] + tp[5]) * gr[5]); w.w = pk2((v1[2] + tp[6]) * gr[6], (v1[3] + tp[7]) * gr[7]);
                        *(u32x4*)(mix + row * D + col0 + bj * 128) = w; } }
        }
    }
};
struct MixOrder {
    static constexpr bool GATHER = false; const int* tok; int G, c;
    __device__ bool next(int i, pg8::Unit& u) const { const int L = (i >> 1) * G + c; if (L >= (S / 256) * (D / 256)) return false; u.pm = L / (D / 256); u.pn = L % (D / 256); u.koff = (i & 1) * AW * 2; u.koffB = u.koff; return true; }
    __device__ __forceinline__ void a_ready(const pg8::Unit&) const {}
    __device__ __forceinline__ void done(const pg8::Unit&) const {}
};
struct EpiBf16P {
    static constexpr bool PERM = true, AFTER_DRAIN = false, MIDK = false;
    bf16* C; long ldc;
    __device__ __forceinline__ void operator()(const pg8::f32x4 (&acc)[2][2][4][2], const pg8::Unit& u, int wr, int wc, int fr, int fq) const {
        const int row0 = u.pm * 256 + wr * 64 + fr; const int col0 = u.pn * 256 + wc * 32 + 8 * fq;
#pragma unroll
        for (int ai = 0; ai < 2; ++ai)
#pragma unroll
            for (int m = 0; m < 4; ++m) { bf16* p = C + (size_t)(row0 + ai * 128 + m * 16) * ldc + col0;
#pragma unroll
                for (int bj = 0; bj < 2; ++bj) { const pg8::f32x4 v0 = acc[ai][bj][m][0], v1 = acc[ai][bj][m][1];
                    u32x4 w; w.x = pk2(v0[0], v0[1]); w.y = pk2(v0[2], v0[3]); w.z = pk2(v1[0], v1[1]); w.w = pk2(v1[2], v1[3]);
                    *(u32x4*)(p + bj * 128) = w; } }
    }
};
struct EpiF32P {
    static constexpr bool PERM = true, AFTER_DRAIN = false, MIDK = false;
    float* C; long ldc;
    __device__ __forceinline__ void operator()(const pg8::f32x4 (&acc)[2][2][4][2], const pg8::Unit& u, int wr, int wc, int fr, int fq) const {
        const int row0 = u.pm * 256 + wr * 64 + fr; const int col0 = u.pn * 256 + wc * 32 + 8 * fq;
#pragma unroll
        for (int ai = 0; ai < 2; ++ai)
#pragma unroll
            for (int m = 0; m < 4; ++m) { float* p = C + (size_t)(row0 + ai * 128 + m * 16) * ldc + col0;
#pragma unroll
                for (int bj = 0; bj < 2; ++bj) { *(f32x4*)(p + bj * 128) = acc[ai][bj][m][0]; *(f32x4*)(p + bj * 128 + 4) = acc[ai][bj][m][1]; } }
    }
};
template <bool GA> struct ExpertOrderT {
    static constexpr bool GATHER = GA; const int* elist;
    LAS const int* tb; int nj, G, c;
    __device__ bool next(int i, pg8::Unit& u) const { const int L = i * G + c; const int pm = L / nj; if (pm >= tb[512]) return false; u.pm = pm; u.pn = tb[128 + pm] * nj + (L % nj); u.koff = 0; u.koffB = 0; return true; }
    __device__ __forceinline__ int row_tok(int pm, int r) const { const int e = tb[128 + pm]; const int q = tb[320 + pm] + r; return q < tb[e] ? elist[e * S + q] : 0; }
    __device__ __forceinline__ void a_ready(const pg8::Unit&) const {}
    __device__ __forceinline__ void done(const pg8::Unit&) const {}
};
struct EpiHid {
    static constexpr bool PERM = true, AFTER_DRAIN = false, MIDK = false;
    unsigned char* hid;
    __device__ __forceinline__ void operator()(const pg8::f32x4 (&acc)[2][2][4][2], const pg8::Unit& u, int wr, int wc, int fr, int fq) const {
        const int row0 = u.pm * 128 + wr * 64 + fr; const int col0 = (u.pn & 3) * 128 + wc * 32 + 8 * fq;
#pragma unroll
        for (int ai = 0; ai < 1; ++ai)
#pragma unroll
            for (int m = 0; m < 4; ++m) { const pg8::f32x4 g0 = acc[ai][0][m][0], g1 = acc[ai][0][m][1], u0 = acc[ai][1][m][0], u1 = acc[ai][1][m][1]; float o[8];
#pragma unroll
                for (int j = 0; j < 4; ++j) { o[j] = g0[j] * sigmoidf_(g0[j]) * u0[j]; o[4 + j] = g1[j] * sigmoidf_(g1[j]) * u1[j]; }
                u32x2 w; w.x = pk_fp8x4(o[0], o[1], o[2], o[3], 8.0f); w.y = pk_fp8x4(o[4], o[5], o[6], o[7], 8.0f);
                *(u32x2*)(hid + (size_t)(row0 + ai * 128 + m * 16) * FF + col0) = w; }
    }
};
struct EpiYbuf {
    static constexpr bool PERM = true, AFTER_DRAIN = false, MIDK = false;
    bf16* ybuf;
    __device__ __forceinline__ void operator()(const pg8::f32x4 (&acc)[2][2][4][2], const pg8::Unit& u, int wr, int wc, int fr, int fq) const {
        const int row0 = u.pm * 128 + wr * 64 + fr; const int col0 = (u.pn & 7) * 256 + wc * 32 + 8 * fq;
#pragma unroll
        for (int ai = 0; ai < 1; ++ai)
#pragma unroll
            for (int m = 0; m < 4; ++m) { bf16* p = ybuf + (size_t)(row0 + ai * 128 + m * 16) * D + col0;
#pragma unroll
                for (int bj = 0; bj < 2; ++bj) { const pg8::f32x4 v0 = acc[ai][bj][m][0], v1 = acc[ai][bj][m][1];
                    u32x4 w; w.x = pk2(v0[0], v0[1]); w.y = pk2(v0[2], v0[3]); w.z = pk2(v1[0], v1[1]); w.w = pk2(v1[2], v1[3]);
                    *(u32x4*)(p + bj * 128) = w; } }
    }
};
constexpr int RS8 = D + 8;

typedef short s16x4 __attribute__((ext_vector_type(4)));
constexpr int KST = 136, VST = 144;
constexpr int KT_BYTES = 64 * KST * 2, VT_BYTES = 64 * VST * 2;
constexpr int AT_BUF = KT_BYTES + VT_BYTES;
constexpr int AT_G = 2 * AT_BUF;
constexpr int AT_HIST = AT_G + 8 * 2112;
constexpr int AT_ITEMS = AT_HIST + 256;
constexpr int LIST_PER_HEAD = 256 * 496;
__device__ __forceinline__ int list_off(int j) { return 256 * (31 * j - (j * (j - 1)) / 2); }
__device__ __forceinline__ s16x4 tr_read4(unsigned addr) { return __builtin_amdgcn_ds_read_tr16_b64_v4i16((LAS s16x4*)(size_t)addr); }

struct AttnBufs { const bf16* q; const bf16* k; const bf16* v; const bf16* kmh; const bf16* kml; unsigned* mask; int* list; int* cnt; bf16* part; float* ml; };

__device__ __forceinline__ void moba_select_unit(LAS unsigned char* lds, const AttnBufs& A, int head, int qt, int tid, int lane, int wave) {
    const int q0 = qt * 128, qblk = qt >> 1, g4 = lane >> 4, c16 = lane & 15; const int myq = q0 + wave * 16 + c16;
    LAS int* hist = (LAS int*)(lds + AT_HIST); LAS int* base = hist + 32;
    if (tid < 32) hist[tid] = 0;
    __syncthreads();
    unsigned msk = 0u; int lp0 = 0, lp1 = 0, lp2 = 0, b0 = 0, b1 = 0, b2 = 0, nsel = 0;
    if (qblk > 0) {
        bf16x8 qf[4];
#pragma unroll
        for (int ks = 0; ks < 4; ++ks) qf[ks] = *(const bf16x8*)(A.q + (size_t)myq * AW + head * AD + 32 * ks + 8 * g4);
        f32x4 gs[2] = {(f32x4){0.f, 0.f, 0.f, 0.f}, (f32x4){0.f, 0.f, 0.f, 0.f}};
#pragma unroll
        for (int mt = 0; mt < 2; ++mt)
#pragma unroll
            for (int ks = 0; ks < 4; ++ks) { const size_t o = (size_t)(head * NB + 16 * mt + c16) * AD + 32 * ks + 8 * g4;
                gs[mt] = __builtin_amdgcn_mfma_f32_16x16x32_bf16(*(const bf16x8*)(A.kmh + o), qf[ks], gs[mt], 0, 0, 0);
                gs[mt] = __builtin_amdgcn_mfma_f32_16x16x32_bf16(*(const bf16x8*)(A.kml + o), qf[ks], gs[mt], 0, 0, 0); }
        LAS float* G = (LAS float*)(lds + AT_G + wave * 2112);
#pragma unroll
        for (int mt = 0; mt < 2; ++mt)
#pragma unroll
            for (int rg = 0; rg < 4; ++rg) G[c16 * 33 + 16 * mt + 4 * g4 + rg] = gs[mt][rg];
        LDS_WAIT(); asm volatile("" ::: "memory");
        if (lane < 16) {
            nsel = qblk < 3 ? qblk : 3;
            float gvv[32];
#pragma unroll
            for (int n = 0; n < 32; ++n) gvv[n] = G[lane * 33 + n];
#pragma unroll
            for (int n = 0; n < 32; ++n) gvv[n] = n < qblk ? gvv[n] : -3e38f;
#pragma unroll
            for (int t = 0; t < 3; ++t) if (t < nsel) { float best = -3e38f; int bi = 0;
#pragma unroll
                for (int n = 0; n < 32; ++n) { const bool take = gvv[n] > best; best = take ? gvv[n] : best; bi = take ? n : bi; }
#pragma unroll
                for (int n = 0; n < 32; ++n) gvv[n] = (n == bi) ? -3e38f : gvv[n];
                msk |= 1u << bi;
                const int lp = atomicAdd((int*)&hist[bi], 1); if (t == 0) { lp0 = lp; b0 = bi; } else if (t == 1) { lp1 = lp; b1 = bi; } else { lp2 = lp; b2 = bi; } }
        }
    }
    if (lane < 16) A.mask[head * S + myq] = msk;
    __syncthreads();
    if (tid < 32) { const int hcount = hist[tid]; base[tid] = hcount > 0 ? atomicAdd(A.cnt + (head * NB + tid) * ACNT_STR, hcount) : 0; }
    __syncthreads();
    if (lane < 16) { int* lh = A.list + head * LIST_PER_HEAD;
        if (nsel > 0) lh[list_off(b0) + base[b0] + lp0] = myq;
        if (nsel > 1) lh[list_off(b1) + base[b1] + lp1] = myq;
        if (nsel > 2) lh[list_off(b2) + base[b2] + lp2] = myq; }
    __syncthreads();
}

__device__ __forceinline__ void moba_item2(LAS unsigned char* lds, const AttnBufs& A, int head, int kvb, bool own, int r, int cntj, int tid, int lane, int wave) {
    const int g4 = lane >> 4, c16 = lane & 15;
    int myq[2]; bool valid[2];
    if (own) { myq[0] = kvb * MB + wave * 32 + c16; myq[1] = myq[0] + 16; valid[0] = true; valid[1] = true; }
    else { const int* lp = A.list + head * LIST_PER_HEAD + list_off(kvb);
#pragma unroll
        for (int g = 0; g < 2; ++g) { const int e = r * 256 + wave * 32 + 16 * g + c16; valid[g] = e < cntj; myq[g] = lp[valid[g] ? e : 0]; } }
    const bool wave_valid = own || (r * 256 + wave * 32 < cntj);
    const int qfirst = kvb * MB + wave * 32;
    bf16x8 qf[2][4];
#pragma unroll
    for (int g = 0; g < 2; ++g)
#pragma unroll
        for (int ks = 0; ks < 4; ++ks) qf[g][ks] = *(const bf16x8*)(A.q + (size_t)myq[g] * AW + head * AD + 32 * ks + 8 * g4);
    f32x4 oacc[2][8];
#pragma unroll
    for (int g = 0; g < 2; ++g)
#pragma unroll
        for (int dt = 0; dt < 8; ++dt) oacc[g][dt] = (f32x4){0.f, 0.f, 0.f, 0.f};
    float mrun[2] = {-1e30f, -1e30f}, lrun[2] = {0.f, 0.f};
    const float sc2 = 0.08838834764831845f * 1.4426950408889634f;
    const int r0 = tid >> 4, ch = tid & 15;
    u32x4 kr[2], vr[2];
    const bf16* kg = A.k + (size_t)(kvb * MB + r0) * AW + head * AD + 8 * ch; const bf16* vg = A.v + (size_t)(kvb * MB + r0) * AW + head * AD + 8 * ch;
    LAS unsigned char* kst = lds + (r0 * KST + 8 * ch) * 2; LAS unsigned char* vst = lds + KT_BYTES + (r0 * VST + 8 * ch) * 2;
    const LAS unsigned char* kld = lds + (c16 * KST + 8 * g4) * 2; const LAS unsigned char* vld = lds + KT_BYTES + ((4 * g4 + (c16 >> 2)) * VST + 4 * (c16 & 3)) * 2;
#define GLD(it) do { kr[0] = *(const u32x4*)(kg + (size_t)(64 * (it)) * AW); kr[1] = *(const u32x4*)(kg + (size_t)(64 * (it) + 32) * AW); vr[0] = *(const u32x4*)(vg + (size_t)(64 * (it)) * AW); vr[1] = *(const u32x4*)(vg + (size_t)(64 * (it) + 32) * AW); } while (0)
#define LST(b) do { *(LAS u32x4*)(kst + (b) * AT_BUF) = kr[0]; *(LAS u32x4*)(kst + (b) * AT_BUF + 32 * KST * 2) = kr[1]; *(LAS u32x4*)(vst + (b) * AT_BUF) = vr[0]; *(LAS u32x4*)(vst + (b) * AT_BUF + 32 * VST * 2) = vr[1]; } while (0)
    GLD(0); LST(0);
    __syncthreads();
#pragma nounroll
    for (int it = 0; it < 4; ++it) {
        const int kp0 = kvb * MB + 64 * it; const int b = it & 1;
        if (it + 1 < 4) GLD(it + 1);
        if (wave_valid && (!own || kp0 <= qfirst + 31)) {
            const LAS unsigned char* Kb = kld + b * AT_BUF; const LAS unsigned char* vb = vld + b * AT_BUF;
            f32x4 st[2][4];
#pragma unroll
            for (int mt = 0; mt < 4; ++mt) { st[0][mt] = (f32x4){0.f, 0.f, 0.f, 0.f}; st[1][mt] = st[0][mt];
#pragma unroll
                for (int ks = 0; ks < 4; ++ks) { const bf16x8 kf = *(const LAS bf16x8*)(Kb + (16 * mt * KST + 32 * ks) * 2);
                    st[0][mt] = __builtin_amdgcn_mfma_f32_16x16x32_bf16(kf, qf[0][ks], st[0][mt], 0, 0, 0);
                    st[1][mt] = __builtin_amdgcn_mfma_f32_16x16x32_bf16(kf, qf[1][ks], st[1][mt], 0, 0, 0); } }
            bf16x8 pf[2][2];
#pragma unroll
            for (int g = 0; g < 2; ++g) {
                if (own && kp0 + 63 > qfirst + 16 * g) {
#pragma unroll
                    for (int mt = 0; mt < 4; ++mt)
#pragma unroll
                        for (int rg = 0; rg < 4; ++rg) { const int kpos = kp0 + 16 * mt + 4 * g4 + rg; st[g][mt][rg] = (kpos <= myq[g]) ? st[g][mt][rg] : -1e30f; }
                }
                float mloc = fmaxf(fmaxf(fmaxf(st[g][0][0], st[g][0][1]), fmaxf(st[g][0][2], st[g][0][3])), fmaxf(fmaxf(st[g][1][0], st[g][1][1]), fmaxf(st[g][1][2], st[g][1][3])));
                mloc = fmaxf(mloc, fmaxf(fmaxf(fmaxf(st[g][2][0], st[g][2][1]), fmaxf(st[g][2][2], st[g][2][3])), fmaxf(fmaxf(st[g][3][0], st[g][3][1]), fmaxf(st[g][3][2], st[g][3][3]))));
                mloc = fmaxf(mloc, __shfl_xor(mloc, 16)); mloc = fmaxf(mloc, __shfl_xor(mloc, 32));
                const float mnew = fmaxf(mrun[g], mloc * sc2); const float alpha = __builtin_amdgcn_exp2f(mrun[g] - mnew); mrun[g] = mnew;
                float psum = 0.f;
#pragma unroll
                for (int mt = 0; mt < 4; ++mt)
#pragma unroll
                    for (int rg = 0; rg < 4; ++rg) { const float p = __builtin_amdgcn_exp2f(fmaf(st[g][mt][rg], sc2, -mnew)); st[g][mt][rg] = p; psum += p; }
                lrun[g] = lrun[g] * alpha + psum;
#pragma unroll
                for (int dt = 0; dt < 8; ++dt) oacc[g][dt] = oacc[g][dt] * alpha;
#pragma unroll
                for (int s = 0; s < 2; ++s) { u32x4 w; w.x = pk2(st[g][2 * s][0], st[g][2 * s][1]); w.y = pk2(st[g][2 * s][2], st[g][2 * s][3]); w.z = pk2(st[g][2 * s + 1][0], st[g][2 * s + 1][1]); w.w = pk2(st[g][2 * s + 1][2], st[g][2 * s + 1][3]);
                    pf[g][s] = __builtin_bit_cast(bf16x8, w); }
            }
#pragma unroll
            for (int dt = 0; dt < 8; ++dt)
#pragma unroll
                for (int s = 0; s < 2; ++s) {
                    const s16x4 lo = __builtin_amdgcn_ds_read_tr16_b64_v4i16((LAS s16x4*)(vb + (32 * s * VST + 16 * dt) * 2));
                    const s16x4 hi = __builtin_amdgcn_ds_read_tr16_b64_v4i16((LAS s16x4*)(vb + ((32 * s + 16) * VST + 16 * dt) * 2));
                    bf16x8 vf; vf[0] = lo[0]; vf[1] = lo[1]; vf[2] = lo[2]; vf[3] = lo[3]; vf[4] = hi[0]; vf[5] = hi[1]; vf[6] = hi[2]; vf[7] = hi[3];
                    oacc[0][dt] = __builtin_amdgcn_mfma_f32_16x16x32_bf16(vf, pf[0][s], oacc[0][dt], 0, 0, 0);
                    oacc[1][dt] = __builtin_amdgcn_mfma_f32_16x16x32_bf16(vf, pf[1][s], oacc[1][dt], 0, 0, 0); }
        }
        if (it + 1 < 4) LST(b ^ 1);
        __syncthreads();
    }
#undef GLD
#undef LST
#pragma unroll
    for (int g = 0; g < 2; ++g) {
        float l = lrun[g]; l += __shfl_xor(l, 16); l += __shfl_xor(l, 32);
        if (valid[g] && wave_valid) {
            int slot = 0; if (!own) { const unsigned mk = A.mask[head * S + myq[g]]; slot = 1 + __builtin_popcount(mk & ((1u << kvb) - 1u)); }
            const size_t pidx = ((size_t)(head * S + myq[g])) * 4 + slot;
            const float inv = 1.0f / l;
            bf16* orow = A.part + pidx * AD + 4 * g4;
#pragma unroll
            for (int dt = 0; dt < 8; ++dt) { u32x2 w; w.x = pk2(oacc[g][dt][0] * inv, oacc[g][dt][1] * inv); w.y = pk2(oacc[g][dt][2] * inv, oacc[g][dt][3] * inv); *(u32x2*)(orow + 16 * dt) = w; }
            if (g4 == 0) { A.ml[pidx * 2] = mrun[g]; A.ml[pidx * 2 + 1] = l; }
        }
    }
}
__device__ __forceinline__ void moba_items(LAS unsigned char* lds, const AttnBufs& A, int* qhead, LAS int* pre, LAS int* tick, int tid, int lane, int wave) {
    const int nitems = AH * NB + pre[256];
    if (tid == 0) tick[0] = atomicAdd(qhead, 1);
    __syncthreads();
    int item = tick[0];
    while (item < nitems) {
        __syncthreads();
        if (tid == 0) tick[0] = atomicAdd(qhead, 1);
        if (item < AH * NB) moba_item2(lds, A, item >> 5, item & 31, true, 0, 0, tid, lane, wave);
        else { const int s = item - AH * NB; int lo_ = 0, hi_ = 256;
            while (hi_ - lo_ > 1) { const int mid = (lo_ + hi_) >> 1; if (pre[mid] <= s) lo_ = mid; else hi_ = mid; }
            moba_item2(lds, A, lo_ >> 5, lo_ & 31, false, s - pre[lo_], A.cnt[lo_ * ACNT_STR], tid, lane, wave); }
        __syncthreads();
        item = tick[0];
    }
}

constexpr int RST = 72, SLOTB = 64 * RST * 2;
constexpr int NCH = S / 64;
__device__ __forceinline__ bf16x8 frag_rows(const LAS bf16* M, int r0, int k0, int c16, int g4) { return *(const LAS bf16x8*)(M + (r0 + c16) * RST + k0 + 8 * g4); }
__device__ __forceinline__ bf16x8 frag_cols(const LAS bf16* M, int c0, int k0, int c16, int g4) {
    const unsigned base = (unsigned)(size_t)M; const int tq = c16 >> 2, tp = c16 & 3;
    const s16x4 lo = tr_read4(base + ((k0 + 8 * g4 + tq) * RST + c0 + 4 * tp) * 2);
    const s16x4 hi = tr_read4(base + ((k0 + 8 * g4 + 4 + tq) * RST + c0 + 4 * tp) * 2);
    bf16x8 r; r[0] = lo[0]; r[1] = lo[1]; r[2] = lo[2]; r[3] = lo[3]; r[4] = hi[0]; r[5] = hi[1]; r[6] = hi[2]; r[7] = hi[3]; return r;
}
__device__ __forceinline__ void st_tile(LAS bf16* M, const f32x4 v, int r0, int c0, int c16, int g4) {
#pragma unroll
    for (int rg = 0; rg < 4; rg += 2) { const unsigned p = pk2(v[rg], v[rg + 1]); M[(r0 + 4 * g4 + rg) * RST + c0 + c16] = (bf16)(p & 0xffffu); M[(r0 + 4 * g4 + rg + 1) * RST + c0 + c16] = (bf16)(p >> 16); }
}
#define MFMA16(a, b, c) __builtin_amdgcn_mfma_f32_16x16x32_bf16(a, b, c, 0, 0, 0)

struct RwkvBufs { const bf16* rkv; const float* lw; const bf16* av; bf16* P; float* QmT; bf16* Rt; bf16* Yi; float* bonus; };

#define R1_BAR() do { asm volatile("s_waitcnt lgkmcnt(0)" ::: "memory"); __builtin_amdgcn_s_barrier(); asm volatile("" ::: "memory"); } while (0)
struct R1In { float lwv[8]; bf16 av[8], rr[9], kr[9], vr[9]; };
__device__ __forceinline__ void rwkv_r1_load(R1In& I, const RwkvBufs& B, int head, int chunk, int lane, int wave) {
    const int ch = head * RN + lane; const int t0 = chunk * 64 + wave * 8;
#pragma unroll
    for (int i = 0; i < 8; ++i) { I.lwv[i] = B.lw[(size_t)(t0 + i) * RW + ch]; I.av[i] = B.av[(size_t)(t0 + i) * RW + ch]; }
#pragma unroll
    for (int i = 0; i < 9; ++i) { const int t = t0 - 1 + i; if (t >= 0) { const bf16* cr = B.rkv + (size_t)t * (3 * RW) + ch; I.rr[i] = cr[0]; I.kr[i] = cr[RW]; I.vr[i] = cr[2 * RW]; } else { I.rr[i] = 0; I.kr[i] = 0; I.vr[i] = 0; } }
}
__device__ __forceinline__ void rwkv_r1_unit(LAS unsigned char* lds, const RwkvBufs& B, const float* const* in, R1In& I, int head, int chunk, int nhead, int nchunk, int tid, int lane, int wave) {
    LAS bf16* sA = (LAS bf16*)(lds + 0 * SLOTB); LAS bf16* sB = (LAS bf16*)(lds + 1 * SLOTB); LAS bf16* sK = (LAS bf16*)(lds + 2 * SLOTB); LAS bf16* sR = (LAS bf16*)(lds + 3 * SLOTB); LAS bf16* sV = (LAS bf16*)(lds + 4 * SLOTB);
    LAS bf16* sM0 = (LAS bf16*)(lds + 5 * SLOTB); LAS bf16* sM1 = (LAS bf16*)(lds + 6 * SLOTB); LAS bf16* sT0 = (LAS bf16*)(lds + 7 * SLOTB); LAS bf16* sT1 = (LAS bf16*)(lds + 8 * SLOTB);
    LAS bf16* sLak = (LAS bf16*)(lds + 9 * SLOTB); LAS bf16* sMrb = (LAS bf16*)(lds + 10 * SLOTB); LAS bf16* sMrk = (LAS bf16*)(lds + 11 * SLOTB); LAS bf16* sX = (LAS bf16*)(lds + 12 * SLOTB);
    LAS bf16* sW = (LAS bf16*)(lds + 13 * SLOTB); LAS bf16* sU = (LAS bf16*)(lds + 14 * SLOTB);
    LAS float* cs = (LAS float*)(lds + 15 * SLOTB); LAS float* gC = cs + 512;
    const int c16 = lane & 15, g4 = lane >> 4;
    {
        const int ch = head * RN + lane; const int t0 = chunk * 64 + wave * 8;
        const float mur = in[9][ch], muk = in[10][ch], muv = in[11][ch], kkc = in[23][ch], kac = in[24][ch], rkc = in[25][ch];
        float run = 0.f;
#pragma unroll
        for (int i = 0; i < 8; ++i) run += I.lwv[i];
        cs[wave * 64 + lane] = run;
        R1_BAR();
        float off = 0.f;
        for (int w = 0; w < wave; ++w) off += cs[w * 64 + lane];
        float gcur = off;
#pragma unroll
        for (int i = 0; i < 8; ++i) {
            const int t = t0 + i;
            const float r0 = bf2f(I.rr[i + 1]), k0 = bf2f(I.kr[i + 1]), v0 = bf2f(I.vr[i + 1]), rp = bf2f(I.rr[i]), kp = bf2f(I.kr[i]), vp = bf2f(I.vr[i]);
            const float r = r0 + (rp - r0) * mur, kx = k0 + (kp - k0) * muk, vx = v0 + (vp - v0) * muv;
            const float a = bf2f(I.av[i]);
            float kk = kx * kkc; const float ss = wave_sum(kk * kk); kk = kk * __builtin_amdgcn_rcpf(fmaxf(sqrtf(ss), 1e-12f));
            const float kt = kx * (1.0f + (a - 1.0f) * kac);
            const float bn = wave_sum(r * kt * rkc);
            if (lane == 0) B.bonus[(size_t)t * RH + head] = bn;
            const float gprev = gcur; gcur += I.lwv[i];
            const float eg = __expf(gcur), egp = __expf(gprev), eng = __expf(-gcur);
            const int tl = wave * 8 + i;
            { const unsigned pab = pk2(-kk * egp, kk * a * eng), pkr = pk2(kt * eng, r * eg), pv_ = pk2(vx, vx);
              sA[tl * RST + lane] = (bf16)(pab & 0xffffu); sB[tl * RST + lane] = (bf16)(pab >> 16); sK[tl * RST + lane] = (bf16)(pkr & 0xffffu); sR[tl * RST + lane] = (bf16)(pkr >> 16); sV[tl * RST + lane] = (bf16)(pv_ & 0xffffu); }
        }
        if (wave == 7) gC[lane] = __expf(gcur);
    }
    if (nhead >= 0) rwkv_r1_load(I, B, nhead, nchunk, lane, wave);
    R1_BAR();
    const int mt = wave >> 1, ntb = 2 * (wave & 1);
    f32x4 Treg[2];
    for (int r14 = 0; r14 < 1 + REP_R1A; ++r14) {
        f32x4 ab[2], ak[2], rb[2], rk[2];
#pragma unroll
        for (int n = 0; n < 2; ++n) { ab[n] = (f32x4){0.f, 0.f, 0.f, 0.f}; ak[n] = ab[n]; rb[n] = ab[n]; rk[n] = ab[n]; }
#pragma unroll
        for (int s = 0; s < 2; ++s) { const bf16x8 aA = frag_rows(sA, 16 * mt, 32 * s, c16, g4), aR = frag_rows(sR, 16 * mt, 32 * s, c16, g4);
#pragma unroll
            for (int n = 0; n < 2; ++n) { const bf16x8 bB = frag_rows(sB, 16 * (ntb + n), 32 * s, c16, g4), bK = frag_rows(sK, 16 * (ntb + n), 32 * s, c16, g4);
                ab[n] = MFMA16(aA, bB, ab[n]); ak[n] = MFMA16(aA, bK, ak[n]); rb[n] = MFMA16(aR, bB, rb[n]); rk[n] = MFMA16(aR, bK, rk[n]); } }
#pragma unroll
        for (int n = 0; n < 2; ++n) { const int i = 16 * (ntb + n) + c16;
#pragma unroll
            for (int rg = 0; rg < 4; ++rg) { const int t = 16 * mt + 4 * g4 + rg; const bool lo = i < t, le = i <= t;
                ab[n][rg] = lo ? ab[n][rg] : 0.f; ak[n][rg] = lo ? ak[n][rg] : 0.f; rb[n][rg] = le ? rb[n][rg] : 0.f; rk[n][rg] = le ? rk[n][rg] : 0.f;
                Treg[n][rg] = ab[n][rg] + (i == t ? 1.0f : 0.f); }
            st_tile(sM0, ab[n], 16 * mt, 16 * (ntb + n), c16, g4); st_tile(sT0, Treg[n], 16 * mt, 16 * (ntb + n), c16, g4);
            st_tile(sLak, ak[n], 16 * mt, 16 * (ntb + n), c16, g4); st_tile(sMrb, rb[n], 16 * mt, 16 * (ntb + n), c16, g4); st_tile(sMrk, rk[n], 16 * mt, 16 * (ntb + n), c16, g4); }
    }
    R1_BAR();
    LAS bf16* Tc = sT0; LAS bf16* Tn = sT1; LAS bf16* Mc = sM0; LAS bf16* Mn = sM1;
    {
        f32x4 am[2] = {(f32x4){0.f, 0.f, 0.f, 0.f}, (f32x4){0.f, 0.f, 0.f, 0.f}}, ax[2] = {(f32x4){0.f, 0.f, 0.f, 0.f}, (f32x4){0.f, 0.f, 0.f, 0.f}};
#pragma unroll
        for (int s = 0; s < 2; ++s) { const bf16x8 aM = frag_rows(Mc, 16 * mt, 32 * s, c16, g4), aL = frag_rows(sLak, 16 * mt, 32 * s, c16, g4);
#pragma unroll
            for (int n = 0; n < 2; ++n) { am[n] = MFMA16(aM, frag_cols(Mc, 16 * (ntb + n), 32 * s, c16, g4), am[n]); ax[n] = MFMA16(aL, frag_cols(sV, 16 * (ntb + n), 32 * s, c16, g4), ax[n]); } }
#pragma unroll
        for (int n = 0; n < 2; ++n) { st_tile(Mn, am[n], 16 * mt, 16 * (ntb + n), c16, g4); st_tile(sX, ax[n], 16 * mt, 16 * (ntb + n), c16, g4); }
        R1_BAR();
        LAS bf16* t2 = Mc; Mc = Mn; Mn = t2;
    }
    for (int kround = 1; kround <= 5 + REP_R1NR; ++kround) {
        f32x4 am[2] = {(f32x4){0.f, 0.f, 0.f, 0.f}, (f32x4){0.f, 0.f, 0.f, 0.f}};
#pragma unroll
        for (int s = 0; s < 2; ++s) { const bf16x8 aT = frag_rows(Tc, 16 * mt, 32 * s, c16, g4), aM = frag_rows(Mc, 16 * mt, 32 * s, c16, g4);
#pragma unroll
            for (int n = 0; n < 2; ++n) { const bf16x8 bM = frag_cols(Mc, 16 * (ntb + n), 32 * s, c16, g4); Treg[n] = MFMA16(aT, bM, Treg[n]); am[n] = MFMA16(aM, bM, am[n]); } }
#pragma unroll
        for (int n = 0; n < 2; ++n) { st_tile(Tn, Treg[n], 16 * mt, 16 * (ntb + n), c16, g4); st_tile(Mn, am[n], 16 * mt, 16 * (ntb + n), c16, g4); }
        R1_BAR();
        LAS bf16* t1 = Tc; Tc = Tn; Tn = t1; LAS bf16* t2 = Mc; Mc = Mn; Mn = t2;
    }
    for (int rwu = 0; rwu < 1 + REP_R1B; ++rwu) {
        f32x4 aw[2] = {(f32x4){0.f, 0.f, 0.f, 0.f}, (f32x4){0.f, 0.f, 0.f, 0.f}}, au[2] = {(f32x4){0.f, 0.f, 0.f, 0.f}, (f32x4){0.f, 0.f, 0.f, 0.f}};
#pragma unroll
        for (int s = 0; s < 2; ++s) { const bf16x8 aT = frag_rows(Tc, 16 * mt, 32 * s, c16, g4);
#pragma unroll
            for (int n = 0; n < 2; ++n) { aw[n] = MFMA16(aT, frag_cols(sA, 16 * (ntb + n), 32 * s, c16, g4), aw[n]); au[n] = MFMA16(aT, frag_cols(sX, 16 * (ntb + n), 32 * s, c16, g4), au[n]); } }
#pragma unroll
        for (int n = 0; n < 2; ++n) { st_tile(sW, aw[n], 16 * mt, 16 * (ntb + n), c16, g4); st_tile(sU, au[n], 16 * mt, 16 * (ntb + n), c16, g4); }
    }
    R1_BAR();
    for (int rs8 = 0; rs8 < 1 + REP_R1C; ++rs8) {
        const size_t ub = (size_t)(head * NCH + chunk) * 4096;
        f32x4 pp[2], qq[2], rr[2], yy[2];
#pragma unroll
        for (int n = 0; n < 2; ++n) { pp[n] = (f32x4){0.f, 0.f, 0.f, 0.f}; qq[n] = pp[n]; rr[n] = pp[n]; yy[n] = pp[n]; }
#pragma unroll
        for (int s = 0; s < 2; ++s) {
            const bf16x8 cW = frag_cols(sW, 16 * mt, 32 * s, c16, g4), cB = frag_cols(sB, 16 * mt, 32 * s, c16, g4), cK = frag_cols(sK, 16 * mt, 32 * s, c16, g4), cU = frag_cols(sU, 16 * mt, 32 * s, c16, g4), cV = frag_cols(sV, 16 * mt, 32 * s, c16, g4);
#pragma unroll
            for (int n = 0; n < 2; ++n) { const int c0 = 16 * (ntb + n);
                const bf16x8 bB = frag_cols(sB, c0, 32 * s, c16, g4), bU = frag_cols(sU, c0, 32 * s, c16, g4), bV = frag_cols(sV, c0, 32 * s, c16, g4);
                const bf16x8 rMrb = frag_rows(sMrb, c0, 32 * s, c16, g4), rMrk = frag_rows(sMrk, c0, 32 * s, c16, g4);
                pp[n] = MFMA16(cW, bB, pp[n]);
                qq[n] = MFMA16(cB, bU, qq[n]); qq[n] = MFMA16(cK, bV, qq[n]);
                rr[n] = MFMA16(cW, rMrb, rr[n]);
                yy[n] = MFMA16(cU, rMrb, yy[n]); yy[n] = MFMA16(cV, rMrk, yy[n]); } }
#pragma unroll
        for (int n = 0; n < 2; ++n) { const int j = 16 * (ntb + n) + c16; const int i0 = 16 * mt + 4 * g4;
            {
                const float gc = gC[j]; float o[4];
#pragma unroll
                for (int rg = 0; rg < 4; ++rg) o[rg] = gc * (pp[n][rg] + ((i0 + rg) == j ? 1.0f : 0.f));
                u32x2 w; w.x = pk2(o[0], o[1]); w.y = pk2(o[2], o[3]); *(u32x2*)(B.P + ub + (size_t)j * 64 + i0) = w; }
            {
                f32x4 o;
#pragma unroll
                for (int rg = 0; rg < 4; ++rg) o[rg] = gC[i0 + rg] * qq[n][rg];
                *(f32x4*)(B.QmT + ub + (size_t)j * 64 + i0) = o; }
            {
                const u32x2 rb2 = *(const LAS u32x2*)(sR + j * RST + i0); float o[4];
                o[0] = rr[n][0] + __uint_as_float(rb2.x << 16); o[1] = rr[n][1] + __uint_as_float(rb2.x & 0xffff0000u); o[2] = rr[n][2] + __uint_as_float(rb2.y << 16); o[3] = rr[n][3] + __uint_as_float(rb2.y & 0xffff0000u);
                u32x2 w; w.x = pk2(o[0], o[1]); w.y = pk2(o[2], o[3]); *(u32x2*)(B.Rt + ub + (size_t)j * 64 + i0) = w; }
            { u32x2 w; w.x = pk2(yy[n][0], yy[n][1]); w.y = pk2(yy[n][2], yy[n][3]); *(u32x2*)(B.Yi + ub + (size_t)j * 64 + i0) = w; }
        }
    }
    R1_BAR();
}

constexpr int R2_PST = 136, R2_QST = 272, R2_QOFF = 64 * R2_PST, R2_SLOT = R2_QOFF + 16 * R2_QST;
__device__ __forceinline__ void rwkv_r2_wg(LAS unsigned char* lds, const bf16* __restrict__ P, const float* __restrict__ QmT, bf16* __restrict__ H0T, int head, int cg, int wave, int lane) {
    const int c16 = lane & 15, g4 = lane >> 4;
    const int lt = ((wave & 3) << 6) | lane;
#define R2_BAR() do { asm volatile("s_waitcnt lgkmcnt(0)" ::: "memory"); __builtin_amdgcn_s_barrier(); asm volatile("" ::: "memory"); } while (0)
    if (wave >= 4) {
        constexpr int NST = 8;
        u32x4 st[NST][3];
        auto gl = [&](int c, u32x4 (&r)[3]) { const size_t ub = (size_t)(head * NCH + c) * 4096;
            const u32x4* p = (const u32x4*)(P + ub); const u32x4* q = (const u32x4*)(QmT + ub + (size_t)(16 * cg) * 64);
            r[0] = p[lt]; r[1] = p[lt + 256]; r[2] = q[lt]; };
        auto lw = [&](int slot, const u32x4 (&r)[3]) { LAS unsigned char* s = lds + slot * R2_SLOT;
#pragma unroll
            for (int i = 0; i < 2; ++i) { const int idx = lt + 256 * i; LAS u32x2* d = (LAS u32x2*)(s + (idx >> 3) * R2_PST + (idx & 7) * 16); u32x2 a; a.x = r[i].x; a.y = r[i].y; u32x2 b; b.x = r[i].z; b.y = r[i].w; d[0] = a; d[1] = b; }
            *(LAS u32x4*)(s + R2_QOFF + (lt >> 4) * R2_QST + (lt & 15) * 16) = r[2]; };
#pragma unroll
        for (int j = 0; j < NST; ++j) gl(j, st[j]);
        lw(0, st[0]); gl(NST, st[0]);
        R2_BAR();
        for (int c4 = 0; c4 < NCH / NST; ++c4) {
#pragma unroll
            for (int j = 0; j < NST; ++j) { const int c = NST * c4 + j;
                if (c + 1 < NCH) lw((c + 1) & 1, st[(j + 1) % NST]);
                if (c + 1 + NST < NCH) gl(c + 1 + NST, st[(j + 1) % NST]);
                R2_BAR(); }
        }
    } else if (wave == 0) {
        f32x4 hacc[4];
#pragma unroll
        for (int m = 0; m < 4; ++m) hacc[m] = (f32x4){0.f, 0.f, 0.f, 0.f};
        R2_BAR();
        for (int c = 0; c < NCH; ++c) {
            const LAS unsigned char* s = lds + (c & 1) * R2_SLOT; const size_t ub = (size_t)(head * NCH + c) * 4096;
            bf16x8 af[4][2]; f32x4 qv[4];
#pragma unroll
            for (int m = 0; m < 4; ++m) { qv[m] = *(const LAS f32x4*)(s + R2_QOFF + c16 * R2_QST + (16 * m + 4 * g4) * 4);
#pragma unroll
                for (int sx = 0; sx < 2; ++sx) { const LAS unsigned char* pr = s + (16 * m + c16) * R2_PST + (32 * sx + 4 * g4) * 2; const u32x2 a = *(const LAS u32x2*)pr, b = *(const LAS u32x2*)(pr + 32);
                    u32x4 w; w.x = a.x; w.y = a.y; w.z = b.x; w.w = b.y; af[m][sx] = __builtin_bit_cast(bf16x8, w); } }
            bf16x8 bfr[2];
#pragma unroll
            for (int sx = 0; sx < 2; ++sx) { u32x4 w; w.x = pk2(hacc[2 * sx][0], hacc[2 * sx][1]); w.y = pk2(hacc[2 * sx][2], hacc[2 * sx][3]); w.z = pk2(hacc[2 * sx + 1][0], hacc[2 * sx + 1][1]); w.w = pk2(hacc[2 * sx + 1][2], hacc[2 * sx + 1][3]);
                bfr[sx] = __builtin_bit_cast(bf16x8, w);
                u32x2 h0; h0.x = w.x; h0.y = w.y; *(u32x2*)(H0T + ub + (size_t)(16 * cg + c16) * 64 + 16 * (2 * sx) + 4 * g4) = h0;
                u32x2 h1; h1.x = w.z; h1.y = w.w; *(u32x2*)(H0T + ub + (size_t)(16 * cg + c16) * 64 + 16 * (2 * sx + 1) + 4 * g4) = h1; }
#pragma unroll
            for (int m = 0; m < 4; ++m) { hacc[m] = MFMA16(af[m][0], bfr[0], qv[m]); hacc[m] = MFMA16(af[m][1], bfr[1], hacc[m]); }
            R2_BAR();
        }
    } else {
        for (int c = 0; c <= NCH; ++c) R2_BAR();
    }
#undef R2_BAR
}

__device__ __forceinline__ f32x4 ld_bf4(const bf16* p) { const u32x2 w = *(const u32x2*)p; return (f32x4){__uint_as_float(w.x << 16), __uint_as_float(w.x & 0xffff0000u), __uint_as_float(w.y << 16), __uint_as_float(w.y & 0xffff0000u)}; }
__device__ __forceinline__ void rwkv_r3_wave(const RwkvBufs& B, const bf16* __restrict__ H0T, const float* const* in, const bf16* __restrict__ gv, bf16* __restrict__ ocat, int head, int chunk, int nt, int lane) {
    const int c16 = lane & 15, g4 = lane >> 4; const size_t ub = (size_t)(head * NCH + chunk) * 4096;
    const int t = chunk * 64 + 16 * nt + c16;
    bf16x8 rf[2], hf[4][2]; f32x4 y[4], gw[4], gb[4], muv[4], gg[4], v0[4], vp[4];
#pragma unroll
    for (int s = 0; s < 2; ++s) rf[s] = *(const bf16x8*)(B.Rt + ub + (size_t)(16 * nt + c16) * 64 + 32 * s + 8 * g4);
#pragma unroll
    for (int m = 0; m < 4; ++m) { y[m] = ld_bf4(B.Yi + ub + (size_t)(16 * nt + c16) * 64 + 16 * m + 4 * g4);
#pragma unroll
        for (int s = 0; s < 2; ++s) hf[m][s] = *(const bf16x8*)(H0T + ub + (size_t)(16 * m + c16) * 64 + 32 * s + 8 * g4); }
    const float bn = B.bonus[(size_t)t * RH + head];
#pragma unroll
    for (int m = 0; m < 4; ++m) { const int ch = head * RN + 16 * m + 4 * g4;
        gw[m] = *(const f32x4*)(in[26] + ch); gb[m] = *(const f32x4*)(in[27] + ch); muv[m] = *(const f32x4*)(in[11] + ch); gg[m] = ld_bf4(gv + (size_t)t * RW + ch);
        v0[m] = ld_bf4(B.rkv + (size_t)t * (3 * RW) + 2 * RW + ch); vp[m] = (f32x4){0.f, 0.f, 0.f, 0.f}; if (t > 0) vp[m] = ld_bf4(B.rkv + (size_t)(t - 1) * (3 * RW) + 2 * RW + ch); }
    float s1 = 0.f;
#pragma unroll
    for (int m = 0; m < 4; ++m) {
#pragma unroll
        for (int s = 0; s < 2; ++s) y[m] = MFMA16(hf[m][s], rf[s], y[m]);
        s1 += (y[m][0] + y[m][1]) + (y[m][2] + y[m][3]); }
    s1 += __shfl_xor(s1, 16); s1 += __shfl_xor(s1, 32);
    const float mean = s1 * (1.0f / 64.0f); float s2 = 0.f;
#pragma unroll
    for (int m = 0; m < 4; ++m) { y[m] = y[m] - mean; s2 += (y[m][0] * y[m][0] + y[m][1] * y[m][1]) + (y[m][2] * y[m][2] + y[m][3] * y[m][3]); }
    s2 += __shfl_xor(s2, 16); s2 += __shfl_xor(s2, 32);
    const float rstd = rsqrtf(s2 * (1.0f / 64.0f) + 64e-5f);
#pragma unroll
    for (int m = 0; m < 4; ++m) { const int ch = head * RN + 16 * m + 4 * g4;
        const f32x4 vx = v0[m] + (vp[m] - v0[m]) * muv[m];
        const f32x4 o = (y[m] * rstd * gw[m] + gb[m] + vx * bn) * gg[m];
        u32x2 w; w.x = pk2(o[0], o[1]); w.y = pk2(o[2], o[3]); *(u32x2*)(ocat + (size_t)t * (2 * RW) + RW + ch) = w; }
}
template <int WHICH> struct Lora2Order { static constexpr bool GATHER = false; const int* tok; int G, c;
    __device__ bool next(int i, pg8::Unit& u) const { const int L = i * G + c; if (L >= (S / 128) * 4) return false; u.pm = L >> 2; u.pn = WHICH * 4 + (L & 3); u.koff = WHICH * 512; u.koffB = 0; return true; }
    __device__ __forceinline__ void a_ready(const pg8::Unit&) const {}
    __device__ __forceinline__ void done(const pg8::Unit&) const {} };
template <int WHICH> struct EpiLora2 {
    static constexpr bool PERM = true, AFTER_DRAIN = false, MIDK = false;
    void* dst; const float* bias;
    __device__ __forceinline__ void operator()(const pg8::f32x4 (&acc)[2][2][4][2], const pg8::Unit& u, int wr, int wc, int fr, int fq) const {
        const int row0 = u.pm * 128 + wr * 64 + fr; const int col0 = (u.pn & 3) * 256 + wc * 32 + 8 * fq;
#pragma unroll
        for (int ai = 0; ai < 1; ++ai)
#pragma unroll
            for (int m = 0; m < 4; ++m) { const size_t off = (size_t)(row0 + ai * 128 + m * 16) * RW + col0;
#pragma unroll
                for (int bj = 0; bj < 2; ++bj) { f32x4 v0 = acc[ai][bj][m][0], v1 = acc[ai][bj][m][1];
                    if (WHICH < 2) { const f32x4 b0 = *(const f32x4*)(bias + col0 + bj * 128), b1 = *(const f32x4*)(bias + col0 + bj * 128 + 4);
#pragma unroll
                        for (int j = 0; j < 4; ++j) { v0[j] = sigmoidf_(v0[j] + b0[j]); v1[j] = sigmoidf_(v1[j] + b1[j]); }
                        if (WHICH == 0) { v0 = v0 * -0.60653065971263342f; v1 = v1 * -0.60653065971263342f; } }
                    if (WHICH == 0) { float* p = (float*)dst + off + bj * 128; *(f32x4*)p = v0; *(f32x4*)(p + 4) = v1; }
                    else { u32x4 w; w.x = pk2(v0[0], v0[1]); w.y = pk2(v0[2], v0[3]); w.z = pk2(v1[0], v1[1]); w.w = pk2(v1[2], v1[3]); *(u32x4*)((bf16*)dst + off + bj * 128) = w; } } }
    }
};

__global__ void __launch_bounds__(NTHR, 2) fwd(Args args) {
    extern __shared__ __attribute__((aligned(16))) unsigned char lds_raw[];
    LAS unsigned char* lds = (LAS unsigned char*)lds_raw;
    const int wave = __builtin_amdgcn_readfirstlane(threadIdx.x >> 6);
    const int G = gridDim.x, wg = blockIdx.x;
    unsigned char* ws = args.ws;
    unsigned* ctl = (unsigned*)(ws + WS_CTL);
    if (threadIdx.x < 4) ((LAS unsigned*)(lds + LDSCTL_OFF))[threadIdx.x] = 0u;
    __syncthreads();
    XcdBarrier bar = xcd_barrier_post(ctl + CW_BAR, (volatile LAS unsigned*)(lds + LDSCTL_OFF));
    const int lo = args.ph_lo, hi = args.ph_hi;
#define IN(k) (lo <= (k) && (k) < hi)
#define PH(k) for (int rep_ = 0; rep_ < ((k) == REP_PHASE ? 1 + REP_N : 1); ++rep_) if (IN(k))
#define SEAM(k) do { if (IN(k) && IN((k) + 1)) xcd_barrier(bar); } while (0)
#define ROUTE_TABLE() do { LAS int* tb_ = (LAS int*)(lds + RT_OFF); \
        if (tid < 64) { const int c_ = ((const int*)ctl)[CW_CNT + tid * CNT_STR]; const int nt_ = (c_ + 127) >> 7; int o_ = nt_; \
            _Pragma("unroll") for (int d_ = 1; d_ < 64; d_ <<= 1) { const int t_ = __shfl_up(o_, d_); if (tid >= d_) o_ += t_; } \
            const int first_ = o_ - nt_; tb_[tid] = c_; tb_[64 + tid] = first_ * 128; \
            for (int t_ = 0; t_ < nt_; ++t_) { tb_[128 + first_ + t_] = tid; tb_[320 + first_ + t_] = t_ * 128; } \
            if (tid == 63) tb_[512] = o_; } \
        __syncthreads(); } while (0)
    const int gw = wg * NWAVES + wave, NGW = G * NWAVES;

    const float* x = args.in[0];
    float* ada = (float*)(ws + WS_ADA); float* rope = (float*)(ws + WS_ROPE);
    bf16* h = (bf16*)(ws + WS_H); bf16* W1t = (bf16*)(ws + WS_W1T); bf16* Wupt = (bf16*)(ws + WS_WUPT); bf16* Wot = (bf16*)(ws + WS_WOT);
    unsigned char* Wgut = ws + WS_WGUT; unsigned char* Wdt = ws + WS_WDT;

    PH(0) { const int lane = lane_fresh(); const int tid = (wave << 6) | lane; (void)tid; (void)lane;
        {
            const float* c = args.in[1]; const float* w_ada = args.in[2]; const float* b_ada = args.in[3];
            LAS float* red = (LAS float*)lds;
            for (int u = wg; u < 6 * D / 64; u += G) {
                const int n = u * 64 + lane; float s = 0.f;
#pragma unroll 8
                for (int kq = wave; kq < D; kq += NWAVES) s += c[kq] * w_ada[(size_t)kq * (6 * D) + n];
                red[wave * 64 + lane] = s;
                __syncthreads();
                if (wave == 0) { float t = b_ada[n]; for (int w = 0; w < NWAVES; ++w) t += red[w * 64 + lane];
                    __hip_atomic_store(ada + n, t, __ATOMIC_RELAXED, __HIP_MEMORY_SCOPE_AGENT);
                    asm volatile("s_waitcnt vmcnt(0)" ::: "memory");
                    if (lane == 0) (void)xb_add(ctl + CW_ADA, 1u); }
                __syncthreads();
            }
        }
        for (int i = wg * NTHR + tid; i < S * 16; i += G * NTHR) {
            const int pos = i >> 4, j = i & 15; const float inv = powf(500000.0f, -(float)j / 16.0f); const float ang = (float)pos * inv;
            rope[2 * i] = cosf(ang); rope[2 * i + 1] = sinf(ang);
        }
        for (int i = wg * NTHR + tid; i < 128 * D / 8; i += G * NTHR) ((u32x4*)(W1t + (size_t)(N1 - 128) * D))[i] = (u32x4){0u, 0u, 0u, 0u};
        {
            bf16* wrh = (bf16*)(ws + WS_WR); bf16* wrl = wrh + 80 * D; const float* w_rg = args.in[31]; const float* w_re = args.in[33];
            for (int i = wg * NTHR + tid; i < 80 * D; i += G * NTHR) { const int n = i / D, kq = i % D; const float v = n < NG ? w_rg[kq * NG + n] : (n < NG + NE ? w_re[kq * NE + n - NG] : 0.f);
                const bf16 hi = f2bf(v); wrh[i] = hi; wrl[i] = f2bf(v - bf2f(hi)); }
        }
        {
            bf16* wl2 = (bf16*)(ws + WS_WL2); const float* w_w2 = args.in[17]; const float* w_a2 = args.in[20]; const float* w_g2 = args.in[22];
            for (int i = wg * NTHR + tid; i < 3 * RW * 256; i += G * NTHR) { const int n = i >> 8, kq = i & 255, which = n / RW, cc = n % RW; float v = 0.f;
                if (which == 0) { if (kq < LW) v = w_w2[kq * RW + cc]; } else if (which == 1) { if (kq < LA) v = w_a2[kq * RW + cc]; } else v = w_g2[kq * RW + cc];
                wl2[i] = f2bf(v); }
        }
        LAS float* scr = (LAS float*)(lds + wave * 16384);
        constexpr int I_W = (D / 64) * (LW / 32), I_A = (D / 64) * (LA / 32), I_G = (D / 64) * (LG / 32);
        constexpr int NIT = 2 * (I_W + I_A + I_G);
        for (int it = gw; it < NIT; it += NGW) {
            int r = it, k0, n0;
            if (r < 2 * I_W) { const int md = 1 + r / I_W; item_kn(r % I_W, LW, k0, n0); tr_item(args.in[16], LW, k0, n0, W1t + (size_t)(INW + (md - 1) * LO + n0) * D + k0, D, args.in[12], md, scr, lane); continue; } r -= 2 * I_W;
            if (r < 2 * I_A) { const int md = 1 + r / I_A; item_kn(r % I_A, LA, k0, n0); tr_item(args.in[19], LA, k0, n0, W1t + (size_t)(INW + (md - 1) * LO + LW + n0) * D + k0, D, args.in[13], md, scr, lane); continue; } r -= 2 * I_A;
            const int md = 1 + r / I_G; item_kn(r % I_G, LG, k0, n0); tr_item(args.in[21], LG, k0, n0, W1t + (size_t)(INW + (md - 1) * LO + LW + LA + n0) * D + k0, D, args.in[14], md, scr, lane);
        }
        __syncthreads();
        {
            const int lr = tid >> 5, c4 = tid & 31, nl = lane & 15, kq = lane >> 4, ncol = 16 * wave + nl;
            f32x4 v[8]; int T = wg;
            if (T < CT_ALL) { const ConvTile t = conv_decode(T, args.in, ws);
#pragma unroll
                for (int i = 0; i < 8; ++i) v[i] = *(const f32x4*)(t.src + (size_t)(lr + 16 * i) * t.ldw + 4 * c4); }
            for (int itc = 0; T < CT_ALL; T += G, ++itc) {
                LAS float* buf = (LAS float*)(lds + (itc & 1) * 69632);
#pragma unroll
                for (int i = 0; i < 8; ++i) *(LAS f32x4*)(buf + conv_off(lr + 16 * i, 4 * c4)) = v[i];
                const ConvTile t = conv_decode(T, args.in, ws);
                if (T + G < CT_ALL) { const ConvTile tn = conv_decode(T + G, args.in, ws);
#pragma unroll
                    for (int i = 0; i < 8; ++i) v[i] = *(const f32x4*)(tn.src + (size_t)(lr + 16 * i) * tn.ldw + 4 * c4); }
                R1_BAR();
                float xv[32];
#pragma unroll
                for (int j = 0; j < 32; ++j) xv[j] = buf[conv_off(32 * kq + j, ncol)];
                if (t.kind) { unsigned char* d = t.dst + (size_t)ncol * t.rs + 32 * kq;
                    u32x4 o0, o1; o0.x = pk_fp8x4(xv[0], xv[1], xv[2], xv[3], t.sc); o0.y = pk_fp8x4(xv[4], xv[5], xv[6], xv[7], t.sc); o0.z = pk_fp8x4(xv[8], xv[9], xv[10], xv[11], t.sc); o0.w = pk_fp8x4(xv[12], xv[13], xv[14], xv[15], t.sc);
                    o1.x = pk_fp8x4(xv[16], xv[17], xv[18], xv[19], t.sc); o1.y = pk_fp8x4(xv[20], xv[21], xv[22], xv[23], t.sc); o1.z = pk_fp8x4(xv[24], xv[25], xv[26], xv[27], t.sc); o1.w = pk_fp8x4(xv[28], xv[29], xv[30], xv[31], t.sc);
                    *(u32x4*)d = o0; *(u32x4*)(d + 16) = o1; }
                else { unsigned char* d = t.dst + (size_t)ncol * t.rs + 64 * kq;
#pragma unroll
                    for (int q = 0; q < 4; ++q) { u32x4 o; o.x = pk2(xv[8 * q], xv[8 * q + 1]); o.y = pk2(xv[8 * q + 2], xv[8 * q + 3]); o.z = pk2(xv[8 * q + 4], xv[8 * q + 5]); o.w = pk2(xv[8 * q + 6], xv[8 * q + 7]); *(u32x4*)(d + 16 * q) = o; } }
            }
            __syncthreads();
        }
        {
            if (tid == 0) { XB_SPIN(xb_ld(ctl + CW_ADA) < (unsigned)(6 * D / 64), bar.bar); __builtin_amdgcn_fence(__ATOMIC_ACQUIRE, "agent"); asm volatile("s_waitcnt vmcnt(0)" ::: "memory"); }
            __syncthreads();
        const float* g = args.in[4]; const float* sh1 = ada; const float* sc1 = ada + D;
        f32x4 gs[8], sh[8];
#pragma unroll
        for (int j = 0; j < 8; ++j) { const int c = 4 * lane + 256 * j; const f32x4 gg = *(const f32x4*)(g + c), ss = *(const f32x4*)(sc1 + c); gs[j] = gg * (ss + 1.0f); sh[j] = *(const f32x4*)(sh1 + c); }
        for (int rb = gw; rb < S; rb += 2 * NGW) {
            f32x4 v[2][8]; float s[2] = {0.f, 0.f};
#pragma unroll
            for (int q = 0; q < 2; ++q) { const f32x4* xr = (const f32x4*)(x + (size_t)(rb + q * NGW) * D) + lane;
#pragma unroll
                for (int j = 0; j < 8; ++j) v[q][j] = xr[64 * j]; }
#pragma unroll
            for (int q = 0; q < 2; ++q)
#pragma unroll
                for (int j = 0; j < 8; ++j) s[q] += (v[q][j].x * v[q][j].x + v[q][j].y * v[q][j].y) + (v[q][j].z * v[q][j].z + v[q][j].w * v[q][j].w);
            float r[2]; r[0] = rsqrtf(wave_sum(s[0]) * (1.0f / D) + 1e-6f); r[1] = rsqrtf(wave_sum(s[1]) * (1.0f / D) + 1e-6f);
#pragma unroll
            for (int q = 0; q < 2; ++q) { u32x2* o = (u32x2*)(h + (size_t)(rb + q * NGW) * D) + lane;
#pragma unroll
                for (int j = 0; j < 8; ++j) { const f32x4 t = v[q][j] * r[q] * gs[j] + sh[j]; u32x2 w; w.x = pk2(t.x, t.y); w.y = pk2(t.z, t.w); o[64 * j] = w; } }
        }

        }
    }
    SEAM(0);
    PH(2) { const int lane = lane_fresh(); const int tid = (wave << 6) | lane; (void)tid; (void)lane;
        EpiProj E{(bf16*)(ws + WS_Q), (bf16*)(ws + WS_K), (bf16*)(ws + WS_V), (bf16*)(ws + WS_RKV), (bf16*)(ws + WS_GATE), (bf16*)(ws + WS_LORA), (bf16*)(ws + WS_LORAB), rope};
        { pg8::Gemm g{h, W1t, S, INW, D, D, D}; pg8::StaticOrder So; So.init(S, INW, G, wg);
          pg8::gemm_phase<EpiProj, pg8::StaticOrder, true, true>(lds, g, So, E); }
        { int ld_ = D; asm volatile("" : "+s"(ld_)); pg8::Gemm g{h, W1t, S, N1, AW, ld_, ld_}; LoraOrder So{nullptr, G, wg};
          pg8::gemm_phase<EpiProj, LoraOrder, true, true>(lds, g, So, E); }
    }
    SEAM(2);

    bf16* qb = (bf16*)(ws + WS_Q); bf16* kb = (bf16*)(ws + WS_K); bf16* vb = (bf16*)(ws + WS_V);
    bf16* kmh = (bf16*)(ws + WS_KMEAN); bf16* kml = kmh + AH * NB * AD;
    AttnBufs AB{qb, kb, vb, kmh, kml, (unsigned*)(ws + WS_AMASK), (int*)(ws + WS_ALIST), (int*)ctl + CW_ACNT, (bf16*)(ws + WS_APART), (float*)(ws + WS_AML)};
    PH(3) { const int lane = lane_fresh(); const int tid = (wave << 6) | lane; (void)tid; (void)lane;
        for (int hb = wg; hb < AH * NB; hb += G) { const int hd = hb / NB, bk = hb % NB; LAS float* red = (LAS float*)lds;
            float s0 = 0.f, s1 = 0.f; const unsigned* src = (const unsigned*)(kb + (size_t)(bk * MB + wave * 32) * AW + hd * AD) + lane;
#pragma unroll 8
            for (int r = 0; r < 32; ++r) { const unsigned w2 = src[(size_t)r * (AW / 2)]; s0 += __uint_as_float(w2 << 16); s1 += __uint_as_float(w2 & 0xffff0000u); }
            red[wave * 128 + 2 * lane] = s0; red[wave * 128 + 2 * lane + 1] = s1;
            __syncthreads();
            if (tid < AD) { float s = 0.f;
#pragma unroll
                for (int w = 0; w < 8; ++w) s += red[w * 128 + tid];
                s *= (1.0f / MB); const bf16 hi = f2bf(s); kmh[hb * AD + tid] = hi; kml[hb * AD + tid] = f2bf(s - bf2f(hi)); }
            __syncthreads();
        }
        {
            const bf16* lora = (const bf16*)(ws + WS_LORA); const bf16* lb = (const bf16*)(ws + WS_LORAB); bf16* al2 = (bf16*)(ws + WS_AL2);
#pragma unroll 4
            for (int i = wg * NTHR + tid; i < S * 384; i += G * NTHR) { const int t = i / 384, j = (i % 384) * 2, which = j >> 8, jj = j & 255; float v0 = 0.f, v1 = 0.f;
                const int src = which == 0 ? jj : (which == 1 ? LW + jj : LW + LA + jj); const bool real = which == 2 || jj < LW;
                if (real) { const unsigned a0 = *(const unsigned*)(lora + (size_t)t * 1024 + src), a1 = *(const unsigned*)(lb + (size_t)t * 1024 + src);
                    unsigned p0 = 0u, p1 = 0u; if (t > 0) { p0 = *(const unsigned*)(lora + (size_t)(t - 1) * 1024 + LO + src); p1 = *(const unsigned*)(lb + (size_t)(t - 1) * 1024 + LO + src); }
                    v0 = (__uint_as_float(a0 << 16) + __uint_as_float(a1 << 16)) + (__uint_as_float(p0 << 16) + __uint_as_float(p1 << 16));
                    v1 = (__uint_as_float(a0 & 0xffff0000u) + __uint_as_float(a1 & 0xffff0000u)) + (__uint_as_float(p0 & 0xffff0000u) + __uint_as_float(p1 & 0xffff0000u));
                    if (which == 0) { v0 = 1.0f - 2.0f / (1.0f + __expf(2.0f * v0)); v1 = 1.0f - 2.0f / (1.0f + __expf(2.0f * v1)); } else if (which == 2) { v0 = sigmoidf_(v0); v1 = sigmoidf_(v1); } }
                *(unsigned*)(al2 + (size_t)t * 768 + j) = pk2(v0, v1); }
        }
    }
    SEAM(3);
    PH(4) { const int lane = lane_fresh(); const int tid = (wave << 6) | lane; (void)tid; (void)lane;
#define L2CALL(W, DST, BIAS, CID) { int lda_ = 768; asm volatile("" : "+s"(lda_)); pg8::Gemm g{(const bf16*)(ws + WS_AL2), (const bf16*)(ws + WS_WL2), S, 3 * RW, 256, lda_, 256}; \
            Lora2Order<W> So{nullptr, G, CID}; EpiLora2<W> E{DST, BIAS}; pg8::gemm_phase<EpiLora2<W>, Lora2Order<W>, true, true, 0, true>(lds, g, So, E); }
        L2CALL(0, (void*)(ws + WS_LW), args.in[15], wg)
        L2CALL(1, (void*)(ws + WS_A), args.in[18], wg)
        L2CALL(2, (void*)(ws + WS_G), nullptr, wg)
#undef L2CALL
        for (int u = wg; u < AH * 64; u += G) moba_select_unit(lds, AB, u >> 6, u & 63, tid, lane, wave);
    }
    SEAM(4);
    RwkvBufs RB{(const bf16*)(ws + WS_RKV), (const float*)(ws + WS_LW), (const bf16*)(ws + WS_A), (bf16*)(ws + WS_RWP), (float*)(ws + WS_RWQ), (bf16*)(ws + WS_RWR), (bf16*)(ws + WS_RWY), (float*)(ws + WS_RWB)};
    bf16* H0T = (bf16*)(ws + WS_RWH);
    PH(5) { const int lane = lane_fresh(); const int tid = (wave << 6) | lane; (void)tid; (void)lane; R1In I; if (wg < RH * NCH) rwkv_r1_load(I, RB, wg / NCH, wg % NCH, lane, wave);
        for (int u = wg; u < RH * NCH; u += G) { const int un = u + G; rwkv_r1_unit(lds, RB, args.in, I, u / NCH, u % NCH, un < RH * NCH ? un / NCH : -1, un % NCH, tid, lane, wave); } }
    SEAM(5);
    PH(7) { const int lane = lane_fresh(); const int tid = (wave << 6) | lane; (void)tid; (void)lane;
        if (wg < RH * 4) { for (int rsc = 0; rsc < 1 + REP_SCAN; ++rsc) { rwkv_r2_wg(lds, RB.P, RB.QmT, H0T, wg >> 2, wg & 3, wave, lane); __syncthreads(); } }
        LAS int* pre = (LAS int*)(lds + AT_ITEMS); LAS int* tick = pre + 260;
        if (tid < 256) pre[1 + tid] = (AB.cnt[tid * ACNT_STR] + 255) >> 8;
        __syncthreads();
        if (wave == 0) {
            int v0 = pre[1 + 4 * lane], v1 = pre[2 + 4 * lane], v2 = pre[3 + 4 * lane], v3 = pre[4 + 4 * lane]; v1 += v0; v2 += v1; v3 += v2; int tot = v3;
#pragma unroll
            for (int o = 1; o < 64; o <<= 1) { const int t = __shfl_up(tot, o); if (lane >= o) tot += t; }
            const int ex = tot - v3; pre[1 + 4 * lane] = ex + v0; pre[2 + 4 * lane] = ex + v1; pre[3 + 4 * lane] = ex + v2; pre[4 + 4 * lane] = ex + v3;
            if (lane == 0) pre[0] = 0; }
        __syncthreads();
        moba_items(lds, AB, (int*)ctl + CW_AQ + rep_, pre, tick, tid, lane, wave);
    }
    SEAM(7);
    PH(8) { const int lane = lane_fresh(); const int tid = (wave << 6) | lane; (void)tid; (void)lane; for (int u = wg * 2 + (wave >> 2); u < RH * NCH; u += 2 * G) rwkv_r3_wave(RB, H0T, args.in, (const bf16*)(ws + WS_G), (bf16*)(ws + WS_OCAT), u / NCH, u % NCH, wave & 3, lane);
#pragma unroll 2
        for (int i = wg * NTHR + tid; i < AH * S * 16; i += G * NTHR) { const int c8 = i & 15, hq = i >> 4, hh = hq / S, qq = hq % S;
            const unsigned mk = AB.mask[hq]; const f32x4 ml0 = *(const f32x4*)(AB.ml + (size_t)hq * 8), ml1 = *(const f32x4*)(AB.ml + (size_t)hq * 8 + 4);
            u32x4 pr[4];
#pragma unroll
            for (int s = 0; s < 4; ++s) pr[s] = *(const u32x4*)(AB.part + ((size_t)hq * 4 + s) * AD + 8 * c8);
            const int ns = 1 + __builtin_popcount(mk);
            const float m_[4] = {ml0[0], ml0[2], ml1[0], ml1[2]}, l_[4] = {ml0[1], ml0[3], ml1[1], ml1[3]};
            float mx = m_[0];
#pragma unroll
            for (int s = 1; s < 4; ++s) mx = (s < ns) ? fmaxf(mx, m_[s]) : mx;
            float wv[4]; float wsum = 0.f;
#pragma unroll
            for (int s = 0; s < 4; ++s) { wv[s] = s < ns ? l_[s] * __builtin_amdgcn_exp2f(m_[s] - mx) : 0.f; wsum += wv[s]; }
            const float inv = 1.0f / wsum; float o[8] = {0.f, 0.f, 0.f, 0.f, 0.f, 0.f, 0.f, 0.f};
#pragma unroll
            for (int s = 0; s < 4; ++s) { float pv[8]; unpack8(pr[s], pv); const float ws_ = wv[s] * inv;
#pragma unroll
                for (int j = 0; j < 8; ++j) o[j] += (s < ns) ? ws_ * pv[j] : 0.f; }
            u32x4 w; w.x = pk2(o[0], o[1]); w.y = pk2(o[2], o[3]); w.z = pk2(o[4], o[5]); w.w = pk2(o[6], o[7]);
            *(u32x4*)((bf16*)(ws + WS_OCAT) + (size_t)qq * (2 * AW) + hh * AD + 8 * c8) = w; }
    }
    SEAM(8);

    bf16* ocat = (bf16*)(ws + WS_OCAT); bf16* gate = (bf16*)(ws + WS_GATE); bf16* mix = (bf16*)(ws + WS_MIX); bf16* y = (bf16*)(ws + WS_Y); bf16* x1 = (bf16*)(ws + WS_X1);     unsigned char* h2 = ws + WS_H2;
    float* ew = (float*)(ws + WS_ROUTE + 65536); int* slot = (int*)(ws + WS_ROUTE + 131072);
    int* elist = (int*)(ws + WS_ELIST);
    unsigned char* xbuf = ws + WS_XBUF; unsigned char* hid = ws + WS_HID; bf16* ybuf = (bf16*)(ws + WS_YBUF);
    PH(9) { const int lane = lane_fresh(); const int tid = (wave << 6) | lane; (void)tid; (void)lane;
        pg8::Gemm g{ocat, Wupt, S, D, AW, D, D}; MixOrder So{nullptr, G, wg};
        EpiMix E{gate, mix};
        pg8::gemm_phase<EpiMix, MixOrder, true, true>(lds, g, So, E);
    }
    SEAM(9);
    PH(10) { const int lane = lane_fresh(); const int tid = (wave << 6) | lane; (void)tid; (void)lane;
        pg8::Gemm g{mix, Wot, S, D, D, D, D}; pg8::StaticOrder So; So.init(S, D, G, wg);
        EpiBf16P E{y, D};
        pg8::gemm_phase<EpiBf16P, pg8::StaticOrder, true, true>(lds, g, So, E);
    }
    SEAM(10);
    PH(11) { const int lane = lane_fresh(); const int tid = (wave << 6) | lane; (void)tid; (void)lane;
        const float* gpost = args.in[5]; const float* gpre2 = args.in[6]; const float* gt1 = ada + 2 * D; const float* sh2 = ada + 3 * D; const float* sc2 = ada + 4 * D;
        const bf16* wrh = (const bf16*)(ws + WS_WR); const bf16* wrl = wrh + 80 * D; const float* b_rg = args.in[32]; const float* b_re = args.in[34];
        LAS bf16* Ah = (LAS bf16*)lds; LAS bf16* Al = Ah + 16 * RS8; LAS float* Pp = (LAS float*)lds;
        LAS float* Lg = (LAS float*)(lds + 8 * 16 * 80 * 4);
        for (int unit = wg; unit < S / 16; unit += G) {
            {
                const int rl0 = wave * 2, row0 = unit * 16 + rl0;
                f32x4 v[2][8], xv[2][8]; float s[2] = {0.f, 0.f};
#pragma unroll
                for (int rr = 0; rr < 2; ++rr) { const u32x2* yr = (const u32x2*)(y + (size_t)(row0 + rr) * D) + lane; const f32x4* xr = (const f32x4*)(x + (size_t)(row0 + rr) * D) + lane;
#pragma unroll
                    for (int j = 0; j < 8; ++j) { const u32x2 yb = yr[64 * j]; v[rr][j] = (f32x4){__uint_as_float(yb.x << 16), __uint_as_float(yb.x & 0xffff0000u), __uint_as_float(yb.y << 16), __uint_as_float(yb.y & 0xffff0000u)}; xv[rr][j] = xr[64 * j]; } }
#pragma unroll
                for (int rr = 0; rr < 2; ++rr)
#pragma unroll
                    for (int j = 0; j < 8; ++j) s[rr] += (v[rr][j].x * v[rr][j].x + v[rr][j].y * v[rr][j].y) + (v[rr][j].z * v[rr][j].z + v[rr][j].w * v[rr][j].w);
                float r1[2]; r1[0] = rsqrtf(wave_sum(s[0]) * (1.0f / D) + 1e-6f); r1[1] = rsqrtf(wave_sum(s[1]) * (1.0f / D) + 1e-6f); s[0] = 0.f; s[1] = 0.f;
#pragma unroll
                for (int rr = 0; rr < 2; ++rr)
#pragma unroll
                    for (int j = 0; j < 8; ++j) { const int c = 4 * lane + 256 * j; const f32x4 t = xv[rr][j] + *(const f32x4*)(gt1 + c) * *(const f32x4*)(gpost + c) * (v[rr][j] * r1[rr]); v[rr][j] = t;
                        { u32x2 xb; xb.x = pk2(t.x, t.y); xb.y = pk2(t.z, t.w); ((u32x2*)(x1 + (size_t)(row0 + rr) * D))[lane + 64 * j] = xb; } s[rr] += (t.x * t.x + t.y * t.y) + (t.z * t.z + t.w * t.w); }
                float r2[2]; r2[0] = rsqrtf(wave_sum(s[0]) * (1.0f / D) + 1e-6f); r2[1] = rsqrtf(wave_sum(s[1]) * (1.0f / D) + 1e-6f);
#pragma unroll
                for (int rr = 0; rr < 2; ++rr)
#pragma unroll
                    for (int j = 0; j < 8; ++j) { const int c = 4 * lane + 256 * j; const f32x4 t = v[rr][j] * r2[rr] * (*(const f32x4*)(gpre2 + c) * (*(const f32x4*)(sc2 + c) + 1.0f)) + *(const f32x4*)(sh2 + c);
                        u32x2 wh; wh.x = pk2(t.x, t.y); wh.y = pk2(t.z, t.w);
                        u32x2 wl; wl.x = pk2(t.x - __uint_as_float(wh.x << 16), t.y - __uint_as_float(wh.x & 0xffff0000u)); wl.y = pk2(t.z - __uint_as_float(wh.y << 16), t.w - __uint_as_float(wh.y & 0xffff0000u));
                        ((unsigned*)(h2 + (size_t)(row0 + rr) * D))[lane + 64 * j] = pk_fp8x4(t.x, t.y, t.z, t.w, 8.0f);
                        *(LAS u32x2*)(Ah + (rl0 + rr) * RS8 + c) = wh; *(LAS u32x2*)(Al + (rl0 + rr) * RS8 + c) = wl; }
            }
            R1_BAR();
            f32x4 acc[5];
#pragma unroll
            for (int nt = 0; nt < 5; ++nt) acc[nt] = (f32x4){0.f, 0.f, 0.f, 0.f};
            for (int rmf = 0; rmf < 1 + REP_P11B; ++rmf) {
#pragma unroll
            for (int nt = 0; nt < 5; ++nt) acc[nt] = (f32x4){0.f, 0.f, 0.f, 0.f};
#pragma unroll 2
            for (int ks = 0; ks < 8; ++ks) {
                const int k0 = 256 * wave + 32 * ks + 8 * (lane >> 4);
                const bf16x8 ah = *(const LAS bf16x8*)(Ah + (lane & 15) * RS8 + k0), al = *(const LAS bf16x8*)(Al + (lane & 15) * RS8 + k0);
#pragma unroll
                for (int nt = 0; nt < 5; ++nt) { const bf16x8 bh = *(const bf16x8*)(wrh + (size_t)(16 * nt + (lane & 15)) * D + k0), bl = *(const bf16x8*)(wrl + (size_t)(16 * nt + (lane & 15)) * D + k0);
                    acc[nt] = __builtin_amdgcn_mfma_f32_16x16x32_bf16(ah, bh, acc[nt], 0, 0, 0);
                    acc[nt] = __builtin_amdgcn_mfma_f32_16x16x32_bf16(al, bh, acc[nt], 0, 0, 0);
                    acc[nt] = __builtin_amdgcn_mfma_f32_16x16x32_bf16(ah, bl, acc[nt], 0, 0, 0); }
            }
            }
            R1_BAR();
#pragma unroll
            for (int nt = 0; nt < 5; ++nt)
#pragma unroll
                for (int rg = 0; rg < 4; ++rg) Pp[(wave * 16 + 4 * (lane >> 4) + rg) * 80 + 16 * nt + (lane & 15)] = acc[nt][rg];
            R1_BAR();
            for (int i = tid; i < 16 * 72; i += NTHR) { const int r = i / 72, c = i % 72; float t = c < NG ? b_rg[c] : b_re[c - NG];
#pragma unroll
                for (int w = 0; w < 8; ++w) t += Pp[(w * 16 + r) * 80 + c];
                Lg[r * 72 + c] = t; }
            R1_BAR();
            if (tid < 16) {
                const LAS float* lg = Lg + tid * 72; const int row = unit * 16 + tid;
                float mx = lg[0]; int gi = 0; for (int j = 1; j < 8; ++j) if (lg[j] > mx) { mx = lg[j]; gi = j; }
                float sg = 0.f; for (int j = 0; j < 8; ++j) sg += __expf(lg[j] - mx);
                const float pg = 1.0f / sg;
                const LAS float* le = lg + 8 + gi * EPG;
                float m1 = le[0]; int i1 = 0; for (int j = 1; j < 8; ++j) if (le[j] > m1) { m1 = le[j]; i1 = j; }
                float m2 = -3e38f; int i2 = 0; for (int j = 0; j < 8; ++j) if (j != i1 && le[j] > m2) { m2 = le[j]; i2 = j; }
                const float e2 = __expf(m2 - m1); const float p1 = 1.0f / (1.0f + e2), p2 = e2 / (1.0f + e2);
                const int e1g = gi * EPG + i1, e2g = gi * EPG + i2;
                ew[row * 2] = pg * p1; ew[row * 2 + 1] = pg * p2;
                if (rep_ == 0) {
                    const int q1 = atomicAdd((int*)ctl + CW_CNT + e1g * CNT_STR, 1), q2 = atomicAdd((int*)ctl + CW_CNT + e2g * CNT_STR, 1);
                    elist[e1g * S + q1] = row; elist[e2g * S + q2] = row; slot[row * 2] = (e1g << 16) | q1; slot[row * 2 + 1] = (e2g << 16) | q2; }
            }
            R1_BAR();
        }
    }
    SEAM(11);
    PH(13) { const int lane = lane_fresh(); const int tid = (wave << 6) | lane; (void)tid; (void)lane;
        ROUTE_TABLE();
        pg8::Gemm g{(const bf16*)h2, (const bf16*)Wgut, MAXROWS, NE * 1024, D / 2, D / 2, D / 2}; ExpertOrderT<true> So{elist, (LAS const int*)(lds + RT_OFF), 4, G, wg};
        EpiHid E{hid};
        pg8::gemm_phase<EpiHid, ExpertOrderT<true>, true, true, (124 << 8) | 119, true>(lds, g, So, E);
    }
    SEAM(13);
    PH(14) { const int lane = lane_fresh(); const int tid = (wave << 6) | lane; (void)tid; (void)lane;
        if (args.ph_lo == 14) ROUTE_TABLE();
        pg8::Gemm g{(const bf16*)hid, (const bf16*)Wdt, MAXROWS, NE * D, FF / 2, FF / 2, FF / 2}; ExpertOrderT<false> So{nullptr, (LAS const int*)(lds + RT_OFF), 8, G, wg};
        EpiYbuf E{ybuf};
        pg8::gemm_phase<EpiYbuf, ExpertOrderT<false>, true, true, (124 << 8) | 120, true>(lds, g, So, E);
    }
    SEAM(14);
    PH(15) { const int lane = lane_fresh(); const int tid = (wave << 6) | lane; (void)tid; (void)lane;
        const float* gpost2 = args.in[7]; const float* gt2 = ada + 5 * D; float* out = args.out;
        if (args.ph_lo == 15) ROUTE_TABLE();
        LAS const int* tb = (LAS const int*)(lds + RT_OFF);
        for (int rb = gw; rb < S; rb += 2 * NGW) {
            int s0[2], s1[2]; float w0[2], w1[2]; const int rows[2] = {rb, rb + NGW};
#pragma unroll
            for (int q = 0; q < 2; ++q) { const int row = rows[q] < S ? rows[q] : rb; const int v0 = slot[row * 2], v1 = slot[row * 2 + 1]; s0[q] = tb[64 + (v0 >> 16)] + (v0 & 0xffff); s1[q] = tb[64 + (v1 >> 16)] + (v1 & 0xffff); w0[q] = ew[row * 2]; w1[q] = ew[row * 2 + 1]; }
            u32x2 xb[2][8];
#pragma unroll
            for (int q = 0; q < 2; ++q) { const int row = rows[q] < S ? rows[q] : rb;
#pragma unroll
                for (int j = 0; j < 8; ++j) xb[q][j] = ((const u32x2*)(x1 + (size_t)row * D))[lane + 64 * j]; }
            f32x4 v[2][8]; float s[2] = {0.f, 0.f};
#pragma unroll
            for (int q = 0; q < 2; ++q) { const u32x2* y0 = (const u32x2*)(ybuf + (size_t)s0[q] * D) + lane; const u32x2* y1 = (const u32x2*)(ybuf + (size_t)s1[q] * D) + lane;
#pragma unroll
                for (int j = 0; j < 8; ++j) { const u32x2 a = y0[64 * j], b = y1[64 * j];
                    v[q][j].x = w0[q] * __uint_as_float(a.x << 16) + w1[q] * __uint_as_float(b.x << 16); v[q][j].y = w0[q] * __uint_as_float(a.x & 0xffff0000u) + w1[q] * __uint_as_float(b.x & 0xffff0000u);
                    v[q][j].z = w0[q] * __uint_as_float(a.y << 16) + w1[q] * __uint_as_float(b.y << 16); v[q][j].w = w0[q] * __uint_as_float(a.y & 0xffff0000u) + w1[q] * __uint_as_float(b.y & 0xffff0000u);
                    s[q] += (v[q][j].x * v[q][j].x + v[q][j].y * v[q][j].y) + (v[q][j].z * v[q][j].z + v[q][j].w * v[q][j].w); } }
            float r[2]; r[0] = rsqrtf(wave_sum(s[0]) * (1.0f / D) + 1e-6f); r[1] = rsqrtf(wave_sum(s[1]) * (1.0f / D) + 1e-6f);
#pragma unroll
            for (int q = 0; q < 2; ++q) if (rows[q] < S) {
#pragma unroll
                for (int j = 0; j < 8; ++j) { const int c = 4 * lane + 256 * j; const u32x2 xx = xb[q][j];
                    const f32x4 xf = (f32x4){__uint_as_float(xx.x << 16), __uint_as_float(xx.x & 0xffff0000u), __uint_as_float(xx.y << 16), __uint_as_float(xx.y & 0xffff0000u)};
                    ((f32x4*)(out + (size_t)rows[q] * D))[lane + 64 * j] = xf + *(const f32x4*)(gt2 + c) * (v[q][j] * r[q] * *(const f32x4*)(gpost2 + c)); } }
        }
    }
#undef IN
#undef SEAM
}
extern "C" void kernel_launch(void* const* d_in, const int* in_sizes, int n_in, void* d_out, int out_size, void* d_ws, size_t ws_size, hipStream_t stream) {
    static int grid = 0;
    if (grid == 0) {
        if (ws_size < WS_END || n_in != 38) { fprintf(stderr, "kernel_launch: unexpected workspace/inputs: %zu < %zu or n_in %d\n", ws_size, (size_t)WS_END, n_in); grid = -1; return; }
        int dev = 0, cus = 0;
        if (hipGetDevice(&dev) != hipSuccess || hipDeviceGetAttribute(&cus, hipDeviceAttributeMultiprocessorCount, dev) != hipSuccess) { fprintf(stderr, "device query failed\n"); grid = -1; return; }
        if (hipFuncSetAttribute((const void*)fwd, hipFuncAttributeMaxDynamicSharedMemorySize, LDS_BYTES) != hipSuccess) { fprintf(stderr, "hipFuncSetAttribute failed\n"); grid = -1; return; }
        grid = cus;
    }
    if (grid < 0) return;
    (void)hipMemsetAsync((char*)d_ws + WS_CTL, 0, 1 * MiB, stream);
    Args a{};
    for (int i = 0; i < 38; ++i) a.in[i] = (const float*)d_in[i];
    a.out = (float*)d_out; a.ws = (unsigned char*)d_ws;
#if N_LAUNCH_PER_PHASE
    for (int ph = 0; ph < 16; ++ph) { a.ph_lo = ph; a.ph_hi = ph + 1; hipLaunchKernelGGL(fwd, dim3(grid), dim3(NTHR), LDS_BYTES, stream, a); }
#else
    a.ph_lo = 0; a.ph_hi = 16; hipLaunchKernelGGL(fwd, dim3(grid), dim3(NTHR), LDS_BYTES, stream, a);
#endif
}
```
